# Optimizing an MI355X kernel written in HIP

```python
import jax, jax.numpy as jnp
from jax import lax
import numpy as np

D_MODEL = 2048
BATCH = 4
SEQ = 4096
DEPTH = 1

MLSTM_HEADS = 4
MLSTM_DK = 256
MLSTM_DV = 256
MLSTM_CONV = 4
MLSTM_CHUNK = 64
RWKV_HEADS = 16
RWKV_HEAD = 64
RWKV_WIDTH = RWKV_HEADS * RWKV_HEAD
W_LORA = 96
A_LORA = 96
G_LORA = 256
PEER_HEADS = 8
N_KEYS = 128
N_EXPERTS = N_KEYS * N_KEYS
PEER_TOPK = 16
D_KEY = 256
EXPERT_BLOCK = 128
RMS_EPS = 1e-6
GN_EPS = 64e-5
L2_EPS = 1e-12

MLSTM_QK = MLSTM_HEADS * MLSTM_DK
MLSTM_V = MLSTM_HEADS * MLSTM_DV
MLSTM_COLS = 2 * MLSTM_QK + 2 * MLSTM_V + 2 * MLSTM_HEADS
RWKV_COLS = 3 * RWKV_WIDTH + W_LORA + A_LORA + G_LORA
GATE_COLS = 2 * D_MODEL
D_IN = MLSTM_COLS + RWKV_COLS + GATE_COLS

kernel_name = "hybrid_mlstm_rwkv7_peer_block"


def rms_norm(x, gain):
    xf = x.astype(jnp.float32)
    y = xf * lax.rsqrt(jnp.mean(xf * xf, axis=-1, keepdims=True) + RMS_EPS)
    return (y * gain.astype(jnp.float32)).astype(x.dtype)


def split_columns(p, sizes):
    offsets = np.cumsum(np.array(sizes))[:-1].tolist()
    return jnp.split(p, offsets, axis=-1)


def token_shift(p):
    return jnp.pad(p, ((0, 0), (1, 0), (0, 0)))[:, :-1]


def causal_depthwise_conv(p, w):
    K, C = w.shape
    return lax.conv_general_dilated(
        p, w[:, None, :].astype(p.dtype), window_strides=(1,), padding=[(K - 1, 0)],
        dimension_numbers=('NWC', 'WIO', 'NWC'), feature_group_count=C)


def mlstm_chunkwise(q, k, v, ig, lf):
    B, H, T, DK = q.shape
    DV = v.shape[-1]
    L = MLSTM_CHUNK
    NC = T // L
    q = q * DK ** -0.5
    causal = jnp.tril(jnp.ones((L, L), dtype=bool))

    def chunks(t):
        return jnp.moveaxis(t.reshape(B, H, NC, L, *t.shape[3:]), 2, 0)

    def step(carry, xs):
        C, n, m = carry
        qc, kc, vc, igc, lfc = xs
        b = jnp.cumsum(lfc, axis=-1)
        dmat = b[..., :, None] - b[..., None, :] + igc[..., None, :]
        dmat = jnp.where(causal, dmat, -jnp.inf)
        inter = b + m[..., None]
        m_t = jnp.maximum(inter, jnp.max(dmat, axis=-1))
        s = jnp.einsum('bhtd,bhsd->bhts', qc, kc) * jnp.exp(dmat - m_t[..., None])
        w_inter = jnp.exp(inter - m_t)
        num = (jnp.einsum('bhts,bhsv->bhtv', s, vc)
               + w_inter[..., None] * jnp.einsum('bhtd,bhdv->bhtv', qc, C))
        den = jnp.sum(s, axis=-1) + w_inter * jnp.einsum('bhtd,bhd->bht', qc, n)
        h = num / jnp.maximum(jnp.abs(den), jnp.exp(-m_t))[..., None]
        g_end = b[..., -1:] - b + igc
        m_new = jnp.maximum(b[..., -1] + m, jnp.max(g_end, axis=-1))
        decay = jnp.exp(b[..., -1] + m - m_new)
        ws = jnp.exp(g_end - m_new[..., None])
        C_new = decay[..., None, None] * C + jnp.einsum('bhsd,bhsv->bhdv', kc * ws[..., None], vc)
        n_new = decay[..., None] * n + jnp.einsum('bhsd,bhs->bhd', kc, ws)
        return (C_new, n_new, m_new), h

    init = (jnp.zeros((B, H, DK, DV), jnp.float32),
            jnp.zeros((B, H, DK), jnp.float32),
            jnp.zeros((B, H), jnp.float32))
    _, h = lax.scan(step, init, tuple(chunks(t) for t in (q, k, v, ig, lf)))
    return jnp.moveaxis(h, 0, 2).reshape(B, H, T, DV)


def mlstm_branch(p, conv_w, b_i, b_f):
    B, T, _ = p.shape
    qk, v, o, i_pre, f_pre = split_columns(p, (2 * MLSTM_QK, MLSTM_V, MLSTM_V, MLSTM_HEADS, MLSTM_HEADS))
    qk = jax.nn.silu(causal_depthwise_conv(qk, conv_w))
    q, k = jnp.split(qk, 2, axis=-1)

    def heads(t):
        return t.reshape(B, T, MLSTM_HEADS, -1).transpose(0, 2, 1, 3).astype(jnp.float32)

    ig = (i_pre + b_i).astype(jnp.float32).transpose(0, 2, 1)
    lf = jax.nn.log_sigmoid((f_pre + b_f).astype(jnp.float32)).transpose(0, 2, 1)
    h = mlstm_chunkwise(heads(q), heads(k), heads(v), ig, lf)
    h = h.transpose(0, 2, 1, 3).reshape(B, T, MLSTM_V).astype(p.dtype)
    return jax.nn.sigmoid(o) * h


def wkv7_scan(r, decay, k, v, aa, bb):
    B, T, H, N = r.shape
    xs = tuple(jnp.moveaxis(t, 1, 0) for t in (r, decay, k, v, aa, bb))

    def step(S, inp):
        r_t, w_t, k_t, v_t, a_t, b_t = inp
        sa = jnp.einsum('bhvk,bhk->bhv', S, a_t)
        S = (S * w_t[:, :, None, :] + sa[..., None] * b_t[:, :, None, :]
             + v_t[..., None] * k_t[:, :, None, :])
        return S, jnp.einsum('bhvk,bhk->bhv', S, r_t)

    _, y = lax.scan(step, jnp.zeros((B, H, N, N), jnp.float32), xs)
    return jnp.moveaxis(y, 0, 1)


def rwkv7_branch(p, mu, w0, w2, a0, a2, g2, k_k, k_a, r_k, ln_w, ln_b):
    B, T, _ = p.shape
    p = p + (token_shift(p) - p) * mu
    r, k, v, wl, al, gl = split_columns(p, (RWKV_WIDTH, RWKV_WIDTH, RWKV_WIDTH, W_LORA, A_LORA, G_LORA))
    w = -jax.nn.softplus(-(w0 + jnp.tanh(wl) @ w2).astype(jnp.float32)) - 0.5
    decay = jnp.exp(-jnp.exp(w))
    a = jax.nn.sigmoid((a0 + al @ a2).astype(jnp.float32))
    g = jax.nn.sigmoid(gl) @ g2

    def heads(t):
        return t.astype(jnp.float32).reshape(B, T, RWKV_HEADS, RWKV_HEAD)

    kk = heads(k * k_k)
    kk = kk / jnp.maximum(jnp.sqrt(jnp.sum(kk * kk, axis=-1, keepdims=True)), L2_EPS)
    k = k.astype(jnp.float32) * (1.0 + (a - 1.0) * k_a)
    rh, kh, vh = heads(r), heads(k), heads(v)
    y = wkv7_scan(rh, heads(decay), kh, vh, -kk, kk * heads(a))
    mean = jnp.mean(y, axis=-1, keepdims=True)
    var = jnp.mean(jnp.square(y - mean), axis=-1, keepdims=True)
    y = ((y - mean) * lax.rsqrt(var + GN_EPS)).reshape(B, T, RWKV_WIDTH)
    y = y * ln_w.astype(jnp.float32) + ln_b.astype(jnp.float32)
    bonus = jnp.sum(rh * kh * r_k.astype(jnp.float32), axis=-1, keepdims=True) * vh
    y = y + bonus.reshape(B, T, RWKV_WIDTH)
    return y.astype(p.dtype) * g


def peer_ffn(xn, w_query, sub_keys, expert_u, expert_v):
    B, T, D = xn.shape
    NT = B * T
    xt = xn.reshape(NT, D)
    q = (xt @ w_query).reshape(NT, PEER_HEADS, 2, D_KEY // 2).astype(jnp.float32)
    s = jnp.einsum('nhpd,pkd->nhpk', q, sub_keys.astype(jnp.float32))
    v1, i1 = lax.top_k(s[:, :, 0], PEER_TOPK)
    v2, i2 = lax.top_k(s[:, :, 1], PEER_TOPK)
    cand = (v1[..., :, None] + v2[..., None, :]).reshape(NT, PEER_HEADS, PEER_TOPK * PEER_TOPK)
    best, ci = lax.top_k(cand, PEER_TOPK)
    e1 = jnp.take_along_axis(i1, ci // PEER_TOPK, axis=-1)
    e2 = jnp.take_along_axis(i2, ci % PEER_TOPK, axis=-1)
    idx = e1 * N_KEYS + e2
    gate = jax.nn.softmax(best, axis=-1)
    NB = NT // EXPERT_BLOCK
    HK = PEER_HEADS * PEER_TOPK
    xb = xt.reshape(NB, EXPERT_BLOCK, D)
    ib = idx.reshape(NB, EXPERT_BLOCK, HK)
    gb = gate.reshape(NB, EXPERT_BLOCK, HK)

    def block(args):
        xc, ic, gc = args
        act = jax.nn.gelu(jnp.einsum('cd,ced->ce', xc, expert_u[ic]), approximate=False)
        return jnp.einsum('ce,ced->cd', (gc * act).astype(xc.dtype), expert_v[ic])

    return lax.map(block, (xb, ib, gb)).reshape(B, T, D)


def setup_inputs(seed: int = 0) -> dict:
    key = jax.random.key(seed)
    ks = jax.random.split(key, 32)
    L = DEPTH

    def nrm(k, shape, scale):
        return jax.random.normal(k, shape, jnp.float32) * scale

    return {
        "x": nrm(ks[0], (BATCH, SEQ, D_MODEL), 1.0),
        "norm_mix_gain": 1.0 + nrm(ks[1], (L, D_MODEL), 0.05),
        "w_in": nrm(ks[2], (L, D_MODEL, D_IN), D_MODEL ** -0.5),
        "mlstm_conv": nrm(ks[3], (L, MLSTM_CONV, 2 * MLSTM_QK), MLSTM_CONV ** -0.5),
        "mlstm_b_i": nrm(ks[4], (L, MLSTM_HEADS), 0.1),
        "mlstm_b_f": jnp.linspace(3.0, 6.0, MLSTM_HEADS, dtype=jnp.float32)[None] + nrm(ks[5], (L, MLSTM_HEADS), 0.1),
        "rwkv_mu": jax.random.uniform(ks[6], (L, RWKV_COLS), jnp.float32),
        "rwkv_w0": nrm(ks[7], (L, RWKV_WIDTH), 0.5),
        "rwkv_w2": nrm(ks[8], (L, W_LORA, RWKV_WIDTH), W_LORA ** -0.5),
        "rwkv_a0": nrm(ks[9], (L, RWKV_WIDTH), 0.1),
        "rwkv_a2": nrm(ks[10], (L, A_LORA, RWKV_WIDTH), A_LORA ** -0.5),
        "rwkv_g2": nrm(ks[11], (L, G_LORA, RWKV_WIDTH), G_LORA ** -0.5),
        "rwkv_k_k": 0.85 + nrm(ks[12], (L, RWKV_WIDTH), 0.1),
        "rwkv_k_a": 1.0 + nrm(ks[13], (L, RWKV_WIDTH), 0.1),
        "rwkv_r_k": nrm(ks[14], (L, RWKV_HEADS, RWKV_HEAD), 0.1),
        "rwkv_ln_w": 1.0 + nrm(ks[15], (L, RWKV_WIDTH), 0.05),
        "rwkv_ln_b": nrm(ks[16], (L, RWKV_WIDTH), 0.01),
        "proj_mlstm": nrm(ks[17], (L, MLSTM_V, D_MODEL), MLSTM_V ** -0.5),
        "proj_rwkv": nrm(ks[18], (L, RWKV_WIDTH, D_MODEL), RWKV_WIDTH ** -0.5),
        "w_out": nrm(ks[19], (L, D_MODEL, D_MODEL), D_MODEL ** -0.5),
        "norm_ffn_gain": 1.0 + nrm(ks[20], (L, D_MODEL), 0.05),
        "peer_w_query": nrm(ks[21], (L, D_MODEL, PEER_HEADS * D_KEY), D_MODEL ** -0.5),
        "peer_sub_keys": nrm(ks[22], (L, 2, N_KEYS, D_KEY // 2), (D_KEY // 2) ** -0.5),
        "peer_u": nrm(ks[23], (L, N_EXPERTS, D_MODEL), D_MODEL ** -0.5),
        "peer_v": nrm(ks[24], (L, N_EXPERTS, D_MODEL), 0.5 * PEER_HEADS ** -0.5),
        "norm_final_gain": 1.0 + nrm(ks[25], (D_MODEL,), 0.05),
    }


def reference(x, norm_mix_gain, w_in, mlstm_conv, mlstm_b_i, mlstm_b_f, rwkv_mu, rwkv_w0, rwkv_w2,
              rwkv_a0, rwkv_a2, rwkv_g2, rwkv_k_k, rwkv_k_a, rwkv_r_k, rwkv_ln_w, rwkv_ln_b,
              proj_mlstm, proj_rwkv, w_out, norm_ffn_gain, peer_w_query, peer_sub_keys,
              peer_u, peer_v, norm_final_gain):
    h = x
    for l in range(DEPTH):
        xn = rms_norm(h, norm_mix_gain[l])
        p = xn @ w_in[l]
        p_m, p_r, p_g = split_columns(p, (MLSTM_COLS, RWKV_COLS, GATE_COLS))
        y_m = mlstm_branch(p_m, mlstm_conv[l], mlstm_b_i[l], mlstm_b_f[l])
        y_r = rwkv7_branch(p_r, rwkv_mu[l], rwkv_w0[l], rwkv_w2[l], rwkv_a0[l], rwkv_a2[l],
                           rwkv_g2[l], rwkv_k_k[l], rwkv_k_a[l], rwkv_r_k[l], rwkv_ln_w[l], rwkv_ln_b[l])
        g_m, g_r = jnp.split(jax.nn.sigmoid(p_g), 2, axis=-1)
        mixed = g_m * (y_m @ proj_mlstm[l]) + g_r * (y_r @ proj_rwkv[l])
        h = h + mixed @ w_out[l]
        h = h + peer_ffn(rms_norm(h, norm_ffn_gain[l]), peer_w_query[l], peer_sub_keys[l],
                         peer_u[l], peer_v[l])
    return rms_norm(h, norm_final_gain)
```

```cpp
#include <hip/hip_runtime.h>
#include <hip/hip_cooperative_groups.h>
#include <cstdio>
namespace cg = cooperative_groups;

#define LAS __attribute__((address_space(3)))
typedef unsigned short bf16_t;
typedef short bf16x8 __attribute__((ext_vector_type(8)));
typedef float f32x4 __attribute__((ext_vector_type(4)));
typedef unsigned u32x4 __attribute__((ext_vector_type(4)));
typedef unsigned u32x2 __attribute__((ext_vector_type(2)));

constexpr int NT = 16384, SEQ = 4096, DM = 2048;
constexpr int LDPM = 4096, LDPR = 3584, LDPG = 4096, N1 = 11776;
constexpr size_t MiB = 1024ull * 1024ull;
constexpr size_t OFF_PM = 0, OFF_PR = 128 * MiB, OFF_PG = 240 * MiB, OFF_XN = 368 * MiB, OFF_WINT = 432 * MiB, OFF_WTS = 478 * MiB;
constexpr size_t OFF_PMT = OFF_WTS, OFF_PRT = OFF_WTS + 4 * MiB, OFF_WOT = OFF_WTS + 8 * MiB, OFF_WQT = OFF_WTS + 16 * MiB, OFF_WAT = OFF_WTS + 24 * MiB,
                 OFF_G2T = OFF_WTS + 25 * MiB, OFF_SUBK = OFF_WTS + 25 * MiB + 512 * 1024, WS_NEED = OFF_WTS + 26 * MiB;
constexpr size_t OFF_YM = OFF_XN, OFF_YR = OFF_XN + 32 * MiB, OFF_Q = OFF_XN, OFF_XN2 = OFF_PR, OFF_PU = OFF_PM, OFF_PV = OFF_PM + 64 * MiB;
constexpr size_t DO_WLOG = 0, DO_AG = 32 * MiB, DO_GG = 64 * MiB, DO_ALORA = 96 * MiB;
constexpr int LDS_BYTES = 150528;

struct KP {
    const float *x, *g_mix, *w_in, *conv_w, *b_i, *b_f, *mu, *w0, *w2, *a0, *a2, *g2, *k_k, *k_a, *r_k, *ln_w, *ln_b, *proj_m, *proj_r, *w_out, *g_ffn,
        *w_query, *sub_keys, *peer_u, *peer_v, *g_final;
    float* out; unsigned char* ws;
};

typedef __bf16 bf16x2_t __attribute__((ext_vector_type(2)));
typedef float f32x2_t __attribute__((ext_vector_type(2)));
__device__ __forceinline__ unsigned cvt_pk_bf16(float lo, float hi) { f32x2_t v = {lo, hi}; bf16x2_t b = __builtin_convertvector(v, bf16x2_t); return __builtin_bit_cast(unsigned, b); }
__device__ __forceinline__ bf16_t f2bf(float f) { return (bf16_t)(cvt_pk_bf16(f, 0.f) & 0xffffu); }
__device__ __forceinline__ float bf2f(bf16_t h) { return __uint_as_float((unsigned)h << 16); }
__device__ __forceinline__ float bflo(unsigned u) { return __uint_as_float(u << 16); }
__device__ __forceinline__ float bfhi(unsigned u) { return __uint_as_float(u & 0xffff0000u); }
__device__ __forceinline__ float sigm(float x) { return __builtin_amdgcn_rcpf(1.f + __expf(-x)); }
template <int CTRL> __device__ __forceinline__ float dppf(float v) { return __builtin_bit_cast(float, __builtin_amdgcn_update_dpp(0, __builtin_bit_cast(int, v), CTRL, 0xF, 0xF, true)); }
template <int CTRL> __device__ __forceinline__ unsigned dppu(unsigned v) { return (unsigned)__builtin_amdgcn_update_dpp(0, (int)v, CTRL, 0xF, 0xF, true); }
__device__ __forceinline__ float red4(float v) { v += dppf<0xB1>(v); v += dppf<0x4E>(v); return v; }
__device__ __forceinline__ float red8(float v) { v = red4(v); v += dppf<0x141>(v); return v; }
__device__ __forceinline__ float red16(float v) { v = red8(v); v += dppf<0x140>(v); return v; }
__device__ __forceinline__ float rlane(float v, int l) { return __builtin_bit_cast(float, __builtin_amdgcn_readlane(__builtin_bit_cast(int, v), l)); }
__device__ __forceinline__ float wave_sum(float v) { v = red16(v); return rlane(v, 0) + rlane(v, 16) + rlane(v, 32) + rlane(v, 48); }
__device__ __forceinline__ unsigned wave_max_u32(unsigned v) {
    v = max(v, dppu<0xB1>(v)); v = max(v, dppu<0x4E>(v)); v = max(v, dppu<0x141>(v)); v = max(v, dppu<0x140>(v));
    unsigned a = (unsigned)__builtin_amdgcn_readlane((int)v, 0), b = (unsigned)__builtin_amdgcn_readlane((int)v, 16), c = (unsigned)__builtin_amdgcn_readlane((int)v, 32), d = (unsigned)__builtin_amdgcn_readlane((int)v, 48);
    return max(max(a, b), max(c, d));
}
__device__ __forceinline__ unsigned ordf(float f) { unsigned u = __float_as_uint(f); return (u & 0x80000000u) ? ~u : (u | 0x80000000u); }
__device__ __forceinline__ float unordf(unsigned k) { return __uint_as_float((k & 0x80000000u) ? (k ^ 0x80000000u) : ~k); }

__device__ __forceinline__ int tid_l() { int t = threadIdx.x; asm volatile("" : "+v"(t)); return t; }
template <class T> __device__ __forceinline__ T* lp(T* q) { asm volatile("" : "+s"(q)); return q; }
namespace pg8 {
constexpr int BM = 256, BK = 64, HALF = 128, HTB = HALF * BK * 2, STAGE_BYTES = 8 * HTB, NXCD = 8, WGM = 8;
__device__ __forceinline__ int lds_byte(int r, int c) { const int st = (r >> 4) * 2 + (c >> 5), rr = r & 15, cc = c & 31, ob = rr * 64 + cc * 2; return st * 1024 + (ob ^ (((ob >> 9) & 1) << 5)); }
__device__ __forceinline__ void stage_rc(int b, int& R, int& C) { const int st = b / 1024, sb = b % 1024, swz = sb ^ (((sb >> 9) & 1) << 5); R = (st >> 1) * 16 + swz / 64; C = (st & 1) * 32 + (swz % 64) / 2; }
__device__ __forceinline__ int perm32(int rho) { const int n = rho >> 4, i = rho & 15; return 8 * (i >> 2) + 4 * n + (i & 3); }
struct Unit { int pm, pn; };
struct Gemm { const bf16_t* A; const bf16_t* Bt; int M, N, K, lda, ldb; };
struct StaticOrder {
    int nM, nN, nwg, G, c;
    __device__ void init(int M, int N, int G_, int c_) { nM = M / BM; nN = N / BM; nwg = nM * nN; G = G_; c = c_; }
    __device__ bool next(int i, Unit& u) const {
        const long L = (long)i * G + c; if (L >= nwg) return false;
        int wgid = (int)L; { const int q = nwg / NXCD, r = nwg % NXCD, xcd = wgid % NXCD, off = wgid / NXCD; wgid = (xcd < r ? xcd * (q + 1) : r * (q + 1) + (xcd - r) * q) + off; }
        const int nig = WGM * nN, gid = wgid / nig, fm = gid * WGM, gsz = (nM - fm) < WGM ? (nM - fm) : WGM;
        u.pm = fm + ((wgid % nig) % gsz); u.pn = (wgid % nig) / gsz; return true;
    }
};

__device__ __forceinline__ void store8(bf16_t* p, f32x4 v0, f32x4 v1) {
    u32x4 w; w.x = cvt_pk_bf16(v0[0], v0[1]); w.y = cvt_pk_bf16(v0[2], v0[3]); w.z = cvt_pk_bf16(v1[0], v1[1]); w.w = cvt_pk_bf16(v1[2], v1[3]); *(u32x4*)p = w;
}
__device__ __forceinline__ void load8(const bf16_t* p, f32x4& v0, f32x4& v1) {
    const u32x4 w = *(const u32x4*)p; v0 = (f32x4){bflo(w.x), bfhi(w.x), bflo(w.y), bfhi(w.y)}; v1 = (f32x4){bflo(w.z), bfhi(w.z), bflo(w.w), bfhi(w.w)};
}

template <int mode> struct Epi {
    static constexpr bool PERM = true;
    unsigned char* ws; unsigned char* dob; const float* x; const float* w0; const float* a0;
    __device__ __forceinline__ void operator()(const f32x4 (&acc)[2][2][4][2], const Unit& u, int wr, int wc, int fr, int fq) const {
        const int row0 = u.pm * BM + wr * 64 + fr, cb = u.pn * BM + wc * 32 + 8 * fq;
#pragma unroll
        for (int ai = 0; ai < 2; ++ai)
#pragma unroll
            for (int m = 0; m < 4; ++m) {
                const size_t row = (size_t)(row0 + ai * HALF + m * 16);
#pragma unroll
                for (int bj = 0; bj < 2; ++bj) {
                    const int col = cb + bj * HALF;
                    f32x4 v0 = acc[ai][bj][m][0], v1 = acc[ai][bj][m][1];
                    if (mode == 0) {
                        if (col < 4096) store8((bf16_t*)(ws + OFF_PM) + row * LDPM + col, v0, v1);
                        else if (col < 7680) store8((bf16_t*)(ws + OFF_PR) + row * LDPR + (col - 4096), v0, v1);
                        else {
#pragma unroll
                            for (int j = 0; j < 4; ++j) { v0[j] = sigm(v0[j]); v1[j] = sigm(v1[j]); }
                            store8((bf16_t*)(ws + OFF_PG) + row * LDPG + (col - 7680), v0, v1);
                        }
                    } else if (mode == 1) {
                        if (col < 1024) {
                            const f32x4 b0 = *(const f32x4*)(w0 + col), b1 = *(const f32x4*)(w0 + col + 4);
#pragma unroll
                            for (int j = 0; j < 4; ++j) {
                                float z = -(b0[j] + v0[j]); float sp = fmaxf(z, 0.f) + __logf(1.f + __expf(-fabsf(z))); v0[j] = -__expf(-sp - 0.5f);
                                z = -(b1[j] + v1[j]); sp = fmaxf(z, 0.f) + __logf(1.f + __expf(-fabsf(z))); v1[j] = -__expf(-sp - 0.5f);
                            }
                            store8((bf16_t*)(dob + DO_WLOG) + row * 1024 + col, v0, v1);
                        } else {
                            const int c2 = col - 1024;
                            const f32x4 b0 = *(const f32x4*)(a0 + c2), b1 = *(const f32x4*)(a0 + c2 + 4);
#pragma unroll
                            for (int j = 0; j < 4; ++j) { v0[j] = sigm(b0[j] + v0[j]); v1[j] = sigm(b1[j] + v1[j]); }
                            store8((bf16_t*)(dob + DO_AG) + row * 1024 + c2, v0, v1);
                        }
                    } else if (mode == 2) {
                        store8((bf16_t*)(dob + DO_GG) + row * 1024 + col, v0, v1);
                    } else if (mode == 3) {
                        bf16_t* pp = (bf16_t*)(ws + OFF_PG) + row * LDPG + col; f32x4 g0, g1; load8(pp, g0, g1);
                        store8(pp, g0 * v0, g1 * v1);
                    } else if (mode == 4) {
                        bf16_t* pp = (bf16_t*)(ws + OFF_PG) + row * LDPG + col; f32x4 m0, m1, g0, g1; load8(pp, m0, m1); load8(pp + 2048, g0, g1);
                        store8(pp, m0 + g0 * v0, m1 + g1 * v1);
                    } else if (mode == 5) {
                        const float* xp = x + row * DM + col; float* op = (float*)dob + row * DM + col;
                        const f32x4 x0 = *(const f32x4*)xp, x1 = *(const f32x4*)(xp + 4);
                        *(f32x4*)op = x0 + v0; *(f32x4*)(op + 4) = x1 + v1;
                    } else {
                        store8((bf16_t*)(ws + OFF_Q) + row * DM + col, v0, v1);
                    }
                    asm volatile("" ::: "memory");
                }
            }
    }
};

template <class EpiT> __device__ __forceinline__ void gemm_phase(LAS unsigned char* lds, const Gemm g, const StaticOrder& S, const EpiT& E) {
    const int tid = tid_l(), wid = __builtin_amdgcn_readfirstlane(tid >> 6), lane = tid & 63, wr = wid >> 2, wc = wid & 3, fr = lane & 15, fq = lane >> 4;
    const int K = g.K, nt = K / BK;
    unsigned voffA[2], voffB[2];
#pragma unroll
    for (int i = 0; i < 2; ++i) { int R, C; stage_rc(tid * 16 + i * 8192, R, C); const int Rb = (R & ~31) + perm32(R & 31);
        voffA[i] = (unsigned)(R * g.lda + C) * 2u; voffB[i] = (unsigned)(Rb * g.ldb + C) * 2u; }
    const size_t kstep = (size_t)(BK * 2);
    const size_t hstepA = (size_t)HALF * g.lda * 2, hstepB = (size_t)HALF * g.ldb * 2;
    const size_t tstepA = 2 * hstepA, tstepB = 2 * hstepB;
    const unsigned ldsw = (unsigned)wid * 1024u;
    const int aoff = lds_byte(wr * 64 + fr, fq * 8), boff = lds_byte(wc * 32 + fr, fq * 8);
#define PG8_SA(b, h) (((b) * 2 + (h)) * HTB)
#define PG8_SB(b, h) ((4 + (b) * 2 + (h)) * HTB)
#define PG8_STAGE(bufoff, gbase, voff) do { _Pragma("unroll") for (int _i = 0; _i < 2; ++_i) \
        __builtin_amdgcn_global_load_lds((const unsigned*)((const char*)(gbase) + (voff)[_i]), (LAS unsigned*)(lds + (bufoff) + ldsw + _i * 8192), 16, 0, 0); } while (0)
#define PG8_LDA(dst, b, h) do { _Pragma("unroll") for (int m = 0; m < 4; ++m) _Pragma("unroll") for (int k = 0; k < 2; ++k) dst[m][k] = *(const LAS bf16x8*)(lds + PG8_SA(b, h) + aoff + m * 2048 + k * 1024); } while (0)
#define PG8_LDB(dst, b, h) do { _Pragma("unroll") for (int n = 0; n < 2; ++n) _Pragma("unroll") for (int k = 0; k < 2; ++k) dst[n][k] = *(const LAS bf16x8*)(lds + PG8_SB(b, h) + boff + n * 2048 + k * 1024); } while (0)
#define PG8_MMA(ai, bj, At, Bt) do { __builtin_amdgcn_s_setprio(1); _Pragma("unroll") for (int m = 0; m < 4; ++m) _Pragma("unroll") for (int n = 0; n < 2; ++n) _Pragma("unroll") for (int k = 0; k < 2; ++k) \
        acc[ai][bj][m][n] = __builtin_amdgcn_mfma_f32_16x16x32_bf16(Bt[n][k], At[m][k], acc[ai][bj][m][n], 0, 0, 0); __builtin_amdgcn_s_setprio(0); } while (0)
#define PG8_WAIT_V(n) asm volatile("s_waitcnt vmcnt(" #n ")" ::: "memory")
#define PG8_WAIT_L(n) asm volatile("s_waitcnt lgkmcnt(" #n ")" ::: "memory")
#define PG8_BAR __builtin_amdgcn_s_barrier()
#define PG8_SCHED __builtin_amdgcn_sched_barrier(0)
    Unit cur, nxt; int ui = 0;
    if (!S.next(0, cur)) return;
    f32x4 acc[2][2][4][2];
#pragma unroll
    for (int a = 0; a < 2; ++a)
#pragma unroll
        for (int b = 0; b < 2; ++b)
#pragma unroll
            for (int m = 0; m < 4; ++m)
#pragma unroll
                for (int n = 0; n < 2; ++n) acc[a][b][m][n] = (f32x4){0.f, 0.f, 0.f, 0.f};
    bf16x8 At[4][2], B0[2][2], B1[2][2];
    const char* cA = (const char*)g.A + (size_t)cur.pm * tstepA; const char* cB = (const char*)g.Bt + (size_t)cur.pn * tstepB;
    PG8_STAGE(PG8_SB(0, 0), cB, voffB); PG8_STAGE(PG8_SA(0, 0), cA, voffA); PG8_STAGE(PG8_SB(0, 1), cB + hstepB, voffB); PG8_STAGE(PG8_SA(0, 1), cA + hstepA, voffA);
    if (wr == 1) PG8_BAR;
    PG8_WAIT_V(4); PG8_BAR;
    PG8_STAGE(PG8_SB(1, 0), cB + kstep, voffB); PG8_STAGE(PG8_SA(1, 0), cA + kstep, voffA); PG8_STAGE(PG8_SB(1, 1), cB + hstepB + kstep, voffB);
    PG8_WAIT_V(6); PG8_BAR;
    for (;;) {
        const bool has_next = S.next(ui + 1, nxt);
        const char* nA = has_next ? (const char*)g.A + (size_t)nxt.pm * tstepA : cA; const char* nB = has_next ? (const char*)g.Bt + (size_t)nxt.pn * tstepB : cB;
        for (int t = 0; t < nt; t += 2) {
            const bool last = (t == nt - 2);
            const char* a1 = cA + (size_t)(t + 1) * kstep;
            const char* a2 = last ? nA : cA + (size_t)(t + 2) * kstep; const char* b2 = last ? nB : cB + (size_t)(t + 2) * kstep;
            const char* a3 = a2 + kstep; const char* b3 = b2 + kstep;
            PG8_LDB(B0, 0, 0); PG8_SCHED; PG8_LDA(At, 0, 0); PG8_STAGE(PG8_SA(1, 1), a1 + hstepA, voffA);
            PG8_WAIT_L(8); PG8_BAR; PG8_WAIT_L(0); PG8_MMA(0, 0, At, B0); PG8_BAR; PG8_SCHED;
            PG8_LDB(B1, 0, 1); PG8_STAGE(PG8_SB(0, 0), b2, voffB);
            PG8_BAR; PG8_WAIT_L(0); PG8_MMA(0, 1, At, B1); PG8_BAR;
            PG8_LDA(At, 0, 1); PG8_STAGE(PG8_SA(0, 0), a2, voffA);
            PG8_BAR; PG8_WAIT_L(0); PG8_MMA(1, 0, At, B0); PG8_BAR; PG8_SCHED;
            PG8_STAGE(PG8_SB(0, 1), b2 + hstepB, voffB);
            PG8_WAIT_V(6); PG8_BAR; PG8_MMA(1, 1, At, B1); PG8_BAR;
            PG8_LDB(B0, 1, 0); PG8_SCHED; PG8_LDA(At, 1, 0); PG8_STAGE(PG8_SA(0, 1), a2 + hstepA, voffA);
            PG8_WAIT_L(8); PG8_BAR; PG8_WAIT_L(0); PG8_MMA(0, 0, At, B0); PG8_BAR; PG8_SCHED;
            PG8_LDB(B1, 1, 1); PG8_STAGE(PG8_SB(1, 0), b3, voffB);
            PG8_BAR; PG8_WAIT_L(0); PG8_MMA(0, 1, At, B1); PG8_BAR;
            PG8_LDA(At, 1, 1); PG8_STAGE(PG8_SA(1, 0), a3, voffA);
            PG8_BAR; PG8_WAIT_L(0); PG8_MMA(1, 0, At, B0); PG8_BAR; PG8_SCHED;
            PG8_STAGE(PG8_SB(1, 1), b3 + hstepB, voffB);
            PG8_WAIT_V(6); PG8_BAR; PG8_MMA(1, 1, At, B1); PG8_BAR;
        }
        E(acc, cur, wr, wc, fr, fq);
        if (!has_next) break;
#pragma unroll
        for (int a = 0; a < 2; ++a)
#pragma unroll
            for (int b = 0; b < 2; ++b)
#pragma unroll
                for (int m = 0; m < 4; ++m)
#pragma unroll
                    for (int n = 0; n < 2; ++n) acc[a][b][m][n] = (f32x4){0.f, 0.f, 0.f, 0.f};
        cur = nxt; cA = nA; cB = nB; ++ui;
    }
    PG8_WAIT_V(0);
    if (wr == 0) PG8_BAR;
    PG8_BAR;
#undef PG8_SA
#undef PG8_SB
#undef PG8_STAGE
#undef PG8_LDA
#undef PG8_LDB
#undef PG8_MMA
#undef PG8_WAIT_V
#undef PG8_WAIT_L
#undef PG8_BAR
#undef PG8_SCHED
}
}

__device__ __forceinline__ void rmsnorm_rows(const float* src, const float* gain, bf16_t* dst, int gw, int nw, int lane) {
    for (int row = gw; row < NT; row += nw) {
        const f32x4* s = (const f32x4*)(src + (size_t)row * DM);
        f32x4 v[8]; float ss = 0.f;
#pragma unroll
        for (int i = 0; i < 8; ++i) { v[i] = s[i * 64 + lane]; ss += v[i][0] * v[i][0] + v[i][1] * v[i][1] + v[i][2] * v[i][2] + v[i][3] * v[i][3]; }
        ss = wave_sum(ss);
        const float r = rsqrtf(ss * (1.f / DM) + 1e-6f);
        u32x2* d = (u32x2*)(dst + (size_t)row * DM);
#pragma unroll
        for (int i = 0; i < 8; ++i) { const f32x4 gg = ((const f32x4*)gain)[i * 64 + lane]; u32x2 o; o.x = cvt_pk_bf16(v[i][0] * r * gg[0], v[i][1] * r * gg[1]); o.y = cvt_pk_bf16(v[i][2] * r * gg[2], v[i][3] * r * gg[3]); d[i * 64 + lane] = o; }
    }
}

__device__ __forceinline__ void tr_tile(const float* src, int ld, int c0, int nvalid, int k0, bf16_t* dst, int ldd, int r0, int kd0, LAS float* tile) {
    const int tid = tid_l();
#pragma unroll
    for (int i = 0; i < 2; ++i) {
        const int k = (tid >> 4) + 32 * i, c4 = (tid & 15) * 4;
        f32x4 v = (f32x4){0.f, 0.f, 0.f, 0.f};
        if (c4 < nvalid) v = *(const f32x4*)(src + (size_t)(k0 + k) * ld + c0 + c4);
        tile[k * 65 + c4] = v[0]; tile[k * 65 + c4 + 1] = v[1]; tile[k * 65 + c4 + 2] = v[2]; tile[k * 65 + c4 + 3] = v[3];
    }
    __syncthreads();
    {
        const int c = tid >> 3, k8 = (tid & 7) * 8;
        float f[8];
#pragma unroll
        for (int j = 0; j < 8; ++j) f[j] = tile[(k8 + j) * 65 + c];
        u32x4 w; w.x = cvt_pk_bf16(f[0], f[1]); w.y = cvt_pk_bf16(f[2], f[3]); w.z = cvt_pk_bf16(f[4], f[5]); w.w = cvt_pk_bf16(f[6], f[7]);
        *(u32x4*)(dst + (size_t)(r0 + c) * ldd + kd0 + k8) = w;
    }
    __syncthreads();
}

__device__ void phase_prep(const KP& p, LAS unsigned char* lds) {
    const int tid = tid_l(), lane = tid & 63, G = gridDim.x, bid = blockIdx.x;
    unsigned char* ws = p.ws;
    rmsnorm_rows(p.x, p.g_mix, (bf16_t*)(ws + OFF_XN), bid * 8 + (tid >> 6), G * 8, lane);
    LAS float* tile = (LAS float*)lds;
    for (int j = bid; j < 8960; j += G) {
        if (j < 5888) {
            const int rt = j >> 5, kt = j & 31; int c0, nv = 64;
            if (rt < 64) c0 = 64 * rt; else if (rt < 119) c0 = 4104 + 64 * (rt - 64); else if (rt == 119) { c0 = 4096; nv = 8; } else c0 = 7624 + 64 * (rt - 120);
            tr_tile(p.w_in, 11720, c0, nv, kt * 64, (bf16_t*)(ws + OFF_WINT), 2048, rt * 64, kt * 64, tile);
        } else if (j < 6400) { const int q = j - 5888, rt = q >> 4, kt = q & 15; tr_tile(p.proj_m, 2048, rt * 64, 64, kt * 64, (bf16_t*)(ws + OFF_PMT), 1024, rt * 64, kt * 64, tile); }
        else if (j < 6912) { const int q = j - 6400, rt = q >> 4, kt = q & 15; tr_tile(p.proj_r, 2048, rt * 64, 64, kt * 64, (bf16_t*)(ws + OFF_PRT), 1024, rt * 64, kt * 64, tile); }
        else if (j < 7936) { const int q = j - 6912, rt = q >> 5, kt = q & 31; tr_tile(p.w_out, 2048, rt * 64, 64, kt * 64, (bf16_t*)(ws + OFF_WOT), 2048, rt * 64, kt * 64, tile); }
        else { const int q = j - 7936, rt = q >> 5, kt = q & 31; tr_tile(p.w_query, 2048, rt * 64, 64, kt * 64, (bf16_t*)(ws + OFF_WQT), 2048, rt * 64, kt * 64, tile); }
    }
    const int gt = bid * 512 + tid, gn = G * 512;
    bf16_t* WAT = (bf16_t*)(ws + OFF_WAT);
    for (int i = gt; i < 2048 * 256; i += gn) { const int r = i >> 8, k = i & 255; float v = 0.f;
        if (r < 1024) { if (k < 96) v = p.w2[k * 1024 + r]; } else { if (k >= 96 && k < 192) v = p.a2[(k - 96) * 1024 + (r - 1024)]; }
        WAT[i] = f2bf(v); }
    bf16_t* G2T = (bf16_t*)(ws + OFF_G2T);
    for (int i = gt; i < 1024 * 256; i += gn) { const int r = i >> 8, k = i & 255; G2T[i] = f2bf(p.g2[k * 1024 + r]); }
    bf16_t* SK = (bf16_t*)(ws + OFF_SUBK);
    for (int i = gt; i < 2 * 128 * 128; i += gn) SK[i] = f2bf(p.sub_keys[i]);
}

__device__ void phase_lora_prep(const KP& p) {
    const bf16_t* PR = (const bf16_t*)(p.ws + OFF_PR);
    bf16_t* AL = (bf16_t*)((unsigned char*)p.out + DO_ALORA);
    const int gt = blockIdx.x * 512 + threadIdx.x, gn = gridDim.x * 512;
    for (int i = gt; i < NT * 64; i += gn) {
        const int tok = i >> 6, g = i & 63;
        u32x4 o = (u32x4){0u, 0u, 0u, 0u};
        if (g < 24 || g >= 32) {
            const int sc = (g < 24) ? (3072 + 8 * g) : (3264 + 8 * (g - 32));
            const u32x4 cu = *(const u32x4*)(PR + (size_t)tok * LDPR + sc);
            u32x4 pv = (u32x4){0u, 0u, 0u, 0u};
            if ((tok & (SEQ - 1)) != 0) pv = *(const u32x4*)(PR + (size_t)(tok - 1) * LDPR + sc);
            const f32x4 m0 = *(const f32x4*)(p.mu + sc), m1 = *(const f32x4*)(p.mu + sc + 4);
            float f[8];
#pragma unroll
            for (int q = 0; q < 4; ++q) {
                const float c0 = bflo(cu[q]), c1 = bfhi(cu[q]), p0 = bflo(pv[q]), p1 = bfhi(pv[q]);
                const float mm0 = (q < 2) ? m0[2 * q] : m1[2 * q - 4], mm1 = (q < 2) ? m0[2 * q + 1] : m1[2 * q - 3];
                f[2 * q] = c0 + (p0 - c0) * mm0; f[2 * q + 1] = c1 + (p1 - c1) * mm1;
            }
            if (g < 12) {
#pragma unroll
                for (int q = 0; q < 8; ++q) f[q] = tanhf(f[q]);
            } else if (g >= 32) {
#pragma unroll
                for (int q = 0; q < 8; ++q) f[q] = sigm(f[q]);
            }
            o.x = cvt_pk_bf16(f[0], f[1]); o.y = cvt_pk_bf16(f[2], f[3]); o.z = cvt_pk_bf16(f[4], f[5]); o.w = cvt_pk_bf16(f[6], f[7]);
        }
        *(u32x4*)(AL + (size_t)tok * 512 + 8 * g) = o;
    }
}

__device__ void rwkv_scan(const KP& p, int bh, LAS unsigned char* lds) {
    const int tid = tid_l();
    const int b = bh >> 4, h = bh & 15;
    LAS float* sR = (LAS float*)lds; LAS float* sW = sR + 2048; LAS float* sK = sW + 2048; LAS float* sV = sK + 2048; LAS float* sA = sV + 2048; LAS float* sB = sA + 2048; LAS float* sY = sB + 2048;
    const bf16_t* PR = (const bf16_t*)(p.ws + OFF_PR);
    const bf16_t* WLOG = (const bf16_t*)((const unsigned char*)p.out + DO_WLOG);
    const bf16_t* AG = (const bf16_t*)((const unsigned char*)p.out + DO_AG);
    const bf16_t* GG = (const bf16_t*)((const unsigned char*)p.out + DO_GG);
    bf16_t* YR = (bf16_t*)(p.ws + OFF_YR);
    const int tt = tid >> 4, cg4 = (tid & 15) * 4, ch = h * 64 + cg4;
    const f32x4 mur = *(const f32x4*)(p.mu + ch), muk = *(const f32x4*)(p.mu + 1024 + ch), muv = *(const f32x4*)(p.mu + 2048 + ch);
    const f32x4 kkc = *(const f32x4*)(p.k_k + ch), kac = *(const f32x4*)(p.k_a + ch), rkc = *(const f32x4*)(p.r_k + ch), lnw = *(const f32x4*)(p.ln_w + ch), lnb = *(const f32x4*)(p.ln_b + ch);
    const int row = tid >> 3, j8 = (tid & 7) * 8;
    float S[8];
#pragma unroll
    for (int k = 0; k < 8; ++k) S[k] = 0.f;
    const size_t tokbase = (size_t)b * SEQ;
    u32x2 r2, k2, v2, pr2, pk2, pv2, w2, a2;
#define RW_LOAD(c) do { const int t_ = (c) * 32 + tt; const size_t tok_ = tokbase + t_; const bf16_t* pr_ = PR + tok_ * LDPR + ch; \
        r2 = *(const u32x2*)pr_; k2 = *(const u32x2*)(pr_ + 1024); v2 = *(const u32x2*)(pr_ + 2048); \
        if (t_ > 0) { pr2 = *(const u32x2*)(pr_ - LDPR); pk2 = *(const u32x2*)(pr_ - LDPR + 1024); pv2 = *(const u32x2*)(pr_ - LDPR + 2048); } else { pr2 = (u32x2){0u, 0u}; pk2 = pr2; pv2 = pr2; } \
        w2 = *(const u32x2*)(WLOG + tok_ * 1024 + ch); a2 = *(const u32x2*)(AG + tok_ * 1024 + ch); } while (0)
    RW_LOAD(0);
    for (int c = 0; c < 128; ++c) {
        {
            f32x4 r, k, v, pr, pk, pv, wl, a;
            r = (f32x4){bflo(r2.x), bfhi(r2.x), bflo(r2.y), bfhi(r2.y)}; k = (f32x4){bflo(k2.x), bfhi(k2.x), bflo(k2.y), bfhi(k2.y)}; v = (f32x4){bflo(v2.x), bfhi(v2.x), bflo(v2.y), bfhi(v2.y)};
            pr = (f32x4){bflo(pr2.x), bfhi(pr2.x), bflo(pr2.y), bfhi(pr2.y)}; pk = (f32x4){bflo(pk2.x), bfhi(pk2.x), bflo(pk2.y), bfhi(pk2.y)}; pv = (f32x4){bflo(pv2.x), bfhi(pv2.x), bflo(pv2.y), bfhi(pv2.y)};
            wl = (f32x4){bflo(w2.x), bfhi(w2.x), bflo(w2.y), bfhi(w2.y)}; a = (f32x4){bflo(a2.x), bfhi(a2.x), bflo(a2.y), bfhi(a2.y)};
            r = r + (pr - r) * mur; k = k + (pk - k) * muk; v = v + (pv - v) * muv;
            f32x4 kk = k * kkc;
            float n2 = kk[0] * kk[0] + kk[1] * kk[1] + kk[2] * kk[2] + kk[3] * kk[3];
            n2 = red16(n2);
            const float inv = 1.f / fmaxf(sqrtf(n2), 1e-12f);
            kk = kk * inv;
            const f32x4 k3 = k * (1.f + (a - 1.f) * kac);
            f32x4 dec; dec[0] = __expf(wl[0]); dec[1] = __expf(wl[1]); dec[2] = __expf(wl[2]); dec[3] = __expf(wl[3]);
            const int o = tt * 64 + cg4;
            *(LAS f32x4*)(sR + o) = r; *(LAS f32x4*)(sW + o) = dec; *(LAS f32x4*)(sK + o) = k3; *(LAS f32x4*)(sV + o) = v; *(LAS f32x4*)(sA + o) = -kk; *(LAS f32x4*)(sB + o) = kk * a;
        }
        __syncthreads();
        if (c + 1 < 128) RW_LOAD(c + 1);
#pragma unroll 2
        for (int s = 0; s < 32; ++s) {
            const f32x4 a0 = *(const LAS f32x4*)(sA + s * 64 + j8), a1 = *(const LAS f32x4*)(sA + s * 64 + j8 + 4);
            const f32x4 b0 = *(const LAS f32x4*)(sB + s * 64 + j8), b1 = *(const LAS f32x4*)(sB + s * 64 + j8 + 4);
            const f32x4 w0 = *(const LAS f32x4*)(sW + s * 64 + j8), w1 = *(const LAS f32x4*)(sW + s * 64 + j8 + 4);
            const f32x4 k0 = *(const LAS f32x4*)(sK + s * 64 + j8), k1 = *(const LAS f32x4*)(sK + s * 64 + j8 + 4);
            const f32x4 r0 = *(const LAS f32x4*)(sR + s * 64 + j8), r1 = *(const LAS f32x4*)(sR + s * 64 + j8 + 4);
            const float vv = sV[s * 64 + row];
            float sa = (S[0] * a0[0] + S[1] * a0[1]) + (S[2] * a0[2] + S[3] * a0[3]) + (S[4] * a1[0] + S[5] * a1[1]) + (S[6] * a1[2] + S[7] * a1[3]);
            sa = red8(sa);
#pragma unroll
            for (int q = 0; q < 4; ++q) { S[q] = S[q] * w0[q] + (sa * b0[q] + vv * k0[q]); S[4 + q] = S[4 + q] * w1[q] + (sa * b1[q] + vv * k1[q]); }
            float y = (S[0] * r0[0] + S[1] * r0[1]) + (S[2] * r0[2] + S[3] * r0[3]) + (S[4] * r1[0] + S[5] * r1[1]) + (S[6] * r1[2] + S[7] * r1[3]);
            y = red8(y);
            if ((tid & 7) == 0) sY[s * 64 + row] = y;
        }
        __syncthreads();
        {
            const int o = tt * 64 + cg4; const size_t tok = tokbase + c * 32 + tt;
            const f32x4 y = *(const LAS f32x4*)(sY + o), r = *(const LAS f32x4*)(sR + o), k3 = *(const LAS f32x4*)(sK + o), v = *(const LAS f32x4*)(sV + o);
            const u32x2 g2 = *(const u32x2*)(GG + tok * 1024 + ch);
            const float mean = red16(y[0] + y[1] + y[2] + y[3]) * (1.f / 64.f);
            const f32x4 d = y - mean;
            const float var = red16(d[0] * d[0] + d[1] * d[1] + d[2] * d[2] + d[3] * d[3]) * (1.f / 64.f);
            const float rs = rsqrtf(var + 64e-5f);
            const f32x4 rk3 = r * k3 * rkc;
            const float bon = red16(rk3[0] + rk3[1] + rk3[2] + rk3[3]);
            const f32x4 g = (f32x4){bflo(g2.x), bfhi(g2.x), bflo(g2.y), bfhi(g2.y)};
            const f32x4 res = (d * rs * lnw + lnb + bon * v) * g;
            u32x2 ov; ov.x = cvt_pk_bf16(res[0], res[1]); ov.y = cvt_pk_bf16(res[2], res[3]);
            *(u32x2*)(YR + tok * 1024 + ch) = ov;
        }
        __syncthreads();
    }
#undef RW_LOAD
}

__device__ __forceinline__ float bfel(const u32x4& w, int e) { const unsigned u = w[e >> 1]; return (e & 1) ? bfhi(u) : bflo(u); }
__device__ void mlstm_run(const KP& p, int item, LAS unsigned char* lds) {
    const int tid0 = tid_l();
    const int bh = item >> 3, b = bh >> 2, h = bh & 3, dv0 = (item & 7) * 32;
    const size_t tokbase = (size_t)b * SEQ;
    LAS bf16_t* Qs = (LAS bf16_t*)(lds + 0);
    LAS bf16_t* Ks = (LAS bf16_t*)(lds + 33792);
    LAS bf16_t* KTs = (LAS bf16_t*)(lds + 67584);
    LAS bf16_t* VTs = (LAS bf16_t*)(lds + 104448);
    LAS bf16_t* VWTs = (LAS bf16_t*)(lds + 109056);
    LAS bf16_t* Ss = (LAS bf16_t*)(lds + 113664);
    LAS bf16_t* CTs = (LAS bf16_t*)(lds + 122880);
    LAS float* CW = (LAS float*)(lds + 139776);
    LAS float* BC = (LAS float*)(lds + 147968);
    LAS float* IG = (LAS float*)(lds + 148224);
    LAS float* NV = (LAS float*)(lds + 148480);
    LAS float* QN = (LAS float*)(lds + 149504);
    LAS float* DP = (LAS float*)(lds + 149760);
    LAS float* WSV = (LAS float*)(lds + 150272);
    const bf16_t* PM = (const bf16_t*)(p.ws + OFF_PM);
    const bf16_t* PR = (const bf16_t*)(p.ws + OFF_PR);
    bf16_t* YM = (bf16_t*)(p.ws + OFF_YM);
    for (int i = tid0; i < 2048; i += 512) { const int j = i >> 9, cc = i & 511; const int qk = cc < 256 ? h * 256 + cc : 1024 + h * 256 + (cc - 256); CW[i] = p.conv_w[j * 2048 + qk]; }
    if (tid0 < 256) NV[tid0] = 0.f;
    for (int i = tid0; i < 32 * 264 / 2; i += 512) ((LAS unsigned*)CTs)[i] = 0u;
    f32x4 cacc[4];
#pragma unroll
    for (int i = 0; i < 4; ++i) cacc[i] = (f32x4){0.f, 0.f, 0.f, 0.f};
    const float bi = p.b_i[h], bff = p.b_f[h];
    u32x4 raw[11];
#define ML_LOAD(c, TID) do { const int rg_ = (TID) >> 6, cg_ = (TID) & 63; const int pmcol_ = (cg_ < 32) ? (h * 256 + 8 * cg_) : (1024 + h * 256 + 8 * (cg_ - 32)); \
        const bf16_t* base_ = PM + (tokbase + (c) * 64 + 8 * rg_) * LDPM + pmcol_; \
        _Pragma("unroll") for (int i_ = 0; i_ < 11; ++i_) { const int t_ = (c) * 64 + 8 * rg_ - 3 + i_; const bool neg_ = t_ < 0; \
        u32x4 v_ = *(const u32x4*)(base_ + (neg_ ? 0 : (i_ - 3) * LDPM)); if (neg_) v_ = (u32x4){0u, 0u, 0u, 0u}; raw[i_] = v_; } } while (0)
    ML_LOAD(0, tid0);
    __syncthreads();
    for (int c = 0; c < 64; ++c) {
        const int t0 = c * 64;
        int tid = tid0; asm volatile("" : "+v"(tid));
        const int lane = tid & 63, w = tid >> 6, fr = lane & 15, fq = lane >> 4, rg = tid >> 6, cg = lane;
        {
            float cwv[4][8];
#pragma unroll
            for (int j = 0; j < 4; ++j) { const f32x4 x0 = *(const LAS f32x4*)(CW + j * 512 + cg * 8), x1 = *(const LAS f32x4*)(CW + j * 512 + cg * 8 + 4);
                cwv[j][0] = x0[0]; cwv[j][1] = x0[1]; cwv[j][2] = x0[2]; cwv[j][3] = x0[3]; cwv[j][4] = x1[0]; cwv[j][5] = x1[1]; cwv[j][6] = x1[2]; cwv[j][7] = x1[3]; }
#pragma unroll
            for (int r = 0; r < 8; ++r) {
                float o[8];
#pragma unroll
                for (int e = 0; e < 8; ++e) {
                    float s = cwv[0][e] * bfel(raw[r], e) + cwv[1][e] * bfel(raw[r + 1], e) + cwv[2][e] * bfel(raw[r + 2], e) + cwv[3][e] * bfel(raw[r + 3], e);
                    s = s * sigm(s);
                    o[e] = (cg < 32) ? s * 0.0625f : s;
                }
                u32x4 pk; pk.x = cvt_pk_bf16(o[0], o[1]); pk.y = cvt_pk_bf16(o[2], o[3]); pk.z = cvt_pk_bf16(o[4], o[5]); pk.w = cvt_pk_bf16(o[6], o[7]);
                if (cg < 32) *(LAS u32x4*)(Qs + (8 * rg + r) * 264 + 8 * cg) = pk;
                else {
                    *(LAS u32x4*)(Ks + (8 * rg + r) * 264 + 8 * (cg - 32)) = pk;
#pragma unroll
                    for (int e = 0; e < 8; ++e) KTs[(8 * (cg - 32) + e) * 72 + 8 * rg + r] = (bf16_t)((e & 1) ? (pk[e >> 1] >> 16) : (pk[e >> 1] & 0xffffu));
                }
            }
        }
        if (w == 0) {
            const size_t tok = tokbase + t0 + lane;
            const float iv = bf2f(PR[tok * LDPR + 3520 + h]) + bi, fv = bf2f(PR[tok * LDPR + 3524 + h]) + bff;
            float lf = fminf(fv, 0.f) - __logf(1.f + __expf(-fabsf(fv)));
#pragma unroll
            for (int d = 1; d < 64; d <<= 1) { const float y = __shfl_up(lf, d); if (lane >= d) lf += y; }
            BC[lane] = lf; IG[lane] = iv;
        }
        asm volatile("" ::: "memory");
        if (c + 1 < 64) ML_LOAD(c + 1, tid);
        asm volatile("" ::: "memory");
        u32x4 vraw = (u32x4){0u, 0u, 0u, 0u};
        if (tid < 256) vraw = *(const u32x4*)(PM + (tokbase + t0 + (tid >> 2)) * LDPM + 2048 + h * 256 + dv0 + 8 * (tid & 3));
        __syncthreads();
        if (tid < 256) {
            const int s = tid >> 2, g = tid & 3;
            const float wsv = __expf(BC[63] - BC[s] + IG[s]);
            if (g == 0) WSV[s] = wsv;
#pragma unroll
            for (int e = 0; e < 8; ++e) { const float vv = bfel(vraw, e); VTs[(8 * g + e) * 72 + s] = f2bf(vv); VWTs[(8 * g + e) * 72 + s] = f2bf(vv * wsv); }
        }
        {
            const int mt = w >> 1, ntb = (w & 1) * 2;
            f32x4 s0 = (f32x4){0.f, 0.f, 0.f, 0.f}, s1 = s0;
#pragma unroll
            for (int ks = 0; ks < 8; ++ks) {
                const bf16x8 a = *(const LAS bf16x8*)(Qs + (16 * mt + fr) * 264 + 32 * ks + 8 * fq);
                const bf16x8 b0 = *(const LAS bf16x8*)(Ks + (16 * ntb + fr) * 264 + 32 * ks + 8 * fq);
                const bf16x8 b1 = *(const LAS bf16x8*)(Ks + (16 * (ntb + 1) + fr) * 264 + 32 * ks + 8 * fq);
                s0 = __builtin_amdgcn_mfma_f32_16x16x32_bf16(a, b0, s0, 0, 0, 0);
                s1 = __builtin_amdgcn_mfma_f32_16x16x32_bf16(a, b1, s1, 0, 0, 0);
            }
            const int sA = 16 * ntb + fr, sB = sA + 16;
            const float gA = IG[sA] - BC[sA], gB = IG[sB] - BC[sB];
#pragma unroll
            for (int j = 0; j < 4; ++j) {
                const int t = 16 * mt + 4 * fq + j; const float bt = BC[t];
                const float vA = (sA <= t) ? s0[j] * __expf(bt + gA) : 0.f, vB = (sB <= t) ? s1[j] * __expf(bt + gB) : 0.f;
                Ss[t * 72 + sA] = f2bf(vA); Ss[t * 72 + sB] = f2bf(vB);
                const float rs = red16(vA + vB);
                if (fr == 0) DP[t * 2 + (w & 1)] = rs;
            }
        }
        {
            const int t = tid >> 3, part = tid & 7; float s = 0.f;
#pragma unroll
            for (int i = 0; i < 4; ++i) { const u32x4 q4 = *(const LAS u32x4*)(Qs + t * 264 + part * 32 + 8 * i);
                const f32x4 n0 = *(const LAS f32x4*)(NV + part * 32 + 8 * i), n1 = *(const LAS f32x4*)(NV + part * 32 + 8 * i + 4);
                s += bflo(q4.x) * n0[0] + bfhi(q4.x) * n0[1] + bflo(q4.y) * n0[2] + bfhi(q4.y) * n0[3] + bflo(q4.z) * n1[0] + bfhi(q4.z) * n1[1] + bflo(q4.w) * n1[2] + bfhi(q4.w) * n1[3]; }
            s = red8(s);
            if (part == 0) QN[t] = s;
        }
        __syncthreads();
        {
            const int mt = w >> 1, nt = w & 1;
            f32x4 aA = (f32x4){0.f, 0.f, 0.f, 0.f}, aB = aA;
#pragma unroll
            for (int ks = 0; ks < 2; ++ks) {
                const bf16x8 a = *(const LAS bf16x8*)(Ss + (16 * mt + fr) * 72 + 32 * ks + 8 * fq);
                const bf16x8 bb = *(const LAS bf16x8*)(VTs + (16 * nt + fr) * 72 + 32 * ks + 8 * fq);
                aA = __builtin_amdgcn_mfma_f32_16x16x32_bf16(a, bb, aA, 0, 0, 0);
            }
#pragma unroll
            for (int ks = 0; ks < 8; ++ks) {
                const bf16x8 a = *(const LAS bf16x8*)(Qs + (16 * mt + fr) * 264 + 32 * ks + 8 * fq);
                const bf16x8 bb = *(const LAS bf16x8*)(CTs + (16 * nt + fr) * 264 + 32 * ks + 8 * fq);
                aB = __builtin_amdgcn_mfma_f32_16x16x32_bf16(a, bb, aB, 0, 0, 0);
            }
            const int dv = dv0 + 16 * nt + fr;
#pragma unroll
            for (int j = 0; j < 4; ++j) {
                const int t = 16 * mt + 4 * fq + j; const float eb = __expf(BC[t]);
                const float num = aA[j] + eb * aB[j], den = DP[2 * t] + DP[2 * t + 1] + eb * QN[t];
                const float hv = num / fmaxf(fabsf(den), 1.f);
                const size_t tok = tokbase + t0 + t;
                const float ov = bf2f(PM[tok * LDPM + 3072 + h * 256 + dv]);
                YM[tok * 1024 + h * 256 + dv] = f2bf(hv * sigm(ov));
            }
        }
        __syncthreads();
        {
            const float decay = __expf(BC[63]);
#pragma unroll
            for (int i = 0; i < 4; ++i) {
                const int mt = 2 * w + (i >> 1), nt = i & 1;
                cacc[i] = cacc[i] * decay;
#pragma unroll
                for (int ks = 0; ks < 2; ++ks) {
                    const bf16x8 a = *(const LAS bf16x8*)(KTs + (16 * mt + fr) * 72 + 32 * ks + 8 * fq);
                    const bf16x8 bb = *(const LAS bf16x8*)(VWTs + (16 * nt + fr) * 72 + 32 * ks + 8 * fq);
                    cacc[i] = __builtin_amdgcn_mfma_f32_16x16x32_bf16(a, bb, cacc[i], 0, 0, 0);
                }
                u32x2 pk; pk.x = cvt_pk_bf16(cacc[i][0], cacc[i][1]); pk.y = cvt_pk_bf16(cacc[i][2], cacc[i][3]);
                *(LAS u32x2*)(CTs + (16 * nt + fr) * 264 + 16 * mt + 4 * fq) = pk;
            }
            const int dk = tid >> 1, hf = tid & 1; float s = 0.f;
#pragma unroll
            for (int i = 0; i < 4; ++i) { const u32x4 k4 = *(const LAS u32x4*)(KTs + dk * 72 + hf * 32 + 8 * i);
                const f32x4 w0 = *(const LAS f32x4*)(WSV + hf * 32 + 8 * i), w1 = *(const LAS f32x4*)(WSV + hf * 32 + 8 * i + 4);
                s += bflo(k4.x) * w0[0] + bfhi(k4.x) * w0[1] + bflo(k4.y) * w0[2] + bfhi(k4.y) * w0[3] + bflo(k4.z) * w1[0] + bfhi(k4.z) * w1[1] + bflo(k4.w) * w1[2] + bfhi(k4.w) * w1[3]; }
            s += dppf<0xB1>(s);
            if (hf == 0) NV[dk] = decay * NV[dk] + s;
        }
        __syncthreads();
    }
#undef ML_LOAD
}

__device__ void phase_norm2_convert(const KP& p) {
    const int tid = tid_l(), lane = tid & 63, G = gridDim.x, bid = blockIdx.x;
    rmsnorm_rows(p.out, p.g_ffn, (bf16_t*)(p.ws + OFF_XN2), bid * 8 + (tid >> 6), G * 8, lane);
    const size_t gt = (size_t)bid * 512 + tid, gn = (size_t)G * 512;
    const size_t n8 = (size_t)NT * DM / 8;
    for (int tb = 0; tb < 2; ++tb) {
        const float* src = tb ? p.peer_v : p.peer_u; bf16_t* dst = (bf16_t*)(p.ws + (tb ? OFF_PV : OFF_PU));
        for (size_t i = gt; i < n8; i += gn) {
            const f32x4 a = *(const f32x4*)(src + i * 8), b = *(const f32x4*)(src + i * 8 + 4);
            u32x4 o; o.x = cvt_pk_bf16(a[0], a[1]); o.y = cvt_pk_bf16(a[2], a[3]); o.z = cvt_pk_bf16(b[0], b[1]); o.w = cvt_pk_bf16(b[2], b[3]);
            *(u32x4*)(dst + i * 8) = o;
        }
    }
}

__device__ void phase_peer(const KP& p, LAS unsigned char* lds) {
    const int tid = tid_l(), lane = tid & 63, w = tid >> 6, fr = lane & 15, fq = lane >> 4;
    LAS unsigned* KEYS = (LAS unsigned*)lds;
    LAS int* TI = (LAS int*)(lds + 32768);
    LAS float* TG = (LAS float*)(lds + 49152);
    const bf16_t* Q = (const bf16_t*)(p.ws + OFF_Q);
    const bf16_t* SK = (const bf16_t*)(p.ws + OFF_SUBK);
    const bf16_t* XN2 = (const bf16_t*)(p.ws + OFF_XN2);
    const bf16_t* PU = (const bf16_t*)(p.ws + OFF_PU);
    const bf16_t* PV = (const bf16_t*)(p.ws + OFF_PV);
    float* out = p.out;
    for (int tile = blockIdx.x; tile < NT / 32; tile += gridDim.x) {
        const int tk0 = tile * 32;
        for (int h = 0; h < 8; ++h) {
            {
                const int pp = w >> 2, ntb = (w & 3) * 2;
                f32x4 acc[2][2];
#pragma unroll
                for (int a = 0; a < 2; ++a)
#pragma unroll
                    for (int b = 0; b < 2; ++b) acc[a][b] = (f32x4){0.f, 0.f, 0.f, 0.f};
#pragma unroll
                for (int ks = 0; ks < 4; ++ks) {
                    bf16x8 af[2], bfr[2];
#pragma unroll
                    for (int mt = 0; mt < 2; ++mt) af[mt] = *(const bf16x8*)(Q + (size_t)(tk0 + 16 * mt + fr) * DM + h * 256 + pp * 128 + 32 * ks + 8 * fq);
#pragma unroll
                    for (int n = 0; n < 2; ++n) bfr[n] = *(const bf16x8*)(SK + (size_t)(pp * 128 + 16 * (ntb + n) + fr) * 128 + 32 * ks + 8 * fq);
#pragma unroll
                    for (int mt = 0; mt < 2; ++mt)
#pragma unroll
                        for (int n = 0; n < 2; ++n) acc[mt][n] = __builtin_amdgcn_mfma_f32_16x16x32_bf16(af[mt], bfr[n], acc[mt][n], 0, 0, 0);
                }
#pragma unroll
                for (int mt = 0; mt < 2; ++mt)
#pragma unroll
                    for (int n = 0; n < 2; ++n)
#pragma unroll
                        for (int j = 0; j < 4; ++j) { const int tokl = 16 * mt + 4 * fq + j, key = 16 * (ntb + n) + fr;
                            KEYS[(tokl * 2 + pp) * 128 + key] = (ordf(acc[mt][n][j]) & ~0x7Fu) | (unsigned)key; }
            }
            __syncthreads();
            for (int q = 0; q < 4; ++q) {
                const int tokl = 4 * w + q;
                unsigned top[2] = {0u, 0u};
#pragma unroll
                for (int pp = 0; pp < 2; ++pp) {
                    unsigned k0 = KEYS[(tokl * 2 + pp) * 128 + lane], k1 = KEYS[(tokl * 2 + pp) * 128 + 64 + lane];
                    for (int it = 0; it < 16; ++it) {
                        const unsigned M = wave_max_u32(max(k0, k1));
                        if (lane == it) top[pp] = M;
                        k0 = (k0 == M) ? 0u : k0; k1 = (k1 == M) ? 0u : k1;
                    }
                }
                const int j = lane & 15, ib = lane >> 4;
                const float v2 = unordf((unsigned)__shfl((int)top[1], j) & ~0x7Fu);
                unsigned cnd[4];
#pragma unroll
                for (int m = 0; m < 4; ++m) { const int i = ib + 4 * m; const float v1 = unordf((unsigned)__shfl((int)top[0], i) & ~0x7Fu);
                    cnd[m] = (ordf(v1 + v2) & ~0xFFu) | (unsigned)(i * 16 + j); }
                unsigned best = 0u;
                for (int it = 0; it < 16; ++it) {
                    const unsigned M = wave_max_u32(max(max(cnd[0], cnd[1]), max(cnd[2], cnd[3])));
                    if (lane == it) best = M;
#pragma unroll
                    for (int m = 0; m < 4; ++m) cnd[m] = (cnd[m] == M) ? 0u : cnd[m];
                }
                const int ci = (int)(best & 0xFFu);
                const float bv = unordf(best & ~0xFFu);
                const int e1 = __shfl((int)top[0], ci >> 4) & 0x7F, e2 = __shfl((int)top[1], ci & 15) & 0x7F;
                const float mx = rlane(bv, 0);
                float ev = (lane < 16) ? __expf(bv - mx) : 0.f;
                const float sum = rlane(red16(ev), 0);
                if (lane < 16) { TI[tokl * 128 + h * 16 + lane] = e1 * 128 + e2; TG[tokl * 128 + h * 16 + lane] = ev / sum; }
            }
            __syncthreads();
        }
        for (int q = 0; q < 4; ++q) {
            const int tokl = 4 * w + q; const size_t tok = (size_t)tk0 + tokl;
            float xv[32], acc[32];
#pragma unroll
            for (int i = 0; i < 4; ++i) { const u32x4 x4 = *(const u32x4*)(XN2 + tok * DM + i * 512 + lane * 8);
#pragma unroll
                for (int e = 0; e < 4; ++e) { xv[i * 8 + 2 * e] = bflo(x4[e]); xv[i * 8 + 2 * e + 1] = bfhi(x4[e]); } }
#pragma unroll
            for (int i = 0; i < 32; ++i) acc[i] = 0.f;
#pragma unroll 2
            for (int e = 0; e < 128; ++e) {
                const int idx = __builtin_amdgcn_readfirstlane(TI[tokl * 128 + e]);
                const float gate = __builtin_bit_cast(float, __builtin_amdgcn_readfirstlane(__builtin_bit_cast(int, TG[tokl * 128 + e])));
                const bf16_t* up = PU + (size_t)idx * DM + lane * 8; const bf16_t* vp = PV + (size_t)idx * DM + lane * 8;
                u32x4 u4[4], v4[4];
#pragma unroll
                for (int i = 0; i < 4; ++i) u4[i] = *(const u32x4*)(up + i * 512);
#pragma unroll
                for (int i = 0; i < 4; ++i) v4[i] = *(const u32x4*)(vp + i * 512);
                float d0 = 0.f, d1 = 0.f;
#pragma unroll
                for (int i = 0; i < 4; ++i)
#pragma unroll
                    for (int k = 0; k < 4; ++k) { d0 += xv[i * 8 + 2 * k] * bflo(u4[i][k]); d1 += xv[i * 8 + 2 * k + 1] * bfhi(u4[i][k]); }
                const float act = wave_sum(d0 + d1);
                const float coef = gate * 0.5f * act * (1.f + erff(act * 0.70710678118f));
#pragma unroll
                for (int i = 0; i < 4; ++i)
#pragma unroll
                    for (int k = 0; k < 4; ++k) { acc[i * 8 + 2 * k] += coef * bflo(v4[i][k]); acc[i * 8 + 2 * k + 1] += coef * bfhi(v4[i][k]); }
            }
            float ss = 0.f;
            float* orow = out + tok * DM;
#pragma unroll
            for (int i = 0; i < 4; ++i) { const f32x4 h0 = *(const f32x4*)(orow + i * 512 + lane * 8), h1 = *(const f32x4*)(orow + i * 512 + lane * 8 + 4);
#pragma unroll
                for (int k = 0; k < 4; ++k) { acc[i * 8 + k] += h0[k]; acc[i * 8 + 4 + k] += h1[k]; ss += acc[i * 8 + k] * acc[i * 8 + k] + acc[i * 8 + 4 + k] * acc[i * 8 + 4 + k]; } }
            ss = wave_sum(ss);
            const float r = rsqrtf(ss * (1.f / DM) + 1e-6f);
#pragma unroll
            for (int i = 0; i < 4; ++i) { const f32x4 g0 = *(const f32x4*)(p.g_final + i * 512 + lane * 8), g1 = *(const f32x4*)(p.g_final + i * 512 + lane * 8 + 4);
                f32x4 o0, o1;
#pragma unroll
                for (int k = 0; k < 4; ++k) { o0[k] = acc[i * 8 + k] * r * g0[k]; o1[k] = acc[i * 8 + 4 + k] * r * g1[k]; }
                *(f32x4*)(orow + i * 512 + lane * 8) = o0; *(f32x4*)(orow + i * 512 + lane * 8 + 4) = o1; }
        }
        __syncthreads();
    }
}

__global__ void __launch_bounds__(512) fwd_megakernel(KP p) {
    extern __shared__ __attribute__((aligned(16))) unsigned char smem[];
    LAS unsigned char* lds = (LAS unsigned char*)smem;
    cg::grid_group grid = cg::this_grid();
#define GRID_SYNC() do { __builtin_amdgcn_fence(__ATOMIC_RELEASE, "agent"); __syncthreads(); grid.sync(); __builtin_amdgcn_fence(__ATOMIC_ACQUIRE, "agent"); } while (0)
    const int G = gridDim.x, bid = blockIdx.x;
    unsigned char* ws = p.ws; unsigned char* dob = (unsigned char*)p.out;

#define RUN_GEMM(MODE, ...) do { unsigned char* ws = lp(p.ws); unsigned char* dob = lp((unsigned char*)p.out); const pg8::Gemm g_ = pg8::Gemm{__VA_ARGS__}; pg8::StaticOrder S_; S_.init(g_.M, g_.N, G, bid); \
        const pg8::Epi<MODE> E_{ws, dob, p.x, p.w0, p.a0}; pg8::gemm_phase(lds, g_, S_, E_); } while (0)
    phase_prep(p, lds);
    GRID_SYNC();
    RUN_GEMM(0, (const bf16_t*)(ws + OFF_XN), (const bf16_t*)(ws + OFF_WINT), NT, N1, 2048, 2048, 2048);
    GRID_SYNC();
    phase_lora_prep(p);
    GRID_SYNC();
    RUN_GEMM(1, (const bf16_t*)(dob + DO_ALORA), (const bf16_t*)(ws + OFF_WAT), NT, 2048, 256, 512, 256);
    RUN_GEMM(2, (const bf16_t*)(dob + DO_ALORA) + 256, (const bf16_t*)(ws + OFF_G2T), NT, 1024, 256, 512, 256);
    GRID_SYNC();
    if (bid < 64) rwkv_scan(p, bid, lds);
    else if (bid < 192) mlstm_run(p, bid - 64, lds);
    GRID_SYNC();
    RUN_GEMM(3, (const bf16_t*)(ws + OFF_YM), (const bf16_t*)(ws + OFF_PMT), NT, 2048, 1024, 1024, 1024);
    RUN_GEMM(4, (const bf16_t*)(ws + OFF_YR), (const bf16_t*)(ws + OFF_PRT), NT, 2048, 1024, 1024, 1024);
    GRID_SYNC();
    RUN_GEMM(5, (const bf16_t*)(ws + OFF_PG), (const bf16_t*)(ws + OFF_WOT), NT, 2048, 2048, LDPG, 2048);
    GRID_SYNC();
    phase_norm2_convert(p);
    GRID_SYNC();
    RUN_GEMM(6, (const bf16_t*)(ws + OFF_XN2), (const bf16_t*)(ws + OFF_WQT), NT, 2048, 2048, 2048, 2048);
    GRID_SYNC();
    phase_peer(p, lds);
}

extern "C" void kernel_launch(void* const* d_in, const int* in_sizes, int n_in, void* d_out, int out_size, void* d_ws, size_t ws_size, hipStream_t stream) {
    static int grid_blocks = 0;
    if (grid_blocks == 0) {
        if (n_in != 26 || out_size != NT * DM || ws_size < WS_NEED) { fprintf(stderr, "kernel_launch: unexpected shapes: n_in %d out %d ws %zu (need %zu)\n", n_in, out_size, ws_size, (size_t)WS_NEED); grid_blocks = -1; return; }
        int dev = 0, cus = 0, per_cu = 0;
        hipGetDevice(&dev);
        hipDeviceGetAttribute(&cus, hipDeviceAttributeMultiprocessorCount, dev);
        if (hipFuncSetAttribute((const void*)fwd_megakernel, hipFuncAttributeMaxDynamicSharedMemorySize, LDS_BYTES) != hipSuccess) { fprintf(stderr, "kernel_launch: hipFuncSetAttribute failed\n"); grid_blocks = -1; return; }
        hipOccupancyMaxActiveBlocksPerMultiprocessor(&per_cu, (const void*)fwd_megakernel, 512, LDS_BYTES);
        if (per_cu < 1) { fprintf(stderr, "kernel_launch: occupancy query says %d blocks per CU\n", per_cu); per_cu = 1; }
        (void)hipGetLastError();
        grid_blocks = cus * 1;
    }
    if (grid_blocks < 0) return;
    KP p{};
    const float** pp = (const float**)&p;
    for (int i = 0; i < 26; ++i) pp[i] = (const float*)d_in[i];
    p.out = (float*)d_out; p.ws = (unsigned char*)d_ws;
    void* args[] = {&p};
    hipError_t e = hipLaunchCooperativeKernel((void*)fwd_megakernel, dim3(grid_blocks), dim3(512), args, LDS_BYTES, stream);
    if (e != hipSuccess) fprintf(stderr, "cooperative launch failed: %s (grid %d)\n", hipGetErrorString(e), grid_blocks);
}
```

```cpp
#include <hip/hip_runtime.h>
#include <hip/hip_cooperative_groups.h>
#include <cstdio>
namespace cg = cooperative_groups;

#define LAS __attribute__((address_space(3)))
typedef unsigned short bf16_t;
typedef short bf16x8 __attribute__((ext_vector_type(8)));
typedef float f32x4 __attribute__((ext_vector_type(4)));
typedef unsigned u32x4 __attribute__((ext_vector_type(4)));
typedef unsigned u32x2 __attribute__((ext_vector_type(2)));

constexpr int NT = 16384, SEQ = 4096, DM = 2048;
constexpr int LDPM = 4096, LDPR = 3584, LDPG = 4096, N1 = 11776;
constexpr size_t MiB = 1024ull * 1024ull;
constexpr size_t OFF_PM = 0, OFF_PR = 128 * MiB, OFF_PG = 240 * MiB, OFF_XN = 368 * MiB, OFF_WINT = 432 * MiB, OFF_WTS = 478 * MiB;
constexpr size_t OFF_PMT = OFF_WTS, OFF_PRT = OFF_WTS + 4 * MiB, OFF_WOT = OFF_WTS + 8 * MiB, OFF_WQT = OFF_WTS + 16 * MiB, OFF_WAT = OFF_WTS + 24 * MiB,
                 OFF_G2T = OFF_WTS + 25 * MiB, OFF_SUBK = OFF_WTS + 25 * MiB + 512 * 1024, WS_NEED = OFF_WTS + 26 * MiB;
constexpr size_t OFF_YM = OFF_XN, OFF_YR = OFF_XN + 32 * MiB, OFF_Q = OFF_XN, OFF_XN2 = OFF_PR, OFF_PU = OFF_PM, OFF_PV = OFF_PM + 32 * MiB,
                 OFF_SCU = OFF_SUBK + 64 * 1024, OFF_SCV = OFF_SCU + 64 * 1024;
constexpr size_t DO_WLOG = 0, DO_AG = 32 * MiB, DO_GG = 64 * MiB, DO_ALORA = 96 * MiB;
constexpr int LDS_BYTES = 150528;

struct KP {
    const float *x, *g_mix, *w_in, *conv_w, *b_i, *b_f, *mu, *w0, *w2, *a0, *a2, *g2, *k_k, *k_a, *r_k, *ln_w, *ln_b, *proj_m, *proj_r, *w_out, *g_ffn,
        *w_query, *sub_keys, *peer_u, *peer_v, *g_final;
    float* out; unsigned char* ws;
};

typedef __bf16 bf16x2_t __attribute__((ext_vector_type(2)));
typedef float f32x2_t __attribute__((ext_vector_type(2)));
__device__ __forceinline__ unsigned cvt_pk_bf16(float lo, float hi) { f32x2_t v = {lo, hi}; bf16x2_t b = __builtin_convertvector(v, bf16x2_t); return __builtin_bit_cast(unsigned, b); }
__device__ __forceinline__ bf16_t f2bf(float f) { return (bf16_t)(cvt_pk_bf16(f, 0.f) & 0xffffu); }
__device__ __forceinline__ float bf2f(bf16_t h) { return __uint_as_float((unsigned)h << 16); }
__device__ __forceinline__ float bflo(unsigned u) { return __uint_as_float(u << 16); }
__device__ __forceinline__ float bfhi(unsigned u) { return __uint_as_float(u & 0xffff0000u); }
__device__ __forceinline__ float sigm(float x) { return __builtin_amdgcn_rcpf(1.f + __expf(-x)); }
template <int CTRL> __device__ __forceinline__ float dppf(float v) { return __builtin_bit_cast(float, __builtin_amdgcn_update_dpp(0, __builtin_bit_cast(int, v), CTRL, 0xF, 0xF, true)); }
template <int CTRL> __device__ __forceinline__ unsigned dppu(unsigned v) { return (unsigned)__builtin_amdgcn_update_dpp(0, (int)v, CTRL, 0xF, 0xF, true); }
__device__ __forceinline__ float red4(float v) { v += dppf<0xB1>(v); v += dppf<0x4E>(v); return v; }
__device__ __forceinline__ float red8(float v) { v = red4(v); v += dppf<0x141>(v); return v; }
__device__ __forceinline__ float red16(float v) { v = red8(v); v += dppf<0x140>(v); return v; }
__device__ __forceinline__ float rlane(float v, int l) { return __builtin_bit_cast(float, __builtin_amdgcn_readlane(__builtin_bit_cast(int, v), l)); }
__device__ __forceinline__ float wave_sum(float v) { v = red16(v); return rlane(v, 0) + rlane(v, 16) + rlane(v, 32) + rlane(v, 48); }
__device__ __forceinline__ unsigned wave_max_u32(unsigned v) {
    v = max(v, dppu<0xB1>(v)); v = max(v, dppu<0x4E>(v)); v = max(v, dppu<0x141>(v)); v = max(v, dppu<0x140>(v));
    unsigned a = (unsigned)__builtin_amdgcn_readlane((int)v, 0), b = (unsigned)__builtin_amdgcn_readlane((int)v, 16), c = (unsigned)__builtin_amdgcn_readlane((int)v, 32), d = (unsigned)__builtin_amdgcn_readlane((int)v, 48);
    return max(max(a, b), max(c, d));
}
__device__ __forceinline__ unsigned ordf(float f) { unsigned u = __float_as_uint(f); return (u & 0x80000000u) ? ~u : (u | 0x80000000u); }
__device__ __forceinline__ float unordf(unsigned k) { return __uint_as_float((k & 0x80000000u) ? (k ^ 0x80000000u) : ~k); }

__device__ __forceinline__ int tid_l() { int t = threadIdx.x; asm volatile("" : "+v"(t)); return t; }
template <class T> __device__ __forceinline__ T* lp(T* q) { asm volatile("" : "+s"(q)); return q; }
namespace pg8 {
constexpr int BM = 256, BK = 64, HALF = 128, HTB = HALF * BK * 2, STAGE_BYTES = 8 * HTB, NXCD = 8, WGM = 8;
__device__ __forceinline__ int lds_byte(int r, int c) { const int st = (r >> 4) * 2 + (c >> 5), rr = r & 15, cc = c & 31, ob = rr * 64 + cc * 2; return st * 1024 + (ob ^ (((ob >> 9) & 1) << 5)); }
__device__ __forceinline__ void stage_rc(int b, int& R, int& C) { const int st = b / 1024, sb = b % 1024, swz = sb ^ (((sb >> 9) & 1) << 5); R = (st >> 1) * 16 + swz / 64; C = (st & 1) * 32 + (swz % 64) / 2; }
__device__ __forceinline__ int perm32(int rho) { const int n = rho >> 4, i = rho & 15; return 8 * (i >> 2) + 4 * n + (i & 3); }
struct Unit { int pm, pn; };
struct Gemm { const bf16_t* A; const bf16_t* Bt; int M, N, K, lda, ldb; };
struct StaticOrder {
    int nM, nN, nwg, G, c;
    __device__ void init(int M, int N, int G_, int c_) { nM = M / BM; nN = N / BM; nwg = nM * nN; G = G_; c = c_; }
    __device__ bool next(int i, Unit& u) const {
        const long L = (long)i * G + c; if (L >= nwg) return false;
        int wgid = (int)L; { const int q = nwg / NXCD, r = nwg % NXCD, xcd = wgid % NXCD, off = wgid / NXCD; wgid = (xcd < r ? xcd * (q + 1) : r * (q + 1) + (xcd - r) * q) + off; }
        const int nig = WGM * nN, gid = wgid / nig, fm = gid * WGM, gsz = (nM - fm) < WGM ? (nM - fm) : WGM;
        u.pm = fm + ((wgid % nig) % gsz); u.pn = (wgid % nig) / gsz; return true;
    }
};

__device__ __forceinline__ void store8(bf16_t* p, f32x4 v0, f32x4 v1) {
    u32x4 w; w.x = cvt_pk_bf16(v0[0], v0[1]); w.y = cvt_pk_bf16(v0[2], v0[3]); w.z = cvt_pk_bf16(v1[0], v1[1]); w.w = cvt_pk_bf16(v1[2], v1[3]); *(u32x4*)p = w;
}
__device__ __forceinline__ void load8(const bf16_t* p, f32x4& v0, f32x4& v1) {
    const u32x4 w = *(const u32x4*)p; v0 = (f32x4){bflo(w.x), bfhi(w.x), bflo(w.y), bfhi(w.y)}; v1 = (f32x4){bflo(w.z), bfhi(w.z), bflo(w.w), bfhi(w.w)};
}

template <int mode> struct Epi {
    static constexpr bool PERM = true;
    unsigned char* ws; unsigned char* dob; const float* x; const float* w0; const float* a0;
    __device__ __forceinline__ void operator()(const f32x4 (&acc)[2][2][4][2], const Unit& u, int wr, int wc, int fr, int fq) const {
        const int row0 = u.pm * BM + wr * 64 + fr, cb = u.pn * BM + wc * 32 + 8 * fq;
#pragma unroll
        for (int ai = 0; ai < 2; ++ai)
#pragma unroll
            for (int m = 0; m < 4; ++m) {
                const size_t row = (size_t)(row0 + ai * HALF + m * 16);
#pragma unroll
                for (int bj = 0; bj < 2; ++bj) {
                    const int col = cb + bj * HALF;
                    f32x4 v0 = acc[ai][bj][m][0], v1 = acc[ai][bj][m][1];
                    if (mode == 0) {
                        if (col < 4096) store8((bf16_t*)(ws + OFF_PM) + row * LDPM + col, v0, v1);
                        else if (col < 7680) store8((bf16_t*)(ws + OFF_PR) + row * LDPR + (col - 4096), v0, v1);
                        else {
#pragma unroll
                            for (int j = 0; j < 4; ++j) { v0[j] = sigm(v0[j]); v1[j] = sigm(v1[j]); }
                            store8((bf16_t*)(ws + OFF_PG) + row * LDPG + (col - 7680), v0, v1);
                        }
                    } else if (mode == 1) {
                        if (col < 1024) {
                            const f32x4 b0 = *(const f32x4*)(w0 + col), b1 = *(const f32x4*)(w0 + col + 4);
#pragma unroll
                            for (int j = 0; j < 4; ++j) {
                                float z = -(b0[j] + v0[j]); float sp = fmaxf(z, 0.f) + __logf(1.f + __expf(-fabsf(z))); v0[j] = -__expf(-sp - 0.5f);
                                z = -(b1[j] + v1[j]); sp = fmaxf(z, 0.f) + __logf(1.f + __expf(-fabsf(z))); v1[j] = -__expf(-sp - 0.5f);
                            }
                            store8((bf16_t*)(dob + DO_WLOG) + row * 1024 + col, v0, v1);
                        } else {
                            const int c2 = col - 1024;
                            const f32x4 b0 = *(const f32x4*)(a0 + c2), b1 = *(const f32x4*)(a0 + c2 + 4);
#pragma unroll
                            for (int j = 0; j < 4; ++j) { v0[j] = sigm(b0[j] + v0[j]); v1[j] = sigm(b1[j] + v1[j]); }
                            store8((bf16_t*)(dob + DO_AG) + row * 1024 + c2, v0, v1);
                        }
                    } else if (mode == 2) {
                        store8((bf16_t*)(dob + DO_GG) + row * 1024 + col, v0, v1);
                    } else if (mode == 3) {
                        bf16_t* pp = (bf16_t*)(ws + OFF_PG) + row * LDPG + col; f32x4 g0, g1; load8(pp, g0, g1);
                        store8(pp, g0 * v0, g1 * v1);
                    } else if (mode == 4) {
                        bf16_t* pp = (bf16_t*)(ws + OFF_PG) + row * LDPG + col; f32x4 m0, m1, g0, g1; load8(pp, m0, m1); load8(pp + 2048, g0, g1);
                        store8(pp, m0 + g0 * v0, m1 + g1 * v1);
                    } else if (mode == 5) {
                        const float* xp = x + row * DM + col; float* op = (float*)dob + row * DM + col;
                        const f32x4 x0 = *(const f32x4*)xp, x1 = *(const f32x4*)(xp + 4);
                        *(f32x4*)op = x0 + v0; *(f32x4*)(op + 4) = x1 + v1;
                    } else {
                        store8((bf16_t*)(ws + OFF_Q) + row * DM + col, v0, v1);
                    }
                    asm volatile("" ::: "memory");
                }
            }
    }
};

template <class EpiT> __device__ __forceinline__ void gemm_phase(LAS unsigned char* lds, const Gemm g, const StaticOrder& S, const EpiT& E) {
    const int tid = tid_l(), wid = __builtin_amdgcn_readfirstlane(tid >> 6), lane = tid & 63, wr = wid >> 2, wc = wid & 3, fr = lane & 15, fq = lane >> 4;
    const int K = g.K, nt = K / BK;
    unsigned voffA[2], voffB[2];
#pragma unroll
    for (int i = 0; i < 2; ++i) { int R, C; stage_rc(tid * 16 + i * 8192, R, C); const int Rb = (R & ~31) + perm32(R & 31);
        voffA[i] = (unsigned)(R * g.lda + C) * 2u; voffB[i] = (unsigned)(Rb * g.ldb + C) * 2u; }
    const size_t kstep = (size_t)(BK * 2);
    const size_t hstepA = (size_t)HALF * g.lda * 2, hstepB = (size_t)HALF * g.ldb * 2;
    const size_t tstepA = 2 * hstepA, tstepB = 2 * hstepB;
    const unsigned ldsw = (unsigned)wid * 1024u;
    const int aoff = lds_byte(wr * 64 + fr, fq * 8), boff = lds_byte(wc * 32 + fr, fq * 8);
#define PG8_SA(b, h) (((b) * 2 + (h)) * HTB)
#define PG8_SB(b, h) ((4 + (b) * 2 + (h)) * HTB)
#define PG8_STAGE(bufoff, gbase, voff) do { _Pragma("unroll") for (int _i = 0; _i < 2; ++_i) \
        __builtin_amdgcn_global_load_lds((const unsigned*)((const char*)(gbase) + (voff)[_i]), (LAS unsigned*)(lds + (bufoff) + ldsw + _i * 8192), 16, 0, 0); } while (0)
#define PG8_LDA(dst, b, h) do { _Pragma("unroll") for (int m = 0; m < 4; ++m) _Pragma("unroll") for (int k = 0; k < 2; ++k) dst[m][k] = *(const LAS bf16x8*)(lds + PG8_SA(b, h) + aoff + m * 2048 + k * 1024); } while (0)
#define PG8_LDB(dst, b, h) do { _Pragma("unroll") for (int n = 0; n < 2; ++n) _Pragma("unroll") for (int k = 0; k < 2; ++k) dst[n][k] = *(const LAS bf16x8*)(lds + PG8_SB(b, h) + boff + n * 2048 + k * 1024); } while (0)
#define PG8_MMA(ai, bj, At, Bt) do { __builtin_amdgcn_s_setprio(1); _Pragma("unroll") for (int m = 0; m < 4; ++m) _Pragma("unroll") for (int n = 0; n < 2; ++n) _Pragma("unroll") for (int k = 0; k < 2; ++k) \
        acc[ai][bj][m][n] = __builtin_amdgcn_mfma_f32_16x16x32_bf16(Bt[n][k], At[m][k], acc[ai][bj][m][n], 0, 0, 0); __builtin_amdgcn_s_setprio(0); } while (0)
#define PG8_WAIT_V(n) asm volatile("s_waitcnt vmcnt(" #n ")" ::: "memory")
#define PG8_WAIT_L(n) asm volatile("s_waitcnt lgkmcnt(" #n ")" ::: "memory")
#define PG8_BAR __builtin_amdgcn_s_barrier()
#define PG8_SCHED __builtin_amdgcn_sched_barrier(0)
    Unit cur, nxt; int ui = 0;
    if (!S.next(0, cur)) return;
    f32x4 acc[2][2][4][2];
#pragma unroll
    for (int a = 0; a < 2; ++a)
#pragma unroll
        for (int b = 0; b < 2; ++b)
#pragma unroll
            for (int m = 0; m < 4; ++m)
#pragma unroll
                for (int n = 0; n < 2; ++n) acc[a][b][m][n] = (f32x4){0.f, 0.f, 0.f, 0.f};
    bf16x8 At[4][2], B0[2][2], B1[2][2];
    const char* cA = (const char*)g.A + (size_t)cur.pm * tstepA; const char* cB = (const char*)g.Bt + (size_t)cur.pn * tstepB;
    PG8_STAGE(PG8_SB(0, 0), cB, voffB); PG8_STAGE(PG8_SA(0, 0), cA, voffA); PG8_STAGE(PG8_SB(0, 1), cB + hstepB, voffB); PG8_STAGE(PG8_SA(0, 1), cA + hstepA, voffA);
    if (wr == 1) PG8_BAR;
    PG8_WAIT_V(4); PG8_BAR;
    PG8_STAGE(PG8_SB(1, 0), cB + kstep, voffB); PG8_STAGE(PG8_SA(1, 0), cA + kstep, voffA); PG8_STAGE(PG8_SB(1, 1), cB + hstepB + kstep, voffB);
    PG8_WAIT_V(6); PG8_BAR;
    for (;;) {
        const bool has_next = S.next(ui + 1, nxt);
        const char* nA = has_next ? (const char*)g.A + (size_t)nxt.pm * tstepA : cA; const char* nB = has_next ? (const char*)g.Bt + (size_t)nxt.pn * tstepB : cB;
        for (int t = 0; t < nt; t += 2) {
            const bool last = (t == nt - 2);
            const char* a1 = cA + (size_t)(t + 1) * kstep;
            const char* a2 = last ? nA : cA + (size_t)(t + 2) * kstep; const char* b2 = last ? nB : cB + (size_t)(t + 2) * kstep;
            const char* a3 = a2 + kstep; const char* b3 = b2 + kstep;
            PG8_LDB(B0, 0, 0); PG8_SCHED; PG8_LDA(At, 0, 0); PG8_STAGE(PG8_SA(1, 1), a1 + hstepA, voffA);
            PG8_WAIT_L(8); PG8_BAR; PG8_WAIT_L(0); PG8_MMA(0, 0, At, B0); PG8_BAR; PG8_SCHED;
            PG8_LDB(B1, 0, 1); PG8_STAGE(PG8_SB(0, 0), b2, voffB);
            PG8_BAR; PG8_WAIT_L(0); PG8_MMA(0, 1, At, B1); PG8_BAR;
            PG8_LDA(At, 0, 1); PG8_STAGE(PG8_SA(0, 0), a2, voffA);
            PG8_BAR; PG8_WAIT_L(0); PG8_MMA(1, 0, At, B0); PG8_BAR; PG8_SCHED;
            PG8_STAGE(PG8_SB(0, 1), b2 + hstepB, voffB);
            PG8_WAIT_V(6); PG8_BAR; PG8_MMA(1, 1, At, B1); PG8_BAR;
            PG8_LDB(B0, 1, 0); PG8_SCHED; PG8_LDA(At, 1, 0); PG8_STAGE(PG8_SA(0, 1), a2 + hstepA, voffA);
            PG8_WAIT_L(8); PG8_BAR; PG8_WAIT_L(0); PG8_MMA(0, 0, At, B0); PG8_BAR; PG8_SCHED;
            PG8_LDB(B1, 1, 1); PG8_STAGE(PG8_SB(1, 0), b3, voffB);
            PG8_BAR; PG8_WAIT_L(0); PG8_MMA(0, 1, At, B1); PG8_BAR;
            PG8_LDA(At, 1, 1); PG8_STAGE(PG8_SA(1, 0), a3, voffA);
            PG8_BAR; PG8_WAIT_L(0); PG8_MMA(1, 0, At, B0); PG8_BAR; PG8_SCHED;
            PG8_STAGE(PG8_SB(1, 1), b3 + hstepB, voffB);
            PG8_WAIT_V(6); PG8_BAR; PG8_MMA(1, 1, At, B1); PG8_BAR;
        }
        E(acc, cur, wr, wc, fr, fq);
        if (!has_next) break;
#pragma unroll
        for (int a = 0; a < 2; ++a)
#pragma unroll
            for (int b = 0; b < 2; ++b)
#pragma unroll
                for (int m = 0; m < 4; ++m)
#pragma unroll
                    for (int n = 0; n < 2; ++n) acc[a][b][m][n] = (f32x4){0.f, 0.f, 0.f, 0.f};
        cur = nxt; cA = nA; cB = nB; ++ui;
    }
    PG8_WAIT_V(0);
    if (wr == 0) PG8_BAR;
    PG8_BAR;
#undef PG8_SA
#undef PG8_SB
#undef PG8_STAGE
#undef PG8_LDA
#undef PG8_LDB
#undef PG8_MMA
#undef PG8_WAIT_V
#undef PG8_WAIT_L
#undef PG8_BAR
#undef PG8_SCHED
}
}

__device__ __forceinline__ void rmsnorm_rows(const float* src, const float* gain, bf16_t* dst, int gw, int nw, int lane) {
    for (int row = gw; row < NT; row += nw) {
        const f32x4* s = (const f32x4*)(src + (size_t)row * DM);
        f32x4 v[8]; float ss = 0.f;
#pragma unroll
        for (int i = 0; i < 8; ++i) { v[i] = s[i * 64 + lane]; ss += v[i][0] * v[i][0] + v[i][1] * v[i][1] + v[i][2] * v[i][2] + v[i][3] * v[i][3]; }
        ss = wave_sum(ss);
        const float r = rsqrtf(ss * (1.f / DM) + 1e-6f);
        u32x2* d = (u32x2*)(dst + (size_t)row * DM);
#pragma unroll
        for (int i = 0; i < 8; ++i) { const f32x4 gg = ((const f32x4*)gain)[i * 64 + lane]; u32x2 o; o.x = cvt_pk_bf16(v[i][0] * r * gg[0], v[i][1] * r * gg[1]); o.y = cvt_pk_bf16(v[i][2] * r * gg[2], v[i][3] * r * gg[3]); d[i * 64 + lane] = o; }
    }
}

__device__ __forceinline__ void tr_tile(const float* src, int ld, int c0, int nvalid, int k0, bf16_t* dst, int ldd, int r0, int kd0, LAS float* tile) {
    const int tid = tid_l();
#pragma unroll
    for (int i = 0; i < 2; ++i) {
        const int k = (tid >> 4) + 32 * i, c4 = (tid & 15) * 4;
        f32x4 v = (f32x4){0.f, 0.f, 0.f, 0.f};
        if (c4 < nvalid) v = *(const f32x4*)(src + (size_t)(k0 + k) * ld + c0 + c4);
        tile[k * 65 + c4] = v[0]; tile[k * 65 + c4 + 1] = v[1]; tile[k * 65 + c4 + 2] = v[2]; tile[k * 65 + c4 + 3] = v[3];
    }
    __syncthreads();
    {
        const int c = tid >> 3, k8 = (tid & 7) * 8;
        float f[8];
#pragma unroll
        for (int j = 0; j < 8; ++j) f[j] = tile[(k8 + j) * 65 + c];
        u32x4 w; w.x = cvt_pk_bf16(f[0], f[1]); w.y = cvt_pk_bf16(f[2], f[3]); w.z = cvt_pk_bf16(f[4], f[5]); w.w = cvt_pk_bf16(f[6], f[7]);
        *(u32x4*)(dst + (size_t)(r0 + c) * ldd + kd0 + k8) = w;
    }
    __syncthreads();
}

__device__ void phase_prep(const KP& p, LAS unsigned char* lds) {
    const int tid = tid_l(), lane = tid & 63, G = gridDim.x, bid = blockIdx.x;
    unsigned char* ws = p.ws;
    rmsnorm_rows(p.x, p.g_mix, (bf16_t*)(ws + OFF_XN), bid * 8 + (tid >> 6), G * 8, lane);
    LAS float* tile = (LAS float*)lds;
    for (int j = bid; j < 8960; j += G) {
        if (j < 5888) {
            const int rt = j >> 5, kt = j & 31; int c0, nv = 64;
            if (rt < 64) c0 = 64 * rt; else if (rt < 119) c0 = 4104 + 64 * (rt - 64); else if (rt == 119) { c0 = 4096; nv = 8; } else c0 = 7624 + 64 * (rt - 120);
            tr_tile(p.w_in, 11720, c0, nv, kt * 64, (bf16_t*)(ws + OFF_WINT), 2048, rt * 64, kt * 64, tile);
        } else if (j < 6400) { const int q = j - 5888, rt = q >> 4, kt = q & 15; tr_tile(p.proj_m, 2048, rt * 64, 64, kt * 64, (bf16_t*)(ws + OFF_PMT), 1024, rt * 64, kt * 64, tile); }
        else if (j < 6912) { const int q = j - 6400, rt = q >> 4, kt = q & 15; tr_tile(p.proj_r, 2048, rt * 64, 64, kt * 64, (bf16_t*)(ws + OFF_PRT), 1024, rt * 64, kt * 64, tile); }
        else if (j < 7936) { const int q = j - 6912, rt = q >> 5, kt = q & 31; tr_tile(p.w_out, 2048, rt * 64, 64, kt * 64, (bf16_t*)(ws + OFF_WOT), 2048, rt * 64, kt * 64, tile); }
        else { const int q = j - 7936, rt = q >> 5, kt = q & 31; tr_tile(p.w_query, 2048, rt * 64, 64, kt * 64, (bf16_t*)(ws + OFF_WQT), 2048, rt * 64, kt * 64, tile); }
    }
    const int gt = bid * 512 + tid, gn = G * 512;
    bf16_t* WAT = (bf16_t*)(ws + OFF_WAT);
    for (int i = gt; i < 2048 * 256; i += gn) { const int r = i >> 8, k = i & 255; float v = 0.f;
        if (r < 1024) { if (k < 96) v = p.w2[k * 1024 + r]; } else { if (k >= 96 && k < 192) v = p.a2[(k - 96) * 1024 + (r - 1024)]; }
        WAT[i] = f2bf(v); }
    bf16_t* G2T = (bf16_t*)(ws + OFF_G2T);
    for (int i = gt; i < 1024 * 256; i += gn) { const int r = i >> 8, k = i & 255; G2T[i] = f2bf(p.g2[k * 1024 + r]); }
    bf16_t* SK = (bf16_t*)(ws + OFF_SUBK);
    for (int i = gt; i < 2 * 128 * 128; i += gn) SK[i] = f2bf(p.sub_keys[i]);
}

__device__ void phase_lora_prep(const KP& p) {
    const bf16_t* PR = (const bf16_t*)(p.ws + OFF_PR);
    bf16_t* AL = (bf16_t*)((unsigned char*)p.out + DO_ALORA);
    const int gt = blockIdx.x * 512 + threadIdx.x, gn = gridDim.x * 512;
    for (int i = gt; i < NT * 64; i += gn) {
        const int tok = i >> 6, g = i & 63;
        u32x4 o = (u32x4){0u, 0u, 0u, 0u};
        if (g < 24 || g >= 32) {
            const int sc = (g < 24) ? (3072 + 8 * g) : (3264 + 8 * (g - 32));
            const u32x4 cu = *(const u32x4*)(PR + (size_t)tok * LDPR + sc);
            u32x4 pv = (u32x4){0u, 0u, 0u, 0u};
            if ((tok & (SEQ - 1)) != 0) pv = *(const u32x4*)(PR + (size_t)(tok - 1) * LDPR + sc);
            const f32x4 m0 = *(const f32x4*)(p.mu + sc), m1 = *(const f32x4*)(p.mu + sc + 4);
            float f[8];
#pragma unroll
            for (int q = 0; q < 4; ++q) {
                const float c0 = bflo(cu[q]), c1 = bfhi(cu[q]), p0 = bflo(pv[q]), p1 = bfhi(pv[q]);
                const float mm0 = (q < 2) ? m0[2 * q] : m1[2 * q - 4], mm1 = (q < 2) ? m0[2 * q + 1] : m1[2 * q - 3];
                f[2 * q] = c0 + (p0 - c0) * mm0; f[2 * q + 1] = c1 + (p1 - c1) * mm1;
            }
            if (g < 12) {
#pragma unroll
                for (int q = 0; q < 8; ++q) f[q] = tanhf(f[q]);
            } else if (g >= 32) {
#pragma unroll
                for (int q = 0; q < 8; ++q) f[q] = sigm(f[q]);
            }
            o.x = cvt_pk_bf16(f[0], f[1]); o.y = cvt_pk_bf16(f[2], f[3]); o.z = cvt_pk_bf16(f[4], f[5]); o.w = cvt_pk_bf16(f[6], f[7]);
        }
        *(u32x4*)(AL + (size_t)tok * 512 + 8 * g) = o;
    }
}

__device__ void rwkv_scan(const KP& p, int bh, LAS unsigned char* lds) {
    const int tid = tid_l();
    const int b = bh >> 4, h = bh & 15;
    LAS float* sR = (LAS float*)lds; LAS float* sW = sR + 2048; LAS float* sK = sW + 2048; LAS float* sV = sK + 2048; LAS float* sA = sV + 2048; LAS float* sB = sA + 2048; LAS float* sY = sB + 2048;
    const bf16_t* PR = (const bf16_t*)(p.ws + OFF_PR);
    const bf16_t* WLOG = (const bf16_t*)((const unsigned char*)p.out + DO_WLOG);
    const bf16_t* AG = (const bf16_t*)((const unsigned char*)p.out + DO_AG);
    const bf16_t* GG = (const bf16_t*)((const unsigned char*)p.out + DO_GG);
    bf16_t* YR = (bf16_t*)(p.ws + OFF_YR);
    const int tt = tid >> 4, cg4 = (tid & 15) * 4, ch = h * 64 + cg4;
    const f32x4 mur = *(const f32x4*)(p.mu + ch), muk = *(const f32x4*)(p.mu + 1024 + ch), muv = *(const f32x4*)(p.mu + 2048 + ch);
    const f32x4 kkc = *(const f32x4*)(p.k_k + ch), kac = *(const f32x4*)(p.k_a + ch), rkc = *(const f32x4*)(p.r_k + ch), lnw = *(const f32x4*)(p.ln_w + ch), lnb = *(const f32x4*)(p.ln_b + ch);
    const int row = tid >> 3, j8 = (tid & 7) * 8;
    float S[8];
#pragma unroll
    for (int k = 0; k < 8; ++k) S[k] = 0.f;
    const size_t tokbase = (size_t)b * SEQ;
    u32x2 r2, k2, v2, pr2, pk2, pv2, w2, a2;
#define RW_LOAD(c) do { const int t_ = (c) * 32 + tt; const size_t tok_ = tokbase + t_; const bf16_t* pr_ = PR + tok_ * LDPR + ch; \
        r2 = *(const u32x2*)pr_; k2 = *(const u32x2*)(pr_ + 1024); v2 = *(const u32x2*)(pr_ + 2048); \
        if (t_ > 0) { pr2 = *(const u32x2*)(pr_ - LDPR); pk2 = *(const u32x2*)(pr_ - LDPR + 1024); pv2 = *(const u32x2*)(pr_ - LDPR + 2048); } else { pr2 = (u32x2){0u, 0u}; pk2 = pr2; pv2 = pr2; } \
        w2 = *(const u32x2*)(WLOG + tok_ * 1024 + ch); a2 = *(const u32x2*)(AG + tok_ * 1024 + ch); } while (0)
    RW_LOAD(0);
    for (int c = 0; c < 128; ++c) {
        {
            f32x4 r, k, v, pr, pk, pv, wl, a;
            r = (f32x4){bflo(r2.x), bfhi(r2.x), bflo(r2.y), bfhi(r2.y)}; k = (f32x4){bflo(k2.x), bfhi(k2.x), bflo(k2.y), bfhi(k2.y)}; v = (f32x4){bflo(v2.x), bfhi(v2.x), bflo(v2.y), bfhi(v2.y)};
            pr = (f32x4){bflo(pr2.x), bfhi(pr2.x), bflo(pr2.y), bfhi(pr2.y)}; pk = (f32x4){bflo(pk2.x), bfhi(pk2.x), bflo(pk2.y), bfhi(pk2.y)}; pv = (f32x4){bflo(pv2.x), bfhi(pv2.x), bflo(pv2.y), bfhi(pv2.y)};
            wl = (f32x4){bflo(w2.x), bfhi(w2.x), bflo(w2.y), bfhi(w2.y)}; a = (f32x4){bflo(a2.x), bfhi(a2.x), bflo(a2.y), bfhi(a2.y)};
            r = r + (pr - r) * mur; k = k + (pk - k) * muk; v = v + (pv - v) * muv;
            f32x4 kk = k * kkc;
            float n2 = kk[0] * kk[0] + kk[1] * kk[1] + kk[2] * kk[2] + kk[3] * kk[3];
            n2 = red16(n2);
            const float inv = 1.f / fmaxf(sqrtf(n2), 1e-12f);
            kk = kk * inv;
            const f32x4 k3 = k * (1.f + (a - 1.f) * kac);
            f32x4 dec; dec[0] = __expf(wl[0]); dec[1] = __expf(wl[1]); dec[2] = __expf(wl[2]); dec[3] = __expf(wl[3]);
            const int o = tt * 64 + cg4;
            *(LAS f32x4*)(sR + o) = r; *(LAS f32x4*)(sW + o) = dec; *(LAS f32x4*)(sK + o) = k3; *(LAS f32x4*)(sV + o) = v; *(LAS f32x4*)(sA + o) = -kk; *(LAS f32x4*)(sB + o) = kk * a;
        }
        __syncthreads();
        if (c + 1 < 128) RW_LOAD(c + 1);
#pragma unroll 2
        for (int s = 0; s < 32; ++s) {
            const f32x4 a0 = *(const LAS f32x4*)(sA + s * 64 + j8), a1 = *(const LAS f32x4*)(sA + s * 64 + j8 + 4);
            const f32x4 b0 = *(const LAS f32x4*)(sB + s * 64 + j8), b1 = *(const LAS f32x4*)(sB + s * 64 + j8 + 4);
            const f32x4 w0 = *(const LAS f32x4*)(sW + s * 64 + j8), w1 = *(const LAS f32x4*)(sW + s * 64 + j8 + 4);
            const f32x4 k0 = *(const LAS f32x4*)(sK + s * 64 + j8), k1 = *(const LAS f32x4*)(sK + s * 64 + j8 + 4);
            const f32x4 r0 = *(const LAS f32x4*)(sR + s * 64 + j8), r1 = *(const LAS f32x4*)(sR + s * 64 + j8 + 4);
            const float vv = sV[s * 64 + row];
            float sa = (S[0] * a0[0] + S[1] * a0[1]) + (S[2] * a0[2] + S[3] * a0[3]) + (S[4] * a1[0] + S[5] * a1[1]) + (S[6] * a1[2] + S[7] * a1[3]);
            sa = red8(sa);
#pragma unroll
            for (int q = 0; q < 4; ++q) { S[q] = S[q] * w0[q] + (sa * b0[q] + vv * k0[q]); S[4 + q] = S[4 + q] * w1[q] + (sa * b1[q] + vv * k1[q]); }
            float y = (S[0] * r0[0] + S[1] * r0[1]) + (S[2] * r0[2] + S[3] * r0[3]) + (S[4] * r1[0] + S[5] * r1[1]) + (S[6] * r1[2] + S[7] * r1[3]);
            y = red8(y);
            if ((tid & 7) == 0) sY[s * 64 + row] = y;
        }
        __syncthreads();
        {
            const int o = tt * 64 + cg4; const size_t tok = tokbase + c * 32 + tt;
            const f32x4 y = *(const LAS f32x4*)(sY + o), r = *(const LAS f32x4*)(sR + o), k3 = *(const LAS f32x4*)(sK + o), v = *(const LAS f32x4*)(sV + o);
            const u32x2 g2 = *(const u32x2*)(GG + tok * 1024 + ch);
            const float mean = red16(y[0] + y[1] + y[2] + y[3]) * (1.f / 64.f);
            const f32x4 d = y - mean;
            const float var = red16(d[0] * d[0] + d[1] * d[1] + d[2] * d[2] + d[3] * d[3]) * (1.f / 64.f);
            const float rs = rsqrtf(var + 64e-5f);
            const f32x4 rk3 = r * k3 * rkc;
            const float bon = red16(rk3[0] + rk3[1] + rk3[2] + rk3[3]);
            const f32x4 g = (f32x4){bflo(g2.x), bfhi(g2.x), bflo(g2.y), bfhi(g2.y)};
            const f32x4 res = (d * rs * lnw + lnb + bon * v) * g;
            u32x2 ov; ov.x = cvt_pk_bf16(res[0], res[1]); ov.y = cvt_pk_bf16(res[2], res[3]);
            *(u32x2*)(YR + tok * 1024 + ch) = ov;
        }
        __syncthreads();
    }
#undef RW_LOAD
}

__device__ __forceinline__ float bfel(const u32x4& w, int e) { const unsigned u = w[e >> 1]; return (e & 1) ? bfhi(u) : bflo(u); }
__device__ void mlstm_run(const KP& p, int item, LAS unsigned char* lds) {
    const int tid0 = tid_l();
    const int bh = item >> 3, b = bh >> 2, h = bh & 3, dv0 = (item & 7) * 32;
    const size_t tokbase = (size_t)b * SEQ;
    LAS bf16_t* Qs = (LAS bf16_t*)(lds + 0);
    LAS bf16_t* Ks = (LAS bf16_t*)(lds + 33792);
    LAS bf16_t* KTs = (LAS bf16_t*)(lds + 67584);
    LAS bf16_t* VTs = (LAS bf16_t*)(lds + 104448);
    LAS bf16_t* VWTs = (LAS bf16_t*)(lds + 109056);
    LAS bf16_t* Ss = (LAS bf16_t*)(lds + 113664);
    LAS bf16_t* CTs = (LAS bf16_t*)(lds + 122880);
    LAS float* CW = (LAS float*)(lds + 139776);
    LAS float* BC = (LAS float*)(lds + 147968);
    LAS float* IG = (LAS float*)(lds + 148224);
    LAS float* NV = (LAS float*)(lds + 148480);
    LAS float* QN = (LAS float*)(lds + 149504);
    LAS float* DP = (LAS float*)(lds + 149760);
    LAS float* WSV = (LAS float*)(lds + 150272);
    const bf16_t* PM = (const bf16_t*)(p.ws + OFF_PM);
    const bf16_t* PR = (const bf16_t*)(p.ws + OFF_PR);
    bf16_t* YM = (bf16_t*)(p.ws + OFF_YM);
    for (int i = tid0; i < 2048; i += 512) { const int j = i >> 9, cc = i & 511; const int qk = cc < 256 ? h * 256 + cc : 1024 + h * 256 + (cc - 256); CW[i] = p.conv_w[j * 2048 + qk]; }
    if (tid0 < 256) NV[tid0] = 0.f;
    for (int i = tid0; i < 32 * 264 / 2; i += 512) ((LAS unsigned*)CTs)[i] = 0u;
    f32x4 cacc[4];
#pragma unroll
    for (int i = 0; i < 4; ++i) cacc[i] = (f32x4){0.f, 0.f, 0.f, 0.f};
    const float bi = p.b_i[h], bff = p.b_f[h];
    u32x4 raw[11];
#define ML_LOAD(c, TID) do { const int rg_ = (TID) >> 6, cg_ = (TID) & 63; const int pmcol_ = (cg_ < 32) ? (h * 256 + 8 * cg_) : (1024 + h * 256 + 8 * (cg_ - 32)); \
        const bf16_t* base_ = PM + (tokbase + (c) * 64 + 8 * rg_) * LDPM + pmcol_; \
        _Pragma("unroll") for (int i_ = 0; i_ < 11; ++i_) { const int t_ = (c) * 64 + 8 * rg_ - 3 + i_; const bool neg_ = t_ < 0; \
        u32x4 v_ = *(const u32x4*)(base_ + (neg_ ? 0 : (i_ - 3) * LDPM)); if (neg_) v_ = (u32x4){0u, 0u, 0u, 0u}; raw[i_] = v_; } } while (0)
    ML_LOAD(0, tid0);
    __syncthreads();
    for (int c = 0; c < 64; ++c) {
        const int t0 = c * 64;
        int tid = tid0; asm volatile("" : "+v"(tid));
        const int lane = tid & 63, w = tid >> 6, fr = lane & 15, fq = lane >> 4, rg = tid >> 6, cg = lane;
        {
            float cwv[4][8];
#pragma unroll
            for (int j = 0; j < 4; ++j) { const f32x4 x0 = *(const LAS f32x4*)(CW + j * 512 + cg * 8), x1 = *(const LAS f32x4*)(CW + j * 512 + cg * 8 + 4);
                cwv[j][0] = x0[0]; cwv[j][1] = x0[1]; cwv[j][2] = x0[2]; cwv[j][3] = x0[3]; cwv[j][4] = x1[0]; cwv[j][5] = x1[1]; cwv[j][6] = x1[2]; cwv[j][7] = x1[3]; }
#pragma unroll
            for (int r = 0; r < 8; ++r) {
                float o[8];
#pragma unroll
                for (int e = 0; e < 8; ++e) {
                    float s = cwv[0][e] * bfel(raw[r], e) + cwv[1][e] * bfel(raw[r + 1], e) + cwv[2][e] * bfel(raw[r + 2], e) + cwv[3][e] * bfel(raw[r + 3], e);
                    s = s * sigm(s);
                    o[e] = (cg < 32) ? s * 0.0625f : s;
                }
                u32x4 pk; pk.x = cvt_pk_bf16(o[0], o[1]); pk.y = cvt_pk_bf16(o[2], o[3]); pk.z = cvt_pk_bf16(o[4], o[5]); pk.w = cvt_pk_bf16(o[6], o[7]);
                if (cg < 32) *(LAS u32x4*)(Qs + (8 * rg + r) * 264 + 8 * cg) = pk;
                else {
                    *(LAS u32x4*)(Ks + (8 * rg + r) * 264 + 8 * (cg - 32)) = pk;
#pragma unroll
                    for (int e = 0; e < 8; ++e) KTs[(8 * (cg - 32) + e) * 72 + 8 * rg + r] = (bf16_t)((e & 1) ? (pk[e >> 1] >> 16) : (pk[e >> 1] & 0xffffu));
                }
            }
        }
        if (w == 0) {
            const size_t tok = tokbase + t0 + lane;
            const float iv = bf2f(PR[tok * LDPR + 3520 + h]) + bi, fv = bf2f(PR[tok * LDPR + 3524 + h]) + bff;
            float lf = fminf(fv, 0.f) - __logf(1.f + __expf(-fabsf(fv)));
#pragma unroll
            for (int d = 1; d < 64; d <<= 1) { const float y = __shfl_up(lf, d); if (lane >= d) lf += y; }
            BC[lane] = lf; IG[lane] = iv;
        }
        asm volatile("" ::: "memory");
        if (c + 1 < 64) ML_LOAD(c + 1, tid);
        asm volatile("" ::: "memory");
        u32x4 vraw = (u32x4){0u, 0u, 0u, 0u};
        if (tid < 256) vraw = *(const u32x4*)(PM + (tokbase + t0 + (tid >> 2)) * LDPM + 2048 + h * 256 + dv0 + 8 * (tid & 3));
        __syncthreads();
        if (tid < 256) {
            const int s = tid >> 2, g = tid & 3;
            const float wsv = __expf(BC[63] - BC[s] + IG[s]);
            if (g == 0) WSV[s] = wsv;
#pragma unroll
            for (int e = 0; e < 8; ++e) { const float vv = bfel(vraw, e); VTs[(8 * g + e) * 72 + s] = f2bf(vv); VWTs[(8 * g + e) * 72 + s] = f2bf(vv * wsv); }
        }
        {
            const int mt = w >> 1, ntb = (w & 1) * 2;
            f32x4 s0 = (f32x4){0.f, 0.f, 0.f, 0.f}, s1 = s0;
#pragma unroll
            for (int ks = 0; ks < 8; ++ks) {
                const bf16x8 a = *(const LAS bf16x8*)(Qs + (16 * mt + fr) * 264 + 32 * ks + 8 * fq);
                const bf16x8 b0 = *(const LAS bf16x8*)(Ks + (16 * ntb + fr) * 264 + 32 * ks + 8 * fq);
                const bf16x8 b1 = *(const LAS bf16x8*)(Ks + (16 * (ntb + 1) + fr) * 264 + 32 * ks + 8 * fq);
                s0 = __builtin_amdgcn_mfma_f32_16x16x32_bf16(a, b0, s0, 0, 0, 0);
                s1 = __builtin_amdgcn_mfma_f32_16x16x32_bf16(a, b1, s1, 0, 0, 0);
            }
            const int sA = 16 * ntb + fr, sB = sA + 16;
            const float gA = IG[sA] - BC[sA], gB = IG[sB] - BC[sB];
#pragma unroll
            for (int j = 0; j < 4; ++j) {
                const int t = 16 * mt + 4 * fq + j; const float bt = BC[t];
                const float vA = (sA <= t) ? s0[j] * __expf(bt + gA) : 0.f, vB = (sB <= t) ? s1[j] * __expf(bt + gB) : 0.f;
                Ss[t * 72 + sA] = f2bf(vA); Ss[t * 72 + sB] = f2bf(vB);
                const float rs = red16(vA + vB);
                if (fr == 0) DP[t * 2 + (w & 1)] = rs;
            }
        }
        {
            const int t = tid >> 3, part = tid & 7; float s = 0.f;
#pragma unroll
            for (int i = 0; i < 4; ++i) { const u32x4 q4 = *(const LAS u32x4*)(Qs + t * 264 + part * 32 + 8 * i);
                const f32x4 n0 = *(const LAS f32x4*)(NV + part * 32 + 8 * i), n1 = *(const LAS f32x4*)(NV + part * 32 + 8 * i + 4);
                s += bflo(q4.x) * n0[0] + bfhi(q4.x) * n0[1] + bflo(q4.y) * n0[2] + bfhi(q4.y) * n0[3] + bflo(q4.z) * n1[0] + bfhi(q4.z) * n1[1] + bflo(q4.w) * n1[2] + bfhi(q4.w) * n1[3]; }
            s = red8(s);
            if (part == 0) QN[t] = s;
        }
        __syncthreads();
        {
            const int mt = w >> 1, nt = w & 1;
            f32x4 aA = (f32x4){0.f, 0.f, 0.f, 0.f}, aB = aA;
#pragma unroll
            for (int ks = 0; ks < 2; ++ks) {
                const bf16x8 a = *(const LAS bf16x8*)(Ss + (16 * mt + fr) * 72 + 32 * ks + 8 * fq);
                const bf16x8 bb = *(const LAS bf16x8*)(VTs + (16 * nt + fr) * 72 + 32 * ks + 8 * fq);
                aA = __builtin_amdgcn_mfma_f32_16x16x32_bf16(a, bb, aA, 0, 0, 0);
            }
#pragma unroll
            for (int ks = 0; ks < 8; ++ks) {
                const bf16x8 a = *(const LAS bf16x8*)(Qs + (16 * mt + fr) * 264 + 32 * ks + 8 * fq);
                const bf16x8 bb = *(const LAS bf16x8*)(CTs + (16 * nt + fr) * 264 + 32 * ks + 8 * fq);
                aB = __builtin_amdgcn_mfma_f32_16x16x32_bf16(a, bb, aB, 0, 0, 0);
            }
            const int dv = dv0 + 16 * nt + fr;
#pragma unroll
            for (int j = 0; j < 4; ++j) {
                const int t = 16 * mt + 4 * fq + j; const float eb = __expf(BC[t]);
                const float num = aA[j] + eb * aB[j], den = DP[2 * t] + DP[2 * t + 1] + eb * QN[t];
                const float hv = num / fmaxf(fabsf(den), 1.f);
                const size_t tok = tokbase + t0 + t;
                const float ov = bf2f(PM[tok * LDPM + 3072 + h * 256 + dv]);
                YM[tok * 1024 + h * 256 + dv] = f2bf(hv * sigm(ov));
            }
        }
        __syncthreads();
        {
            const float decay = __expf(BC[63]);
#pragma unroll
            for (int i = 0; i < 4; ++i) {
                const int mt = 2 * w + (i >> 1), nt = i & 1;
                cacc[i] = cacc[i] * decay;
#pragma unroll
                for (int ks = 0; ks < 2; ++ks) {
                    const bf16x8 a = *(const LAS bf16x8*)(KTs + (16 * mt + fr) * 72 + 32 * ks + 8 * fq);
                    const bf16x8 bb = *(const LAS bf16x8*)(VWTs + (16 * nt + fr) * 72 + 32 * ks + 8 * fq);
                    cacc[i] = __builtin_amdgcn_mfma_f32_16x16x32_bf16(a, bb, cacc[i], 0, 0, 0);
                }
                u32x2 pk; pk.x = cvt_pk_bf16(cacc[i][0], cacc[i][1]); pk.y = cvt_pk_bf16(cacc[i][2], cacc[i][3]);
                *(LAS u32x2*)(CTs + (16 * nt + fr) * 264 + 16 * mt + 4 * fq) = pk;
            }
            const int dk = tid >> 1, hf = tid & 1; float s = 0.f;
#pragma unroll
            for (int i = 0; i < 4; ++i) { const u32x4 k4 = *(const LAS u32x4*)(KTs + dk * 72 + hf * 32 + 8 * i);
                const f32x4 w0 = *(const LAS f32x4*)(WSV + hf * 32 + 8 * i), w1 = *(const LAS f32x4*)(WSV + hf * 32 + 8 * i + 4);
                s += bflo(k4.x) * w0[0] + bfhi(k4.x) * w0[1] + bflo(k4.y) * w0[2] + bfhi(k4.y) * w0[3] + bflo(k4.z) * w1[0] + bfhi(k4.z) * w1[1] + bflo(k4.w) * w1[2] + bfhi(k4.w) * w1[3]; }
            s += dppf<0xB1>(s);
            if (hf == 0) NV[dk] = decay * NV[dk] + s;
        }
        __syncthreads();
    }
#undef ML_LOAD
}

__device__ void phase_norm2_convert(const KP& p) {
    const int tid = tid_l(), lane = tid & 63, G = gridDim.x, bid = blockIdx.x;
    rmsnorm_rows(p.out, p.g_ffn, (bf16_t*)(p.ws + OFF_XN2), bid * 8 + (tid >> 6), G * 8, lane);
    const int gw = bid * 8 + (tid >> 6), nw = G * 8;
    for (int tb = 0; tb < 2; ++tb) {
        const float* src = tb ? p.peer_v : p.peer_u; unsigned char* dst = p.ws + (tb ? OFF_PV : OFF_PU); float* sc = (float*)(p.ws + (tb ? OFF_SCV : OFF_SCU));
        for (int row = gw; row < 16384; row += nw) {
            const float* sp = src + (size_t)row * DM + lane * 16;
            f32x4 v[8]; float am = 0.f;
#pragma unroll
            for (int i = 0; i < 2; ++i)
#pragma unroll
                for (int q = 0; q < 4; ++q) { v[i * 4 + q] = *(const f32x4*)(sp + i * 1024 + q * 4);
                    am = fmaxf(am, fmaxf(fmaxf(fabsf(v[i * 4 + q][0]), fabsf(v[i * 4 + q][1])), fmaxf(fabsf(v[i * 4 + q][2]), fabsf(v[i * 4 + q][3])))); }
            const unsigned amu = wave_max_u32(__float_as_uint(am));
            const float amax = __uint_as_float(amu);
            float scl = 1.f;
            if (amax > 0.f) scl = exp2f(floorf(log2f(240.f / amax)));
            if (lane == 0) sc[row] = 1.f / scl;
#pragma unroll
            for (int i = 0; i < 2; ++i) { u32x4 o;
#pragma unroll
                for (int q = 0; q < 4; ++q) { const f32x4 t = v[i * 4 + q] * scl; int w = __builtin_amdgcn_cvt_pk_fp8_f32(t[0], t[1], 0, false); w = __builtin_amdgcn_cvt_pk_fp8_f32(t[2], t[3], w, true); o[q] = (unsigned)w; }
                *(u32x4*)(dst + (size_t)row * DM + i * 1024 + lane * 16) = o; }
        }
    }
}

__device__ void phase_peer(const KP& p, LAS unsigned char* lds) {
    const int tid = tid_l(), lane = tid & 63, w = tid >> 6, fr = lane & 15, fq = lane >> 4;
    LAS unsigned* KEYS = (LAS unsigned*)lds;
    LAS int* TI = (LAS int*)(lds + 32768);
    LAS float* TG = (LAS float*)(lds + 49152);
    const bf16_t* Q = (const bf16_t*)(p.ws + OFF_Q);
    const bf16_t* SK = (const bf16_t*)(p.ws + OFF_SUBK);
    const bf16_t* XN2 = (const bf16_t*)(p.ws + OFF_XN2);
    const unsigned char* PU = p.ws + OFF_PU; const unsigned char* PV = p.ws + OFF_PV;
    const float* SCU = (const float*)(p.ws + OFF_SCU); const float* SCV = (const float*)(p.ws + OFF_SCV);
    float* out = p.out;
    for (int tile = blockIdx.x; tile < NT / 32; tile += gridDim.x) {
        const int tk0 = tile * 32;
        for (int h = 0; h < 8; ++h) {
            {
                const int pp = w >> 2, ntb = (w & 3) * 2;
                f32x4 acc[2][2];
#pragma unroll
                for (int a = 0; a < 2; ++a)
#pragma unroll
                    for (int b = 0; b < 2; ++b) acc[a][b] = (f32x4){0.f, 0.f, 0.f, 0.f};
#pragma unroll
                for (int ks = 0; ks < 4; ++ks) {
                    bf16x8 af[2], bfr[2];
#pragma unroll
                    for (int mt = 0; mt < 2; ++mt) af[mt] = *(const bf16x8*)(Q + (size_t)(tk0 + 16 * mt + fr) * DM + h * 256 + pp * 128 + 32 * ks + 8 * fq);
#pragma unroll
                    for (int n = 0; n < 2; ++n) bfr[n] = *(const bf16x8*)(SK + (size_t)(pp * 128 + 16 * (ntb + n) + fr) * 128 + 32 * ks + 8 * fq);
#pragma unroll
                    for (int mt = 0; mt < 2; ++mt)
#pragma unroll
                        for (int n = 0; n < 2; ++n) acc[mt][n] = __builtin_amdgcn_mfma_f32_16x16x32_bf16(af[mt], bfr[n], acc[mt][n], 0, 0, 0);
                }
#pragma unroll
                for (int mt = 0; mt < 2; ++mt)
#pragma unroll
                    for (int n = 0; n < 2; ++n)
#pragma unroll
                        for (int j = 0; j < 4; ++j) { const int tokl = 16 * mt + 4 * fq + j, key = 16 * (ntb + n) + fr;
                            KEYS[(tokl * 2 + pp) * 128 + key] = (ordf(acc[mt][n][j]) & ~0x7Fu) | (unsigned)key; }
            }
            __syncthreads();
            for (int q = 0; q < 4; ++q) {
                const int tokl = 4 * w + q;
                unsigned top[2] = {0u, 0u};
#pragma unroll
                for (int pp = 0; pp < 2; ++pp) {
                    unsigned k0 = KEYS[(tokl * 2 + pp) * 128 + lane], k1 = KEYS[(tokl * 2 + pp) * 128 + 64 + lane];
                    for (int it = 0; it < 16; ++it) {
                        const unsigned M = wave_max_u32(max(k0, k1));
                        if (lane == it) top[pp] = M;
                        k0 = (k0 == M) ? 0u : k0; k1 = (k1 == M) ? 0u : k1;
                    }
                }
                const int j = lane & 15, ib = lane >> 4;
                const float v2 = unordf((unsigned)__shfl((int)top[1], j) & ~0x7Fu);
                unsigned cnd[4];
#pragma unroll
                for (int m = 0; m < 4; ++m) { const int i = ib + 4 * m; const float v1 = unordf((unsigned)__shfl((int)top[0], i) & ~0x7Fu);
                    cnd[m] = (ordf(v1 + v2) & ~0xFFu) | (unsigned)(i * 16 + j); }
                unsigned best = 0u;
                for (int it = 0; it < 16; ++it) {
                    const unsigned M = wave_max_u32(max(max(cnd[0], cnd[1]), max(cnd[2], cnd[3])));
                    if (lane == it) best = M;
#pragma unroll
                    for (int m = 0; m < 4; ++m) cnd[m] = (cnd[m] == M) ? 0u : cnd[m];
                }
                const int ci = (int)(best & 0xFFu);
                const float bv = unordf(best & ~0xFFu);
                const int e1 = __shfl((int)top[0], ci >> 4) & 0x7F, e2 = __shfl((int)top[1], ci & 15) & 0x7F;
                const float mx = rlane(bv, 0);
                float ev = (lane < 16) ? __expf(bv - mx) : 0.f;
                const float sum = rlane(red16(ev), 0);
                if (lane < 16) { TI[tokl * 128 + h * 16 + lane] = e1 * 128 + e2; TG[tokl * 128 + h * 16 + lane] = ev / sum; }
            }
            __syncthreads();
        }
        for (int q = 0; q < 4; ++q) {
            const int tokl = 4 * w + q; const size_t tok = (size_t)tk0 + tokl;
            float xv[32], acc[32];
#pragma unroll
            for (int i = 0; i < 2; ++i)
#pragma unroll
                for (int hh = 0; hh < 2; ++hh) { const u32x4 x4 = *(const u32x4*)(XN2 + tok * DM + i * 1024 + lane * 16 + hh * 8);
#pragma unroll
                    for (int e = 0; e < 4; ++e) { xv[i * 16 + hh * 8 + 2 * e] = bflo(x4[e]); xv[i * 16 + hh * 8 + 2 * e + 1] = bfhi(x4[e]); } }
#pragma unroll
            for (int i = 0; i < 32; ++i) acc[i] = 0.f;
#pragma unroll 4
            for (int e = 0; e < 128; ++e) {
                const int idx = __builtin_amdgcn_readfirstlane(TI[tokl * 128 + e]);
                const float gate = __builtin_bit_cast(float, __builtin_amdgcn_readfirstlane(__builtin_bit_cast(int, TG[tokl * 128 + e])));
                const unsigned char* up = PU + (size_t)idx * DM + lane * 16; const unsigned char* vp = PV + (size_t)idx * DM + lane * 16;
                u32x4 u4[2], v4[2];
                u4[0] = *(const u32x4*)up; u4[1] = *(const u32x4*)(up + 1024); v4[0] = *(const u32x4*)vp; v4[1] = *(const u32x4*)(vp + 1024);
                const float su = SCU[idx], sv = SCV[idx];
                float d0 = 0.f, d1 = 0.f, d2 = 0.f, d3 = 0.f;
#pragma unroll
                for (int i = 0; i < 2; ++i)
#pragma unroll
                    for (int k = 0; k < 4; ++k) { const f32x2_t lo = __builtin_amdgcn_cvt_pk_f32_fp8((int)u4[i][k], false), hi = __builtin_amdgcn_cvt_pk_f32_fp8((int)u4[i][k], true);
                        d0 += xv[i * 16 + 4 * k] * lo.x; d1 += xv[i * 16 + 4 * k + 1] * lo.y; d2 += xv[i * 16 + 4 * k + 2] * hi.x; d3 += xv[i * 16 + 4 * k + 3] * hi.y; }
                const float act = wave_sum((d0 + d1) + (d2 + d3)) * su;
                const float coef = gate * 0.5f * act * (1.f + erff(act * 0.70710678118f)) * sv;
#pragma unroll
                for (int i = 0; i < 2; ++i)
#pragma unroll
                    for (int k = 0; k < 4; ++k) { const f32x2_t lo = __builtin_amdgcn_cvt_pk_f32_fp8((int)v4[i][k], false), hi = __builtin_amdgcn_cvt_pk_f32_fp8((int)v4[i][k], true);
                        acc[i * 16 + 4 * k] += coef * lo.x; acc[i * 16 + 4 * k + 1] += coef * lo.y; acc[i * 16 + 4 * k + 2] += coef * hi.x; acc[i * 16 + 4 * k + 3] += coef * hi.y; }
            }
            float ss = 0.f;
            float* orow = out + tok * DM + lane * 16;
#pragma unroll
            for (int i = 0; i < 2; ++i)
#pragma unroll
                for (int k = 0; k < 4; ++k) { const f32x4 h0 = *(const f32x4*)(orow + i * 1024 + 4 * k);
#pragma unroll
                    for (int j = 0; j < 4; ++j) { acc[i * 16 + 4 * k + j] += h0[j]; ss += acc[i * 16 + 4 * k + j] * acc[i * 16 + 4 * k + j]; } }
            ss = wave_sum(ss);
            const float r = rsqrtf(ss * (1.f / DM) + 1e-6f);
#pragma unroll
            for (int i = 0; i < 2; ++i)
#pragma unroll
                for (int k = 0; k < 4; ++k) { const f32x4 g0 = *(const f32x4*)(p.g_final + i * 1024 + lane * 16 + 4 * k); f32x4 o0;
#pragma unroll
                    for (int j = 0; j < 4; ++j) o0[j] = acc[i * 16 + 4 * k + j] * r * g0[j];
                    *(f32x4*)(orow + i * 1024 + 4 * k) = o0; }
        }
        __syncthreads();
    }
}

__global__ void __launch_bounds__(512) fwd_megakernel(KP p) {
    extern __shared__ __attribute__((aligned(16))) unsigned char smem[];
    LAS unsigned char* lds = (LAS unsigned char*)smem;
    cg::grid_group grid = cg::this_grid();
#define GRID_SYNC() do { __builtin_amdgcn_fence(__ATOMIC_RELEASE, "agent"); __syncthreads(); grid.sync(); __builtin_amdgcn_fence(__ATOMIC_ACQUIRE, "agent"); } while (0)
    const int G = gridDim.x, bid = blockIdx.x;
    unsigned char* ws = p.ws; unsigned char* dob = (unsigned char*)p.out;

#define RUN_GEMM(MODE, ...) do { unsigned char* ws = lp(p.ws); unsigned char* dob = lp((unsigned char*)p.out); const pg8::Gemm g_ = pg8::Gemm{__VA_ARGS__}; pg8::StaticOrder S_; S_.init(g_.M, g_.N, G, bid); \
        const pg8::Epi<MODE> E_{ws, dob, p.x, p.w0, p.a0}; pg8::gemm_phase(lds, g_, S_, E_); } while (0)
    phase_prep(p, lds);
    GRID_SYNC();
    RUN_GEMM(0, (const bf16_t*)(ws + OFF_XN), (const bf16_t*)(ws + OFF_WINT), NT, N1, 2048, 2048, 2048);
    GRID_SYNC();
    phase_lora_prep(p);
    GRID_SYNC();
    RUN_GEMM(1, (const bf16_t*)(dob + DO_ALORA), (const bf16_t*)(ws + OFF_WAT), NT, 2048, 256, 512, 256);
    RUN_GEMM(2, (const bf16_t*)(dob + DO_ALORA) + 256, (const bf16_t*)(ws + OFF_G2T), NT, 1024, 256, 512, 256);
    GRID_SYNC();
    if (bid < 64) rwkv_scan(p, bid, lds);
    else if (bid < 192) mlstm_run(p, bid - 64, lds);
    GRID_SYNC();
    RUN_GEMM(3, (const bf16_t*)(ws + OFF_YM), (const bf16_t*)(ws + OFF_PMT), NT, 2048, 1024, 1024, 1024);
    RUN_GEMM(4, (const bf16_t*)(ws + OFF_YR), (const bf16_t*)(ws + OFF_PRT), NT, 2048, 1024, 1024, 1024);
    GRID_SYNC();
    RUN_GEMM(5, (const bf16_t*)(ws + OFF_PG), (const bf16_t*)(ws + OFF_WOT), NT, 2048, 2048, LDPG, 2048);
    GRID_SYNC();
    phase_norm2_convert(p);
    GRID_SYNC();
    RUN_GEMM(6, (const bf16_t*)(ws + OFF_XN2), (const bf16_t*)(ws + OFF_WQT), NT, 2048, 2048, 2048, 2048);
    GRID_SYNC();
    phase_peer(p, lds);
}

extern "C" void kernel_launch(void* const* d_in, const int* in_sizes, int n_in, void* d_out, int out_size, void* d_ws, size_t ws_size, hipStream_t stream) {
    static int grid_blocks = 0;
    if (grid_blocks == 0) {
        if (n_in != 26 || out_size != NT * DM || ws_size < WS_NEED) { fprintf(stderr, "kernel_launch: unexpected shapes: n_in %d out %d ws %zu (need %zu)\n", n_in, out_size, ws_size, (size_t)WS_NEED); grid_blocks = -1; return; }
        int dev = 0, cus = 0, per_cu = 0;
        hipGetDevice(&dev);
        hipDeviceGetAttribute(&cus, hipDeviceAttributeMultiprocessorCount, dev);
        if (hipFuncSetAttribute((const void*)fwd_megakernel, hipFuncAttributeMaxDynamicSharedMemorySize, LDS_BYTES) != hipSuccess) { fprintf(stderr, "kernel_launch: hipFuncSetAttribute failed\n"); grid_blocks = -1; return; }
        hipOccupancyMaxActiveBlocksPerMultiprocessor(&per_cu, (const void*)fwd_megakernel, 512, LDS_BYTES);
        if (per_cu < 1) { fprintf(stderr, "kernel_launch: occupancy query says %d blocks per CU\n", per_cu); per_cu = 1; }
        (void)hipGetLastError();
        grid_blocks = cus * 1;
    }
    if (grid_blocks < 0) return;
    KP p{};
    const float** pp = (const float**)&p;
    for (int i = 0; i < 26; ++i) pp[i] = (const float*)d_in[i];
    p.out = (float*)d_out; p.ws = (unsigned char*)d_ws;
    void* args[] = {&p};
    hipError_t e = hipLaunchCooperativeKernel((void*)fwd_megakernel, dim3(grid_blocks), dim3(512), args, LDS_BYTES, stream);
    if (e != hipSuccess) fprintf(stderr, "cooperative launch failed: %s (grid %d)\n", hipGetErrorString(e), grid_blocks);
}
```

```cpp
#include <hip/hip_runtime.h>
#include <hip/hip_cooperative_groups.h>
#include <cstdio>
namespace cg = cooperative_groups;

#define LAS __attribute__((address_space(3)))
typedef unsigned short bf16_t;
typedef short bf16x8 __attribute__((ext_vector_type(8)));
typedef float f32x4 __attribute__((ext_vector_type(4)));
typedef unsigned u32x4 __attribute__((ext_vector_type(4)));
typedef unsigned u32x2 __attribute__((ext_vector_type(2)));

constexpr int NT = 16384, SEQ = 4096, DM = 2048;
constexpr int LDPM = 4096, LDPR = 3584, LDPG = 4096, N1 = 11776;
constexpr size_t MiB = 1024ull * 1024ull;
constexpr size_t OFF_PM = 0, OFF_PR = 128 * MiB, OFF_PG = 240 * MiB, OFF_XN = 368 * MiB, OFF_WINT = 432 * MiB, OFF_WTS = 478 * MiB;
constexpr size_t OFF_PMT = OFF_WTS, OFF_PRT = OFF_WTS + 4 * MiB, OFF_WOT = OFF_WTS + 8 * MiB, OFF_WQT = OFF_WTS + 16 * MiB, OFF_WAT = OFF_WTS + 24 * MiB,
                 OFF_G2T = OFF_WTS + 25 * MiB, OFF_SUBK = OFF_WTS + 25 * MiB + 512 * 1024, WS_NEED = OFF_WTS + 26 * MiB;
constexpr size_t OFF_QC = OFF_XN, OFF_KC = OFF_XN + 32 * MiB, OFF_YR = OFF_WINT, OFF_Q = OFF_XN, OFF_XN2 = OFF_PR, OFF_PU = OFF_PM, OFF_PV = OFF_PM + 32 * MiB,
                 OFF_SCU = OFF_SUBK + 64 * 1024, OFF_SCV = OFF_SCU + 64 * 1024;
constexpr size_t DO_WLOG = 0, DO_AG = 32 * MiB, DO_GG = 64 * MiB, DO_ALORA = 96 * MiB, DO_GB = 112 * MiB, DO_GA = DO_GB + 256 * 1024, DO_GW = DO_GA + 256 * 1024;
constexpr int LDS_BYTES = 150528;

struct KP {
    const float *x, *g_mix, *w_in, *conv_w, *b_i, *b_f, *mu, *w0, *w2, *a0, *a2, *g2, *k_k, *k_a, *r_k, *ln_w, *ln_b, *proj_m, *proj_r, *w_out, *g_ffn,
        *w_query, *sub_keys, *peer_u, *peer_v, *g_final;
    float* out; unsigned char* ws;
};

typedef __bf16 bf16x2_t __attribute__((ext_vector_type(2)));
typedef float f32x2_t __attribute__((ext_vector_type(2)));
__device__ __forceinline__ unsigned cvt_pk_bf16(float lo, float hi) { f32x2_t v = {lo, hi}; bf16x2_t b = __builtin_convertvector(v, bf16x2_t); return __builtin_bit_cast(unsigned, b); }
__device__ __forceinline__ bf16_t f2bf(float f) { return (bf16_t)(cvt_pk_bf16(f, 0.f) & 0xffffu); }
__device__ __forceinline__ float bf2f(bf16_t h) { return __uint_as_float((unsigned)h << 16); }
__device__ __forceinline__ float bflo(unsigned u) { return __uint_as_float(u << 16); }
__device__ __forceinline__ float bfhi(unsigned u) { return __uint_as_float(u & 0xffff0000u); }
__device__ __forceinline__ float sigm(float x) { return __builtin_amdgcn_rcpf(1.f + __expf(-x)); }
template <int CTRL> __device__ __forceinline__ float dppf(float v) { return __builtin_bit_cast(float, __builtin_amdgcn_update_dpp(0, __builtin_bit_cast(int, v), CTRL, 0xF, 0xF, true)); }
template <int CTRL> __device__ __forceinline__ unsigned dppu(unsigned v) { return (unsigned)__builtin_amdgcn_update_dpp(0, (int)v, CTRL, 0xF, 0xF, true); }
__device__ __forceinline__ float red4(float v) { v += dppf<0xB1>(v); v += dppf<0x4E>(v); return v; }
__device__ __forceinline__ float red8(float v) { v = red4(v); v += dppf<0x141>(v); return v; }
__device__ __forceinline__ float red16(float v) { v = red8(v); v += dppf<0x140>(v); return v; }
__device__ __forceinline__ float rlane(float v, int l) { return __builtin_bit_cast(float, __builtin_amdgcn_readlane(__builtin_bit_cast(int, v), l)); }
__device__ __forceinline__ float wave_sum(float v) { v = red16(v); return rlane(v, 0) + rlane(v, 16) + rlane(v, 32) + rlane(v, 48); }
__device__ __forceinline__ unsigned wave_max_u32(unsigned v) {
    v = max(v, dppu<0xB1>(v)); v = max(v, dppu<0x4E>(v)); v = max(v, dppu<0x141>(v)); v = max(v, dppu<0x140>(v));
    unsigned a = (unsigned)__builtin_amdgcn_readlane((int)v, 0), b = (unsigned)__builtin_amdgcn_readlane((int)v, 16), c = (unsigned)__builtin_amdgcn_readlane((int)v, 32), d = (unsigned)__builtin_amdgcn_readlane((int)v, 48);
    return max(max(a, b), max(c, d));
}
__device__ __forceinline__ unsigned ordf(float f) { unsigned u = __float_as_uint(f); return (u & 0x80000000u) ? ~u : (u | 0x80000000u); }
__device__ __forceinline__ float unordf(unsigned k) { return __uint_as_float((k & 0x80000000u) ? (k ^ 0x80000000u) : ~k); }

__device__ __forceinline__ int tid_l() { int t = threadIdx.x; asm volatile("" : "+v"(t)); return t; }
template <class T> __device__ __forceinline__ T* lp(T* q) { asm volatile("" : "+s"(q)); return q; }
namespace pg8 {
constexpr int BM = 256, BK = 64, HALF = 128, HTB = HALF * BK * 2, STAGE_BYTES = 8 * HTB, NXCD = 8, WGM = 8;
__device__ __forceinline__ int lds_byte(int r, int c) { const int st = (r >> 4) * 2 + (c >> 5), rr = r & 15, cc = c & 31, ob = rr * 64 + cc * 2; return st * 1024 + (ob ^ (((ob >> 9) & 1) << 5)); }
__device__ __forceinline__ void stage_rc(int b, int& R, int& C) { const int st = b / 1024, sb = b % 1024, swz = sb ^ (((sb >> 9) & 1) << 5); R = (st >> 1) * 16 + swz / 64; C = (st & 1) * 32 + (swz % 64) / 2; }
__device__ __forceinline__ int perm32(int rho) { const int n = rho >> 4, i = rho & 15; return 8 * (i >> 2) + 4 * n + (i & 3); }
struct Unit { int pm, pn; };
struct Gemm { const bf16_t* A; const bf16_t* Bt; int M, N, K, lda, ldb; };
struct StaticOrder {
    int nM, nN, nwg, G, c;
    __device__ void init(int M, int N, int G_, int c_) { nM = M / BM; nN = N / BM; nwg = nM * nN; G = G_; c = c_; }
    __device__ bool next(int i, Unit& u) const {
        const long L = (long)i * G + c; if (L >= nwg) return false;
        int wgid = (int)L; { const int q = nwg / NXCD, r = nwg % NXCD, xcd = wgid % NXCD, off = wgid / NXCD; wgid = (xcd < r ? xcd * (q + 1) : r * (q + 1) + (xcd - r) * q) + off; }
        const int nig = WGM * nN, gid = wgid / nig, fm = gid * WGM, gsz = (nM - fm) < WGM ? (nM - fm) : WGM;
        u.pm = fm + ((wgid % nig) % gsz); u.pn = (wgid % nig) / gsz; return true;
    }
};

__device__ __forceinline__ void store8(bf16_t* p, f32x4 v0, f32x4 v1) {
    u32x4 w; w.x = cvt_pk_bf16(v0[0], v0[1]); w.y = cvt_pk_bf16(v0[2], v0[3]); w.z = cvt_pk_bf16(v1[0], v1[1]); w.w = cvt_pk_bf16(v1[2], v1[3]); *(u32x4*)p = w;
}
__device__ __forceinline__ void load8(const bf16_t* p, f32x4& v0, f32x4& v1) {
    const u32x4 w = *(const u32x4*)p; v0 = (f32x4){bflo(w.x), bfhi(w.x), bflo(w.y), bfhi(w.y)}; v1 = (f32x4){bflo(w.z), bfhi(w.z), bflo(w.w), bfhi(w.w)};
}

template <int mode> struct Epi {
    static constexpr bool PERM = true;
    unsigned char* ws; unsigned char* dob; const float* x; const float* w0; const float* a0;
    __device__ __forceinline__ void operator()(const f32x4 (&acc)[2][2][4][2], const Unit& u, int wr, int wc, int fr, int fq) const {
        const int row0 = u.pm * BM + wr * 64 + fr, cb = u.pn * BM + wc * 32 + 8 * fq;
#pragma unroll
        for (int ai = 0; ai < 2; ++ai)
#pragma unroll
            for (int m = 0; m < 4; ++m) {
                const size_t row = (size_t)(row0 + ai * HALF + m * 16);
#pragma unroll
                for (int bj = 0; bj < 2; ++bj) {
                    const int col = cb + bj * HALF;
                    f32x4 v0 = acc[ai][bj][m][0], v1 = acc[ai][bj][m][1];
                    if (mode == 0) {
                        if (col < 4096) store8((bf16_t*)(ws + OFF_PM) + row * LDPM + col, v0, v1);
                        else if (col < 7680) store8((bf16_t*)(ws + OFF_PR) + row * LDPR + (col - 4096), v0, v1);
                        else {
#pragma unroll
                            for (int j = 0; j < 4; ++j) { v0[j] = sigm(v0[j]); v1[j] = sigm(v1[j]); }
                            store8((bf16_t*)(ws + OFF_PG) + row * LDPG + (col - 7680), v0, v1);
                        }
                    } else if (mode == 1) {
                        if (col < 1024) {
                            const f32x4 b0 = *(const f32x4*)(w0 + col), b1 = *(const f32x4*)(w0 + col + 4);
#pragma unroll
                            for (int j = 0; j < 4; ++j) {
                                float z = -(b0[j] + v0[j]); float sp = fmaxf(z, 0.f) + __logf(1.f + __expf(-fabsf(z))); v0[j] = -__expf(-sp - 0.5f);
                                z = -(b1[j] + v1[j]); sp = fmaxf(z, 0.f) + __logf(1.f + __expf(-fabsf(z))); v1[j] = -__expf(-sp - 0.5f);
                            }
                            store8((bf16_t*)(dob + DO_WLOG) + row * 1024 + col, v0, v1);
                        } else {
                            const int c2 = col - 1024;
                            const f32x4 b0 = *(const f32x4*)(a0 + c2), b1 = *(const f32x4*)(a0 + c2 + 4);
#pragma unroll
                            for (int j = 0; j < 4; ++j) { v0[j] = sigm(b0[j] + v0[j]); v1[j] = sigm(b1[j] + v1[j]); }
                            store8((bf16_t*)(dob + DO_AG) + row * 1024 + c2, v0, v1);
                        }
                    } else if (mode == 2) {
                        store8((bf16_t*)(dob + DO_GG) + row * 1024 + col, v0, v1);
                    } else if (mode == 3) {
                        bf16_t* pp = (bf16_t*)(ws + OFF_PG) + row * LDPG + col; f32x4 g0, g1; load8(pp, g0, g1);
                        store8(pp, g0 * v0, g1 * v1);
                    } else if (mode == 4) {
                        bf16_t* pp = (bf16_t*)(ws + OFF_PG) + row * LDPG + col; f32x4 m0, m1, g0, g1; load8(pp, m0, m1); load8(pp + 2048, g0, g1);
                        store8(pp, m0 + g0 * v0, m1 + g1 * v1);
                    } else if (mode == 5) {
                        const float* xp = x + row * DM + col; float* op = (float*)dob + row * DM + col;
                        const f32x4 x0 = *(const f32x4*)xp, x1 = *(const f32x4*)(xp + 4);
                        *(f32x4*)op = x0 + v0; *(f32x4*)(op + 4) = x1 + v1;
                    } else {
                        store8((bf16_t*)(ws + OFF_Q) + row * DM + col, v0, v1);
                    }
                    asm volatile("" ::: "memory");
                }
            }
    }
};

template <class EpiT> __device__ __forceinline__ void gemm_phase(LAS unsigned char* lds, const Gemm g, const StaticOrder& S, const EpiT& E) {
    const int tid = tid_l(), wid = __builtin_amdgcn_readfirstlane(tid >> 6), lane = tid & 63, wr = wid >> 2, wc = wid & 3, fr = lane & 15, fq = lane >> 4;
    const int K = g.K, nt = K / BK;
    unsigned voffA[2], voffB[2];
#pragma unroll
    for (int i = 0; i < 2; ++i) { int R, C; stage_rc(tid * 16 + i * 8192, R, C); const int Rb = (R & ~31) + perm32(R & 31);
        voffA[i] = (unsigned)(R * g.lda + C) * 2u; voffB[i] = (unsigned)(Rb * g.ldb + C) * 2u; }
    const size_t kstep = (size_t)(BK * 2);
    const size_t hstepA = (size_t)HALF * g.lda * 2, hstepB = (size_t)HALF * g.ldb * 2;
    const size_t tstepA = 2 * hstepA, tstepB = 2 * hstepB;
    const unsigned ldsw = (unsigned)wid * 1024u;
    const int aoff = lds_byte(wr * 64 + fr, fq * 8), boff = lds_byte(wc * 32 + fr, fq * 8);
#define PG8_SA(b, h) (((b) * 2 + (h)) * HTB)
#define PG8_SB(b, h) ((4 + (b) * 2 + (h)) * HTB)
#define PG8_STAGE(bufoff, gbase, voff) do { _Pragma("unroll") for (int _i = 0; _i < 2; ++_i) \
        __builtin_amdgcn_global_load_lds((const unsigned*)((const char*)(gbase) + (voff)[_i]), (LAS unsigned*)(lds + (bufoff) + ldsw + _i * 8192), 16, 0, 0); } while (0)
#define PG8_LDA(dst, b, h) do { _Pragma("unroll") for (int m = 0; m < 4; ++m) _Pragma("unroll") for (int k = 0; k < 2; ++k) dst[m][k] = *(const LAS bf16x8*)(lds + PG8_SA(b, h) + aoff + m * 2048 + k * 1024); } while (0)
#define PG8_LDB(dst, b, h) do { _Pragma("unroll") for (int n = 0; n < 2; ++n) _Pragma("unroll") for (int k = 0; k < 2; ++k) dst[n][k] = *(const LAS bf16x8*)(lds + PG8_SB(b, h) + boff + n * 2048 + k * 1024); } while (0)
#define PG8_MMA(ai, bj, At, Bt) do { __builtin_amdgcn_s_setprio(1); _Pragma("unroll") for (int m = 0; m < 4; ++m) _Pragma("unroll") for (int n = 0; n < 2; ++n) _Pragma("unroll") for (int k = 0; k < 2; ++k) \
        acc[ai][bj][m][n] = __builtin_amdgcn_mfma_f32_16x16x32_bf16(Bt[n][k], At[m][k], acc[ai][bj][m][n], 0, 0, 0); __builtin_amdgcn_s_setprio(0); } while (0)
#define PG8_WAIT_V(n) asm volatile("s_waitcnt vmcnt(" #n ")" ::: "memory")
#define PG8_WAIT_L(n) asm volatile("s_waitcnt lgkmcnt(" #n ")" ::: "memory")
#define PG8_BAR __builtin_amdgcn_s_barrier()
#define PG8_SCHED __builtin_amdgcn_sched_barrier(0)
    Unit cur, nxt; int ui = 0;
    if (!S.next(0, cur)) return;
    f32x4 acc[2][2][4][2];
#pragma unroll
    for (int a = 0; a < 2; ++a)
#pragma unroll
        for (int b = 0; b < 2; ++b)
#pragma unroll
            for (int m = 0; m < 4; ++m)
#pragma unroll
                for (int n = 0; n < 2; ++n) acc[a][b][m][n] = (f32x4){0.f, 0.f, 0.f, 0.f};
    bf16x8 At[4][2], B0[2][2], B1[2][2];
    const char* cA = (const char*)g.A + (size_t)cur.pm * tstepA; const char* cB = (const char*)g.Bt + (size_t)cur.pn * tstepB;
    PG8_STAGE(PG8_SB(0, 0), cB, voffB); PG8_STAGE(PG8_SA(0, 0), cA, voffA); PG8_STAGE(PG8_SB(0, 1), cB + hstepB, voffB); PG8_STAGE(PG8_SA(0, 1), cA + hstepA, voffA);
    if (wr == 1) PG8_BAR;
    PG8_WAIT_V(4); PG8_BAR;
    PG8_STAGE(PG8_SB(1, 0), cB + kstep, voffB); PG8_STAGE(PG8_SA(1, 0), cA + kstep, voffA); PG8_STAGE(PG8_SB(1, 1), cB + hstepB + kstep, voffB);
    PG8_WAIT_V(6); PG8_BAR;
    for (;;) {
        const bool has_next = S.next(ui + 1, nxt);
        const char* nA = has_next ? (const char*)g.A + (size_t)nxt.pm * tstepA : cA; const char* nB = has_next ? (const char*)g.Bt + (size_t)nxt.pn * tstepB : cB;
        for (int t = 0; t < nt; t += 2) {
            const bool last = (t == nt - 2);
            const char* a1 = cA + (size_t)(t + 1) * kstep;
            const char* a2 = last ? nA : cA + (size_t)(t + 2) * kstep; const char* b2 = last ? nB : cB + (size_t)(t + 2) * kstep;
            const char* a3 = a2 + kstep; const char* b3 = b2 + kstep;
            PG8_LDB(B0, 0, 0); PG8_SCHED; PG8_LDA(At, 0, 0); PG8_STAGE(PG8_SA(1, 1), a1 + hstepA, voffA);
            PG8_WAIT_L(8); PG8_BAR; PG8_WAIT_L(0); PG8_MMA(0, 0, At, B0); PG8_BAR; PG8_SCHED;
            PG8_LDB(B1, 0, 1); PG8_STAGE(PG8_SB(0, 0), b2, voffB);
            PG8_BAR; PG8_WAIT_L(0); PG8_MMA(0, 1, At, B1); PG8_BAR;
            PG8_LDA(At, 0, 1); PG8_STAGE(PG8_SA(0, 0), a2, voffA);
            PG8_BAR; PG8_WAIT_L(0); PG8_MMA(1, 0, At, B0); PG8_BAR; PG8_SCHED;
            PG8_STAGE(PG8_SB(0, 1), b2 + hstepB, voffB);
            PG8_WAIT_V(6); PG8_BAR; PG8_MMA(1, 1, At, B1); PG8_BAR;
            PG8_LDB(B0, 1, 0); PG8_SCHED; PG8_LDA(At, 1, 0); PG8_STAGE(PG8_SA(0, 1), a2 + hstepA, voffA);
            PG8_WAIT_L(8); PG8_BAR; PG8_WAIT_L(0); PG8_MMA(0, 0, At, B0); PG8_BAR; PG8_SCHED;
            PG8_LDB(B1, 1, 1); PG8_STAGE(PG8_SB(1, 0), b3, voffB);
            PG8_BAR; PG8_WAIT_L(0); PG8_MMA(0, 1, At, B1); PG8_BAR;
            PG8_LDA(At, 1, 1); PG8_STAGE(PG8_SA(1, 0), a3, voffA);
            PG8_BAR; PG8_WAIT_L(0); PG8_MMA(1, 0, At, B0); PG8_BAR; PG8_SCHED;
            PG8_STAGE(PG8_SB(1, 1), b3 + hstepB, voffB);
            PG8_WAIT_V(6); PG8_BAR; PG8_MMA(1, 1, At, B1); PG8_BAR;
        }
        E(acc, cur, wr, wc, fr, fq);
        if (!has_next) break;
#pragma unroll
        for (int a = 0; a < 2; ++a)
#pragma unroll
            for (int b = 0; b < 2; ++b)
#pragma unroll
                for (int m = 0; m < 4; ++m)
#pragma unroll
                    for (int n = 0; n < 2; ++n) acc[a][b][m][n] = (f32x4){0.f, 0.f, 0.f, 0.f};
        cur = nxt; cA = nA; cB = nB; ++ui;
    }
    PG8_WAIT_V(0);
    if (wr == 0) PG8_BAR;
    PG8_BAR;
#undef PG8_SA
#undef PG8_SB
#undef PG8_STAGE
#undef PG8_LDA
#undef PG8_LDB
#undef PG8_MMA
#undef PG8_WAIT_V
#undef PG8_WAIT_L
#undef PG8_BAR
#undef PG8_SCHED
}
}

__device__ __forceinline__ void rmsnorm_rows(const float* src, const float* gain, bf16_t* dst, int gw, int nw, int lane) {
    for (int row = gw; row < NT; row += nw) {
        const f32x4* s = (const f32x4*)(src + (size_t)row * DM);
        f32x4 v[8]; float ss = 0.f;
#pragma unroll
        for (int i = 0; i < 8; ++i) { v[i] = s[i * 64 + lane]; ss += v[i][0] * v[i][0] + v[i][1] * v[i][1] + v[i][2] * v[i][2] + v[i][3] * v[i][3]; }
        ss = wave_sum(ss);
        const float r = rsqrtf(ss * (1.f / DM) + 1e-6f);
        u32x2* d = (u32x2*)(dst + (size_t)row * DM);
#pragma unroll
        for (int i = 0; i < 8; ++i) { const f32x4 gg = ((const f32x4*)gain)[i * 64 + lane]; u32x2 o; o.x = cvt_pk_bf16(v[i][0] * r * gg[0], v[i][1] * r * gg[1]); o.y = cvt_pk_bf16(v[i][2] * r * gg[2], v[i][3] * r * gg[3]); d[i * 64 + lane] = o; }
    }
}

__device__ __forceinline__ void tr_tile(const float* src, int ld, int c0, int nvalid, int k0, bf16_t* dst, int ldd, int r0, int kd0, LAS float* tile) {
    const int tid = tid_l();
#pragma unroll
    for (int i = 0; i < 2; ++i) {
        const int k = (tid >> 4) + 32 * i, c4 = (tid & 15) * 4;
        f32x4 v = (f32x4){0.f, 0.f, 0.f, 0.f};
        if (c4 < nvalid) v = *(const f32x4*)(src + (size_t)(k0 + k) * ld + c0 + c4);
        tile[k * 65 + c4] = v[0]; tile[k * 65 + c4 + 1] = v[1]; tile[k * 65 + c4 + 2] = v[2]; tile[k * 65 + c4 + 3] = v[3];
    }
    __syncthreads();
    {
        const int c = tid >> 3, k8 = (tid & 7) * 8;
        float f[8];
#pragma unroll
        for (int j = 0; j < 8; ++j) f[j] = tile[(k8 + j) * 65 + c];
        u32x4 w; w.x = cvt_pk_bf16(f[0], f[1]); w.y = cvt_pk_bf16(f[2], f[3]); w.z = cvt_pk_bf16(f[4], f[5]); w.w = cvt_pk_bf16(f[6], f[7]);
        *(u32x4*)(dst + (size_t)(r0 + c) * ldd + kd0 + k8) = w;
    }
    __syncthreads();
}

__device__ void phase_prep(const KP& p, LAS unsigned char* lds) {
    const int tid = tid_l(), lane = tid & 63, G = gridDim.x, bid = blockIdx.x;
    unsigned char* ws = p.ws;
    rmsnorm_rows(p.x, p.g_mix, (bf16_t*)(ws + OFF_XN), bid * 8 + (tid >> 6), G * 8, lane);
    LAS float* tile = (LAS float*)lds;
    for (int j = bid; j < 8960; j += G) {
        if (j < 5888) {
            const int rt = j >> 5, kt = j & 31; int c0, nv = 64;
            if (rt < 64) c0 = 64 * rt; else if (rt < 119) c0 = 4104 + 64 * (rt - 64); else if (rt == 119) { c0 = 4096; nv = 8; } else c0 = 7624 + 64 * (rt - 120);
            tr_tile(p.w_in, 11720, c0, nv, kt * 64, (bf16_t*)(ws + OFF_WINT), 2048, rt * 64, kt * 64, tile);
        } else if (j < 6400) { const int q = j - 5888, rt = q >> 4, kt = q & 15; tr_tile(p.proj_m, 2048, rt * 64, 64, kt * 64, (bf16_t*)(ws + OFF_PMT), 1024, rt * 64, kt * 64, tile); }
        else if (j < 6912) { const int q = j - 6400, rt = q >> 4, kt = q & 15; tr_tile(p.proj_r, 2048, rt * 64, 64, kt * 64, (bf16_t*)(ws + OFF_PRT), 1024, rt * 64, kt * 64, tile); }
        else if (j < 7936) { const int q = j - 6912, rt = q >> 5, kt = q & 31; tr_tile(p.w_out, 2048, rt * 64, 64, kt * 64, (bf16_t*)(ws + OFF_WOT), 2048, rt * 64, kt * 64, tile); }
        else { const int q = j - 7936, rt = q >> 5, kt = q & 31; tr_tile(p.w_query, 2048, rt * 64, 64, kt * 64, (bf16_t*)(ws + OFF_WQT), 2048, rt * 64, kt * 64, tile); }
    }
    const int gt = bid * 512 + tid, gn = G * 512;
    bf16_t* WAT = (bf16_t*)(ws + OFF_WAT);
    for (int i = gt; i < 2048 * 256; i += gn) { const int r = i >> 8, k = i & 255; float v = 0.f;
        if (r < 1024) { if (k < 96) v = p.w2[k * 1024 + r]; } else { if (k >= 96 && k < 192) v = p.a2[(k - 96) * 1024 + (r - 1024)]; }
        WAT[i] = f2bf(v); }
    bf16_t* G2T = (bf16_t*)(ws + OFF_G2T);
    for (int i = gt; i < 1024 * 256; i += gn) { const int r = i >> 8, k = i & 255; G2T[i] = f2bf(p.g2[k * 1024 + r]); }
    bf16_t* SK = (bf16_t*)(ws + OFF_SUBK);
    for (int i = gt; i < 2 * 128 * 128; i += gn) SK[i] = f2bf(p.sub_keys[i]);
}

__device__ __forceinline__ float bfel(const u32x4& w, int e) { const unsigned u = w[e >> 1]; return (e & 1) ? bfhi(u) : bflo(u); }
__device__ void phase_lora_prep(const KP& p) {
    const bf16_t* PR = (const bf16_t*)(p.ws + OFF_PR);
    bf16_t* AL = (bf16_t*)((unsigned char*)p.out + DO_ALORA);
    const int gt = blockIdx.x * 512 + threadIdx.x, gn = gridDim.x * 512;
    for (int i = gt; i < NT * 64; i += gn) {
        const int tok = i >> 6, g = i & 63;
        u32x4 o = (u32x4){0u, 0u, 0u, 0u};
        if (g < 24 || g >= 32) {
            const int sc = (g < 24) ? (3072 + 8 * g) : (3264 + 8 * (g - 32));
            const u32x4 cu = *(const u32x4*)(PR + (size_t)tok * LDPR + sc);
            u32x4 pv = (u32x4){0u, 0u, 0u, 0u};
            if ((tok & (SEQ - 1)) != 0) pv = *(const u32x4*)(PR + (size_t)(tok - 1) * LDPR + sc);
            const f32x4 m0 = *(const f32x4*)(p.mu + sc), m1 = *(const f32x4*)(p.mu + sc + 4);
            float f[8];
#pragma unroll
            for (int q = 0; q < 4; ++q) {
                const float c0 = bflo(cu[q]), c1 = bfhi(cu[q]), p0 = bflo(pv[q]), p1 = bfhi(pv[q]);
                const float mm0 = (q < 2) ? m0[2 * q] : m1[2 * q - 4], mm1 = (q < 2) ? m0[2 * q + 1] : m1[2 * q - 3];
                f[2 * q] = c0 + (p0 - c0) * mm0; f[2 * q + 1] = c1 + (p1 - c1) * mm1;
            }
            if (g < 12) {
#pragma unroll
                for (int q = 0; q < 8; ++q) f[q] = tanhf(f[q]);
            } else if (g >= 32) {
#pragma unroll
                for (int q = 0; q < 8; ++q) f[q] = sigm(f[q]);
            }
            o.x = cvt_pk_bf16(f[0], f[1]); o.y = cvt_pk_bf16(f[2], f[3]); o.z = cvt_pk_bf16(f[4], f[5]); o.w = cvt_pk_bf16(f[6], f[7]);
        }
        *(u32x4*)(AL + (size_t)tok * 512 + 8 * g) = o;
    }
    {
        const bf16_t* PM = (const bf16_t*)(p.ws + OFF_PM);
        bf16_t* QC = (bf16_t*)(p.ws + OFF_QC); bf16_t* KC = (bf16_t*)(p.ws + OFF_KC);
        for (int i = gt; i < (NT / 8) * 256; i += gn) {
            const int tb = i >> 8, col = (i & 255) * 8; const int tok0 = tb * 8, t0 = tok0 & (SEQ - 1);
            f32x4 cw[4][2];
#pragma unroll
            for (int j = 0; j < 4; ++j) { cw[j][0] = *(const f32x4*)(p.conv_w + j * 2048 + col); cw[j][1] = *(const f32x4*)(p.conv_w + j * 2048 + col + 4); }
            u32x4 raw[11];
#pragma unroll
            for (int q = 0; q < 11; ++q) { const bool neg = (t0 - 3 + q) < 0; u32x4 v = *(const u32x4*)(PM + (size_t)(tok0 + (neg ? 0 : q - 3)) * LDPM + col); if (neg) v = (u32x4){0u, 0u, 0u, 0u}; raw[q] = v; }
            const float scl = (col < 1024) ? 0.0625f : 1.f;
            bf16_t* dst = (col < 1024) ? (QC + (size_t)tok0 * 1024 + col) : (KC + (size_t)tok0 * 1024 + (col - 1024));
#pragma unroll
            for (int r = 0; r < 8; ++r) {
                float o[8];
#pragma unroll
                for (int e = 0; e < 8; ++e) {
                    const float c0 = (e < 4) ? cw[0][0][e] : cw[0][1][e - 4], c1 = (e < 4) ? cw[1][0][e] : cw[1][1][e - 4], c2 = (e < 4) ? cw[2][0][e] : cw[2][1][e - 4], c3 = (e < 4) ? cw[3][0][e] : cw[3][1][e - 4];
                    float sv = c0 * bfel(raw[r], e) + c1 * bfel(raw[r + 1], e) + c2 * bfel(raw[r + 2], e) + c3 * bfel(raw[r + 3], e);
                    o[e] = sv * sigm(sv) * scl;
                }
                u32x4 pk; pk.x = cvt_pk_bf16(o[0], o[1]); pk.y = cvt_pk_bf16(o[2], o[3]); pk.z = cvt_pk_bf16(o[4], o[5]); pk.w = cvt_pk_bf16(o[6], o[7]);
                *(u32x4*)(dst + (size_t)r * 1024) = pk;
            }
        }
    }
    {
        const int lane = threadIdx.x & 63, gw = blockIdx.x * 8 + (threadIdx.x >> 6), nw = gridDim.x * 8;
        float* GB = (float*)((unsigned char*)p.out + DO_GB); float* GA = (float*)((unsigned char*)p.out + DO_GA); float* GW = (float*)((unsigned char*)p.out + DO_GW);
        for (int task = gw; task < 1024; task += nw) {
            const int bh = task >> 6, c = task & 63, bb = bh >> 2, h = bh & 3; const size_t tok = (size_t)bb * SEQ + c * 64 + lane;
            const float iv = bf2f(PR[tok * LDPR + 3520 + h]) + p.b_i[h], fv = bf2f(PR[tok * LDPR + 3524 + h]) + p.b_f[h];
            float lf = fminf(fv, 0.f) - __logf(1.f + __expf(-fabsf(fv)));
#pragma unroll
            for (int d = 1; d < 64; d <<= 1) { const float y = __shfl_up(lf, d); if (lane >= d) lf += y; }
            const float bl = rlane(lf, 63);
            const int o = bh * SEQ + c * 64 + lane;
            GB[o] = lf; GA[o] = iv - lf; GW[o] = __expf(bl - lf + iv);
        }
    }
}

constexpr size_t OFF_YRAW = OFF_WINT, OFF_BON = OFF_WINT + 32 * MiB;
struct RwOps { f32x4 a0, a1, q0, q1, w0, w1, b0, b1, k0, k1; float v, br, kr; };
__device__ __forceinline__ f32x2_t lo2(f32x4 v) { return __builtin_shufflevector(v, v, 0, 1); }
__device__ __forceinline__ f32x2_t hi2(f32x4 v) { return __builtin_shufflevector(v, v, 2, 3); }
__device__ __forceinline__ f32x2_t fma2(f32x2_t a, f32x2_t b, f32x2_t c) { return __builtin_elementwise_fma(a, b, c); }
__device__ void rwkv_scan(const KP& p, int blk, LAS unsigned char* lds) {
    const int tid0 = tid_l();
    const int bh = blk >> 1, half = blk & 1, b = bh >> 4, h = bh & 15;
    constexpr int BUFB = 53760;
    const bf16_t* PR = (const bf16_t*)(p.ws + OFF_PR);
    const bf16_t* WLOG = (const bf16_t*)((const unsigned char*)p.out + DO_WLOG);
    const bf16_t* AG = (const bf16_t*)((const unsigned char*)p.out + DO_AG);
    bf16_t* YRAW = (bf16_t*)(p.ws + OFF_YRAW); float* BON = (float*)(p.ws + OFF_BON);
    const size_t tokbase = (size_t)b * SEQ;
    if (tid0 < 256) {
        const int rowl = tid0 >> 3, j8 = (tid0 & 7) * 8, row = 32 * half + rowl;
        f32x2_t S2[4];
#pragma unroll
        for (int k = 0; k < 4; ++k) S2[k] = (f32x2_t){0.f, 0.f};
        __syncthreads();
        for (int c = 0; c < 128; ++c) {
            const LAS float* bp = (const LAS float*)(lds + (c & 1) * BUFB);
            LAS float* yb = (LAS float*)(lds + (c & 1) * BUFB + 49408);
#define RW_LD(O, s) do { const LAS float* q_ = bp + (s) * 64 + j8; O.a0 = *(const LAS f32x4*)(q_); O.a1 = *(const LAS f32x4*)(q_ + 4); O.b0 = *(const LAS f32x4*)(q_ + 2048); O.b1 = *(const LAS f32x4*)(q_ + 2052); \
            O.w0 = *(const LAS f32x4*)(q_ + 4096); O.w1 = *(const LAS f32x4*)(q_ + 4100); O.k0 = *(const LAS f32x4*)(q_ + 6144); O.k1 = *(const LAS f32x4*)(q_ + 6148); \
            O.q0 = *(const LAS f32x4*)(q_ + 8192); O.q1 = *(const LAS f32x4*)(q_ + 8196); O.v = bp[10240 + (s) * 64 + row]; O.br = bp[12288 + (s)]; O.kr = bp[12320 + (s)]; } while (0)
#define RW_STEP(O, s) do { \
            f32x2_t pa = S2[0] * lo2(O.a0); f32x2_t py = S2[0] * lo2(O.q0); \
            pa = fma2(S2[1], hi2(O.a0), pa); py = fma2(S2[1], hi2(O.q0), py); pa = fma2(S2[2], lo2(O.a1), pa); py = fma2(S2[2], lo2(O.q1), py); \
            pa = fma2(S2[3], hi2(O.a1), pa); py = fma2(S2[3], hi2(O.q1), py); \
            float sa = pa.x + pa.y, yy = py.x + py.y; \
            sa += dppf<0xB1>(sa); yy += dppf<0xB1>(yy); sa += dppf<0x4E>(sa); yy += dppf<0x4E>(yy); sa += dppf<0x141>(sa); yy += dppf<0x141>(yy); \
            const f32x2_t sa2 = (f32x2_t){sa, sa}, vv2 = (f32x2_t){O.v, O.v}; \
            S2[0] = fma2(S2[0], lo2(O.w0), fma2(vv2, lo2(O.k0), sa2 * lo2(O.b0))); S2[1] = fma2(S2[1], hi2(O.w0), fma2(vv2, hi2(O.k0), sa2 * hi2(O.b0))); \
            S2[2] = fma2(S2[2], lo2(O.w1), fma2(vv2, lo2(O.k1), sa2 * lo2(O.b1))); S2[3] = fma2(S2[3], hi2(O.w1), fma2(vv2, hi2(O.k1), sa2 * hi2(O.b1))); \
            if ((tid0 & 7) == 0) yb[(s) * 32 + rowl] = yy + sa * O.br + O.v * O.kr; } while (0)
            RwOps o0, o1;
            RW_LD(o0, 0);
#pragma unroll 1
            for (int s = 0; s < 32; s += 2) {
                RW_LD(o1, s + 1);
                RW_STEP(o0, s);
                { const int sn = (s + 2 < 32) ? s + 2 : 31; RW_LD(o0, sn); }
                RW_STEP(o1, s + 1);
            }
#undef RW_LD
#undef RW_STEP
            __syncthreads();
        }
    } else {
        const int ht = tid0 - 256, tt = ht >> 3, cg8 = (ht & 7) * 8, ch = h * 64 + cg8;
        float mur[8], muk[8], muv[8], kkc[8], kac[8], rkc[8];
#pragma unroll
        for (int e = 0; e < 8; ++e) { mur[e] = p.mu[ch + e]; muk[e] = p.mu[1024 + ch + e]; muv[e] = p.mu[2048 + ch + e]; kkc[e] = p.k_k[ch + e]; kac[e] = p.k_a[ch + e]; rkc[e] = p.r_k[ch + e]; }
        for (int c = -1; c < 128; ++c) {
            if (c >= 1) {
                const LAS float* yb = (const LAS float*)(lds + ((c - 1) & 1) * BUFB + 49408);
                const int r4 = (ht & 7) * 4; const f32x4 y4 = *(const LAS f32x4*)(yb + tt * 32 + r4);
                u32x2 ov; ov.x = cvt_pk_bf16(y4[0], y4[1]); ov.y = cvt_pk_bf16(y4[2], y4[3]);
                *(u32x2*)(YRAW + (tokbase + (size_t)(c - 1) * 32 + tt) * 1024 + h * 64 + 32 * half + r4) = ov;
            }
            if (c + 1 < 128) {
                const int cn = c + 1, t = cn * 32 + tt; const size_t tok = tokbase + t;
                LAS float* bp = (LAS float*)(lds + (cn & 1) * BUFB);
                const bf16_t* pr_ = PR + tok * LDPR + ch;
                const u32x4 r4 = *(const u32x4*)pr_, k4 = *(const u32x4*)(pr_ + 1024), v4 = *(const u32x4*)(pr_ + 2048);
                u32x4 pr4 = (u32x4){0u, 0u, 0u, 0u}, pk4 = pr4, pv4 = pr4;
                if (t > 0) { pr4 = *(const u32x4*)(pr_ - LDPR); pk4 = *(const u32x4*)(pr_ - LDPR + 1024); pv4 = *(const u32x4*)(pr_ - LDPR + 2048); }
                const u32x4 w4 = *(const u32x4*)(WLOG + tok * 1024 + ch), a4 = *(const u32x4*)(AG + tok * 1024 + ch);
                float r[8], k[8], v[8], kk[8], av[8], dec[8];
                float n2 = 0.f;
#pragma unroll
                for (int e = 0; e < 8; ++e) {
                    const float rc = bfel(r4, e), kc = bfel(k4, e), vc = bfel(v4, e);
                    r[e] = rc + (bfel(pr4, e) - rc) * mur[e]; k[e] = kc + (bfel(pk4, e) - kc) * muk[e]; v[e] = vc + (bfel(pv4, e) - vc) * muv[e];
                    kk[e] = k[e] * kkc[e]; n2 += kk[e] * kk[e]; av[e] = bfel(a4, e); dec[e] = __expf(bfel(w4, e));
                }
                n2 = red8(n2);
                const float inv = 1.f / fmaxf(sqrtf(n2), 1e-12f);
                float br = 0.f, kr = 0.f, bon = 0.f;
                f32x4 oa[2], ob[2], ow[2], ok[2], oq[2], ovv[2];
#pragma unroll
                for (int e = 0; e < 8; ++e) {
                    const float kn = kk[e] * inv, k3 = k[e] * (1.f + (av[e] - 1.f) * kac[e]), bb = kn * av[e];
                    oa[e >> 2][e & 3] = -kn; ob[e >> 2][e & 3] = bb; ow[e >> 2][e & 3] = dec[e]; ok[e >> 2][e & 3] = k3; oq[e >> 2][e & 3] = dec[e] * r[e]; ovv[e >> 2][e & 3] = v[e];
                    br += bb * r[e]; kr += k3 * r[e]; bon += r[e] * k3 * rkc[e];
                }
                br = red8(br); kr = red8(kr); bon = red8(bon);
                LAS float* q_ = bp + tt * 64 + cg8;
#pragma unroll
                for (int i = 0; i < 2; ++i) { *(LAS f32x4*)(q_ + 4 * i) = oa[i]; *(LAS f32x4*)(q_ + 2048 + 4 * i) = ob[i]; *(LAS f32x4*)(q_ + 4096 + 4 * i) = ow[i]; *(LAS f32x4*)(q_ + 6144 + 4 * i) = ok[i];
                    *(LAS f32x4*)(q_ + 8192 + 4 * i) = oq[i]; *(LAS f32x4*)(q_ + 10240 + 4 * i) = ovv[i]; }
                if ((ht & 7) == 0) { bp[12288 + tt] = br; bp[12320 + tt] = kr; if (half == 0) BON[tok * 16 + h] = bon; }
            }
            __syncthreads();
        }
        {
            const LAS float* yb = (const LAS float*)(lds + (127 & 1) * BUFB + 49408);
            const int r4 = (ht & 7) * 4; const f32x4 y4 = *(const LAS f32x4*)(yb + tt * 32 + r4);
            u32x2 ov; ov.x = cvt_pk_bf16(y4[0], y4[1]); ov.y = cvt_pk_bf16(y4[2], y4[3]);
            *(u32x2*)(YRAW + (tokbase + (size_t)127 * 32 + tt) * 1024 + h * 64 + 32 * half + r4) = ov;
        }
    }
}

__device__ void phase_rwkv_post(const KP& p) {
    const bf16_t* PR = (const bf16_t*)(p.ws + OFF_PR);
    const bf16_t* GG = (const bf16_t*)((const unsigned char*)p.out + DO_GG);
    bf16_t* YR = (bf16_t*)(p.ws + OFF_YRAW); const float* BON = (const float*)(p.ws + OFF_BON);
    const int gt = blockIdx.x * 512 + tid_l(), gn = gridDim.x * 512;
    for (int i = gt; i < NT * 256; i += gn) {
        const int tok = i >> 8, h = (i >> 4) & 15, ch = h * 64 + (i & 15) * 4;
        const u32x2 y2 = *(const u32x2*)(YR + (size_t)tok * 1024 + ch), v2 = *(const u32x2*)(PR + (size_t)tok * LDPR + 2048 + ch), g2 = *(const u32x2*)(GG + (size_t)tok * 1024 + ch);
        u32x2 pv2 = (u32x2){0u, 0u};
        if ((tok & (SEQ - 1)) != 0) pv2 = *(const u32x2*)(PR + (size_t)(tok - 1) * LDPR + 2048 + ch);
        const float bon = BON[tok * 16 + h];
        const f32x4 muv = *(const f32x4*)(p.mu + 2048 + ch), lnw = *(const f32x4*)(p.ln_w + ch), lnb = *(const f32x4*)(p.ln_b + ch);
        const f32x4 y = (f32x4){bflo(y2.x), bfhi(y2.x), bflo(y2.y), bfhi(y2.y)}, vc = (f32x4){bflo(v2.x), bfhi(v2.x), bflo(v2.y), bfhi(v2.y)}, vp = (f32x4){bflo(pv2.x), bfhi(pv2.x), bflo(pv2.y), bfhi(pv2.y)};
        const f32x4 g = (f32x4){bflo(g2.x), bfhi(g2.x), bflo(g2.y), bfhi(g2.y)};
        const f32x4 v = vc + (vp - vc) * muv;
        const float mean = red16(y[0] + y[1] + y[2] + y[3]) * (1.f / 64.f);
        const f32x4 d = y - mean;
        const float var = red16(d[0] * d[0] + d[1] * d[1] + d[2] * d[2] + d[3] * d[3]) * (1.f / 64.f);
        const float rs = rsqrtf(var + 64e-5f);
        const f32x4 res = (d * rs * lnw + lnb + bon * v) * g;
        u32x2 ov; ov.x = cvt_pk_bf16(res[0], res[1]); ov.y = cvt_pk_bf16(res[2], res[3]);
        *(u32x2*)(YR + (size_t)tok * 1024 + ch) = ov;
    }
}

typedef short v4i16_t __attribute__((ext_vector_type(4)));
__device__ __forceinline__ bf16x8 tr_frag(const LAS unsigned char* base, int stride_b, int krow0, int ncol0, int lane) {
    const int g = lane >> 4, q = (lane & 15) >> 2, pp = lane & 3;
    const LAS unsigned char* a0 = base + (krow0 + 8 * g + q) * stride_b + (ncol0 + 4 * pp) * 2;
    const v4i16_t x = __builtin_amdgcn_ds_read_tr16_b64_v4i16((LAS v4i16_t*)a0), y = __builtin_amdgcn_ds_read_tr16_b64_v4i16((LAS v4i16_t*)(a0 + 4 * stride_b));
    return (bf16x8){x[0], x[1], x[2], x[3], y[0], y[1], y[2], y[3]};
}
__device__ void mlstm_run(const KP& p, int item, LAS unsigned char* lds) {
    const int tid0 = tid_l();
    const int bh = item >> 3, b = bh >> 2, h = bh & 3, dv0 = (item & 7) * 32;
    const size_t tokbase = (size_t)b * SEQ;
    LAS bf16_t* Qs = (LAS bf16_t*)(lds + 0);
    LAS bf16_t* Ks = (LAS bf16_t*)(lds + 33792);
    LAS bf16_t* Vs = (LAS bf16_t*)(lds + 67584);
    LAS bf16_t* Vws = (LAS bf16_t*)(lds + 74752);
    LAS bf16_t* Ss = (LAS bf16_t*)(lds + 81920);
    LAS bf16_t* CT0 = (LAS bf16_t*)(lds + 91136);
    LAS bf16_t* Os = (LAS bf16_t*)(lds + 141824);
    LAS float* BC = (LAS float*)(lds + 146944);
    LAS float* GAs = (LAS float*)(lds + 147200);
    const bf16_t* QC = (const bf16_t*)(p.ws + OFF_QC); const bf16_t* KC = (const bf16_t*)(p.ws + OFF_KC);
    bf16_t* PM = (bf16_t*)(p.ws + OFF_PM);
    const float* GB = (const float*)((const unsigned char*)p.out + DO_GB); const float* GA = (const float*)((const unsigned char*)p.out + DO_GA); const float* GW = (const float*)((const unsigned char*)p.out + DO_GW);
    for (int i = tid0; i < 2 * 48 * 264 / 2; i += 512) ((LAS unsigned*)CT0)[i] = 0u;
    for (int i = tid0; i < 2 * 64 * 56 / 2; i += 512) ((LAS unsigned*)Vs)[i] = 0u;
    __syncthreads();
    if (tid0 < 64) Vs[tid0 * 56 + 32] = (bf16_t)0x3F80;
    f32x4 cacc[6];
#pragma unroll
    for (int i = 0; i < 6; ++i) cacc[i] = (f32x4){0.f, 0.f, 0.f, 0.f};
    u32x4 q4[4], k4[4], vo4; float gb = 0.f, ga = 0.f, gwv = 0.f;
#define ML_LOAD(c, TID) do { const int row_ = (TID) >> 3, pc_ = (TID) & 7; const size_t tk_ = tokbase + (size_t)(c) * 64; \
        const bf16_t* qp_ = QC + (tk_ + row_) * 1024 + h * 256 + pc_ * 32; const bf16_t* kp_ = KC + (tk_ + row_) * 1024 + h * 256 + pc_ * 32; \
        _Pragma("unroll") for (int i_ = 0; i_ < 4; ++i_) { q4[i_] = *(const u32x4*)(qp_ + 8 * i_); k4[i_] = *(const u32x4*)(kp_ + 8 * i_); } \
        const int sg_ = (TID) & 255, s_ = sg_ >> 2, g_ = sg_ & 3; \
        vo4 = *(const u32x4*)(PM + (tk_ + s_) * LDPM + ((TID) < 256 ? 2048 : 3072) + h * 256 + dv0 + 8 * g_); \
        gwv = GW[bh * SEQ + (c) * 64 + s_]; \
        if ((TID) < 64) { gb = GB[bh * SEQ + (c) * 64 + (TID)]; ga = GA[bh * SEQ + (c) * 64 + (TID)]; } } while (0)
    ML_LOAD(0, tid0);
    __syncthreads();
    int cur = 0;
    for (int c = 0; c < 64; ++c) {
        int tid = tid0; asm volatile("" : "+v"(tid));
        const int lane = tid & 63, w = tid >> 6, fr = lane & 15, fq = lane >> 4;
        LAS bf16_t* CTc = CT0 + cur * (48 * 264); LAS bf16_t* CTn = CT0 + (cur ^ 1) * (48 * 264);
        {
            const int row = tid >> 3, pc = tid & 7;
#pragma unroll
            for (int i = 0; i < 4; ++i) { *(LAS u32x4*)(Qs + row * 264 + pc * 32 + 8 * i) = q4[i]; *(LAS u32x4*)(Ks + row * 264 + pc * 32 + 8 * i) = k4[i]; }
            const int sg = tid & 255, s = sg >> 2, g = sg & 3;
            if (tid < 256) {
                *(LAS u32x4*)(Vs + s * 56 + 8 * g) = vo4;
                u32x4 wv;
#pragma unroll
                for (int e = 0; e < 4; ++e) wv[e] = cvt_pk_bf16(bflo(vo4[e]) * gwv, bfhi(vo4[e]) * gwv);
                *(LAS u32x4*)(Vws + s * 56 + 8 * g) = wv;
                if (g == 0) Vws[s * 56 + 32] = f2bf(gwv);
            } else {
                if (c > 0) { const u32x4 yv = *(const LAS u32x4*)(Os + s * 40 + 8 * g); *(u32x4*)(PM + (tokbase + (size_t)(c - 1) * 64 + s) * LDPM + 3072 + h * 256 + dv0 + 8 * g) = yv; }
                *(LAS u32x4*)(Os + s * 40 + 8 * g) = vo4;
            }
            if (tid < 64) { BC[tid] = gb; GAs[tid] = ga; }
        }
        asm volatile("" ::: "memory");
        if (c + 1 < 64) ML_LOAD(c + 1, tid);
        asm volatile("" ::: "memory");
        __syncthreads();
        {
            const int mt = w >> 1, ntb = (w & 1) * 2;
            f32x4 s0 = (f32x4){0.f, 0.f, 0.f, 0.f}, s1 = s0;
#pragma unroll
            for (int ks = 0; ks < 8; ++ks) {
                const bf16x8 a = *(const LAS bf16x8*)(Qs + (16 * mt + fr) * 264 + 32 * ks + 8 * fq);
                const bf16x8 b0 = *(const LAS bf16x8*)(Ks + (16 * ntb + fr) * 264 + 32 * ks + 8 * fq);
                const bf16x8 b1 = *(const LAS bf16x8*)(Ks + (16 * (ntb + 1) + fr) * 264 + 32 * ks + 8 * fq);
                s0 = __builtin_amdgcn_mfma_f32_16x16x32_bf16(a, b0, s0, 0, 0, 0);
                s1 = __builtin_amdgcn_mfma_f32_16x16x32_bf16(a, b1, s1, 0, 0, 0);
            }
            const int sA = 16 * ntb + fr, sB = sA + 16;
            const float gA = GAs[sA], gB = GAs[sB];
#pragma unroll
            for (int j = 0; j < 4; ++j) {
                const int t = 16 * mt + 4 * fq + j; const float bt = BC[t];
                const float vA = (sA <= t) ? s0[j] * __expf(bt + gA) : 0.f, vB = (sB <= t) ? s1[j] * __expf(bt + gB) : 0.f;
                Ss[t * 72 + sA] = f2bf(vA); Ss[t * 72 + sB] = f2bf(vB);
            }
        }
        __syncthreads();
        {
            const int mt = w >> 1, nt = w & 1;
            f32x4 aA = (f32x4){0.f, 0.f, 0.f, 0.f}, aB = aA, xA = aA, xB = aA;
#pragma unroll
            for (int ks = 0; ks < 2; ++ks) {
                const bf16x8 a = *(const LAS bf16x8*)(Ss + (16 * mt + fr) * 72 + 32 * ks + 8 * fq);
                const bf16x8 bm = tr_frag((const LAS unsigned char*)Vs, 112, 32 * ks, 16 * nt, lane);
                const bf16x8 bx = tr_frag((const LAS unsigned char*)Vs, 112, 32 * ks, 32, lane);
                aA = __builtin_amdgcn_mfma_f32_16x16x32_bf16(a, bm, aA, 0, 0, 0);
                xA = __builtin_amdgcn_mfma_f32_16x16x32_bf16(a, bx, xA, 0, 0, 0);
            }
#pragma unroll
            for (int ks = 0; ks < 8; ++ks) {
                const bf16x8 a = *(const LAS bf16x8*)(Qs + (16 * mt + fr) * 264 + 32 * ks + 8 * fq);
                const bf16x8 bm = *(const LAS bf16x8*)(CTc + (16 * nt + fr) * 264 + 32 * ks + 8 * fq);
                const bf16x8 bx = *(const LAS bf16x8*)(CTc + (32 + fr) * 264 + 32 * ks + 8 * fq);
                aB = __builtin_amdgcn_mfma_f32_16x16x32_bf16(a, bm, aB, 0, 0, 0);
                xB = __builtin_amdgcn_mfma_f32_16x16x32_bf16(a, bx, xB, 0, 0, 0);
            }
#pragma unroll
            for (int j = 0; j < 4; ++j) {
                const int t = 16 * mt + 4 * fq + j; const float eb = __expf(BC[t]);
                const float num = aA[j] + eb * aB[j];
                const float den = __shfl(xA[j] + eb * xB[j], lane & 48);
                const float hv = num / fmaxf(fabsf(den), 1.f);
                LAS bf16_t* op = Os + t * 40 + 16 * nt + fr;
                *op = f2bf(hv * sigm(bf2f(*op)));
            }
            const float decay = __expf(BC[63]);
            bf16x8 bw[3][2];
#pragma unroll
            for (int n3 = 0; n3 < 3; ++n3)
#pragma unroll
                for (int ks = 0; ks < 2; ++ks) bw[n3][ks] = tr_frag((const LAS unsigned char*)Vws, 112, 32 * ks, 16 * n3, lane);
#pragma unroll
            for (int m2 = 0; m2 < 2; ++m2) {
                const int mtk = 2 * w + m2;
                const bf16x8 ka0 = tr_frag((const LAS unsigned char*)Ks, 528, 0, 16 * mtk, lane), ka1 = tr_frag((const LAS unsigned char*)Ks, 528, 32, 16 * mtk, lane);
#pragma unroll
                for (int n3 = 0; n3 < 3; ++n3) {
                    f32x4 cc = cacc[m2 * 3 + n3] * decay;
                    cc = __builtin_amdgcn_mfma_f32_16x16x32_bf16(ka0, bw[n3][0], cc, 0, 0, 0);
                    cc = __builtin_amdgcn_mfma_f32_16x16x32_bf16(ka1, bw[n3][1], cc, 0, 0, 0);
                    cacc[m2 * 3 + n3] = cc;
                    u32x2 pk; pk.x = cvt_pk_bf16(cc[0], cc[1]); pk.y = cvt_pk_bf16(cc[2], cc[3]);
                    *(LAS u32x2*)(CTn + (16 * n3 + fr) * 264 + 16 * mtk + 4 * fq) = pk;
                }
            }
        }
        cur ^= 1;
        __syncthreads();
    }
    if (tid0 >= 256) { const int sg = tid0 & 255, s = sg >> 2, g = sg & 3; const u32x4 yv = *(const LAS u32x4*)(Os + s * 40 + 8 * g);
        *(u32x4*)(PM + (tokbase + (size_t)63 * 64 + s) * LDPM + 3072 + h * 256 + dv0 + 8 * g) = yv; }
#undef ML_LOAD
}

__device__ void phase_norm2_convert(const KP& p) {
    const int tid = tid_l(), lane = tid & 63, G = gridDim.x, bid = blockIdx.x;
    rmsnorm_rows(p.out, p.g_ffn, (bf16_t*)(p.ws + OFF_XN2), bid * 8 + (tid >> 6), G * 8, lane);
    const int gw = bid * 8 + (tid >> 6), nw = G * 8;
    for (int tb = 0; tb < 2; ++tb) {
        const float* src = tb ? p.peer_v : p.peer_u; unsigned char* dst = p.ws + (tb ? OFF_PV : OFF_PU); float* sc = (float*)(p.ws + (tb ? OFF_SCV : OFF_SCU));
        for (int row = gw; row < 16384; row += nw) {
            const float* sp = src + (size_t)row * DM + lane * 16;
            f32x4 v[8]; float am = 0.f;
#pragma unroll
            for (int i = 0; i < 2; ++i)
#pragma unroll
                for (int q = 0; q < 4; ++q) { v[i * 4 + q] = *(const f32x4*)(sp + i * 1024 + q * 4);
                    am = fmaxf(am, fmaxf(fmaxf(fabsf(v[i * 4 + q][0]), fabsf(v[i * 4 + q][1])), fmaxf(fabsf(v[i * 4 + q][2]), fabsf(v[i * 4 + q][3])))); }
            const unsigned amu = wave_max_u32(__float_as_uint(am));
            const float amax = __uint_as_float(amu);
            float scl = 1.f;
            if (amax > 0.f) scl = exp2f(floorf(log2f(240.f / amax)));
            if (lane == 0) sc[row] = 1.f / scl;
#pragma unroll
            for (int i = 0; i < 2; ++i) { u32x4 o;
#pragma unroll
                for (int q = 0; q < 4; ++q) { const f32x4 t = v[i * 4 + q] * scl; int w = __builtin_amdgcn_cvt_pk_fp8_f32(t[0], t[1], 0, false); w = __builtin_amdgcn_cvt_pk_fp8_f32(t[2], t[3], w, true); o[q] = (unsigned)w; }
                *(u32x4*)(dst + (size_t)row * DM + i * 1024 + lane * 16) = o; }
        }
    }
}

__device__ void phase_peer(const KP& p, LAS unsigned char* lds) {
    const int tid = tid_l(), lane = tid & 63, w = tid >> 6, fr = lane & 15, fq = lane >> 4;
    LAS unsigned* KEYS = (LAS unsigned*)lds;
    LAS int* TI = (LAS int*)(lds + 32768);
    LAS float* TG = (LAS float*)(lds + 49152);
    const bf16_t* Q = (const bf16_t*)(p.ws + OFF_Q);
    const bf16_t* SK = (const bf16_t*)(p.ws + OFF_SUBK);
    const bf16_t* XN2 = (const bf16_t*)(p.ws + OFF_XN2);
    const unsigned char* PU = p.ws + OFF_PU; const unsigned char* PV = p.ws + OFF_PV;
    const float* SCU = (const float*)(p.ws + OFF_SCU); const float* SCV = (const float*)(p.ws + OFF_SCV);
    float* out = p.out;
    for (int tile = blockIdx.x; tile < NT / 32; tile += gridDim.x) {
        const int tk0 = tile * 32;
        for (int h = 0; h < 8; ++h) {
            {
                const int pp = w >> 2, ntb = (w & 3) * 2;
                f32x4 acc[2][2];
#pragma unroll
                for (int a = 0; a < 2; ++a)
#pragma unroll
                    for (int b = 0; b < 2; ++b) acc[a][b] = (f32x4){0.f, 0.f, 0.f, 0.f};
#pragma unroll
                for (int ks = 0; ks < 4; ++ks) {
                    bf16x8 af[2], bfr[2];
#pragma unroll
                    for (int mt = 0; mt < 2; ++mt) af[mt] = *(const bf16x8*)(Q + (size_t)(tk0 + 16 * mt + fr) * DM + h * 256 + pp * 128 + 32 * ks + 8 * fq);
#pragma unroll
                    for (int n = 0; n < 2; ++n) bfr[n] = *(const bf16x8*)(SK + (size_t)(pp * 128 + 16 * (ntb + n) + fr) * 128 + 32 * ks + 8 * fq);
#pragma unroll
                    for (int mt = 0; mt < 2; ++mt)
#pragma unroll
                        for (int n = 0; n < 2; ++n) acc[mt][n] = __builtin_amdgcn_mfma_f32_16x16x32_bf16(af[mt], bfr[n], acc[mt][n], 0, 0, 0);
                }
#pragma unroll
                for (int mt = 0; mt < 2; ++mt)
#pragma unroll
                    for (int n = 0; n < 2; ++n)
#pragma unroll
                        for (int j = 0; j < 4; ++j) { const int tokl = 16 * mt + 4 * fq + j, key = 16 * (ntb + n) + fr;
                            KEYS[(tokl * 2 + pp) * 128 + key] = (ordf(acc[mt][n][j]) & ~0x7Fu) | (unsigned)key; }
            }
            __syncthreads();
            for (int q = 0; q < 4; ++q) {
                const int tokl = 4 * w + q;
                unsigned top[2] = {0u, 0u};
#pragma unroll
                for (int pp = 0; pp < 2; ++pp) {
                    unsigned k0 = KEYS[(tokl * 2 + pp) * 128 + lane], k1 = KEYS[(tokl * 2 + pp) * 128 + 64 + lane];
                    for (int it = 0; it < 16; ++it) {
                        const unsigned M = wave_max_u32(max(k0, k1));
                        if (lane == it) top[pp] = M;
                        k0 = (k0 == M) ? 0u : k0; k1 = (k1 == M) ? 0u : k1;
                    }
                }
                const int j = lane & 15, ib = lane >> 4;
                const float v2 = unordf((unsigned)__shfl((int)top[1], j) & ~0x7Fu);
                unsigned cnd[4];
#pragma unroll
                for (int m = 0; m < 4; ++m) { const int i = ib + 4 * m; const float v1 = unordf((unsigned)__shfl((int)top[0], i) & ~0x7Fu);
                    cnd[m] = (ordf(v1 + v2) & ~0xFFu) | (unsigned)(i * 16 + j); }
                unsigned best = 0u;
                for (int it = 0; it < 16; ++it) {
                    const unsigned M = wave_max_u32(max(max(cnd[0], cnd[1]), max(cnd[2], cnd[3])));
                    if (lane == it) best = M;
#pragma unroll
                    for (int m = 0; m < 4; ++m) cnd[m] = (cnd[m] == M) ? 0u : cnd[m];
                }
                const int ci = (int)(best & 0xFFu);
                const float bv = unordf(best & ~0xFFu);
                const int e1 = __shfl((int)top[0], ci >> 4) & 0x7F, e2 = __shfl((int)top[1], ci & 15) & 0x7F;
                const float mx = rlane(bv, 0);
                float ev = (lane < 16) ? __expf(bv - mx) : 0.f;
                const float sum = rlane(red16(ev), 0);
                if (lane < 16) { TI[tokl * 128 + h * 16 + lane] = e1 * 128 + e2; TG[tokl * 128 + h * 16 + lane] = ev / sum; }
            }
            __syncthreads();
        }
        for (int q = 0; q < 4; ++q) {
            const int tokl = 4 * w + q; const size_t tok = (size_t)tk0 + tokl;
            float xv[32], acc[32];
#pragma unroll
            for (int i = 0; i < 2; ++i)
#pragma unroll
                for (int hh = 0; hh < 2; ++hh) { const u32x4 x4 = *(const u32x4*)(XN2 + tok * DM + i * 1024 + lane * 16 + hh * 8);
#pragma unroll
                    for (int e = 0; e < 4; ++e) { xv[i * 16 + hh * 8 + 2 * e] = bflo(x4[e]); xv[i * 16 + hh * 8 + 2 * e + 1] = bfhi(x4[e]); } }
#pragma unroll
            for (int i = 0; i < 32; ++i) acc[i] = 0.f;
#pragma unroll 4
            for (int e = 0; e < 128; ++e) {
                const int idx = __builtin_amdgcn_readfirstlane(TI[tokl * 128 + e]);
                const float gate = __builtin_bit_cast(float, __builtin_amdgcn_readfirstlane(__builtin_bit_cast(int, TG[tokl * 128 + e])));
                const unsigned char* up = PU + (size_t)idx * DM + lane * 16; const unsigned char* vp = PV + (size_t)idx * DM + lane * 16;
                u32x4 u4[2], v4[2];
                u4[0] = *(const u32x4*)up; u4[1] = *(const u32x4*)(up + 1024); v4[0] = *(const u32x4*)vp; v4[1] = *(const u32x4*)(vp + 1024);
                const float su = SCU[idx], sv = SCV[idx];
                float d0 = 0.f, d1 = 0.f, d2 = 0.f, d3 = 0.f;
#pragma unroll
                for (int i = 0; i < 2; ++i)
#pragma unroll
                    for (int k = 0; k < 4; ++k) { const f32x2_t lo = __builtin_amdgcn_cvt_pk_f32_fp8((int)u4[i][k], false), hi = __builtin_amdgcn_cvt_pk_f32_fp8((int)u4[i][k], true);
                        d0 += xv[i * 16 + 4 * k] * lo.x; d1 += xv[i * 16 + 4 * k + 1] * lo.y; d2 += xv[i * 16 + 4 * k + 2] * hi.x; d3 += xv[i * 16 + 4 * k + 3] * hi.y; }
                const float act = wave_sum((d0 + d1) + (d2 + d3)) * su;
                const float coef = gate * 0.5f * act * (1.f + erff(act * 0.70710678118f)) * sv;
#pragma unroll
                for (int i = 0; i < 2; ++i)
#pragma unroll
                    for (int k = 0; k < 4; ++k) { const f32x2_t lo = __builtin_amdgcn_cvt_pk_f32_fp8((int)v4[i][k], false), hi = __builtin_amdgcn_cvt_pk_f32_fp8((int)v4[i][k], true);
                        acc[i * 16 + 4 * k] += coef * lo.x; acc[i * 16 + 4 * k + 1] += coef * lo.y; acc[i * 16 + 4 * k + 2] += coef * hi.x; acc[i * 16 + 4 * k + 3] += coef * hi.y; }
            }
            float ss = 0.f;
            float* orow = out + tok * DM + lane * 16;
#pragma unroll
            for (int i = 0; i < 2; ++i)
#pragma unroll
                for (int k = 0; k < 4; ++k) { const f32x4 h0 = *(const f32x4*)(orow + i * 1024 + 4 * k);
#pragma unroll
                    for (int j = 0; j < 4; ++j) { acc[i * 16 + 4 * k + j] += h0[j]; ss += acc[i * 16 + 4 * k + j] * acc[i * 16 + 4 * k + j]; } }
            ss = wave_sum(ss);
            const float r = rsqrtf(ss * (1.f / DM) + 1e-6f);
#pragma unroll
            for (int i = 0; i < 2; ++i)
#pragma unroll
                for (int k = 0; k < 4; ++k) { const f32x4 g0 = *(const f32x4*)(p.g_final + i * 1024 + lane * 16 + 4 * k); f32x4 o0;
#pragma unroll
                    for (int j = 0; j < 4; ++j) o0[j] = acc[i * 16 + 4 * k + j] * r * g0[j];
                    *(f32x4*)(orow + i * 1024 + 4 * k) = o0; }
        }
        __syncthreads();
    }
}

__global__ void __launch_bounds__(512) fwd_megakernel(KP p) {
    extern __shared__ __attribute__((aligned(16))) unsigned char smem[];
    LAS unsigned char* lds = (LAS unsigned char*)smem;
    cg::grid_group grid = cg::this_grid();
#define GRID_SYNC() do { __builtin_amdgcn_fence(__ATOMIC_RELEASE, "agent"); __syncthreads(); grid.sync(); __builtin_amdgcn_fence(__ATOMIC_ACQUIRE, "agent"); } while (0)
    const int G = gridDim.x, bid = blockIdx.x;
    unsigned char* ws = p.ws; unsigned char* dob = (unsigned char*)p.out;

#define RUN_GEMM(MODE, ...) do { unsigned char* ws = lp(p.ws); unsigned char* dob = lp((unsigned char*)p.out); const pg8::Gemm g_ = pg8::Gemm{__VA_ARGS__}; pg8::StaticOrder S_; S_.init(g_.M, g_.N, G, bid); \
        const pg8::Epi<MODE> E_{ws, dob, p.x, p.w0, p.a0}; pg8::gemm_phase(lds, g_, S_, E_); } while (0)
    phase_prep(p, lds);
    GRID_SYNC();
    RUN_GEMM(0, (const bf16_t*)(ws + OFF_XN), (const bf16_t*)(ws + OFF_WINT), NT, N1, 2048, 2048, 2048);
    GRID_SYNC();
    phase_lora_prep(p);
    GRID_SYNC();
    RUN_GEMM(1, (const bf16_t*)(dob + DO_ALORA), (const bf16_t*)(ws + OFF_WAT), NT, 2048, 256, 512, 256);
    RUN_GEMM(2, (const bf16_t*)(dob + DO_ALORA) + 256, (const bf16_t*)(ws + OFF_G2T), NT, 1024, 256, 512, 256);
    GRID_SYNC();
    if (bid < 128) rwkv_scan(p, bid, lds);
    else mlstm_run(p, bid - 128, lds);
    GRID_SYNC();
    phase_rwkv_post(p);
    GRID_SYNC();
    RUN_GEMM(3, (const bf16_t*)(ws + OFF_PM) + 3072, (const bf16_t*)(ws + OFF_PMT), NT, 2048, 1024, LDPM, 1024);
    RUN_GEMM(4, (const bf16_t*)(ws + OFF_YR), (const bf16_t*)(ws + OFF_PRT), NT, 2048, 1024, 1024, 1024);
    GRID_SYNC();
    RUN_GEMM(5, (const bf16_t*)(ws + OFF_PG), (const bf16_t*)(ws + OFF_WOT), NT, 2048, 2048, LDPG, 2048);
    GRID_SYNC();
    phase_norm2_convert(p);
    GRID_SYNC();
    RUN_GEMM(6, (const bf16_t*)(ws + OFF_XN2), (const bf16_t*)(ws + OFF_WQT), NT, 2048, 2048, 2048, 2048);
    GRID_SYNC();
    phase_peer(p, lds);
}

extern "C" void kernel_launch(void* const* d_in, const int* in_sizes, int n_in, void* d_out, int out_size, void* d_ws, size_t ws_size, hipStream_t stream) {
    static int grid_blocks = 0;
    if (grid_blocks == 0) {
        if (n_in != 26 || out_size != NT * DM || ws_size < WS_NEED) { fprintf(stderr, "kernel_launch: unexpected shapes: n_in %d out %d ws %zu (need %zu)\n", n_in, out_size, ws_size, (size_t)WS_NEED); grid_blocks = -1; return; }
        int dev = 0, cus = 0, per_cu = 0;
        hipGetDevice(&dev);
        hipDeviceGetAttribute(&cus, hipDeviceAttributeMultiprocessorCount, dev);
        if (hipFuncSetAttribute((const void*)fwd_megakernel, hipFuncAttributeMaxDynamicSharedMemorySize, LDS_BYTES) != hipSuccess) { fprintf(stderr, "kernel_launch: hipFuncSetAttribute failed\n"); grid_blocks = -1; return; }
        hipOccupancyMaxActiveBlocksPerMultiprocessor(&per_cu, (const void*)fwd_megakernel, 512, LDS_BYTES);
        if (per_cu < 1) { fprintf(stderr, "kernel_launch: occupancy query says %d blocks per CU\n", per_cu); per_cu = 1; }
        (void)hipGetLastError();
        grid_blocks = cus * 1;
    }
    if (grid_blocks < 0) return;
    KP p{};
    const float** pp = (const float**)&p;
    for (int i = 0; i < 26; ++i) pp[i] = (const float*)d_in[i];
    p.out = (float*)d_out; p.ws = (unsigned char*)d_ws;
    void* args[] = {&p};
    hipError_t e = hipLaunchCooperativeKernel((void*)fwd_megakernel, dim3(grid_blocks), dim3(512), args, LDS_BYTES, stream);
    if (e != hipSuccess) fprintf(stderr, "cooperative launch failed: %s (grid %d)\n", hipGetErrorString(e), grid_blocks);
}
```

```cpp
#include <hip/hip_runtime.h>
#include <hip/hip_cooperative_groups.h>
#include <cstdio>
namespace cg = cooperative_groups;

#define LAS __attribute__((address_space(3)))
typedef unsigned short bf16_t;
typedef short bf16x8 __attribute__((ext_vector_type(8)));
typedef float f32x4 __attribute__((ext_vector_type(4)));
typedef unsigned u32x4 __attribute__((ext_vector_type(4)));
typedef unsigned u32x2 __attribute__((ext_vector_type(2)));

constexpr int NT = 16384, SEQ = 4096, DM = 2048;
constexpr int LDPM = 4096, LDPR = 3584, LDPG = 4096, N1 = 11776;
constexpr size_t MiB = 1024ull * 1024ull;
constexpr size_t OFF_PM = 0, OFF_PR = 128 * MiB, OFF_PG = 240 * MiB, OFF_XN = 368 * MiB, OFF_WINT = 432 * MiB, OFF_WTS = 478 * MiB;
constexpr size_t OFF_PMT = OFF_WTS, OFF_PRT = OFF_WTS + 4 * MiB, OFF_WOT = OFF_WTS + 8 * MiB, OFF_WQT = OFF_WTS + 16 * MiB, OFF_WAT = OFF_WTS + 24 * MiB,
                 OFF_G2T = OFF_WTS + 25 * MiB, OFF_SUBK = OFF_WTS + 25 * MiB + 512 * 1024, WS_NEED = OFF_WTS + 26 * MiB;
constexpr size_t OFF_QC = OFF_XN, OFF_KC = OFF_XN + 32 * MiB, OFF_YR = OFF_WINT, OFF_Q = OFF_XN, OFF_XN2 = OFF_PR, OFF_PU = OFF_PM, OFF_PV = OFF_PM + 32 * MiB,
                 OFF_SCU = OFF_SUBK + 64 * 1024, OFF_SCV = OFF_SCU + 64 * 1024;
constexpr size_t DO_WLOG = 0, DO_AG = 32 * MiB, DO_GG = 64 * MiB, DO_ALORA = 96 * MiB, DO_GB = 112 * MiB, DO_GA = DO_GB + 256 * 1024, DO_GW = DO_GA + 256 * 1024;
constexpr int LDS_BYTES = 150528;

struct KP {
    const float *x, *g_mix, *w_in, *conv_w, *b_i, *b_f, *mu, *w0, *w2, *a0, *a2, *g2, *k_k, *k_a, *r_k, *ln_w, *ln_b, *proj_m, *proj_r, *w_out, *g_ffn,
        *w_query, *sub_keys, *peer_u, *peer_v, *g_final;
    float* out; unsigned char* ws;
};

typedef __bf16 bf16x2_t __attribute__((ext_vector_type(2)));
typedef float f32x2_t __attribute__((ext_vector_type(2)));
__device__ __forceinline__ unsigned cvt_pk_bf16(float lo, float hi) { f32x2_t v = {lo, hi}; bf16x2_t b = __builtin_convertvector(v, bf16x2_t); return __builtin_bit_cast(unsigned, b); }
__device__ __forceinline__ bf16_t f2bf(float f) { return (bf16_t)(cvt_pk_bf16(f, 0.f) & 0xffffu); }
__device__ __forceinline__ float bf2f(bf16_t h) { return __uint_as_float((unsigned)h << 16); }
__device__ __forceinline__ float bflo(unsigned u) { return __uint_as_float(u << 16); }
__device__ __forceinline__ float bfhi(unsigned u) { return __uint_as_float(u & 0xffff0000u); }
__device__ __forceinline__ float sigm(float x) { return __builtin_amdgcn_rcpf(1.f + __expf(-x)); }
template <int CTRL> __device__ __forceinline__ float dppf(float v) { return __builtin_bit_cast(float, __builtin_amdgcn_update_dpp(0, __builtin_bit_cast(int, v), CTRL, 0xF, 0xF, true)); }
template <int CTRL> __device__ __forceinline__ unsigned dppu(unsigned v) { return (unsigned)__builtin_amdgcn_update_dpp(0, (int)v, CTRL, 0xF, 0xF, true); }
__device__ __forceinline__ float red4(float v) { v += dppf<0xB1>(v); v += dppf<0x4E>(v); return v; }
__device__ __forceinline__ float red8(float v) { v = red4(v); v += dppf<0x141>(v); return v; }
__device__ __forceinline__ float red16(float v) { v = red8(v); v += dppf<0x140>(v); return v; }
__device__ __forceinline__ float rlane(float v, int l) { return __builtin_bit_cast(float, __builtin_amdgcn_readlane(__builtin_bit_cast(int, v), l)); }
__device__ __forceinline__ float wave_sum(float v) { v = red16(v); return rlane(v, 0) + rlane(v, 16) + rlane(v, 32) + rlane(v, 48); }
__device__ __forceinline__ unsigned wave_max_u32(unsigned v) {
    v = max(v, dppu<0xB1>(v)); v = max(v, dppu<0x4E>(v)); v = max(v, dppu<0x141>(v)); v = max(v, dppu<0x140>(v));
    unsigned a = (unsigned)__builtin_amdgcn_readlane((int)v, 0), b = (unsigned)__builtin_amdgcn_readlane((int)v, 16), c = (unsigned)__builtin_amdgcn_readlane((int)v, 32), d = (unsigned)__builtin_amdgcn_readlane((int)v, 48);
    return max(max(a, b), max(c, d));
}
__device__ __forceinline__ unsigned ordf(float f) { unsigned u = __float_as_uint(f); return (u & 0x80000000u) ? ~u : (u | 0x80000000u); }
__device__ __forceinline__ float unordf(unsigned k) { return __uint_as_float((k & 0x80000000u) ? (k ^ 0x80000000u) : ~k); }

__device__ __forceinline__ int tid_l() { int t = threadIdx.x; asm volatile("" : "+v"(t)); return t; }
template <class T> __device__ __forceinline__ T* lp(T* q) { asm volatile("" : "+s"(q)); return q; }
namespace pg8 {
constexpr int BM = 256, BK = 64, HALF = 128, HTB = HALF * BK * 2, STAGE_BYTES = 8 * HTB, NXCD = 8, WGM = 8;
__device__ __forceinline__ int lds_byte(int r, int c) { const int st = (r >> 4) * 2 + (c >> 5), rr = r & 15, cc = c & 31, ob = rr * 64 + cc * 2; return st * 1024 + (ob ^ (((ob >> 9) & 1) << 5)); }
__device__ __forceinline__ void stage_rc(int b, int& R, int& C) { const int st = b / 1024, sb = b % 1024, swz = sb ^ (((sb >> 9) & 1) << 5); R = (st >> 1) * 16 + swz / 64; C = (st & 1) * 32 + (swz % 64) / 2; }
__device__ __forceinline__ int perm32(int rho) { const int n = rho >> 4, i = rho & 15; return 8 * (i >> 2) + 4 * n + (i & 3); }
struct Unit { int pm, pn; };
struct Gemm { const bf16_t* A; const bf16_t* Bt; int M, N, K, lda, ldb; };
struct StaticOrder {
    int nM, nN, nwg, G, c;
    __device__ void init(int M, int N, int G_, int c_) { nM = M / BM; nN = N / BM; nwg = nM * nN; G = G_; c = c_; }
    __device__ bool next(int i, Unit& u) const {
        const long L = (long)i * G + c; if (L >= nwg) return false;
        int wgid = (int)L; { const int q = nwg / NXCD, r = nwg % NXCD, xcd = wgid % NXCD, off = wgid / NXCD; wgid = (xcd < r ? xcd * (q + 1) : r * (q + 1) + (xcd - r) * q) + off; }
        const int nig = WGM * nN, gid = wgid / nig, fm = gid * WGM, gsz = (nM - fm) < WGM ? (nM - fm) : WGM;
        u.pm = fm + ((wgid % nig) % gsz); u.pn = (wgid % nig) / gsz; return true;
    }
};

__device__ __forceinline__ void store8(bf16_t* p, f32x4 v0, f32x4 v1) {
    u32x4 w; w.x = cvt_pk_bf16(v0[0], v0[1]); w.y = cvt_pk_bf16(v0[2], v0[3]); w.z = cvt_pk_bf16(v1[0], v1[1]); w.w = cvt_pk_bf16(v1[2], v1[3]); *(u32x4*)p = w;
}
__device__ __forceinline__ void load8(const bf16_t* p, f32x4& v0, f32x4& v1) {
    const u32x4 w = *(const u32x4*)p; v0 = (f32x4){bflo(w.x), bfhi(w.x), bflo(w.y), bfhi(w.y)}; v1 = (f32x4){bflo(w.z), bfhi(w.z), bflo(w.w), bfhi(w.w)};
}

template <int mode> struct Epi {
    static constexpr bool PERM = true;
    unsigned char* ws; unsigned char* dob; const float* x; const float* w0; const float* a0;
    __device__ __forceinline__ void operator()(const f32x4 (&acc)[2][2][4][2], const Unit& u, int wr, int wc, int fr, int fq) const {
        const int row0 = u.pm * BM + wr * 64 + fr, cb = u.pn * BM + wc * 32 + 8 * fq;
#pragma unroll
        for (int ai = 0; ai < 2; ++ai)
#pragma unroll
            for (int m = 0; m < 4; ++m) {
                const size_t row = (size_t)(row0 + ai * HALF + m * 16);
#pragma unroll
                for (int bj = 0; bj < 2; ++bj) {
                    const int col = cb + bj * HALF;
                    f32x4 v0 = acc[ai][bj][m][0], v1 = acc[ai][bj][m][1];
                    if (mode == 0) {
                        if (col < 4096) store8((bf16_t*)(ws + OFF_PM) + row * LDPM + col, v0, v1);
                        else if (col < 7680) store8((bf16_t*)(ws + OFF_PR) + row * LDPR + (col - 4096), v0, v1);
                        else {
#pragma unroll
                            for (int j = 0; j < 4; ++j) { v0[j] = sigm(v0[j]); v1[j] = sigm(v1[j]); }
                            store8((bf16_t*)(ws + OFF_PG) + row * LDPG + (col - 7680), v0, v1);
                        }
                    } else if (mode == 1) {
                        if (col < 1024) {
                            const f32x4 b0 = *(const f32x4*)(w0 + col), b1 = *(const f32x4*)(w0 + col + 4);
#pragma unroll
                            for (int j = 0; j < 4; ++j) {
                                float z = -(b0[j] + v0[j]); float sp = fmaxf(z, 0.f) + __logf(1.f + __expf(-fabsf(z))); v0[j] = -__expf(-sp - 0.5f);
                                z = -(b1[j] + v1[j]); sp = fmaxf(z, 0.f) + __logf(1.f + __expf(-fabsf(z))); v1[j] = -__expf(-sp - 0.5f);
                            }
                            store8((bf16_t*)(dob + DO_WLOG) + row * 1024 + col, v0, v1);
                        } else {
                            const int c2 = col - 1024;
                            const f32x4 b0 = *(const f32x4*)(a0 + c2), b1 = *(const f32x4*)(a0 + c2 + 4);
#pragma unroll
                            for (int j = 0; j < 4; ++j) { v0[j] = sigm(b0[j] + v0[j]); v1[j] = sigm(b1[j] + v1[j]); }
                            store8((bf16_t*)(dob + DO_AG) + row * 1024 + c2, v0, v1);
                        }
                    } else if (mode == 2) {
                        store8((bf16_t*)(dob + DO_GG) + row * 1024 + col, v0, v1);
                    } else if (mode == 3) {
                        bf16_t* pp = (bf16_t*)(ws + OFF_PG) + row * LDPG + col; f32x4 g0, g1; load8(pp, g0, g1);
                        store8(pp, g0 * v0, g1 * v1);
                    } else if (mode == 4) {
                        bf16_t* pp = (bf16_t*)(ws + OFF_PG) + row * LDPG + col; f32x4 m0, m1, g0, g1; load8(pp, m0, m1); load8(pp + 2048, g0, g1);
                        store8(pp, m0 + g0 * v0, m1 + g1 * v1);
                    } else if (mode == 5) {
                        const float* xp = x + row * DM + col; float* op = (float*)dob + row * DM + col;
                        const f32x4 x0 = *(const f32x4*)xp, x1 = *(const f32x4*)(xp + 4);
                        *(f32x4*)op = x0 + v0; *(f32x4*)(op + 4) = x1 + v1;
                    } else {
                        store8((bf16_t*)(ws + OFF_Q) + row * DM + col, v0, v1);
                    }
                    asm volatile("" ::: "memory");
                }
            }
    }
};

template <class EpiT> __device__ __forceinline__ void gemm_phase(LAS unsigned char* lds, const Gemm g, const StaticOrder& S, const EpiT& E) {
    const int tid = tid_l(), wid = __builtin_amdgcn_readfirstlane(tid >> 6), lane = tid & 63, wr = wid >> 2, wc = wid & 3, fr = lane & 15, fq = lane >> 4;
    const int K = g.K, nt = K / BK;
    unsigned voffA[2], voffB[2];
#pragma unroll
    for (int i = 0; i < 2; ++i) { int R, C; stage_rc(tid * 16 + i * 8192, R, C); const int Rb = (R & ~31) + perm32(R & 31);
        voffA[i] = (unsigned)(R * g.lda + C) * 2u; voffB[i] = (unsigned)(Rb * g.ldb + C) * 2u; }
    const size_t kstep = (size_t)(BK * 2);
    const size_t hstepA = (size_t)HALF * g.lda * 2, hstepB = (size_t)HALF * g.ldb * 2;
    const size_t tstepA = 2 * hstepA, tstepB = 2 * hstepB;
    const unsigned ldsw = (unsigned)wid * 1024u;
    const int aoff = lds_byte(wr * 64 + fr, fq * 8), boff = lds_byte(wc * 32 + fr, fq * 8);
#define PG8_SA(b, h) (((b) * 2 + (h)) * HTB)
#define PG8_SB(b, h) ((4 + (b) * 2 + (h)) * HTB)
#define PG8_STAGE(bufoff, gbase, voff) do { _Pragma("unroll") for (int _i = 0; _i < 2; ++_i) \
        __builtin_amdgcn_global_load_lds((const unsigned*)((const char*)(gbase) + (voff)[_i]), (LAS unsigned*)(lds + (bufoff) + ldsw + _i * 8192), 16, 0, 0); } while (0)
#define PG8_LDA(dst, b, h) do { _Pragma("unroll") for (int m = 0; m < 4; ++m) _Pragma("unroll") for (int k = 0; k < 2; ++k) dst[m][k] = *(const LAS bf16x8*)(lds + PG8_SA(b, h) + aoff + m * 2048 + k * 1024); } while (0)
#define PG8_LDB(dst, b, h) do { _Pragma("unroll") for (int n = 0; n < 2; ++n) _Pragma("unroll") for (int k = 0; k < 2; ++k) dst[n][k] = *(const LAS bf16x8*)(lds + PG8_SB(b, h) + boff + n * 2048 + k * 1024); } while (0)
#define PG8_MMA(ai, bj, At, Bt) do { __builtin_amdgcn_s_setprio(1); _Pragma("unroll") for (int m = 0; m < 4; ++m) _Pragma("unroll") for (int n = 0; n < 2; ++n) _Pragma("unroll") for (int k = 0; k < 2; ++k) \
        acc[ai][bj][m][n] = __builtin_amdgcn_mfma_f32_16x16x32_bf16(Bt[n][k], At[m][k], acc[ai][bj][m][n], 0, 0, 0); __builtin_amdgcn_s_setprio(0); } while (0)
#define PG8_WAIT_V(n) asm volatile("s_waitcnt vmcnt(" #n ")" ::: "memory")
#define PG8_WAIT_L(n) asm volatile("s_waitcnt lgkmcnt(" #n ")" ::: "memory")
#define PG8_BAR __builtin_amdgcn_s_barrier()
#define PG8_SCHED __builtin_amdgcn_sched_barrier(0)
    Unit cur, nxt; int ui = 0;
    if (!S.next(0, cur)) return;
    f32x4 acc[2][2][4][2];
#pragma unroll
    for (int a = 0; a < 2; ++a)
#pragma unroll
        for (int b = 0; b < 2; ++b)
#pragma unroll
            for (int m = 0; m < 4; ++m)
#pragma unroll
                for (int n = 0; n < 2; ++n) acc[a][b][m][n] = (f32x4){0.f, 0.f, 0.f, 0.f};
    bf16x8 At[4][2], B0[2][2], B1[2][2];
    const char* cA = (const char*)g.A + (size_t)cur.pm * tstepA; const char* cB = (const char*)g.Bt + (size_t)cur.pn * tstepB;
    PG8_STAGE(PG8_SB(0, 0), cB, voffB); PG8_STAGE(PG8_SA(0, 0), cA, voffA); PG8_STAGE(PG8_SB(0, 1), cB + hstepB, voffB); PG8_STAGE(PG8_SA(0, 1), cA + hstepA, voffA);
    if (wr == 1) PG8_BAR;
    PG8_WAIT_V(4); PG8_BAR;
    PG8_STAGE(PG8_SB(1, 0), cB + kstep, voffB); PG8_STAGE(PG8_SA(1, 0), cA + kstep, voffA); PG8_STAGE(PG8_SB(1, 1), cB + hstepB + kstep, voffB);
    PG8_WAIT_V(6); PG8_BAR;
    for (;;) {
        const bool has_next = S.next(ui + 1, nxt);
        const char* nA = has_next ? (const char*)g.A + (size_t)nxt.pm * tstepA : cA; const char* nB = has_next ? (const char*)g.Bt + (size_t)nxt.pn * tstepB : cB;
        for (int t = 0; t < nt; t += 2) {
            const bool last = (t == nt - 2);
            const char* a1 = cA + (size_t)(t + 1) * kstep;
            const char* a2 = last ? nA : cA + (size_t)(t + 2) * kstep; const char* b2 = last ? nB : cB + (size_t)(t + 2) * kstep;
            const char* a3 = a2 + kstep; const char* b3 = b2 + kstep;
            PG8_LDB(B0, 0, 0); PG8_SCHED; PG8_LDA(At, 0, 0); PG8_STAGE(PG8_SA(1, 1), a1 + hstepA, voffA);
            PG8_WAIT_L(8); PG8_BAR; PG8_WAIT_L(0); PG8_MMA(0, 0, At, B0); PG8_BAR; PG8_SCHED;
            PG8_LDB(B1, 0, 1); PG8_STAGE(PG8_SB(0, 0), b2, voffB);
            PG8_BAR; PG8_WAIT_L(0); PG8_MMA(0, 1, At, B1); PG8_BAR;
            PG8_LDA(At, 0, 1); PG8_STAGE(PG8_SA(0, 0), a2, voffA);
            PG8_BAR; PG8_WAIT_L(0); PG8_MMA(1, 0, At, B0); PG8_BAR; PG8_SCHED;
            PG8_STAGE(PG8_SB(0, 1), b2 + hstepB, voffB);
            PG8_WAIT_V(6); PG8_BAR; PG8_MMA(1, 1, At, B1); PG8_BAR;
            PG8_LDB(B0, 1, 0); PG8_SCHED; PG8_LDA(At, 1, 0); PG8_STAGE(PG8_SA(0, 1), a2 + hstepA, voffA);
            PG8_WAIT_L(8); PG8_BAR; PG8_WAIT_L(0); PG8_MMA(0, 0, At, B0); PG8_BAR; PG8_SCHED;
            PG8_LDB(B1, 1, 1); PG8_STAGE(PG8_SB(1, 0), b3, voffB);
            PG8_BAR; PG8_WAIT_L(0); PG8_MMA(0, 1, At, B1); PG8_BAR;
            PG8_LDA(At, 1, 1); PG8_STAGE(PG8_SA(1, 0), a3, voffA);
            PG8_BAR; PG8_WAIT_L(0); PG8_MMA(1, 0, At, B0); PG8_BAR; PG8_SCHED;
            PG8_STAGE(PG8_SB(1, 1), b3 + hstepB, voffB);
            PG8_WAIT_V(6); PG8_BAR; PG8_MMA(1, 1, At, B1); PG8_BAR;
        }
        E(acc, cur, wr, wc, fr, fq);
        if (!has_next) break;
#pragma unroll
        for (int a = 0; a < 2; ++a)
#pragma unroll
            for (int b = 0; b < 2; ++b)
#pragma unroll
                for (int m = 0; m < 4; ++m)
#pragma unroll
                    for (int n = 0; n < 2; ++n) acc[a][b][m][n] = (f32x4){0.f, 0.f, 0.f, 0.f};
        cur = nxt; cA = nA; cB = nB; ++ui;
    }
    PG8_WAIT_V(0);
    if (wr == 0) PG8_BAR;
    PG8_BAR;
#undef PG8_SA
#undef PG8_SB
#undef PG8_STAGE
#undef PG8_LDA
#undef PG8_LDB
#undef PG8_MMA
#undef PG8_WAIT_V
#undef PG8_WAIT_L
#undef PG8_BAR
#undef PG8_SCHED
}
}

__device__ __forceinline__ void rmsnorm_rows(const float* src, const float* gain, bf16_t* dst, int gw, int nw, int lane) {
    for (int row = gw; row < NT; row += nw) {
        const f32x4* s = (const f32x4*)(src + (size_t)row * DM);
        f32x4 v[8]; float ss = 0.f;
#pragma unroll
        for (int i = 0; i < 8; ++i) { v[i] = s[i * 64 + lane]; ss += v[i][0] * v[i][0] + v[i][1] * v[i][1] + v[i][2] * v[i][2] + v[i][3] * v[i][3]; }
        ss = wave_sum(ss);
        const float r = rsqrtf(ss * (1.f / DM) + 1e-6f);
        u32x2* d = (u32x2*)(dst + (size_t)row * DM);
#pragma unroll
        for (int i = 0; i < 8; ++i) { const f32x4 gg = ((const f32x4*)gain)[i * 64 + lane]; u32x2 o; o.x = cvt_pk_bf16(v[i][0] * r * gg[0], v[i][1] * r * gg[1]); o.y = cvt_pk_bf16(v[i][2] * r * gg[2], v[i][3] * r * gg[3]); d[i * 64 + lane] = o; }
    }
}

__device__ __forceinline__ void tr_tile(const float* src, int ld, int c0, int nvalid, int k0, bf16_t* dst, int ldd, int r0, int kd0, LAS float* tile) {
    const int tid = tid_l();
#pragma unroll
    for (int i = 0; i < 2; ++i) {
        const int k = (tid >> 4) + 32 * i, c4 = (tid & 15) * 4;
        f32x4 v = (f32x4){0.f, 0.f, 0.f, 0.f};
        if (c4 < nvalid) v = *(const f32x4*)(src + (size_t)(k0 + k) * ld + c0 + c4);
        tile[k * 65 + c4] = v[0]; tile[k * 65 + c4 + 1] = v[1]; tile[k * 65 + c4 + 2] = v[2]; tile[k * 65 + c4 + 3] = v[3];
    }
    __syncthreads();
    {
        const int c = tid >> 3, k8 = (tid & 7) * 8;
        float f[8];
#pragma unroll
        for (int j = 0; j < 8; ++j) f[j] = tile[(k8 + j) * 65 + c];
        u32x4 w; w.x = cvt_pk_bf16(f[0], f[1]); w.y = cvt_pk_bf16(f[2], f[3]); w.z = cvt_pk_bf16(f[4], f[5]); w.w = cvt_pk_bf16(f[6], f[7]);
        *(u32x4*)(dst + (size_t)(r0 + c) * ldd + kd0 + k8) = w;
    }
    __syncthreads();
}

__device__ void phase_prep(const KP& p, LAS unsigned char* lds) {
    const int tid = tid_l(), lane = tid & 63, G = gridDim.x, bid = blockIdx.x;
    unsigned char* ws = p.ws;
    rmsnorm_rows(p.x, p.g_mix, (bf16_t*)(ws + OFF_XN), bid * 8 + (tid >> 6), G * 8, lane);
    LAS float* tile = (LAS float*)lds;
    for (int j = bid; j < 8960; j += G) {
        if (j < 5888) {
            const int rt = j >> 5, kt = j & 31; int c0, nv = 64;
            if (rt < 64) c0 = 64 * rt; else if (rt < 119) c0 = 4104 + 64 * (rt - 64); else if (rt == 119) { c0 = 4096; nv = 8; } else c0 = 7624 + 64 * (rt - 120);
            tr_tile(p.w_in, 11720, c0, nv, kt * 64, (bf16_t*)(ws + OFF_WINT), 2048, rt * 64, kt * 64, tile);
        } else if (j < 6400) { const int q = j - 5888, rt = q >> 4, kt = q & 15; tr_tile(p.proj_m, 2048, rt * 64, 64, kt * 64, (bf16_t*)(ws + OFF_PMT), 1024, rt * 64, kt * 64, tile); }
        else if (j < 6912) { const int q = j - 6400, rt = q >> 4, kt = q & 15; tr_tile(p.proj_r, 2048, rt * 64, 64, kt * 64, (bf16_t*)(ws + OFF_PRT), 1024, rt * 64, kt * 64, tile); }
        else if (j < 7936) { const int q = j - 6912, rt = q >> 5, kt = q & 31; tr_tile(p.w_out, 2048, rt * 64, 64, kt * 64, (bf16_t*)(ws + OFF_WOT), 2048, rt * 64, kt * 64, tile); }
        else { const int q = j - 7936, rt = q >> 5, kt = q & 31; tr_tile(p.w_query, 2048, rt * 64, 64, kt * 64, (bf16_t*)(ws + OFF_WQT), 2048, rt * 64, kt * 64, tile); }
    }
    const int gt = bid * 512 + tid, gn = G * 512;
    bf16_t* WAT = (bf16_t*)(ws + OFF_WAT);
    for (int i = gt; i < 2048 * 256; i += gn) { const int r = i >> 8, k = i & 255; float v = 0.f;
        if (r < 1024) { if (k < 96) v = p.w2[k * 1024 + r]; } else { if (k >= 96 && k < 192) v = p.a2[(k - 96) * 1024 + (r - 1024)]; }
        WAT[i] = f2bf(v); }
    bf16_t* G2T = (bf16_t*)(ws + OFF_G2T);
    for (int i = gt; i < 1024 * 256; i += gn) { const int r = i >> 8, k = i & 255; G2T[i] = f2bf(p.g2[k * 1024 + r]); }
    bf16_t* SK = (bf16_t*)(ws + OFF_SUBK);
    for (int i = gt; i < 2 * 128 * 128; i += gn) SK[i] = f2bf(p.sub_keys[i]);
}

__device__ __forceinline__ float bfel(const u32x4& w, int e) { const unsigned u = w[e >> 1]; return (e & 1) ? bfhi(u) : bflo(u); }
__device__ void phase_lora_prep(const KP& p) {
    const bf16_t* PR = (const bf16_t*)(p.ws + OFF_PR);
    bf16_t* AL = (bf16_t*)((unsigned char*)p.out + DO_ALORA);
    const int gt = blockIdx.x * 512 + threadIdx.x, gn = gridDim.x * 512;
    for (int i = gt; i < NT * 64; i += gn) {
        const int tok = i >> 6, g = i & 63;
        u32x4 o = (u32x4){0u, 0u, 0u, 0u};
        if (g < 24 || g >= 32) {
            const int sc = (g < 24) ? (3072 + 8 * g) : (3264 + 8 * (g - 32));
            const u32x4 cu = *(const u32x4*)(PR + (size_t)tok * LDPR + sc);
            u32x4 pv = (u32x4){0u, 0u, 0u, 0u};
            if ((tok & (SEQ - 1)) != 0) pv = *(const u32x4*)(PR + (size_t)(tok - 1) * LDPR + sc);
            const f32x4 m0 = *(const f32x4*)(p.mu + sc), m1 = *(const f32x4*)(p.mu + sc + 4);
            float f[8];
#pragma unroll
            for (int q = 0; q < 4; ++q) {
                const float c0 = bflo(cu[q]), c1 = bfhi(cu[q]), p0 = bflo(pv[q]), p1 = bfhi(pv[q]);
                const float mm0 = (q < 2) ? m0[2 * q] : m1[2 * q - 4], mm1 = (q < 2) ? m0[2 * q + 1] : m1[2 * q - 3];
                f[2 * q] = c0 + (p0 - c0) * mm0; f[2 * q + 1] = c1 + (p1 - c1) * mm1;
            }
            if (g < 12) {
#pragma unroll
                for (int q = 0; q < 8; ++q) f[q] = tanhf(f[q]);
            } else if (g >= 32) {
#pragma unroll
                for (int q = 0; q < 8; ++q) f[q] = sigm(f[q]);
            }
            o.x = cvt_pk_bf16(f[0], f[1]); o.y = cvt_pk_bf16(f[2], f[3]); o.z = cvt_pk_bf16(f[4], f[5]); o.w = cvt_pk_bf16(f[6], f[7]);
        }
        *(u32x4*)(AL + (size_t)tok * 512 + 8 * g) = o;
    }
    {
        const bf16_t* PM = (const bf16_t*)(p.ws + OFF_PM);
        bf16_t* QC = (bf16_t*)(p.ws + OFF_QC); bf16_t* KC = (bf16_t*)(p.ws + OFF_KC);
        for (int i = gt; i < (NT / 8) * 256; i += gn) {
            const int tb = i >> 8, col = (i & 255) * 8; const int tok0 = tb * 8, t0 = tok0 & (SEQ - 1);
            f32x4 cw[4][2];
#pragma unroll
            for (int j = 0; j < 4; ++j) { cw[j][0] = *(const f32x4*)(p.conv_w + j * 2048 + col); cw[j][1] = *(const f32x4*)(p.conv_w + j * 2048 + col + 4); }
            u32x4 raw[11];
#pragma unroll
            for (int q = 0; q < 11; ++q) { const bool neg = (t0 - 3 + q) < 0; u32x4 v = *(const u32x4*)(PM + (size_t)(tok0 + (neg ? 0 : q - 3)) * LDPM + col); if (neg) v = (u32x4){0u, 0u, 0u, 0u}; raw[q] = v; }
            const float scl = (col < 1024) ? 0.0625f : 1.f;
            bf16_t* dst = (col < 1024) ? (QC + (size_t)tok0 * 1024 + col) : (KC + (size_t)tok0 * 1024 + (col - 1024));
#pragma unroll
            for (int r = 0; r < 8; ++r) {
                float o[8];
#pragma unroll
                for (int e = 0; e < 8; ++e) {
                    const float c0 = (e < 4) ? cw[0][0][e] : cw[0][1][e - 4], c1 = (e < 4) ? cw[1][0][e] : cw[1][1][e - 4], c2 = (e < 4) ? cw[2][0][e] : cw[2][1][e - 4], c3 = (e < 4) ? cw[3][0][e] : cw[3][1][e - 4];
                    float sv = c0 * bfel(raw[r], e) + c1 * bfel(raw[r + 1], e) + c2 * bfel(raw[r + 2], e) + c3 * bfel(raw[r + 3], e);
                    o[e] = sv * sigm(sv) * scl;
                }
                u32x4 pk; pk.x = cvt_pk_bf16(o[0], o[1]); pk.y = cvt_pk_bf16(o[2], o[3]); pk.z = cvt_pk_bf16(o[4], o[5]); pk.w = cvt_pk_bf16(o[6], o[7]);
                *(u32x4*)(dst + (size_t)r * 1024) = pk;
            }
        }
    }
    {
        const int lane = threadIdx.x & 63, gw = blockIdx.x * 8 + (threadIdx.x >> 6), nw = gridDim.x * 8;
        float* GB = (float*)((unsigned char*)p.out + DO_GB); float* GA = (float*)((unsigned char*)p.out + DO_GA); float* GW = (float*)((unsigned char*)p.out + DO_GW);
        for (int task = gw; task < 1024; task += nw) {
            const int bh = task >> 6, c = task & 63, bb = bh >> 2, h = bh & 3; const size_t tok = (size_t)bb * SEQ + c * 64 + lane;
            const float iv = bf2f(PR[tok * LDPR + 3520 + h]) + p.b_i[h], fv = bf2f(PR[tok * LDPR + 3524 + h]) + p.b_f[h];
            float lf = fminf(fv, 0.f) - __logf(1.f + __expf(-fabsf(fv)));
#pragma unroll
            for (int d = 1; d < 64; d <<= 1) { const float y = __shfl_up(lf, d); if (lane >= d) lf += y; }
            const float bl = rlane(lf, 63);
            const int o = bh * SEQ + c * 64 + lane;
            GB[o] = lf; GA[o] = iv - lf; GW[o] = __expf(bl - lf + iv);
        }
    }
}

constexpr size_t OFF_YRAW = OFF_WINT, OFF_BON = OFF_WINT + 32 * MiB;
struct RwOps { f32x4 a0, a1, q0, q1, w0, w1, b0, b1, k0, k1; float v, br, kr; };
__device__ __forceinline__ f32x2_t lo2(f32x4 v) { return __builtin_shufflevector(v, v, 0, 1); }
__device__ __forceinline__ f32x2_t hi2(f32x4 v) { return __builtin_shufflevector(v, v, 2, 3); }
__device__ __forceinline__ f32x2_t fma2(f32x2_t a, f32x2_t b, f32x2_t c) { return __builtin_elementwise_fma(a, b, c); }
__device__ void rwkv_scan(const KP& p, int blk, LAS unsigned char* lds) {
    const int tid0 = tid_l();
    const int bh = blk >> 1, half = blk & 1, b = bh >> 4, h = bh & 15;
    constexpr int BUFB = 53760;
    const bf16_t* PR = (const bf16_t*)(p.ws + OFF_PR);
    const bf16_t* WLOG = (const bf16_t*)((const unsigned char*)p.out + DO_WLOG);
    const bf16_t* AG = (const bf16_t*)((const unsigned char*)p.out + DO_AG);
    bf16_t* YRAW = (bf16_t*)(p.ws + OFF_YRAW); float* BON = (float*)(p.ws + OFF_BON);
    const size_t tokbase = (size_t)b * SEQ;
    if (tid0 < 256) {
        const int rowl = tid0 >> 3, j8 = (tid0 & 7) * 8, row = 32 * half + rowl;
        f32x2_t S2[4];
#pragma unroll
        for (int k = 0; k < 4; ++k) S2[k] = (f32x2_t){0.f, 0.f};
        __syncthreads();
        for (int c = 0; c < 128; ++c) {
            const LAS float* bp = (const LAS float*)(lds + (c & 1) * BUFB);
            LAS float* yb = (LAS float*)(lds + (c & 1) * BUFB + 49408);
#define RW_LD(O, s) do { const LAS float* q_ = bp + (s) * 64 + j8; O.a0 = *(const LAS f32x4*)(q_); O.a1 = *(const LAS f32x4*)(q_ + 4); O.b0 = *(const LAS f32x4*)(q_ + 2048); O.b1 = *(const LAS f32x4*)(q_ + 2052); \
            O.w0 = *(const LAS f32x4*)(q_ + 4096); O.w1 = *(const LAS f32x4*)(q_ + 4100); O.k0 = *(const LAS f32x4*)(q_ + 6144); O.k1 = *(const LAS f32x4*)(q_ + 6148); \
            O.q0 = *(const LAS f32x4*)(q_ + 8192); O.q1 = *(const LAS f32x4*)(q_ + 8196); O.v = bp[10240 + (s) * 64 + row]; O.br = bp[12288 + (s)]; O.kr = bp[12320 + (s)]; } while (0)
#define RW_STEP(O, s) do { \
            f32x2_t pa = S2[0] * lo2(O.a0); f32x2_t py = S2[0] * lo2(O.q0); \
            pa = fma2(S2[1], hi2(O.a0), pa); py = fma2(S2[1], hi2(O.q0), py); pa = fma2(S2[2], lo2(O.a1), pa); py = fma2(S2[2], lo2(O.q1), py); \
            pa = fma2(S2[3], hi2(O.a1), pa); py = fma2(S2[3], hi2(O.q1), py); \
            float sa = pa.x + pa.y, yy = py.x + py.y; \
            sa += dppf<0xB1>(sa); yy += dppf<0xB1>(yy); sa += dppf<0x4E>(sa); yy += dppf<0x4E>(yy); sa += dppf<0x141>(sa); yy += dppf<0x141>(yy); \
            const f32x2_t sa2 = (f32x2_t){sa, sa}, vv2 = (f32x2_t){O.v, O.v}; \
            S2[0] = fma2(S2[0], lo2(O.w0), fma2(vv2, lo2(O.k0), sa2 * lo2(O.b0))); S2[1] = fma2(S2[1], hi2(O.w0), fma2(vv2, hi2(O.k0), sa2 * hi2(O.b0))); \
            S2[2] = fma2(S2[2], lo2(O.w1), fma2(vv2, lo2(O.k1), sa2 * lo2(O.b1))); S2[3] = fma2(S2[3], hi2(O.w1), fma2(vv2, hi2(O.k1), sa2 * hi2(O.b1))); \
            if ((tid0 & 7) == 0) yb[(s) * 32 + rowl] = yy + sa * O.br + O.v * O.kr; } while (0)
            RwOps o0, o1;
            RW_LD(o0, 0);
#pragma unroll 1
            for (int s = 0; s < 32; s += 2) {
                RW_LD(o1, s + 1);
                RW_STEP(o0, s);
                { const int sn = (s + 2 < 32) ? s + 2 : 31; RW_LD(o0, sn); }
                RW_STEP(o1, s + 1);
            }
#undef RW_LD
#undef RW_STEP
            __syncthreads();
        }
    } else {
        const int ht = tid0 - 256, tt = ht >> 3, cg8 = (ht & 7) * 8, ch = h * 64 + cg8;
        float mur[8], muk[8], muv[8], kkc[8], kac[8], rkc[8];
#pragma unroll
        for (int e = 0; e < 8; ++e) { mur[e] = p.mu[ch + e]; muk[e] = p.mu[1024 + ch + e]; muv[e] = p.mu[2048 + ch + e]; kkc[e] = p.k_k[ch + e]; kac[e] = p.k_a[ch + e]; rkc[e] = p.r_k[ch + e]; }
        for (int c = -1; c < 128; ++c) {
            if (c >= 1) {
                const LAS float* yb = (const LAS float*)(lds + ((c - 1) & 1) * BUFB + 49408);
                const int r4 = (ht & 7) * 4; const f32x4 y4 = *(const LAS f32x4*)(yb + tt * 32 + r4);
                u32x2 ov; ov.x = cvt_pk_bf16(y4[0], y4[1]); ov.y = cvt_pk_bf16(y4[2], y4[3]);
                *(u32x2*)(YRAW + (tokbase + (size_t)(c - 1) * 32 + tt) * 1024 + h * 64 + 32 * half + r4) = ov;
            }
            if (c + 1 < 128) {
                const int cn = c + 1, t = cn * 32 + tt; const size_t tok = tokbase + t;
                LAS float* bp = (LAS float*)(lds + (cn & 1) * BUFB);
                const bf16_t* pr_ = PR + tok * LDPR + ch;
                const u32x4 r4 = *(const u32x4*)pr_, k4 = *(const u32x4*)(pr_ + 1024), v4 = *(const u32x4*)(pr_ + 2048);
                u32x4 pr4 = (u32x4){0u, 0u, 0u, 0u}, pk4 = pr4, pv4 = pr4;
                if (t > 0) { pr4 = *(const u32x4*)(pr_ - LDPR); pk4 = *(const u32x4*)(pr_ - LDPR + 1024); pv4 = *(const u32x4*)(pr_ - LDPR + 2048); }
                const u32x4 w4 = *(const u32x4*)(WLOG + tok * 1024 + ch), a4 = *(const u32x4*)(AG + tok * 1024 + ch);
                float r[8], k[8], v[8], kk[8], av[8], dec[8];
                float n2 = 0.f;
#pragma unroll
                for (int e = 0; e < 8; ++e) {
                    const float rc = bfel(r4, e), kc = bfel(k4, e), vc = bfel(v4, e);
                    r[e] = rc + (bfel(pr4, e) - rc) * mur[e]; k[e] = kc + (bfel(pk4, e) - kc) * muk[e]; v[e] = vc + (bfel(pv4, e) - vc) * muv[e];
                    kk[e] = k[e] * kkc[e]; n2 += kk[e] * kk[e]; av[e] = bfel(a4, e); dec[e] = __expf(bfel(w4, e));
                }
                n2 = red8(n2);
                const float inv = 1.f / fmaxf(sqrtf(n2), 1e-12f);
                float br = 0.f, kr = 0.f, bon = 0.f;
                f32x4 oa[2], ob[2], ow[2], ok[2], oq[2], ovv[2];
#pragma unroll
                for (int e = 0; e < 8; ++e) {
                    const float kn = kk[e] * inv, k3 = k[e] * (1.f + (av[e] - 1.f) * kac[e]), bb = kn * av[e];
                    oa[e >> 2][e & 3] = -kn; ob[e >> 2][e & 3] = bb; ow[e >> 2][e & 3] = dec[e]; ok[e >> 2][e & 3] = k3; oq[e >> 2][e & 3] = dec[e] * r[e]; ovv[e >> 2][e & 3] = v[e];
                    br += bb * r[e]; kr += k3 * r[e]; bon += r[e] * k3 * rkc[e];
                }
                br = red8(br); kr = red8(kr); bon = red8(bon);
                LAS float* q_ = bp + tt * 64 + cg8;
#pragma unroll
                for (int i = 0; i < 2; ++i) { *(LAS f32x4*)(q_ + 4 * i) = oa[i]; *(LAS f32x4*)(q_ + 2048 + 4 * i) = ob[i]; *(LAS f32x4*)(q_ + 4096 + 4 * i) = ow[i]; *(LAS f32x4*)(q_ + 6144 + 4 * i) = ok[i];
                    *(LAS f32x4*)(q_ + 8192 + 4 * i) = oq[i]; *(LAS f32x4*)(q_ + 10240 + 4 * i) = ovv[i]; }
                if ((ht & 7) == 0) { bp[12288 + tt] = br; bp[12320 + tt] = kr; if (half == 0) BON[tok * 16 + h] = bon; }
            }
            __syncthreads();
        }
        {
            const LAS float* yb = (const LAS float*)(lds + (127 & 1) * BUFB + 49408);
            const int r4 = (ht & 7) * 4; const f32x4 y4 = *(const LAS f32x4*)(yb + tt * 32 + r4);
            u32x2 ov; ov.x = cvt_pk_bf16(y4[0], y4[1]); ov.y = cvt_pk_bf16(y4[2], y4[3]);
            *(u32x2*)(YRAW + (tokbase + (size_t)127 * 32 + tt) * 1024 + h * 64 + 32 * half + r4) = ov;
        }
    }
}

__device__ void phase_rwkv_post(const KP& p) {
    const bf16_t* PR = (const bf16_t*)(p.ws + OFF_PR);
    const bf16_t* GG = (const bf16_t*)((const unsigned char*)p.out + DO_GG);
    bf16_t* YR = (bf16_t*)(p.ws + OFF_YRAW); const float* BON = (const float*)(p.ws + OFF_BON);
    const int gt = blockIdx.x * 512 + tid_l(), gn = gridDim.x * 512;
    for (int i = gt; i < NT * 256; i += gn) {
        const int tok = i >> 8, h = (i >> 4) & 15, ch = h * 64 + (i & 15) * 4;
        const u32x2 y2 = *(const u32x2*)(YR + (size_t)tok * 1024 + ch), v2 = *(const u32x2*)(PR + (size_t)tok * LDPR + 2048 + ch), g2 = *(const u32x2*)(GG + (size_t)tok * 1024 + ch);
        u32x2 pv2 = (u32x2){0u, 0u};
        if ((tok & (SEQ - 1)) != 0) pv2 = *(const u32x2*)(PR + (size_t)(tok - 1) * LDPR + 2048 + ch);
        const float bon = BON[tok * 16 + h];
        const f32x4 muv = *(const f32x4*)(p.mu + 2048 + ch), lnw = *(const f32x4*)(p.ln_w + ch), lnb = *(const f32x4*)(p.ln_b + ch);
        const f32x4 y = (f32x4){bflo(y2.x), bfhi(y2.x), bflo(y2.y), bfhi(y2.y)}, vc = (f32x4){bflo(v2.x), bfhi(v2.x), bflo(v2.y), bfhi(v2.y)}, vp = (f32x4){bflo(pv2.x), bfhi(pv2.x), bflo(pv2.y), bfhi(pv2.y)};
        const f32x4 g = (f32x4){bflo(g2.x), bfhi(g2.x), bflo(g2.y), bfhi(g2.y)};
        const f32x4 v = vc + (vp - vc) * muv;
        const float mean = red16(y[0] + y[1] + y[2] + y[3]) * (1.f / 64.f);
        const f32x4 d = y - mean;
        const float var = red16(d[0] * d[0] + d[1] * d[1] + d[2] * d[2] + d[3] * d[3]) * (1.f / 64.f);
        const float rs = rsqrtf(var + 64e-5f);
        const f32x4 res = (d * rs * lnw + lnb + bon * v) * g;
        u32x2 ov; ov.x = cvt_pk_bf16(res[0], res[1]); ov.y = cvt_pk_bf16(res[2], res[3]);
        *(u32x2*)(YR + (size_t)tok * 1024 + ch) = ov;
    }
}

typedef short v4i16_t __attribute__((ext_vector_type(4)));
__device__ __forceinline__ bf16x8 tr_frag(const LAS unsigned char* base, int stride_b, int krow0, int ncol0, int lane) {
    const int g = lane >> 4, q = (lane & 15) >> 2, pp = lane & 3;
    const LAS unsigned char* a0 = base + (krow0 + 8 * g + q) * stride_b + (ncol0 + 4 * pp) * 2;
    const v4i16_t x = __builtin_amdgcn_ds_read_tr16_b64_v4i16((LAS v4i16_t*)a0), y = __builtin_amdgcn_ds_read_tr16_b64_v4i16((LAS v4i16_t*)(a0 + 4 * stride_b));
    return (bf16x8){x[0], x[1], x[2], x[3], y[0], y[1], y[2], y[3]};
}
__device__ void mlstm_run(const KP& p, int item, LAS unsigned char* lds) {
    const int tid0 = tid_l();
    const int bh = item >> 3, b = bh >> 2, h = bh & 3, dv0 = (item & 7) * 32;
    const size_t tokbase = (size_t)b * SEQ;
    LAS bf16_t* Qs = (LAS bf16_t*)(lds + 0);
    LAS bf16_t* Ks = (LAS bf16_t*)(lds + 33792);
    LAS bf16_t* Vs = (LAS bf16_t*)(lds + 67584);
    LAS bf16_t* Vws = (LAS bf16_t*)(lds + 74752);
    LAS bf16_t* Ss = (LAS bf16_t*)(lds + 81920);
    LAS bf16_t* CT0 = (LAS bf16_t*)(lds + 91136);
    LAS bf16_t* Os = (LAS bf16_t*)(lds + 141824);
    LAS float* BC = (LAS float*)(lds + 146944);
    LAS float* GAs = (LAS float*)(lds + 147200);
    const bf16_t* QC = (const bf16_t*)(p.ws + OFF_QC); const bf16_t* KC = (const bf16_t*)(p.ws + OFF_KC);
    bf16_t* PM = (bf16_t*)(p.ws + OFF_PM);
    const float* GB = (const float*)((const unsigned char*)p.out + DO_GB); const float* GA = (const float*)((const unsigned char*)p.out + DO_GA); const float* GW = (const float*)((const unsigned char*)p.out + DO_GW);
    for (int i = tid0; i < 2 * 48 * 264 / 2; i += 512) ((LAS unsigned*)CT0)[i] = 0u;
    for (int i = tid0; i < 2 * 64 * 56 / 2; i += 512) ((LAS unsigned*)Vs)[i] = 0u;
    __syncthreads();
    if (tid0 < 64) Vs[tid0 * 56 + 32] = (bf16_t)0x3F80;
    f32x4 cacc[6];
#pragma unroll
    for (int i = 0; i < 6; ++i) cacc[i] = (f32x4){0.f, 0.f, 0.f, 0.f};
    u32x4 q4[4], k4[4], vo4; float gb = 0.f, ga = 0.f, gwv = 0.f;
#define ML_LOAD(c, TID) do { const int row_ = (TID) >> 3, pc_ = (TID) & 7; const size_t tk_ = tokbase + (size_t)(c) * 64; \
        const bf16_t* qp_ = QC + (tk_ + row_) * 1024 + h * 256 + pc_ * 32; const bf16_t* kp_ = KC + (tk_ + row_) * 1024 + h * 256 + pc_ * 32; \
        _Pragma("unroll") for (int i_ = 0; i_ < 4; ++i_) { q4[i_] = *(const u32x4*)(qp_ + 8 * i_); k4[i_] = *(const u32x4*)(kp_ + 8 * i_); } \
        const int sg_ = (TID) & 255, s_ = sg_ >> 2, g_ = sg_ & 3; \
        vo4 = *(const u32x4*)(PM + (tk_ + s_) * LDPM + ((TID) < 256 ? 2048 : 3072) + h * 256 + dv0 + 8 * g_); \
        gwv = GW[bh * SEQ + (c) * 64 + s_]; \
        if ((TID) < 64) { gb = GB[bh * SEQ + (c) * 64 + (TID)]; ga = GA[bh * SEQ + (c) * 64 + (TID)]; } } while (0)
    ML_LOAD(0, tid0);
    __syncthreads();
    int cur = 0;
    for (int c = 0; c < 64; ++c) {
        int tid = tid0; asm volatile("" : "+v"(tid));
        const int lane = tid & 63, w = tid >> 6, fr = lane & 15, fq = lane >> 4;
        LAS bf16_t* CTc = CT0 + cur * (48 * 264); LAS bf16_t* CTn = CT0 + (cur ^ 1) * (48 * 264);
        {
            const int row = tid >> 3, pc = tid & 7;
#pragma unroll
            for (int i = 0; i < 4; ++i) { *(LAS u32x4*)(Qs + row * 264 + pc * 32 + 8 * i) = q4[i]; *(LAS u32x4*)(Ks + row * 264 + pc * 32 + 8 * i) = k4[i]; }
            const int sg = tid & 255, s = sg >> 2, g = sg & 3;
            if (tid < 256) {
                *(LAS u32x4*)(Vs + s * 56 + 8 * g) = vo4;
                u32x4 wv;
#pragma unroll
                for (int e = 0; e < 4; ++e) wv[e] = cvt_pk_bf16(bflo(vo4[e]) * gwv, bfhi(vo4[e]) * gwv);
                *(LAS u32x4*)(Vws + s * 56 + 8 * g) = wv;
                if (g == 0) Vws[s * 56 + 32] = f2bf(gwv);
            } else {
                if (c > 0) { const u32x4 yv = *(const LAS u32x4*)(Os + s * 40 + 8 * g); *(u32x4*)(PM + (tokbase + (size_t)(c - 1) * 64 + s) * LDPM + 3072 + h * 256 + dv0 + 8 * g) = yv; }
                *(LAS u32x4*)(Os + s * 40 + 8 * g) = vo4;
            }
            if (tid < 64) { BC[tid] = gb; GAs[tid] = ga; }
        }
        asm volatile("" ::: "memory");
        if (c + 1 < 64) ML_LOAD(c + 1, tid);
        asm volatile("" ::: "memory");
        __syncthreads();
        {
            const int mt = w >> 1, ntb = (w & 1) * 2;
            f32x4 s0 = (f32x4){0.f, 0.f, 0.f, 0.f}, s1 = s0;
#pragma unroll
            for (int ks = 0; ks < 8; ++ks) {
                const bf16x8 a = *(const LAS bf16x8*)(Qs + (16 * mt + fr) * 264 + 32 * ks + 8 * fq);
                const bf16x8 b0 = *(const LAS bf16x8*)(Ks + (16 * ntb + fr) * 264 + 32 * ks + 8 * fq);
                const bf16x8 b1 = *(const LAS bf16x8*)(Ks + (16 * (ntb + 1) + fr) * 264 + 32 * ks + 8 * fq);
                s0 = __builtin_amdgcn_mfma_f32_16x16x32_bf16(a, b0, s0, 0, 0, 0);
                s1 = __builtin_amdgcn_mfma_f32_16x16x32_bf16(a, b1, s1, 0, 0, 0);
            }
            const int sA = 16 * ntb + fr, sB = sA + 16;
            const float gA = GAs[sA], gB = GAs[sB];
#pragma unroll
            for (int j = 0; j < 4; ++j) {
                const int t = 16 * mt + 4 * fq + j; const float bt = BC[t];
                const float vA = (sA <= t) ? s0[j] * __expf(bt + gA) : 0.f, vB = (sB <= t) ? s1[j] * __expf(bt + gB) : 0.f;
                Ss[t * 72 + sA] = f2bf(vA); Ss[t * 72 + sB] = f2bf(vB);
            }
        }
        __syncthreads();
        {
            const int mt = w >> 1, nt = w & 1;
            f32x4 aA = (f32x4){0.f, 0.f, 0.f, 0.f}, aB = aA, xA = aA, xB = aA;
#pragma unroll
            for (int ks = 0; ks < 2; ++ks) {
                const bf16x8 a = *(const LAS bf16x8*)(Ss + (16 * mt + fr) * 72 + 32 * ks + 8 * fq);
                const bf16x8 bm = tr_frag((const LAS unsigned char*)Vs, 112, 32 * ks, 16 * nt, lane);
                const bf16x8 bx = tr_frag((const LAS unsigned char*)Vs, 112, 32 * ks, 32, lane);
                aA = __builtin_amdgcn_mfma_f32_16x16x32_bf16(a, bm, aA, 0, 0, 0);
                xA = __builtin_amdgcn_mfma_f32_16x16x32_bf16(a, bx, xA, 0, 0, 0);
            }
#pragma unroll
            for (int ks = 0; ks < 8; ++ks) {
                const bf16x8 a = *(const LAS bf16x8*)(Qs + (16 * mt + fr) * 264 + 32 * ks + 8 * fq);
                const bf16x8 bm = *(const LAS bf16x8*)(CTc + (16 * nt + fr) * 264 + 32 * ks + 8 * fq);
                const bf16x8 bx = *(const LAS bf16x8*)(CTc + (32 + fr) * 264 + 32 * ks + 8 * fq);
                aB = __builtin_amdgcn_mfma_f32_16x16x32_bf16(a, bm, aB, 0, 0, 0);
                xB = __builtin_amdgcn_mfma_f32_16x16x32_bf16(a, bx, xB, 0, 0, 0);
            }
#pragma unroll
            for (int j = 0; j < 4; ++j) {
                const int t = 16 * mt + 4 * fq + j; const float eb = __expf(BC[t]);
                const float num = aA[j] + eb * aB[j];
                const float den = __shfl(xA[j] + eb * xB[j], lane & 48);
                const float hv = num / fmaxf(fabsf(den), 1.f);
                LAS bf16_t* op = Os + t * 40 + 16 * nt + fr;
                *op = f2bf(hv * sigm(bf2f(*op)));
            }
            const float decay = __expf(BC[63]);
            bf16x8 bw[3][2];
#pragma unroll
            for (int n3 = 0; n3 < 3; ++n3)
#pragma unroll
                for (int ks = 0; ks < 2; ++ks) bw[n3][ks] = tr_frag((const LAS unsigned char*)Vws, 112, 32 * ks, 16 * n3, lane);
#pragma unroll
            for (int m2 = 0; m2 < 2; ++m2) {
                const int mtk = 2 * w + m2;
                const bf16x8 ka0 = tr_frag((const LAS unsigned char*)Ks, 528, 0, 16 * mtk, lane), ka1 = tr_frag((const LAS unsigned char*)Ks, 528, 32, 16 * mtk, lane);
#pragma unroll
                for (int n3 = 0; n3 < 3; ++n3) {
                    f32x4 cc = cacc[m2 * 3 + n3] * decay;
                    cc = __builtin_amdgcn_mfma_f32_16x16x32_bf16(ka0, bw[n3][0], cc, 0, 0, 0);
                    cc = __builtin_amdgcn_mfma_f32_16x16x32_bf16(ka1, bw[n3][1], cc, 0, 0, 0);
                    cacc[m2 * 3 + n3] = cc;
                    u32x2 pk; pk.x = cvt_pk_bf16(cc[0], cc[1]); pk.y = cvt_pk_bf16(cc[2], cc[3]);
                    *(LAS u32x2*)(CTn + (16 * n3 + fr) * 264 + 16 * mtk + 4 * fq) = pk;
                }
            }
        }
        cur ^= 1;
        __syncthreads();
    }
    if (tid0 >= 256) { const int sg = tid0 & 255, s = sg >> 2, g = sg & 3; const u32x4 yv = *(const LAS u32x4*)(Os + s * 40 + 8 * g);
        *(u32x4*)(PM + (tokbase + (size_t)63 * 64 + s) * LDPM + 3072 + h * 256 + dv0 + 8 * g) = yv; }
#undef ML_LOAD
}

__device__ void phase_norm2_convert(const KP& p) {
    const int tid = tid_l(), lane = tid & 63, G = gridDim.x, bid = blockIdx.x;
    rmsnorm_rows(p.out, p.g_ffn, (bf16_t*)(p.ws + OFF_XN2), bid * 8 + (tid >> 6), G * 8, lane);
    const int gw = bid * 8 + (tid >> 6), nw = G * 8;
    for (int tb = 0; tb < 2; ++tb) {
        const float* src = tb ? p.peer_v : p.peer_u; unsigned char* dst = p.ws + (tb ? OFF_PV : OFF_PU); float* sc = (float*)(p.ws + (tb ? OFF_SCV : OFF_SCU));
        for (int row = gw; row < 16384; row += nw) {
            const float* sp = src + (size_t)row * DM + lane * 16;
            f32x4 v[8]; float am = 0.f;
#pragma unroll
            for (int i = 0; i < 2; ++i)
#pragma unroll
                for (int q = 0; q < 4; ++q) { v[i * 4 + q] = *(const f32x4*)(sp + i * 1024 + q * 4);
                    am = fmaxf(am, fmaxf(fmaxf(fabsf(v[i * 4 + q][0]), fabsf(v[i * 4 + q][1])), fmaxf(fabsf(v[i * 4 + q][2]), fabsf(v[i * 4 + q][3])))); }
            const unsigned amu = wave_max_u32(__float_as_uint(am));
            const float amax = __uint_as_float(amu);
            float scl = 1.f;
            if (amax > 0.f) scl = exp2f(floorf(log2f(240.f / amax)));
            if (lane == 0) sc[row] = 1.f / scl;
#pragma unroll
            for (int i = 0; i < 2; ++i) { u32x4 o;
#pragma unroll
                for (int q = 0; q < 4; ++q) { const f32x4 t = v[i * 4 + q] * scl; int w = __builtin_amdgcn_cvt_pk_fp8_f32(t[0], t[1], 0, false); w = __builtin_amdgcn_cvt_pk_fp8_f32(t[2], t[3], w, true); o[q] = (unsigned)w; }
                *(u32x4*)(dst + (size_t)row * DM + i * 1024 + lane * 16) = o; }
        }
    }
}

__device__ void phase_peer(const KP& p, LAS unsigned char* lds) {
    const int tid = tid_l(), lane = tid & 63, w = tid >> 6, fr = lane & 15, fq = lane >> 4;
    LAS unsigned* KEYS = (LAS unsigned*)lds;
    LAS int* TI = (LAS int*)(lds + 32768);
    LAS float* TG = (LAS float*)(lds + 49152);
    const bf16_t* Q = (const bf16_t*)(p.ws + OFF_Q);
    const bf16_t* SK = (const bf16_t*)(p.ws + OFF_SUBK);
    const bf16_t* XN2 = (const bf16_t*)(p.ws + OFF_XN2);
    const unsigned char* PU = p.ws + OFF_PU; const unsigned char* PV = p.ws + OFF_PV;
    const float* SCU = (const float*)(p.ws + OFF_SCU); const float* SCV = (const float*)(p.ws + OFF_SCV);
    float* out = p.out;
    LAS int* IJ = (LAS int*)(lds + 65536);
    int ci[4], cj[4]; bool cv[4];
#pragma unroll
    for (int m = 0; m < 4; ++m) { const int e = m * 16 + fr; int i = 0, base = 0;
        for (; i < 16; ++i) { const int cnt = 16 / (i + 1); if (e < base + cnt) break; base += cnt; }
        cv[m] = i < 16; ci[m] = cv[m] ? i : 0; cj[m] = cv[m] ? e - base : 0;
        if (w == 0 && fq == 0) IJ[e] = cv[m] ? ci[m] * 16 + cj[m] : 0; }
    const int pp_ = w >> 2, ntb = (w & 3) * 2;
    bf16x8 bfr[2][4];
#pragma unroll
    for (int n = 0; n < 2; ++n)
#pragma unroll
        for (int ks = 0; ks < 4; ++ks) bfr[n][ks] = *(const bf16x8*)(SK + (size_t)(pp_ * 128 + 16 * (ntb + n) + fr) * 128 + 32 * ks + 8 * fq);
    __syncthreads();
    for (int tile = blockIdx.x; tile < NT / 32; tile += gridDim.x) {
        const int tk0 = tile * 32;
        bf16x8 afn[2][4];
#pragma unroll
        for (int mt = 0; mt < 2; ++mt)
#pragma unroll
            for (int ks = 0; ks < 4; ++ks) afn[mt][ks] = *(const bf16x8*)(Q + (size_t)(tk0 + 16 * mt + fr) * DM + pp_ * 128 + 32 * ks + 8 * fq);
        for (int h = 0; h < 8; ++h) {
            {
                bf16x8 af[2][4];
#pragma unroll
                for (int mt = 0; mt < 2; ++mt)
#pragma unroll
                    for (int ks = 0; ks < 4; ++ks) af[mt][ks] = afn[mt][ks];
                if (h + 1 < 8) {
#pragma unroll
                    for (int mt = 0; mt < 2; ++mt)
#pragma unroll
                        for (int ks = 0; ks < 4; ++ks) afn[mt][ks] = *(const bf16x8*)(Q + (size_t)(tk0 + 16 * mt + fr) * DM + (h + 1) * 256 + pp_ * 128 + 32 * ks + 8 * fq);
                }
                f32x4 acc[2][2];
#pragma unroll
                for (int a_ = 0; a_ < 2; ++a_)
#pragma unroll
                    for (int b_ = 0; b_ < 2; ++b_) acc[a_][b_] = (f32x4){0.f, 0.f, 0.f, 0.f};
#pragma unroll
                for (int ks = 0; ks < 4; ++ks)
#pragma unroll
                    for (int mt = 0; mt < 2; ++mt)
#pragma unroll
                        for (int n = 0; n < 2; ++n) acc[mt][n] = __builtin_amdgcn_mfma_f32_16x16x32_bf16(af[mt][ks], bfr[n][ks], acc[mt][n], 0, 0, 0);
#pragma unroll
                for (int mt = 0; mt < 2; ++mt)
#pragma unroll
                    for (int n = 0; n < 2; ++n)
#pragma unroll
                        for (int j = 0; j < 4; ++j) { const int tokl = 16 * mt + 4 * fq + j, key = 16 * (ntb + n) + fr;
                            KEYS[(tokl * 2 + pp_) * 128 + key] = (ordf(acc[mt][n][j]) & ~0x7Fu) | (unsigned)key; }
            }
            __syncthreads();
            {
                const int tokl = 4 * w + fq, rb = lane & 48;
                unsigned top[2];
#pragma unroll
                for (int pp = 0; pp < 2; ++pp) {
                    unsigned kx[8];
#pragma unroll
                    for (int m = 0; m < 8; ++m) kx[m] = KEYS[(tokl * 2 + pp) * 128 + fr + 16 * m];
                    unsigned tp = 0u;
                    for (int it = 0; it < 16; ++it) {
                        unsigned M = max(max(max(kx[0], kx[1]), max(kx[2], kx[3])), max(max(kx[4], kx[5]), max(kx[6], kx[7])));
                        M = max(M, dppu<0xB1>(M)); M = max(M, dppu<0x4E>(M)); M = max(M, dppu<0x141>(M)); M = max(M, dppu<0x140>(M));
                        if (fr == it) tp = M;
#pragma unroll
                        for (int m = 0; m < 8; ++m) kx[m] = (kx[m] == M) ? 0u : kx[m];
                    }
                    top[pp] = tp;
                }
                unsigned cnd[4];
#pragma unroll
                for (int m = 0; m < 4; ++m) {
                    const float v1 = unordf((unsigned)__shfl((int)top[0], rb + ci[m]) & ~0x7Fu), v2 = unordf((unsigned)__shfl((int)top[1], rb + cj[m]) & ~0x7Fu);
                    cnd[m] = cv[m] ? ((ordf(v1 + v2) & ~0x3Fu) | (unsigned)(m * 16 + fr)) : 0u;
                }
                unsigned best = 0u;
                for (int it = 0; it < 16; ++it) {
                    unsigned M = max(max(cnd[0], cnd[1]), max(cnd[2], cnd[3]));
                    M = max(M, dppu<0xB1>(M)); M = max(M, dppu<0x4E>(M)); M = max(M, dppu<0x141>(M)); M = max(M, dppu<0x140>(M));
                    if (fr == it) best = M;
#pragma unroll
                    for (int m = 0; m < 4; ++m) cnd[m] = (cnd[m] == M) ? 0u : cnd[m];
                }
                const int ij = IJ[best & 0x3Fu];
                const float bv = unordf(best & ~0x3Fu);
                const int e1 = __shfl((int)top[0], rb + (ij >> 4)) & 0x7F, e2 = __shfl((int)top[1], rb + (ij & 15)) & 0x7F;
                const float mx = __shfl(bv, rb);
                const float ev = __expf(bv - mx);
                const float sum = red16(ev);
                TI[tokl * 128 + h * 16 + fr] = e1 * 128 + e2; TG[tokl * 128 + h * 16 + fr] = ev / sum;
            }
            __syncthreads();
        }
        for (int q = 0; q < 4; ++q) {
            const int tokl = 4 * w + q; const size_t tok = (size_t)tk0 + tokl;
            float xv[32], acc[32];
#pragma unroll
            for (int i = 0; i < 2; ++i)
#pragma unroll
                for (int hh = 0; hh < 2; ++hh) { const u32x4 x4 = *(const u32x4*)(XN2 + tok * DM + i * 1024 + lane * 16 + hh * 8);
#pragma unroll
                    for (int e = 0; e < 4; ++e) { xv[i * 16 + hh * 8 + 2 * e] = bflo(x4[e]); xv[i * 16 + hh * 8 + 2 * e + 1] = bfhi(x4[e]); } }
#pragma unroll
            for (int i = 0; i < 32; ++i) acc[i] = 0.f;
#pragma unroll 4
            for (int e = 0; e < 128; ++e) {
                const int idx = __builtin_amdgcn_readfirstlane(TI[tokl * 128 + e]);
                const float gate = __builtin_bit_cast(float, __builtin_amdgcn_readfirstlane(__builtin_bit_cast(int, TG[tokl * 128 + e])));
                const unsigned char* up = PU + (size_t)idx * DM + lane * 16; const unsigned char* vp = PV + (size_t)idx * DM + lane * 16;
                u32x4 u4[2], v4[2];
                u4[0] = *(const u32x4*)up; u4[1] = *(const u32x4*)(up + 1024); v4[0] = *(const u32x4*)vp; v4[1] = *(const u32x4*)(vp + 1024);
                const float su = SCU[idx], sv = SCV[idx];
                float d0 = 0.f, d1 = 0.f, d2 = 0.f, d3 = 0.f;
#pragma unroll
                for (int i = 0; i < 2; ++i)
#pragma unroll
                    for (int k = 0; k < 4; ++k) { const f32x2_t lo = __builtin_amdgcn_cvt_pk_f32_fp8((int)u4[i][k], false), hi = __builtin_amdgcn_cvt_pk_f32_fp8((int)u4[i][k], true);
                        d0 += xv[i * 16 + 4 * k] * lo.x; d1 += xv[i * 16 + 4 * k + 1] * lo.y; d2 += xv[i * 16 + 4 * k + 2] * hi.x; d3 += xv[i * 16 + 4 * k + 3] * hi.y; }
                const float act = wave_sum((d0 + d1) + (d2 + d3)) * su;
                const float coef = gate * 0.5f * act * (1.f + erff(act * 0.70710678118f)) * sv;
#pragma unroll
                for (int i = 0; i < 2; ++i)
#pragma unroll
                    for (int k = 0; k < 4; ++k) { const f32x2_t lo = __builtin_amdgcn_cvt_pk_f32_fp8((int)v4[i][k], false), hi = __builtin_amdgcn_cvt_pk_f32_fp8((int)v4[i][k], true);
                        acc[i * 16 + 4 * k] += coef * lo.x; acc[i * 16 + 4 * k + 1] += coef * lo.y; acc[i * 16 + 4 * k + 2] += coef * hi.x; acc[i * 16 + 4 * k + 3] += coef * hi.y; }
            }
            float ss = 0.f;
            float* orow = out + tok * DM + lane * 16;
#pragma unroll
            for (int i = 0; i < 2; ++i)
#pragma unroll
                for (int k = 0; k < 4; ++k) { const f32x4 h0 = *(const f32x4*)(orow + i * 1024 + 4 * k);
#pragma unroll
                    for (int j = 0; j < 4; ++j) { acc[i * 16 + 4 * k + j] += h0[j]; ss += acc[i * 16 + 4 * k + j] * acc[i * 16 + 4 * k + j]; } }
            ss = wave_sum(ss);
            const float r = rsqrtf(ss * (1.f / DM) + 1e-6f);
#pragma unroll
            for (int i = 0; i < 2; ++i)
#pragma unroll
                for (int k = 0; k < 4; ++k) { const f32x4 g0 = *(const f32x4*)(p.g_final + i * 1024 + lane * 16 + 4 * k); f32x4 o0;
#pragma unroll
                    for (int j = 0; j < 4; ++j) o0[j] = acc[i * 16 + 4 * k + j] * r * g0[j];
                    *(f32x4*)(orow + i * 1024 + 4 * k) = o0; }
        }
        __syncthreads();
    }
}

__global__ void __launch_bounds__(512) fwd_megakernel(KP p) {
    extern __shared__ __attribute__((aligned(16))) unsigned char smem[];
    LAS unsigned char* lds = (LAS unsigned char*)smem;
    cg::grid_group grid = cg::this_grid();
#define GRID_SYNC() do { __builtin_amdgcn_fence(__ATOMIC_RELEASE, "agent"); __syncthreads(); grid.sync(); __builtin_amdgcn_fence(__ATOMIC_ACQUIRE, "agent"); } while (0)
    const int G = gridDim.x, bid = blockIdx.x;
    unsigned char* ws = p.ws; unsigned char* dob = (unsigned char*)p.out;

#define RUN_GEMM(MODE, ...) do { unsigned char* ws = lp(p.ws); unsigned char* dob = lp((unsigned char*)p.out); const pg8::Gemm g_ = pg8::Gemm{__VA_ARGS__}; pg8::StaticOrder S_; S_.init(g_.M, g_.N, G, bid); \
        const pg8::Epi<MODE> E_{ws, dob, p.x, p.w0, p.a0}; pg8::gemm_phase(lds, g_, S_, E_); } while (0)
    phase_prep(p, lds);
    GRID_SYNC();
    RUN_GEMM(0, (const bf16_t*)(ws + OFF_XN), (const bf16_t*)(ws + OFF_WINT), NT, N1, 2048, 2048, 2048);
    GRID_SYNC();
    phase_lora_prep(p);
    GRID_SYNC();
    RUN_GEMM(1, (const bf16_t*)(dob + DO_ALORA), (const bf16_t*)(ws + OFF_WAT), NT, 2048, 256, 512, 256);
    RUN_GEMM(2, (const bf16_t*)(dob + DO_ALORA) + 256, (const bf16_t*)(ws + OFF_G2T), NT, 1024, 256, 512, 256);
    GRID_SYNC();
    if (bid < 128) rwkv_scan(p, bid, lds);
    else mlstm_run(p, bid - 128, lds);
    GRID_SYNC();
    phase_rwkv_post(p);
    GRID_SYNC();
    RUN_GEMM(3, (const bf16_t*)(ws + OFF_PM) + 3072, (const bf16_t*)(ws + OFF_PMT), NT, 2048, 1024, LDPM, 1024);
    RUN_GEMM(4, (const bf16_t*)(ws + OFF_YR), (const bf16_t*)(ws + OFF_PRT), NT, 2048, 1024, 1024, 1024);
    GRID_SYNC();
    RUN_GEMM(5, (const bf16_t*)(ws + OFF_PG), (const bf16_t*)(ws + OFF_WOT), NT, 2048, 2048, LDPG, 2048);
    GRID_SYNC();
    phase_norm2_convert(p);
    GRID_SYNC();
    RUN_GEMM(6, (const bf16_t*)(ws + OFF_XN2), (const bf16_t*)(ws + OFF_WQT), NT, 2048, 2048, 2048, 2048);
    GRID_SYNC();
    phase_peer(p, lds);
}

extern "C" void kernel_launch(void* const* d_in, const int* in_sizes, int n_in, void* d_out, int out_size, void* d_ws, size_t ws_size, hipStream_t stream) {
    static int grid_blocks = 0;
    if (grid_blocks == 0) {
        if (n_in != 26 || out_size != NT * DM || ws_size < WS_NEED) { fprintf(stderr, "kernel_launch: unexpected shapes: n_in %d out %d ws %zu (need %zu)\n", n_in, out_size, ws_size, (size_t)WS_NEED); grid_blocks = -1; return; }
        int dev = 0, cus = 0, per_cu = 0;
        hipGetDevice(&dev);
        hipDeviceGetAttribute(&cus, hipDeviceAttributeMultiprocessorCount, dev);
        if (hipFuncSetAttribute((const void*)fwd_megakernel, hipFuncAttributeMaxDynamicSharedMemorySize, LDS_BYTES) != hipSuccess) { fprintf(stderr, "kernel_launch: hipFuncSetAttribute failed\n"); grid_blocks = -1; return; }
        hipOccupancyMaxActiveBlocksPerMultiprocessor(&per_cu, (const void*)fwd_megakernel, 512, LDS_BYTES);
        if (per_cu < 1) { fprintf(stderr, "kernel_launch: occupancy query says %d blocks per CU\n", per_cu); per_cu = 1; }
        (void)hipGetLastError();
        grid_blocks = cus * 1;
    }
    if (grid_blocks < 0) return;
    KP p{};
    const float** pp = (const float**)&p;
    for (int i = 0; i < 26; ++i) pp[i] = (const float*)d_in[i];
    p.out = (float*)d_out; p.ws = (unsigned char*)d_ws;
    void* args[] = {&p};
    hipError_t e = hipLaunchCooperativeKernel((void*)fwd_megakernel, dim3(grid_blocks), dim3(512), args, LDS_BYTES, stream);
    if (e != hipSuccess) fprintf(stderr, "cooperative launch failed: %s (grid %d)\n", hipGetErrorString(e), grid_blocks);
}
```

```cpp
#include <hip/hip_runtime.h>
#include <hip/hip_cooperative_groups.h>
#include <cstdio>
namespace cg = cooperative_groups;

#define LAS __attribute__((address_space(3)))
typedef unsigned short bf16_t;
typedef short bf16x8 __attribute__((ext_vector_type(8)));
typedef float f32x4 __attribute__((ext_vector_type(4)));
typedef unsigned u32x4 __attribute__((ext_vector_type(4)));
typedef unsigned u32x2 __attribute__((ext_vector_type(2)));

constexpr int NT = 16384, SEQ = 4096, DM = 2048;
constexpr int LDPM = 4096, LDPR = 3584, LDPG = 4096, N1 = 11776;
constexpr size_t MiB = 1024ull * 1024ull;
constexpr size_t OFF_PM = 0, OFF_PR = 128 * MiB, OFF_PG = 240 * MiB, OFF_XN = 368 * MiB, OFF_WINT = 432 * MiB, OFF_WTS = 478 * MiB;
constexpr size_t OFF_PMT = OFF_WTS, OFF_PRT = OFF_WTS + 4 * MiB, OFF_WOT = OFF_WTS + 8 * MiB, OFF_WQT = OFF_WTS + 16 * MiB, OFF_WAT = OFF_WTS + 24 * MiB,
                 OFF_G2T = OFF_WTS + 25 * MiB, OFF_SUBK = OFF_WTS + 25 * MiB + 512 * 1024, WS_NEED = OFF_WTS + 26 * MiB;
constexpr size_t OFF_QC = OFF_XN, OFF_KC = OFF_XN + 32 * MiB, OFF_YR = OFF_WINT, OFF_Q = OFF_XN, OFF_XN2 = OFF_PR, OFF_PU = OFF_PM, OFF_PV = OFF_PM + 2048, OFF_SUBBAR = OFF_SUBK + 192 * 1024,
                 OFF_SCU = OFF_SUBK + 64 * 1024, OFF_SCV = OFF_SCU + 64 * 1024;
constexpr size_t DO_WLOG = 0, DO_AG = 32 * MiB, DO_GG = 64 * MiB, DO_ALORA = 96 * MiB, DO_GB = 112 * MiB, DO_GA = DO_GB + 256 * 1024, DO_GW = DO_GA + 256 * 1024;
constexpr int LDS_BYTES = 150528;

struct KP {
    const float *x, *g_mix, *w_in, *conv_w, *b_i, *b_f, *mu, *w0, *w2, *a0, *a2, *g2, *k_k, *k_a, *r_k, *ln_w, *ln_b, *proj_m, *proj_r, *w_out, *g_ffn,
        *w_query, *sub_keys, *peer_u, *peer_v, *g_final;
    float* out; unsigned char* ws;
};

typedef __bf16 bf16x2_t __attribute__((ext_vector_type(2)));
typedef float f32x2_t __attribute__((ext_vector_type(2)));
__device__ __forceinline__ unsigned cvt_pk_bf16(float lo, float hi) { f32x2_t v = {lo, hi}; bf16x2_t b = __builtin_convertvector(v, bf16x2_t); return __builtin_bit_cast(unsigned, b); }
__device__ __forceinline__ bf16_t f2bf(float f) { return (bf16_t)(cvt_pk_bf16(f, 0.f) & 0xffffu); }
__device__ __forceinline__ float bf2f(bf16_t h) { return __uint_as_float((unsigned)h << 16); }
__device__ __forceinline__ float bflo(unsigned u) { return __uint_as_float(u << 16); }
__device__ __forceinline__ float bfhi(unsigned u) { return __uint_as_float(u & 0xffff0000u); }
__device__ __forceinline__ float sigm(float x) { return __builtin_amdgcn_rcpf(1.f + __expf(-x)); }
template <int CTRL> __device__ __forceinline__ float dppf(float v) { return __builtin_bit_cast(float, __builtin_amdgcn_update_dpp(0, __builtin_bit_cast(int, v), CTRL, 0xF, 0xF, true)); }
template <int CTRL> __device__ __forceinline__ unsigned dppu(unsigned v) { return (unsigned)__builtin_amdgcn_update_dpp(0, (int)v, CTRL, 0xF, 0xF, true); }
__device__ __forceinline__ float red4(float v) { v += dppf<0xB1>(v); v += dppf<0x4E>(v); return v; }
__device__ __forceinline__ float red8(float v) { v = red4(v); v += dppf<0x141>(v); return v; }
__device__ __forceinline__ float red16(float v) { v = red8(v); v += dppf<0x140>(v); return v; }
__device__ __forceinline__ float rlane(float v, int l) { return __builtin_bit_cast(float, __builtin_amdgcn_readlane(__builtin_bit_cast(int, v), l)); }
__device__ __forceinline__ float wave_sum(float v) { v = red16(v); return rlane(v, 0) + rlane(v, 16) + rlane(v, 32) + rlane(v, 48); }
__device__ __forceinline__ unsigned wave_max_u32(unsigned v) {
    v = max(v, dppu<0xB1>(v)); v = max(v, dppu<0x4E>(v)); v = max(v, dppu<0x141>(v)); v = max(v, dppu<0x140>(v));
    unsigned a = (unsigned)__builtin_amdgcn_readlane((int)v, 0), b = (unsigned)__builtin_amdgcn_readlane((int)v, 16), c = (unsigned)__builtin_amdgcn_readlane((int)v, 32), d = (unsigned)__builtin_amdgcn_readlane((int)v, 48);
    return max(max(a, b), max(c, d));
}
__device__ __forceinline__ unsigned ordf(float f) { unsigned u = __float_as_uint(f); return (u & 0x80000000u) ? ~u : (u | 0x80000000u); }
__device__ __forceinline__ float unordf(unsigned k) { return __uint_as_float((k & 0x80000000u) ? (k ^ 0x80000000u) : ~k); }

__device__ __forceinline__ int tid_l() { int t = threadIdx.x; asm volatile("" : "+v"(t)); return t; }
template <class T> __device__ __forceinline__ T* lp(T* q) { asm volatile("" : "+s"(q)); return q; }
namespace pg8 {
constexpr int BM = 256, BK = 64, HALF = 128, HTB = HALF * BK * 2, STAGE_BYTES = 8 * HTB, NXCD = 8, WGM = 8;
__device__ __forceinline__ int lds_byte(int r, int c) { const int st = (r >> 4) * 2 + (c >> 5), rr = r & 15, cc = c & 31, ob = rr * 64 + cc * 2; return st * 1024 + (ob ^ (((ob >> 9) & 1) << 5)); }
__device__ __forceinline__ void stage_rc(int b, int& R, int& C) { const int st = b / 1024, sb = b % 1024, swz = sb ^ (((sb >> 9) & 1) << 5); R = (st >> 1) * 16 + swz / 64; C = (st & 1) * 32 + (swz % 64) / 2; }
__device__ __forceinline__ int perm32(int rho) { const int n = rho >> 4, i = rho & 15; return 8 * (i >> 2) + 4 * n + (i & 3); }
struct Unit { int pm, pn; };
struct Gemm { const bf16_t* A; const bf16_t* Bt; int M, N, K, lda, ldb; };
struct StaticOrder {
    int nM, nN, nwg, G, c;
    __device__ void init(int M, int N, int G_, int c_) { nM = M / BM; nN = N / BM; nwg = nM * nN; G = G_; c = c_; }
    __device__ bool next(int i, Unit& u) const {
        const long L = (long)i * G + c; if (L >= nwg) return false;
        int wgid = (int)L; { const int q = nwg / NXCD, r = nwg % NXCD, xcd = wgid % NXCD, off = wgid / NXCD; wgid = (xcd < r ? xcd * (q + 1) : r * (q + 1) + (xcd - r) * q) + off; }
        const int nig = WGM * nN, gid = wgid / nig, fm = gid * WGM, gsz = (nM - fm) < WGM ? (nM - fm) : WGM;
        u.pm = fm + ((wgid % nig) % gsz); u.pn = (wgid % nig) / gsz; return true;
    }
};

__device__ __forceinline__ void store8(bf16_t* p, f32x4 v0, f32x4 v1) {
    u32x4 w; w.x = cvt_pk_bf16(v0[0], v0[1]); w.y = cvt_pk_bf16(v0[2], v0[3]); w.z = cvt_pk_bf16(v1[0], v1[1]); w.w = cvt_pk_bf16(v1[2], v1[3]); *(u32x4*)p = w;
}
__device__ __forceinline__ void load8(const bf16_t* p, f32x4& v0, f32x4& v1) {
    const u32x4 w = *(const u32x4*)p; v0 = (f32x4){bflo(w.x), bfhi(w.x), bflo(w.y), bfhi(w.y)}; v1 = (f32x4){bflo(w.z), bfhi(w.z), bflo(w.w), bfhi(w.w)};
}

template <int mode> struct Epi {
    static constexpr bool PERM = true;
    unsigned char* ws; unsigned char* dob; const float* x; const float* w0; const float* a0;
    __device__ __forceinline__ void operator()(const f32x4 (&acc)[2][2][4][2], const Unit& u, int wr, int wc, int fr, int fq) const {
        const int row0 = u.pm * BM + wr * 64 + fr, cb = u.pn * BM + wc * 32 + 8 * fq;
#pragma unroll
        for (int ai = 0; ai < 2; ++ai)
#pragma unroll
            for (int m = 0; m < 4; ++m) {
                const size_t row = (size_t)(row0 + ai * HALF + m * 16);
#pragma unroll
                for (int bj = 0; bj < 2; ++bj) {
                    const int col = cb + bj * HALF;
                    f32x4 v0 = acc[ai][bj][m][0], v1 = acc[ai][bj][m][1];
                    if (mode == 0) {
                        if (col < 4096) store8((bf16_t*)(ws + OFF_PM) + row * LDPM + col, v0, v1);
                        else if (col < 7680) store8((bf16_t*)(ws + OFF_PR) + row * LDPR + (col - 4096), v0, v1);
                        else {
#pragma unroll
                            for (int j = 0; j < 4; ++j) { v0[j] = sigm(v0[j]); v1[j] = sigm(v1[j]); }
                            store8((bf16_t*)(ws + OFF_PG) + row * LDPG + (col - 7680), v0, v1);
                        }
                    } else if (mode == 1) {
                        if (col < 1024) {
                            const f32x4 b0 = *(const f32x4*)(w0 + col), b1 = *(const f32x4*)(w0 + col + 4);
#pragma unroll
                            for (int j = 0; j < 4; ++j) {
                                float z = -(b0[j] + v0[j]); float sp = fmaxf(z, 0.f) + __logf(1.f + __expf(-fabsf(z))); v0[j] = -__expf(-sp - 0.5f);
                                z = -(b1[j] + v1[j]); sp = fmaxf(z, 0.f) + __logf(1.f + __expf(-fabsf(z))); v1[j] = -__expf(-sp - 0.5f);
                            }
                            store8((bf16_t*)(dob + DO_WLOG) + row * 1024 + col, v0, v1);
                        } else {
                            const int c2 = col - 1024;
                            const f32x4 b0 = *(const f32x4*)(a0 + c2), b1 = *(const f32x4*)(a0 + c2 + 4);
#pragma unroll
                            for (int j = 0; j < 4; ++j) { v0[j] = sigm(b0[j] + v0[j]); v1[j] = sigm(b1[j] + v1[j]); }
                            store8((bf16_t*)(dob + DO_AG) + row * 1024 + c2, v0, v1);
                        }
                    } else if (mode == 2) {
                        store8((bf16_t*)(dob + DO_GG) + row * 1024 + col, v0, v1);
                    } else if (mode == 3) {
                        bf16_t* pp = (bf16_t*)(ws + OFF_PG) + row * LDPG + col; f32x4 g0, g1; load8(pp, g0, g1);
                        store8(pp, g0 * v0, g1 * v1);
                    } else if (mode == 4) {
                        bf16_t* pp = (bf16_t*)(ws + OFF_PG) + row * LDPG + col; f32x4 m0, m1, g0, g1; load8(pp, m0, m1); load8(pp + 2048, g0, g1);
                        store8(pp, m0 + g0 * v0, m1 + g1 * v1);
                    } else if (mode == 5) {
                        const float* xp = x + row * DM + col; float* op = (float*)dob + row * DM + col;
                        const f32x4 x0 = *(const f32x4*)xp, x1 = *(const f32x4*)(xp + 4);
                        *(f32x4*)op = x0 + v0; *(f32x4*)(op + 4) = x1 + v1;
                    } else {
                        store8((bf16_t*)(ws + OFF_Q) + row * DM + col, v0, v1);
                    }
                    asm volatile("" ::: "memory");
                }
            }
    }
};

template <class EpiT> __device__ __forceinline__ void gemm_phase(LAS unsigned char* lds, const Gemm g, const StaticOrder& S, const EpiT& E) {
    const int tid = tid_l(), wid = __builtin_amdgcn_readfirstlane(tid >> 6), lane = tid & 63, wr = wid >> 2, wc = wid & 3, fr = lane & 15, fq = lane >> 4;
    const int K = g.K, nt = K / BK;
    unsigned voffA[2], voffB[2];
#pragma unroll
    for (int i = 0; i < 2; ++i) { int R, C; stage_rc(tid * 16 + i * 8192, R, C); const int Rb = (R & ~31) + perm32(R & 31);
        voffA[i] = (unsigned)(R * g.lda + C) * 2u; voffB[i] = (unsigned)(Rb * g.ldb + C) * 2u; }
    const size_t kstep = (size_t)(BK * 2);
    const size_t hstepA = (size_t)HALF * g.lda * 2, hstepB = (size_t)HALF * g.ldb * 2;
    const size_t tstepA = 2 * hstepA, tstepB = 2 * hstepB;
    const unsigned ldsw = (unsigned)wid * 1024u;
    const int aoff = lds_byte(wr * 64 + fr, fq * 8), boff = lds_byte(wc * 32 + fr, fq * 8);
#define PG8_SA(b, h) (((b) * 2 + (h)) * HTB)
#define PG8_SB(b, h) ((4 + (b) * 2 + (h)) * HTB)
#define PG8_STAGE(bufoff, gbase, voff) do { _Pragma("unroll") for (int _i = 0; _i < 2; ++_i) \
        __builtin_amdgcn_global_load_lds((const unsigned*)((const char*)(gbase) + (voff)[_i]), (LAS unsigned*)(lds + (bufoff) + ldsw + _i * 8192), 16, 0, 0); } while (0)
#define PG8_LDA(dst, b, h) do { _Pragma("unroll") for (int m = 0; m < 4; ++m) _Pragma("unroll") for (int k = 0; k < 2; ++k) dst[m][k] = *(const LAS bf16x8*)(lds + PG8_SA(b, h) + aoff + m * 2048 + k * 1024); } while (0)
#define PG8_LDB(dst, b, h) do { _Pragma("unroll") for (int n = 0; n < 2; ++n) _Pragma("unroll") for (int k = 0; k < 2; ++k) dst[n][k] = *(const LAS bf16x8*)(lds + PG8_SB(b, h) + boff + n * 2048 + k * 1024); } while (0)
#define PG8_MMA(ai, bj, At, Bt) do { __builtin_amdgcn_s_setprio(1); _Pragma("unroll") for (int m = 0; m < 4; ++m) _Pragma("unroll") for (int n = 0; n < 2; ++n) _Pragma("unroll") for (int k = 0; k < 2; ++k) \
        acc[ai][bj][m][n] = __builtin_amdgcn_mfma_f32_16x16x32_bf16(Bt[n][k], At[m][k], acc[ai][bj][m][n], 0, 0, 0); __builtin_amdgcn_s_setprio(0); } while (0)
#define PG8_WAIT_V(n) asm volatile("s_waitcnt vmcnt(" #n ")" ::: "memory")
#define PG8_WAIT_L(n) asm volatile("s_waitcnt lgkmcnt(" #n ")" ::: "memory")
#define PG8_BAR __builtin_amdgcn_s_barrier()
#define PG8_SCHED __builtin_amdgcn_sched_barrier(0)
    Unit cur, nxt; int ui = 0;
    if (!S.next(0, cur)) return;
    f32x4 acc[2][2][4][2];
#pragma unroll
    for (int a = 0; a < 2; ++a)
#pragma unroll
        for (int b = 0; b < 2; ++b)
#pragma unroll
            for (int m = 0; m < 4; ++m)
#pragma unroll
                for (int n = 0; n < 2; ++n) acc[a][b][m][n] = (f32x4){0.f, 0.f, 0.f, 0.f};
    bf16x8 At[4][2], B0[2][2], B1[2][2];
    const char* cA = (const char*)g.A + (size_t)cur.pm * tstepA; const char* cB = (const char*)g.Bt + (size_t)cur.pn * tstepB;
    PG8_STAGE(PG8_SB(0, 0), cB, voffB); PG8_STAGE(PG8_SA(0, 0), cA, voffA); PG8_STAGE(PG8_SB(0, 1), cB + hstepB, voffB); PG8_STAGE(PG8_SA(0, 1), cA + hstepA, voffA);
    if (wr == 1) PG8_BAR;
    PG8_WAIT_V(4); PG8_BAR;
    PG8_STAGE(PG8_SB(1, 0), cB + kstep, voffB); PG8_STAGE(PG8_SA(1, 0), cA + kstep, voffA); PG8_STAGE(PG8_SB(1, 1), cB + hstepB + kstep, voffB);
    PG8_WAIT_V(6); PG8_BAR;
    for (;;) {
        const bool has_next = S.next(ui + 1, nxt);
        const char* nA = has_next ? (const char*)g.A + (size_t)nxt.pm * tstepA : cA; const char* nB = has_next ? (const char*)g.Bt + (size_t)nxt.pn * tstepB : cB;
        for (int t = 0; t < nt; t += 2) {
            const bool last = (t == nt - 2);
            const char* a1 = cA + (size_t)(t + 1) * kstep;
            const char* a2 = last ? nA : cA + (size_t)(t + 2) * kstep; const char* b2 = last ? nB : cB + (size_t)(t + 2) * kstep;
            const char* a3 = a2 + kstep; const char* b3 = b2 + kstep;
            PG8_LDB(B0, 0, 0); PG8_SCHED; PG8_LDA(At, 0, 0); PG8_STAGE(PG8_SA(1, 1), a1 + hstepA, voffA);
            PG8_WAIT_L(8); PG8_BAR; PG8_WAIT_L(0); PG8_MMA(0, 0, At, B0); PG8_BAR; PG8_SCHED;
            PG8_LDB(B1, 0, 1); PG8_STAGE(PG8_SB(0, 0), b2, voffB);
            PG8_BAR; PG8_WAIT_L(0); PG8_MMA(0, 1, At, B1); PG8_BAR;
            PG8_LDA(At, 0, 1); PG8_STAGE(PG8_SA(0, 0), a2, voffA);
            PG8_BAR; PG8_WAIT_L(0); PG8_MMA(1, 0, At, B0); PG8_BAR; PG8_SCHED;
            PG8_STAGE(PG8_SB(0, 1), b2 + hstepB, voffB);
            PG8_WAIT_V(6); PG8_BAR; PG8_MMA(1, 1, At, B1); PG8_BAR;
            PG8_LDB(B0, 1, 0); PG8_SCHED; PG8_LDA(At, 1, 0); PG8_STAGE(PG8_SA(0, 1), a2 + hstepA, voffA);
            PG8_WAIT_L(8); PG8_BAR; PG8_WAIT_L(0); PG8_MMA(0, 0, At, B0); PG8_BAR; PG8_SCHED;
            PG8_LDB(B1, 1, 1); PG8_STAGE(PG8_SB(1, 0), b3, voffB);
            PG8_BAR; PG8_WAIT_L(0); PG8_MMA(0, 1, At, B1); PG8_BAR;
            PG8_LDA(At, 1, 1); PG8_STAGE(PG8_SA(1, 0), a3, voffA);
            PG8_BAR; PG8_WAIT_L(0); PG8_MMA(1, 0, At, B0); PG8_BAR; PG8_SCHED;
            PG8_STAGE(PG8_SB(1, 1), b3 + hstepB, voffB);
            PG8_WAIT_V(6); PG8_BAR; PG8_MMA(1, 1, At, B1); PG8_BAR;
        }
        E(acc, cur, wr, wc, fr, fq);
        if (!has_next) break;
#pragma unroll
        for (int a = 0; a < 2; ++a)
#pragma unroll
            for (int b = 0; b < 2; ++b)
#pragma unroll
                for (int m = 0; m < 4; ++m)
#pragma unroll
                    for (int n = 0; n < 2; ++n) acc[a][b][m][n] = (f32x4){0.f, 0.f, 0.f, 0.f};
        cur = nxt; cA = nA; cB = nB; ++ui;
    }
    PG8_WAIT_V(0);
    if (wr == 0) PG8_BAR;
    PG8_BAR;
#undef PG8_SA
#undef PG8_SB
#undef PG8_STAGE
#undef PG8_LDA
#undef PG8_LDB
#undef PG8_MMA
#undef PG8_WAIT_V
#undef PG8_WAIT_L
#undef PG8_BAR
#undef PG8_SCHED
}
}

__device__ __forceinline__ void rmsnorm_rows(const float* src, const float* gain, bf16_t* dst, int gw, int nw, int lane) {
    for (int row = gw; row < NT; row += nw) {
        const f32x4* s = (const f32x4*)(src + (size_t)row * DM);
        f32x4 v[8]; float ss = 0.f;
#pragma unroll
        for (int i = 0; i < 8; ++i) { v[i] = s[i * 64 + lane]; ss += v[i][0] * v[i][0] + v[i][1] * v[i][1] + v[i][2] * v[i][2] + v[i][3] * v[i][3]; }
        ss = wave_sum(ss);
        const float r = rsqrtf(ss * (1.f / DM) + 1e-6f);
        u32x2* d = (u32x2*)(dst + (size_t)row * DM);
#pragma unroll
        for (int i = 0; i < 8; ++i) { const f32x4 gg = ((const f32x4*)gain)[i * 64 + lane]; u32x2 o; o.x = cvt_pk_bf16(v[i][0] * r * gg[0], v[i][1] * r * gg[1]); o.y = cvt_pk_bf16(v[i][2] * r * gg[2], v[i][3] * r * gg[3]); d[i * 64 + lane] = o; }
    }
}

__device__ __forceinline__ void tr_tile(const float* src, int ld, int c0, int nvalid, int k0, bf16_t* dst, int ldd, int r0, int kd0, LAS float* tile) {
    const int tid = tid_l();
#pragma unroll
    for (int i = 0; i < 2; ++i) {
        const int k = (tid >> 4) + 32 * i, c4 = (tid & 15) * 4;
        f32x4 v = (f32x4){0.f, 0.f, 0.f, 0.f};
        if (c4 < nvalid) v = *(const f32x4*)(src + (size_t)(k0 + k) * ld + c0 + c4);
        tile[k * 65 + c4] = v[0]; tile[k * 65 + c4 + 1] = v[1]; tile[k * 65 + c4 + 2] = v[2]; tile[k * 65 + c4 + 3] = v[3];
    }
    __syncthreads();
    {
        const int c = tid >> 3, k8 = (tid & 7) * 8;
        float f[8];
#pragma unroll
        for (int j = 0; j < 8; ++j) f[j] = tile[(k8 + j) * 65 + c];
        u32x4 w; w.x = cvt_pk_bf16(f[0], f[1]); w.y = cvt_pk_bf16(f[2], f[3]); w.z = cvt_pk_bf16(f[4], f[5]); w.w = cvt_pk_bf16(f[6], f[7]);
        *(u32x4*)(dst + (size_t)(r0 + c) * ldd + kd0 + k8) = w;
    }
    __syncthreads();
}

__device__ void phase_prep(const KP& p, LAS unsigned char* lds) {
    const int tid = tid_l(), lane = tid & 63, G = gridDim.x, bid = blockIdx.x;
    unsigned char* ws = p.ws;
    rmsnorm_rows(p.x, p.g_mix, (bf16_t*)(ws + OFF_XN), bid * 8 + (tid >> 6), G * 8, lane);
    LAS float* tile = (LAS float*)lds;
    for (int j = bid; j < 8960; j += G) {
        if (j < 5888) {
            const int rt = j >> 5, kt = j & 31; int c0, nv = 64;
            if (rt < 64) c0 = 64 * rt; else if (rt < 119) c0 = 4104 + 64 * (rt - 64); else if (rt == 119) { c0 = 4096; nv = 8; } else c0 = 7624 + 64 * (rt - 120);
            tr_tile(p.w_in, 11720, c0, nv, kt * 64, (bf16_t*)(ws + OFF_WINT), 2048, rt * 64, kt * 64, tile);
        } else if (j < 6400) { const int q = j - 5888, rt = q >> 4, kt = q & 15; tr_tile(p.proj_m, 2048, rt * 64, 64, kt * 64, (bf16_t*)(ws + OFF_PMT), 1024, rt * 64, kt * 64, tile); }
        else if (j < 6912) { const int q = j - 6400, rt = q >> 4, kt = q & 15; tr_tile(p.proj_r, 2048, rt * 64, 64, kt * 64, (bf16_t*)(ws + OFF_PRT), 1024, rt * 64, kt * 64, tile); }
        else if (j < 7936) { const int q = j - 6912, rt = q >> 5, kt = q & 31; tr_tile(p.w_out, 2048, rt * 64, 64, kt * 64, (bf16_t*)(ws + OFF_WOT), 2048, rt * 64, kt * 64, tile); }
        else { const int q = j - 7936, rt = q >> 5, kt = q & 31; tr_tile(p.w_query, 2048, rt * 64, 64, kt * 64, (bf16_t*)(ws + OFF_WQT), 2048, rt * 64, kt * 64, tile); }
    }
    const int gt = bid * 512 + tid, gn = G * 512;
    bf16_t* WAT = (bf16_t*)(ws + OFF_WAT);
    for (int i = gt; i < 2048 * 256; i += gn) { const int r = i >> 8, k = i & 255; float v = 0.f;
        if (r < 1024) { if (k < 96) v = p.w2[k * 1024 + r]; } else { if (k >= 96 && k < 192) v = p.a2[(k - 96) * 1024 + (r - 1024)]; }
        WAT[i] = f2bf(v); }
    bf16_t* G2T = (bf16_t*)(ws + OFF_G2T);
    for (int i = gt; i < 1024 * 256; i += gn) { const int r = i >> 8, k = i & 255; G2T[i] = f2bf(p.g2[k * 1024 + r]); }
    bf16_t* SK = (bf16_t*)(ws + OFF_SUBK);
    for (int i = gt; i < 2 * 128 * 128; i += gn) SK[i] = f2bf(p.sub_keys[i]);
    if (gt == 0) *(unsigned*)(ws + OFF_SUBBAR) = 0u;
}

__device__ __forceinline__ float bfel(const u32x4& w, int e) { const unsigned u = w[e >> 1]; return (e & 1) ? bfhi(u) : bflo(u); }
__device__ void phase_lora_prep(const KP& p) {
    const bf16_t* PR = (const bf16_t*)(p.ws + OFF_PR);
    bf16_t* AL = (bf16_t*)((unsigned char*)p.out + DO_ALORA);
    const int gt = blockIdx.x * 512 + threadIdx.x, gn = gridDim.x * 512;
    for (int i = gt; i < NT * 64; i += gn) {
        const int tok = i >> 6, g = i & 63;
        u32x4 o = (u32x4){0u, 0u, 0u, 0u};
        if (g < 24 || g >= 32) {
            const int sc = (g < 24) ? (3072 + 8 * g) : (3264 + 8 * (g - 32));
            const u32x4 cu = *(const u32x4*)(PR + (size_t)tok * LDPR + sc);
            u32x4 pv = (u32x4){0u, 0u, 0u, 0u};
            if ((tok & (SEQ - 1)) != 0) pv = *(const u32x4*)(PR + (size_t)(tok - 1) * LDPR + sc);
            const f32x4 m0 = *(const f32x4*)(p.mu + sc), m1 = *(const f32x4*)(p.mu + sc + 4);
            float f[8];
#pragma unroll
            for (int q = 0; q < 4; ++q) {
                const float c0 = bflo(cu[q]), c1 = bfhi(cu[q]), p0 = bflo(pv[q]), p1 = bfhi(pv[q]);
                const float mm0 = (q < 2) ? m0[2 * q] : m1[2 * q - 4], mm1 = (q < 2) ? m0[2 * q + 1] : m1[2 * q - 3];
                f[2 * q] = c0 + (p0 - c0) * mm0; f[2 * q + 1] = c1 + (p1 - c1) * mm1;
            }
            if (g < 12) {
#pragma unroll
                for (int q = 0; q < 8; ++q) f[q] = tanhf(f[q]);
            } else if (g >= 32) {
#pragma unroll
                for (int q = 0; q < 8; ++q) f[q] = sigm(f[q]);
            }
            o.x = cvt_pk_bf16(f[0], f[1]); o.y = cvt_pk_bf16(f[2], f[3]); o.z = cvt_pk_bf16(f[4], f[5]); o.w = cvt_pk_bf16(f[6], f[7]);
        }
        *(u32x4*)(AL + (size_t)tok * 512 + 8 * g) = o;
    }
    {
        const bf16_t* PM = (const bf16_t*)(p.ws + OFF_PM);
        bf16_t* QC = (bf16_t*)(p.ws + OFF_QC); bf16_t* KC = (bf16_t*)(p.ws + OFF_KC);
        for (int i = gt; i < (NT / 8) * 256; i += gn) {
            const int tb = i >> 8, col = (i & 255) * 8; const int tok0 = tb * 8, t0 = tok0 & (SEQ - 1);
            f32x4 cw[4][2];
#pragma unroll
            for (int j = 0; j < 4; ++j) { cw[j][0] = *(const f32x4*)(p.conv_w + j * 2048 + col); cw[j][1] = *(const f32x4*)(p.conv_w + j * 2048 + col + 4); }
            u32x4 raw[11];
#pragma unroll
            for (int q = 0; q < 11; ++q) { const bool neg = (t0 - 3 + q) < 0; u32x4 v = *(const u32x4*)(PM + (size_t)(tok0 + (neg ? 0 : q - 3)) * LDPM + col); if (neg) v = (u32x4){0u, 0u, 0u, 0u}; raw[q] = v; }
            const float scl = (col < 1024) ? 0.0625f : 1.f;
            bf16_t* dst = (col < 1024) ? (QC + (size_t)tok0 * 1024 + col) : (KC + (size_t)tok0 * 1024 + (col - 1024));
#pragma unroll
            for (int r = 0; r < 8; ++r) {
                float o[8];
#pragma unroll
                for (int e = 0; e < 8; ++e) {
                    const float c0 = (e < 4) ? cw[0][0][e] : cw[0][1][e - 4], c1 = (e < 4) ? cw[1][0][e] : cw[1][1][e - 4], c2 = (e < 4) ? cw[2][0][e] : cw[2][1][e - 4], c3 = (e < 4) ? cw[3][0][e] : cw[3][1][e - 4];
                    float sv = c0 * bfel(raw[r], e) + c1 * bfel(raw[r + 1], e) + c2 * bfel(raw[r + 2], e) + c3 * bfel(raw[r + 3], e);
                    o[e] = sv * sigm(sv) * scl;
                }
                u32x4 pk; pk.x = cvt_pk_bf16(o[0], o[1]); pk.y = cvt_pk_bf16(o[2], o[3]); pk.z = cvt_pk_bf16(o[4], o[5]); pk.w = cvt_pk_bf16(o[6], o[7]);
                *(u32x4*)(dst + (size_t)r * 1024) = pk;
            }
        }
    }
    {
        const int lane = threadIdx.x & 63, gw = blockIdx.x * 8 + (threadIdx.x >> 6), nw = gridDim.x * 8;
        float* GB = (float*)((unsigned char*)p.out + DO_GB); float* GA = (float*)((unsigned char*)p.out + DO_GA); float* GW = (float*)((unsigned char*)p.out + DO_GW);
        for (int task = gw; task < 1024; task += nw) {
            const int bh = task >> 6, c = task & 63, bb = bh >> 2, h = bh & 3; const size_t tok = (size_t)bb * SEQ + c * 64 + lane;
            const float iv = bf2f(PR[tok * LDPR + 3520 + h]) + p.b_i[h], fv = bf2f(PR[tok * LDPR + 3524 + h]) + p.b_f[h];
            float lf = fminf(fv, 0.f) - __logf(1.f + __expf(-fabsf(fv)));
#pragma unroll
            for (int d = 1; d < 64; d <<= 1) { const float y = __shfl_up(lf, d); if (lane >= d) lf += y; }
            const float bl = rlane(lf, 63);
            const int o = bh * SEQ + c * 64 + lane;
            GB[o] = lf; GA[o] = iv - lf; GW[o] = __expf(bl - lf + iv);
        }
    }
}

constexpr size_t OFF_YRAW = OFF_WINT, OFF_BON = OFF_WINT + 32 * MiB;
struct RwOps { f32x4 a0, a1, q0, q1, w0, w1, b0, b1, k0, k1; float v, br, kr; };
__device__ __forceinline__ f32x2_t lo2(f32x4 v) { return __builtin_shufflevector(v, v, 0, 1); }
__device__ __forceinline__ f32x2_t hi2(f32x4 v) { return __builtin_shufflevector(v, v, 2, 3); }
__device__ __forceinline__ f32x2_t fma2(f32x2_t a, f32x2_t b, f32x2_t c) { return __builtin_elementwise_fma(a, b, c); }
__device__ void rwkv_scan(const KP& p, int blk, LAS unsigned char* lds) {
    const int tid0 = tid_l();
    const int bh = blk >> 1, half = blk & 1, b = bh >> 4, h = bh & 15;
    constexpr int BUFB = 53760;
    const bf16_t* PR = (const bf16_t*)(p.ws + OFF_PR);
    const bf16_t* WLOG = (const bf16_t*)((const unsigned char*)p.out + DO_WLOG);
    const bf16_t* AG = (const bf16_t*)((const unsigned char*)p.out + DO_AG);
    bf16_t* YRAW = (bf16_t*)(p.ws + OFF_YRAW); float* BON = (float*)(p.ws + OFF_BON);
    const size_t tokbase = (size_t)b * SEQ;
    if (tid0 < 256) {
        const int rowl = tid0 >> 3, j8 = (tid0 & 7) * 8, row = 32 * half + rowl;
        f32x2_t S2[4];
#pragma unroll
        for (int k = 0; k < 4; ++k) S2[k] = (f32x2_t){0.f, 0.f};
        __syncthreads();
        for (int c = 0; c < 128; ++c) {
            const LAS float* bp = (const LAS float*)(lds + (c & 1) * BUFB);
            LAS float* yb = (LAS float*)(lds + (c & 1) * BUFB + 49408);
#define RW_LD(O, s) do { const LAS float* q_ = bp + (s) * 64 + j8; O.a0 = *(const LAS f32x4*)(q_); O.a1 = *(const LAS f32x4*)(q_ + 4); O.b0 = *(const LAS f32x4*)(q_ + 2048); O.b1 = *(const LAS f32x4*)(q_ + 2052); \
            O.w0 = *(const LAS f32x4*)(q_ + 4096); O.w1 = *(const LAS f32x4*)(q_ + 4100); O.k0 = *(const LAS f32x4*)(q_ + 6144); O.k1 = *(const LAS f32x4*)(q_ + 6148); \
            O.q0 = *(const LAS f32x4*)(q_ + 8192); O.q1 = *(const LAS f32x4*)(q_ + 8196); O.v = bp[10240 + (s) * 64 + row]; O.br = bp[12288 + (s)]; O.kr = bp[12320 + (s)]; } while (0)
#define RW_STEP(O, s) do { \
            f32x2_t pa = S2[0] * lo2(O.a0); f32x2_t py = S2[0] * lo2(O.q0); \
            pa = fma2(S2[1], hi2(O.a0), pa); py = fma2(S2[1], hi2(O.q0), py); pa = fma2(S2[2], lo2(O.a1), pa); py = fma2(S2[2], lo2(O.q1), py); \
            pa = fma2(S2[3], hi2(O.a1), pa); py = fma2(S2[3], hi2(O.q1), py); \
            float sa = pa.x + pa.y, yy = py.x + py.y; \
            sa += dppf<0xB1>(sa); yy += dppf<0xB1>(yy); sa += dppf<0x4E>(sa); yy += dppf<0x4E>(yy); sa += dppf<0x141>(sa); yy += dppf<0x141>(yy); \
            const f32x2_t sa2 = (f32x2_t){sa, sa}, vv2 = (f32x2_t){O.v, O.v}; \
            S2[0] = fma2(S2[0], lo2(O.w0), fma2(vv2, lo2(O.k0), sa2 * lo2(O.b0))); S2[1] = fma2(S2[1], hi2(O.w0), fma2(vv2, hi2(O.k0), sa2 * hi2(O.b0))); \
            S2[2] = fma2(S2[2], lo2(O.w1), fma2(vv2, lo2(O.k1), sa2 * lo2(O.b1))); S2[3] = fma2(S2[3], hi2(O.w1), fma2(vv2, hi2(O.k1), sa2 * hi2(O.b1))); \
            if ((tid0 & 7) == 0) yb[(s) * 32 + rowl] = yy + sa * O.br + O.v * O.kr; } while (0)
            RwOps o0, o1;
            RW_LD(o0, 0);
#pragma unroll 1
            for (int s = 0; s < 32; s += 2) {
                RW_LD(o1, s + 1);
                RW_STEP(o0, s);
                { const int sn = (s + 2 < 32) ? s + 2 : 31; RW_LD(o0, sn); }
                RW_STEP(o1, s + 1);
            }
#undef RW_LD
#undef RW_STEP
            __syncthreads();
        }
    } else {
        const int ht = tid0 - 256, tt = ht >> 3, cg8 = (ht & 7) * 8, ch = h * 64 + cg8;
        float mur[8], muk[8], muv[8], kkc[8], kac[8], rkc[8];
#pragma unroll
        for (int e = 0; e < 8; ++e) { mur[e] = p.mu[ch + e]; muk[e] = p.mu[1024 + ch + e]; muv[e] = p.mu[2048 + ch + e]; kkc[e] = p.k_k[ch + e]; kac[e] = p.k_a[ch + e]; rkc[e] = p.r_k[ch + e]; }
        for (int c = -1; c < 128; ++c) {
            if (c >= 1) {
                const LAS float* yb = (const LAS float*)(lds + ((c - 1) & 1) * BUFB + 49408);
                const int r4 = (ht & 7) * 4; const f32x4 y4 = *(const LAS f32x4*)(yb + tt * 32 + r4);
                u32x2 ov; ov.x = cvt_pk_bf16(y4[0], y4[1]); ov.y = cvt_pk_bf16(y4[2], y4[3]);
                *(u32x2*)(YRAW + (tokbase + (size_t)(c - 1) * 32 + tt) * 1024 + h * 64 + 32 * half + r4) = ov;
            }
            if (c + 1 < 128) {
                const int cn = c + 1, t = cn * 32 + tt; const size_t tok = tokbase + t;
                LAS float* bp = (LAS float*)(lds + (cn & 1) * BUFB);
                const bf16_t* pr_ = PR + tok * LDPR + ch;
                const u32x4 r4 = *(const u32x4*)pr_, k4 = *(const u32x4*)(pr_ + 1024), v4 = *(const u32x4*)(pr_ + 2048);
                u32x4 pr4 = (u32x4){0u, 0u, 0u, 0u}, pk4 = pr4, pv4 = pr4;
                if (t > 0) { pr4 = *(const u32x4*)(pr_ - LDPR); pk4 = *(const u32x4*)(pr_ - LDPR + 1024); pv4 = *(const u32x4*)(pr_ - LDPR + 2048); }
                const u32x4 w4 = *(const u32x4*)(WLOG + tok * 1024 + ch), a4 = *(const u32x4*)(AG + tok * 1024 + ch);
                float r[8], k[8], v[8], kk[8], av[8], dec[8];
                float n2 = 0.f;
#pragma unroll
                for (int e = 0; e < 8; ++e) {
                    const float rc = bfel(r4, e), kc = bfel(k4, e), vc = bfel(v4, e);
                    r[e] = rc + (bfel(pr4, e) - rc) * mur[e]; k[e] = kc + (bfel(pk4, e) - kc) * muk[e]; v[e] = vc + (bfel(pv4, e) - vc) * muv[e];
                    kk[e] = k[e] * kkc[e]; n2 += kk[e] * kk[e]; av[e] = bfel(a4, e); dec[e] = __expf(bfel(w4, e));
                }
                n2 = red8(n2);
                const float inv = 1.f / fmaxf(sqrtf(n2), 1e-12f);
                float br = 0.f, kr = 0.f, bon = 0.f;
                f32x4 oa[2], ob[2], ow[2], ok[2], oq[2], ovv[2];
#pragma unroll
                for (int e = 0; e < 8; ++e) {
                    const float kn = kk[e] * inv, k3 = k[e] * (1.f + (av[e] - 1.f) * kac[e]), bb = kn * av[e];
                    oa[e >> 2][e & 3] = -kn; ob[e >> 2][e & 3] = bb; ow[e >> 2][e & 3] = dec[e]; ok[e >> 2][e & 3] = k3; oq[e >> 2][e & 3] = dec[e] * r[e]; ovv[e >> 2][e & 3] = v[e];
                    br += bb * r[e]; kr += k3 * r[e]; bon += r[e] * k3 * rkc[e];
                }
                br = red8(br); kr = red8(kr); bon = red8(bon);
                LAS float* q_ = bp + tt * 64 + cg8;
#pragma unroll
                for (int i = 0; i < 2; ++i) { *(LAS f32x4*)(q_ + 4 * i) = oa[i]; *(LAS f32x4*)(q_ + 2048 + 4 * i) = ob[i]; *(LAS f32x4*)(q_ + 4096 + 4 * i) = ow[i]; *(LAS f32x4*)(q_ + 6144 + 4 * i) = ok[i];
                    *(LAS f32x4*)(q_ + 8192 + 4 * i) = oq[i]; *(LAS f32x4*)(q_ + 10240 + 4 * i) = ovv[i]; }
                if ((ht & 7) == 0) { bp[12288 + tt] = br; bp[12320 + tt] = kr; if (half == 0) BON[tok * 16 + h] = bon; }
            }
            __syncthreads();
        }
        {
            const LAS float* yb = (const LAS float*)(lds + (127 & 1) * BUFB + 49408);
            const int r4 = (ht & 7) * 4; const f32x4 y4 = *(const LAS f32x4*)(yb + tt * 32 + r4);
            u32x2 ov; ov.x = cvt_pk_bf16(y4[0], y4[1]); ov.y = cvt_pk_bf16(y4[2], y4[3]);
            *(u32x2*)(YRAW + (tokbase + (size_t)127 * 32 + tt) * 1024 + h * 64 + 32 * half + r4) = ov;
        }
    }
}

__device__ void phase_rwkv_post(const KP& p) {
    const bf16_t* PR = (const bf16_t*)(p.ws + OFF_PR);
    const bf16_t* GG = (const bf16_t*)((const unsigned char*)p.out + DO_GG);
    bf16_t* YR = (bf16_t*)(p.ws + OFF_YRAW); const float* BON = (const float*)(p.ws + OFF_BON);
    const int gt = blockIdx.x * 512 + tid_l(), gn = gridDim.x * 512;
    for (int i = gt; i < NT * 256; i += gn) {
        const int tok = i >> 8, h = (i >> 4) & 15, ch = h * 64 + (i & 15) * 4;
        const u32x2 y2 = *(const u32x2*)(YR + (size_t)tok * 1024 + ch), v2 = *(const u32x2*)(PR + (size_t)tok * LDPR + 2048 + ch), g2 = *(const u32x2*)(GG + (size_t)tok * 1024 + ch);
        u32x2 pv2 = (u32x2){0u, 0u};
        if ((tok & (SEQ - 1)) != 0) pv2 = *(const u32x2*)(PR + (size_t)(tok - 1) * LDPR + 2048 + ch);
        const float bon = BON[tok * 16 + h];
        const f32x4 muv = *(const f32x4*)(p.mu + 2048 + ch), lnw = *(const f32x4*)(p.ln_w + ch), lnb = *(const f32x4*)(p.ln_b + ch);
        const f32x4 y = (f32x4){bflo(y2.x), bfhi(y2.x), bflo(y2.y), bfhi(y2.y)}, vc = (f32x4){bflo(v2.x), bfhi(v2.x), bflo(v2.y), bfhi(v2.y)}, vp = (f32x4){bflo(pv2.x), bfhi(pv2.x), bflo(pv2.y), bfhi(pv2.y)};
        const f32x4 g = (f32x4){bflo(g2.x), bfhi(g2.x), bflo(g2.y), bfhi(g2.y)};
        const f32x4 v = vc + (vp - vc) * muv;
        const float mean = red16(y[0] + y[1] + y[2] + y[3]) * (1.f / 64.f);
        const f32x4 d = y - mean;
        const float var = red16(d[0] * d[0] + d[1] * d[1] + d[2] * d[2] + d[3] * d[3]) * (1.f / 64.f);
        const float rs = rsqrtf(var + 64e-5f);
        const f32x4 res = (d * rs * lnw + lnb + bon * v) * g;
        u32x2 ov; ov.x = cvt_pk_bf16(res[0], res[1]); ov.y = cvt_pk_bf16(res[2], res[3]);
        *(u32x2*)(YR + (size_t)tok * 1024 + ch) = ov;
    }
}

typedef short v4i16_t __attribute__((ext_vector_type(4)));
__device__ __forceinline__ bf16x8 tr_frag(const LAS unsigned char* base, int stride_b, int krow0, int ncol0, int lane) {
    const int g = lane >> 4, q = (lane & 15) >> 2, pp = lane & 3;
    const LAS unsigned char* a0 = base + (krow0 + 8 * g + q) * stride_b + (ncol0 + 4 * pp) * 2;
    const v4i16_t x = __builtin_amdgcn_ds_read_tr16_b64_v4i16((LAS v4i16_t*)a0), y = __builtin_amdgcn_ds_read_tr16_b64_v4i16((LAS v4i16_t*)(a0 + 4 * stride_b));
    return (bf16x8){x[0], x[1], x[2], x[3], y[0], y[1], y[2], y[3]};
}
__device__ void mlstm_run(const KP& p, int item, LAS unsigned char* lds) {
    const int tid0 = tid_l();
    const int bh = item >> 3, b = bh >> 2, h = bh & 3, dv0 = (item & 7) * 32;
    const size_t tokbase = (size_t)b * SEQ;
    LAS bf16_t* Qs = (LAS bf16_t*)(lds + 0);
    LAS bf16_t* Ks = (LAS bf16_t*)(lds + 33792);
    LAS bf16_t* Vs = (LAS bf16_t*)(lds + 67584);
    LAS bf16_t* Vws = (LAS bf16_t*)(lds + 74752);
    LAS bf16_t* Ss = (LAS bf16_t*)(lds + 81920);
    LAS bf16_t* CT0 = (LAS bf16_t*)(lds + 91136);
    LAS bf16_t* Os = (LAS bf16_t*)(lds + 141824);
    LAS float* BC = (LAS float*)(lds + 146944);
    LAS float* GAs = (LAS float*)(lds + 147200);
    const bf16_t* QC = (const bf16_t*)(p.ws + OFF_QC); const bf16_t* KC = (const bf16_t*)(p.ws + OFF_KC);
    bf16_t* PM = (bf16_t*)(p.ws + OFF_PM);
    const float* GB = (const float*)((const unsigned char*)p.out + DO_GB); const float* GA = (const float*)((const unsigned char*)p.out + DO_GA); const float* GW = (const float*)((const unsigned char*)p.out + DO_GW);
    for (int i = tid0; i < 2 * 48 * 264 / 2; i += 512) ((LAS unsigned*)CT0)[i] = 0u;
    for (int i = tid0; i < 2 * 64 * 56 / 2; i += 512) ((LAS unsigned*)Vs)[i] = 0u;
    __syncthreads();
    if (tid0 < 64) Vs[tid0 * 56 + 32] = (bf16_t)0x3F80;
    f32x4 cacc[6];
#pragma unroll
    for (int i = 0; i < 6; ++i) cacc[i] = (f32x4){0.f, 0.f, 0.f, 0.f};
    u32x4 q4[4], k4[4], vo4; float gb = 0.f, ga = 0.f, gwv = 0.f;
#define ML_LOAD(c, TID) do { const int row_ = (TID) >> 3, pc_ = (TID) & 7; const size_t tk_ = tokbase + (size_t)(c) * 64; \
        const bf16_t* qp_ = QC + (tk_ + row_) * 1024 + h * 256 + pc_ * 32; const bf16_t* kp_ = KC + (tk_ + row_) * 1024 + h * 256 + pc_ * 32; \
        _Pragma("unroll") for (int i_ = 0; i_ < 4; ++i_) { q4[i_] = *(const u32x4*)(qp_ + 8 * i_); k4[i_] = *(const u32x4*)(kp_ + 8 * i_); } \
        const int sg_ = (TID) & 255, s_ = sg_ >> 2, g_ = sg_ & 3; \
        vo4 = *(const u32x4*)(PM + (tk_ + s_) * LDPM + ((TID) < 256 ? 2048 : 3072) + h * 256 + dv0 + 8 * g_); \
        gwv = GW[bh * SEQ + (c) * 64 + s_]; \
        if ((TID) < 64) { gb = GB[bh * SEQ + (c) * 64 + (TID)]; ga = GA[bh * SEQ + (c) * 64 + (TID)]; } } while (0)
    ML_LOAD(0, tid0);
    __syncthreads();
    int cur = 0;
    for (int c = 0; c < 64; ++c) {
        int tid = tid0; asm volatile("" : "+v"(tid));
        const int lane = tid & 63, w = tid >> 6, fr = lane & 15, fq = lane >> 4;
        LAS bf16_t* CTc = CT0 + cur * (48 * 264); LAS bf16_t* CTn = CT0 + (cur ^ 1) * (48 * 264);
        {
            const int row = tid >> 3, pc = tid & 7;
#pragma unroll
            for (int i = 0; i < 4; ++i) { *(LAS u32x4*)(Qs + row * 264 + pc * 32 + 8 * i) = q4[i]; *(LAS u32x4*)(Ks + row * 264 + pc * 32 + 8 * i) = k4[i]; }
            const int sg = tid & 255, s = sg >> 2, g = sg & 3;
            if (tid < 256) {
                *(LAS u32x4*)(Vs + s * 56 + 8 * g) = vo4;
                u32x4 wv;
#pragma unroll
                for (int e = 0; e < 4; ++e) wv[e] = cvt_pk_bf16(bflo(vo4[e]) * gwv, bfhi(vo4[e]) * gwv);
                *(LAS u32x4*)(Vws + s * 56 + 8 * g) = wv;
                if (g == 0) Vws[s * 56 + 32] = f2bf(gwv);
            } else {
                if (c > 0) { const u32x4 yv = *(const LAS u32x4*)(Os + s * 40 + 8 * g); *(u32x4*)(PM + (tokbase + (size_t)(c - 1) * 64 + s) * LDPM + 3072 + h * 256 + dv0 + 8 * g) = yv; }
                *(LAS u32x4*)(Os + s * 40 + 8 * g) = vo4;
            }
            if (tid < 64) { BC[tid] = gb; GAs[tid] = ga; }
        }
        asm volatile("" ::: "memory");
        if (c + 1 < 64) ML_LOAD(c + 1, tid);
        asm volatile("" ::: "memory");
        __syncthreads();
        {
            const int mt = w >> 1, ntb = (w & 1) * 2;
            f32x4 s0 = (f32x4){0.f, 0.f, 0.f, 0.f}, s1 = s0;
#pragma unroll
            for (int ks = 0; ks < 8; ++ks) {
                const bf16x8 a = *(const LAS bf16x8*)(Qs + (16 * mt + fr) * 264 + 32 * ks + 8 * fq);
                const bf16x8 b0 = *(const LAS bf16x8*)(Ks + (16 * ntb + fr) * 264 + 32 * ks + 8 * fq);
                const bf16x8 b1 = *(const LAS bf16x8*)(Ks + (16 * (ntb + 1) + fr) * 264 + 32 * ks + 8 * fq);
                s0 = __builtin_amdgcn_mfma_f32_16x16x32_bf16(a, b0, s0, 0, 0, 0);
                s1 = __builtin_amdgcn_mfma_f32_16x16x32_bf16(a, b1, s1, 0, 0, 0);
            }
            const int sA = 16 * ntb + fr, sB = sA + 16;
            const float gA = GAs[sA], gB = GAs[sB];
#pragma unroll
            for (int j = 0; j < 4; ++j) {
                const int t = 16 * mt + 4 * fq + j; const float bt = BC[t];
                const float vA = (sA <= t) ? s0[j] * __expf(bt + gA) : 0.f, vB = (sB <= t) ? s1[j] * __expf(bt + gB) : 0.f;
                Ss[t * 72 + sA] = f2bf(vA); Ss[t * 72 + sB] = f2bf(vB);
            }
        }
        __syncthreads();
        {
            const int mt = w >> 1, nt = w & 1;
            f32x4 aA = (f32x4){0.f, 0.f, 0.f, 0.f}, aB = aA, xA = aA, xB = aA;
#pragma unroll
            for (int ks = 0; ks < 2; ++ks) {
                const bf16x8 a = *(const LAS bf16x8*)(Ss + (16 * mt + fr) * 72 + 32 * ks + 8 * fq);
                const bf16x8 bm = tr_frag((const LAS unsigned char*)Vs, 112, 32 * ks, 16 * nt, lane);
                const bf16x8 bx = tr_frag((const LAS unsigned char*)Vs, 112, 32 * ks, 32, lane);
                aA = __builtin_amdgcn_mfma_f32_16x16x32_bf16(a, bm, aA, 0, 0, 0);
                xA = __builtin_amdgcn_mfma_f32_16x16x32_bf16(a, bx, xA, 0, 0, 0);
            }
#pragma unroll
            for (int ks = 0; ks < 8; ++ks) {
                const bf16x8 a = *(const LAS bf16x8*)(Qs + (16 * mt + fr) * 264 + 32 * ks + 8 * fq);
                const bf16x8 bm = *(const LAS bf16x8*)(CTc + (16 * nt + fr) * 264 + 32 * ks + 8 * fq);
                const bf16x8 bx = *(const LAS bf16x8*)(CTc + (32 + fr) * 264 + 32 * ks + 8 * fq);
                aB = __builtin_amdgcn_mfma_f32_16x16x32_bf16(a, bm, aB, 0, 0, 0);
                xB = __builtin_amdgcn_mfma_f32_16x16x32_bf16(a, bx, xB, 0, 0, 0);
            }
#pragma unroll
            for (int j = 0; j < 4; ++j) {
                const int t = 16 * mt + 4 * fq + j; const float eb = __expf(BC[t]);
                const float num = aA[j] + eb * aB[j];
                const float den = __shfl(xA[j] + eb * xB[j], lane & 48);
                const float hv = num / fmaxf(fabsf(den), 1.f);
                LAS bf16_t* op = Os + t * 40 + 16 * nt + fr;
                *op = f2bf(hv * sigm(bf2f(*op)));
            }
            const float decay = __expf(BC[63]);
            bf16x8 bw[3][2];
#pragma unroll
            for (int n3 = 0; n3 < 3; ++n3)
#pragma unroll
                for (int ks = 0; ks < 2; ++ks) bw[n3][ks] = tr_frag((const LAS unsigned char*)Vws, 112, 32 * ks, 16 * n3, lane);
#pragma unroll
            for (int m2 = 0; m2 < 2; ++m2) {
                const int mtk = 2 * w + m2;
                const bf16x8 ka0 = tr_frag((const LAS unsigned char*)Ks, 528, 0, 16 * mtk, lane), ka1 = tr_frag((const LAS unsigned char*)Ks, 528, 32, 16 * mtk, lane);
#pragma unroll
                for (int n3 = 0; n3 < 3; ++n3) {
                    f32x4 cc = cacc[m2 * 3 + n3] * decay;
                    cc = __builtin_amdgcn_mfma_f32_16x16x32_bf16(ka0, bw[n3][0], cc, 0, 0, 0);
                    cc = __builtin_amdgcn_mfma_f32_16x16x32_bf16(ka1, bw[n3][1], cc, 0, 0, 0);
                    cacc[m2 * 3 + n3] = cc;
                    u32x2 pk; pk.x = cvt_pk_bf16(cc[0], cc[1]); pk.y = cvt_pk_bf16(cc[2], cc[3]);
                    *(LAS u32x2*)(CTn + (16 * n3 + fr) * 264 + 16 * mtk + 4 * fq) = pk;
                }
            }
        }
        cur ^= 1;
        __syncthreads();
    }
    if (tid0 >= 256) { const int sg = tid0 & 255, s = sg >> 2, g = sg & 3; const u32x4 yv = *(const LAS u32x4*)(Os + s * 40 + 8 * g);
        *(u32x4*)(PM + (tokbase + (size_t)63 * 64 + s) * LDPM + 3072 + h * 256 + dv0 + 8 * g) = yv; }
#undef ML_LOAD
}

__device__ void phase_norm2(const KP& p) {
    const int tid = tid_l(), lane = tid & 63, G = gridDim.x, bid = blockIdx.x;
    rmsnorm_rows(p.out, p.g_ffn, (bf16_t*)(p.ws + OFF_XN2), bid * 8 + (tid >> 6), G * 8, lane);
}
__device__ void convert_tables(const KP& p, int gw, int nw) {
    const int lane = tid_l() & 63;
    for (int tb = 0; tb < 2; ++tb) {
        const float* src = tb ? p.peer_v : p.peer_u; unsigned char* dst = p.ws + (tb ? OFF_PV : OFF_PU); float* sc = (float*)(p.ws + (tb ? OFF_SCV : OFF_SCU));
        for (int row = gw; row < 16384; row += nw) {
            const float* sp = src + (size_t)row * DM + lane * 16;
            f32x4 v[8]; float am = 0.f;
#pragma unroll
            for (int i = 0; i < 2; ++i)
#pragma unroll
                for (int q = 0; q < 4; ++q) { v[i * 4 + q] = *(const f32x4*)(sp + i * 1024 + q * 4);
                    am = fmaxf(am, fmaxf(fmaxf(fabsf(v[i * 4 + q][0]), fabsf(v[i * 4 + q][1])), fmaxf(fabsf(v[i * 4 + q][2]), fabsf(v[i * 4 + q][3])))); }
            const unsigned amu = wave_max_u32(__float_as_uint(am));
            const float amax = __uint_as_float(amu);
            float scl = 1.f;
            if (amax > 0.f) scl = exp2f(floorf(log2f(240.f / amax)));
            if (lane == 0) sc[row] = 1.f / scl;
#pragma unroll
            for (int i = 0; i < 2; ++i) { u32x4 o;
#pragma unroll
                for (int q = 0; q < 4; ++q) { const f32x4 t = v[i * 4 + q] * scl; int w = __builtin_amdgcn_cvt_pk_fp8_f32(t[0], t[1], 0, false); w = __builtin_amdgcn_cvt_pk_fp8_f32(t[2], t[3], w, true); o[q] = (unsigned)w; }
                *(u32x4*)(dst + (size_t)row * 8192 + i * 1024 + lane * 16) = o; }
        }
    }
}

__device__ void phase_peer(const KP& p, LAS unsigned char* lds) {
    const int tid = tid_l(), lane = tid & 63, w = tid >> 6, fr = lane & 15, fq = lane >> 4;
    LAS unsigned* KEYS = (LAS unsigned*)lds;
    LAS int* TI = (LAS int*)(lds + 32768);
    LAS float* TG = (LAS float*)(lds + 49152);
    const bf16_t* Q = (const bf16_t*)(p.ws + OFF_Q);
    const bf16_t* SK = (const bf16_t*)(p.ws + OFF_SUBK);
    const bf16_t* XN2 = (const bf16_t*)(p.ws + OFF_XN2);
    const unsigned char* PU = p.ws + OFF_PU; const unsigned char* PV = p.ws + OFF_PV;
    const float* SCU = (const float*)(p.ws + OFF_SCU); const float* SCV = (const float*)(p.ws + OFF_SCV);
    float* out = p.out;
    LAS int* IJ = (LAS int*)(lds + 65536);
    int ci[4], cj[4]; bool cv[4];
#pragma unroll
    for (int m = 0; m < 4; ++m) { const int e = m * 16 + fr; int i = 0, base = 0;
        for (; i < 16; ++i) { const int cnt = 16 / (i + 1); if (e < base + cnt) break; base += cnt; }
        cv[m] = i < 16; ci[m] = cv[m] ? i : 0; cj[m] = cv[m] ? e - base : 0;
        if (w == 0 && fq == 0) IJ[e] = cv[m] ? ci[m] * 16 + cj[m] : 0; }
    const int pp_ = w >> 2, ntb = (w & 3) * 2;
    bf16x8 bfr[2][4];
#pragma unroll
    for (int n = 0; n < 2; ++n)
#pragma unroll
        for (int ks = 0; ks < 4; ++ks) bfr[n][ks] = *(const bf16x8*)(SK + (size_t)(pp_ * 128 + 16 * (ntb + n) + fr) * 128 + 32 * ks + 8 * fq);
    __syncthreads();
    for (int tile = blockIdx.x; tile < NT / 32; tile += gridDim.x) {
        const int tk0 = tile * 32;
        bf16x8 afn[2][4];
#pragma unroll
        for (int mt = 0; mt < 2; ++mt)
#pragma unroll
            for (int ks = 0; ks < 4; ++ks) afn[mt][ks] = *(const bf16x8*)(Q + (size_t)(tk0 + 16 * mt + fr) * DM + pp_ * 128 + 32 * ks + 8 * fq);
        for (int h = 0; h < 8; ++h) {
            {
                bf16x8 af[2][4];
#pragma unroll
                for (int mt = 0; mt < 2; ++mt)
#pragma unroll
                    for (int ks = 0; ks < 4; ++ks) af[mt][ks] = afn[mt][ks];
                if (h + 1 < 8) {
#pragma unroll
                    for (int mt = 0; mt < 2; ++mt)
#pragma unroll
                        for (int ks = 0; ks < 4; ++ks) afn[mt][ks] = *(const bf16x8*)(Q + (size_t)(tk0 + 16 * mt + fr) * DM + (h + 1) * 256 + pp_ * 128 + 32 * ks + 8 * fq);
                }
                f32x4 acc[2][2];
#pragma unroll
                for (int a_ = 0; a_ < 2; ++a_)
#pragma unroll
                    for (int b_ = 0; b_ < 2; ++b_) acc[a_][b_] = (f32x4){0.f, 0.f, 0.f, 0.f};
#pragma unroll
                for (int ks = 0; ks < 4; ++ks)
#pragma unroll
                    for (int mt = 0; mt < 2; ++mt)
#pragma unroll
                        for (int n = 0; n < 2; ++n) acc[mt][n] = __builtin_amdgcn_mfma_f32_16x16x32_bf16(af[mt][ks], bfr[n][ks], acc[mt][n], 0, 0, 0);
#pragma unroll
                for (int mt = 0; mt < 2; ++mt)
#pragma unroll
                    for (int n = 0; n < 2; ++n)
#pragma unroll
                        for (int j = 0; j < 4; ++j) { const int tokl = 16 * mt + 4 * fq + j, key = 16 * (ntb + n) + fr;
                            KEYS[(tokl * 2 + pp_) * 128 + key] = (ordf(acc[mt][n][j]) & ~0x7Fu) | (unsigned)key; }
            }
            __syncthreads();
            {
                const int tokl = 4 * w + fq, rb = lane & 48;
                unsigned top[2];
#pragma unroll
                for (int pp = 0; pp < 2; ++pp) {
                    unsigned kx[8];
#pragma unroll
                    for (int m = 0; m < 8; ++m) kx[m] = KEYS[(tokl * 2 + pp) * 128 + fr + 16 * m];
                    unsigned tp = 0u;
                    for (int it = 0; it < 16; ++it) {
                        unsigned M = max(max(max(kx[0], kx[1]), max(kx[2], kx[3])), max(max(kx[4], kx[5]), max(kx[6], kx[7])));
                        M = max(M, dppu<0xB1>(M)); M = max(M, dppu<0x4E>(M)); M = max(M, dppu<0x141>(M)); M = max(M, dppu<0x140>(M));
                        if (fr == it) tp = M;
#pragma unroll
                        for (int m = 0; m < 8; ++m) kx[m] = (kx[m] == M) ? 0u : kx[m];
                    }
                    top[pp] = tp;
                }
                unsigned cnd[4];
#pragma unroll
                for (int m = 0; m < 4; ++m) {
                    const float v1 = unordf((unsigned)__shfl((int)top[0], rb + ci[m]) & ~0x7Fu), v2 = unordf((unsigned)__shfl((int)top[1], rb + cj[m]) & ~0x7Fu);
                    cnd[m] = cv[m] ? ((ordf(v1 + v2) & ~0x3Fu) | (unsigned)(m * 16 + fr)) : 0u;
                }
                unsigned best = 0u;
                for (int it = 0; it < 16; ++it) {
                    unsigned M = max(max(cnd[0], cnd[1]), max(cnd[2], cnd[3]));
                    M = max(M, dppu<0xB1>(M)); M = max(M, dppu<0x4E>(M)); M = max(M, dppu<0x141>(M)); M = max(M, dppu<0x140>(M));
                    if (fr == it) best = M;
#pragma unroll
                    for (int m = 0; m < 4; ++m) cnd[m] = (cnd[m] == M) ? 0u : cnd[m];
                }
                const int ij = IJ[best & 0x3Fu];
                const float bv = unordf(best & ~0x3Fu);
                const int e1 = __shfl((int)top[0], rb + (ij >> 4)) & 0x7F, e2 = __shfl((int)top[1], rb + (ij & 15)) & 0x7F;
                const float mx = __shfl(bv, rb);
                const float ev = __expf(bv - mx);
                const float sum = red16(ev);
                TI[tokl * 128 + h * 16 + fr] = e1 * 128 + e2; TG[tokl * 128 + h * 16 + fr] = ev / sum;
            }
            __syncthreads();
        }
        for (int q = 0; q < 4; ++q) {
            const int tokl = 4 * w + q; const size_t tok = (size_t)tk0 + tokl;
            float xv[32], acc[32];
#pragma unroll
            for (int i = 0; i < 2; ++i)
#pragma unroll
                for (int hh = 0; hh < 2; ++hh) { const u32x4 x4 = *(const u32x4*)(XN2 + tok * DM + i * 1024 + lane * 16 + hh * 8);
#pragma unroll
                    for (int e = 0; e < 4; ++e) { xv[i * 16 + hh * 8 + 2 * e] = bflo(x4[e]); xv[i * 16 + hh * 8 + 2 * e + 1] = bfhi(x4[e]); } }
#pragma unroll
            for (int i = 0; i < 32; ++i) acc[i] = 0.f;
#pragma unroll 4
            for (int e = 0; e < 128; ++e) {
                const int idx = __builtin_amdgcn_readfirstlane(TI[tokl * 128 + e]);
                const float gate = __builtin_bit_cast(float, __builtin_amdgcn_readfirstlane(__builtin_bit_cast(int, TG[tokl * 128 + e])));
                const unsigned char* up = PU + (size_t)idx * 8192 + lane * 16; const unsigned char* vp = PV + (size_t)idx * 8192 + lane * 16;
                u32x4 u4[2], v4[2];
                u4[0] = *(const u32x4*)up; u4[1] = *(const u32x4*)(up + 1024); v4[0] = *(const u32x4*)vp; v4[1] = *(const u32x4*)(vp + 1024);
                const float su = SCU[idx], sv = SCV[idx];
                float d0 = 0.f, d1 = 0.f, d2 = 0.f, d3 = 0.f;
#pragma unroll
                for (int i = 0; i < 2; ++i)
#pragma unroll
                    for (int k = 0; k < 4; ++k) { const f32x2_t lo = __builtin_amdgcn_cvt_pk_f32_fp8((int)u4[i][k], false), hi = __builtin_amdgcn_cvt_pk_f32_fp8((int)u4[i][k], true);
                        d0 += xv[i * 16 + 4 * k] * lo.x; d1 += xv[i * 16 + 4 * k + 1] * lo.y; d2 += xv[i * 16 + 4 * k + 2] * hi.x; d3 += xv[i * 16 + 4 * k + 3] * hi.y; }
                const float act = wave_sum((d0 + d1) + (d2 + d3)) * su;
                const float coef = gate * 0.5f * act * (1.f + erff(act * 0.70710678118f)) * sv;
#pragma unroll
                for (int i = 0; i < 2; ++i)
#pragma unroll
                    for (int k = 0; k < 4; ++k) { const f32x2_t lo = __builtin_amdgcn_cvt_pk_f32_fp8((int)v4[i][k], false), hi = __builtin_amdgcn_cvt_pk_f32_fp8((int)v4[i][k], true);
                        acc[i * 16 + 4 * k] += coef * lo.x; acc[i * 16 + 4 * k + 1] += coef * lo.y; acc[i * 16 + 4 * k + 2] += coef * hi.x; acc[i * 16 + 4 * k + 3] += coef * hi.y; }
            }
            float ss = 0.f;
            float* orow = out + tok * DM + lane * 16;
#pragma unroll
            for (int i = 0; i < 2; ++i)
#pragma unroll
                for (int k = 0; k < 4; ++k) { const f32x4 h0 = *(const f32x4*)(orow + i * 1024 + 4 * k);
#pragma unroll
                    for (int j = 0; j < 4; ++j) { acc[i * 16 + 4 * k + j] += h0[j]; ss += acc[i * 16 + 4 * k + j] * acc[i * 16 + 4 * k + j]; } }
            ss = wave_sum(ss);
            const float r = rsqrtf(ss * (1.f / DM) + 1e-6f);
#pragma unroll
            for (int i = 0; i < 2; ++i)
#pragma unroll
                for (int k = 0; k < 4; ++k) { const f32x4 g0 = *(const f32x4*)(p.g_final + i * 1024 + lane * 16 + 4 * k); f32x4 o0;
#pragma unroll
                    for (int j = 0; j < 4; ++j) o0[j] = acc[i * 16 + 4 * k + j] * r * g0[j];
                    *(f32x4*)(orow + i * 1024 + 4 * k) = o0; }
        }
        __syncthreads();
    }
}

__global__ void __launch_bounds__(512) fwd_megakernel(KP p) {
    extern __shared__ __attribute__((aligned(16))) unsigned char smem[];
    LAS unsigned char* lds = (LAS unsigned char*)smem;
    cg::grid_group grid = cg::this_grid();
#define GRID_SYNC() do { __builtin_amdgcn_fence(__ATOMIC_RELEASE, "agent"); __syncthreads(); grid.sync(); __builtin_amdgcn_fence(__ATOMIC_ACQUIRE, "agent"); } while (0)
    const int G = gridDim.x, bid = blockIdx.x;
    unsigned char* ws = p.ws; unsigned char* dob = (unsigned char*)p.out;

#define RUN_GEMM(MODE, ...) do { unsigned char* ws = lp(p.ws); unsigned char* dob = lp((unsigned char*)p.out); const pg8::Gemm g_ = pg8::Gemm{__VA_ARGS__}; pg8::StaticOrder S_; S_.init(g_.M, g_.N, G, bid); \
        const pg8::Epi<MODE> E_{ws, dob, p.x, p.w0, p.a0}; pg8::gemm_phase(lds, g_, S_, E_); } while (0)
    phase_prep(p, lds);
    GRID_SYNC();
    RUN_GEMM(0, (const bf16_t*)(ws + OFF_XN), (const bf16_t*)(ws + OFF_WINT), NT, N1, 2048, 2048, 2048);
    GRID_SYNC();
    phase_lora_prep(p);
    GRID_SYNC();
    RUN_GEMM(1, (const bf16_t*)(dob + DO_ALORA), (const bf16_t*)(ws + OFF_WAT), NT, 2048, 256, 512, 256);
    RUN_GEMM(2, (const bf16_t*)(dob + DO_ALORA) + 256, (const bf16_t*)(ws + OFF_G2T), NT, 1024, 256, 512, 256);
    GRID_SYNC();
    if (bid < 128) rwkv_scan(p, bid, lds);
    else {
        mlstm_run(p, bid - 128, lds);
        convert_tables(p, (bid - 128) * 8 + (tid_l() >> 6), 1024);
        __builtin_amdgcn_fence(__ATOMIC_RELEASE, "agent"); __syncthreads();
        if (threadIdx.x == 0) { unsigned* cnt = (unsigned*)(p.ws + OFF_SUBBAR); __hip_atomic_fetch_add(cnt, 1u, __ATOMIC_RELAXED, __HIP_MEMORY_SCOPE_AGENT);
            while (__hip_atomic_load(cnt, __ATOMIC_RELAXED, __HIP_MEMORY_SCOPE_AGENT) < 128u) __builtin_amdgcn_s_sleep(2); }
        __syncthreads(); __builtin_amdgcn_fence(__ATOMIC_ACQUIRE, "agent");
        { unsigned char* ws = lp(p.ws); unsigned char* dob = lp((unsigned char*)p.out); const pg8::Gemm g_ = pg8::Gemm{(const bf16_t*)(ws + OFF_PM) + 3072, (const bf16_t*)(ws + OFF_PMT), NT, 2048, 1024, LDPM, 1024};
          pg8::StaticOrder S_; S_.init(g_.M, g_.N, 128, bid - 128); const pg8::Epi<3> E_{ws, dob, p.x, p.w0, p.a0}; pg8::gemm_phase(lds, g_, S_, E_); }
    }
    GRID_SYNC();
    phase_rwkv_post(p);
    GRID_SYNC();
    RUN_GEMM(4, (const bf16_t*)(ws + OFF_YR), (const bf16_t*)(ws + OFF_PRT), NT, 2048, 1024, 1024, 1024);
    GRID_SYNC();
    RUN_GEMM(5, (const bf16_t*)(ws + OFF_PG), (const bf16_t*)(ws + OFF_WOT), NT, 2048, 2048, LDPG, 2048);
    GRID_SYNC();
    phase_norm2(p);
    GRID_SYNC();
    RUN_GEMM(6, (const bf16_t*)(ws + OFF_XN2), (const bf16_t*)(ws + OFF_WQT), NT, 2048, 2048, 2048, 2048);
    GRID_SYNC();
    phase_peer(p, lds);
}

extern "C" void kernel_launch(void* const* d_in, const int* in_sizes, int n_in, void* d_out, int out_size, void* d_ws, size_t ws_size, hipStream_t stream) {
    static int grid_blocks = 0;
    if (grid_blocks == 0) {
        if (n_in != 26 || out_size != NT * DM || ws_size < WS_NEED) { fprintf(stderr, "kernel_launch: unexpected shapes: n_in %d out %d ws %zu (need %zu)\n", n_in, out_size, ws_size, (size_t)WS_NEED); grid_blocks = -1; return; }
        int dev = 0, cus = 0, per_cu = 0;
        hipGetDevice(&dev);
        hipDeviceGetAttribute(&cus, hipDeviceAttributeMultiprocessorCount, dev);
        if (hipFuncSetAttribute((const void*)fwd_megakernel, hipFuncAttributeMaxDynamicSharedMemorySize, LDS_BYTES) != hipSuccess) { fprintf(stderr, "kernel_launch: hipFuncSetAttribute failed\n"); grid_blocks = -1; return; }
        hipOccupancyMaxActiveBlocksPerMultiprocessor(&per_cu, (const void*)fwd_megakernel, 512, LDS_BYTES);
        if (per_cu < 1) { fprintf(stderr, "kernel_launch: occupancy query says %d blocks per CU\n", per_cu); per_cu = 1; }
        (void)hipGetLastError();
        grid_blocks = cus * 1;
    }
    if (grid_blocks < 0) return;
    KP p{};
    const float** pp = (const float**)&p;
    for (int i = 0; i < 26; ++i) pp[i] = (const float*)d_in[i];
    p.out = (float*)d_out; p.ws = (unsigned char*)d_ws;
    void* args[] = {&p};
    hipError_t e = hipLaunchCooperativeKernel((void*)fwd_megakernel, dim3(grid_blocks), dim3(512), args, LDS_BYTES, stream);
    if (e != hipSuccess) fprintf(stderr, "cooperative launch failed: %s (grid %d)\n", hipGetErrorString(e), grid_blocks);
}
```

```cpp
#include <hip/hip_runtime.h>
#include <hip/hip_cooperative_groups.h>
#include <cstdio>
namespace cg = cooperative_groups;

#define LAS __attribute__((address_space(3)))
typedef unsigned short bf16_t;
typedef short bf16x8 __attribute__((ext_vector_type(8)));
typedef float f32x4 __attribute__((ext_vector_type(4)));
typedef unsigned u32x4 __attribute__((ext_vector_type(4)));
typedef unsigned u32x2 __attribute__((ext_vector_type(2)));

constexpr int NT = 16384, SEQ = 4096, DM = 2048;
constexpr int LDPM = 4096, LDPR = 3584, LDPG = 4096, N1 = 11776;
constexpr size_t MiB = 1024ull * 1024ull;
constexpr size_t OFF_PM = 0, OFF_PR = 128 * MiB, OFF_PG = 240 * MiB, OFF_XN = 368 * MiB, OFF_WINT = 432 * MiB, OFF_WTS = 478 * MiB;
constexpr size_t OFF_PMT = OFF_WTS, OFF_PRT = OFF_WTS + 4 * MiB, OFF_WOT = OFF_WTS + 8 * MiB, OFF_WQT = OFF_WTS + 16 * MiB, OFF_WAT = OFF_WTS + 24 * MiB,
                 OFF_G2T = OFF_WTS + 25 * MiB, OFF_SUBK = OFF_WTS + 25 * MiB + 512 * 1024, WS_NEED = OFF_WTS + 26 * MiB;
constexpr size_t OFF_QC = OFF_XN, OFF_KC = OFF_XN + 32 * MiB, OFF_YR = OFF_WINT, OFF_Q = OFF_XN, OFF_XN2 = OFF_PR, OFF_PU = OFF_PM, OFF_PV = OFF_PM + 2048, OFF_SUBBAR = OFF_SUBK + 192 * 1024,
                 OFF_SCU = OFF_SUBK + 64 * 1024, OFF_SCV = OFF_SCU + 64 * 1024;
constexpr size_t DO_WLOG = 0, DO_AG = 32 * MiB, DO_GG = 64 * MiB, DO_ALORA = 96 * MiB, DO_GB = 112 * MiB, DO_GA = DO_GB + 256 * 1024, DO_GW = DO_GA + 256 * 1024;
constexpr int LDS_BYTES = 150528;

struct KP {
    const float *x, *g_mix, *w_in, *conv_w, *b_i, *b_f, *mu, *w0, *w2, *a0, *a2, *g2, *k_k, *k_a, *r_k, *ln_w, *ln_b, *proj_m, *proj_r, *w_out, *g_ffn,
        *w_query, *sub_keys, *peer_u, *peer_v, *g_final;
    float* out; unsigned char* ws;
};

typedef __bf16 bf16x2_t __attribute__((ext_vector_type(2)));
typedef float f32x2_t __attribute__((ext_vector_type(2)));
__device__ __forceinline__ unsigned cvt_pk_bf16(float lo, float hi) { f32x2_t v = {lo, hi}; bf16x2_t b = __builtin_convertvector(v, bf16x2_t); return __builtin_bit_cast(unsigned, b); }
__device__ __forceinline__ bf16_t f2bf(float f) { return (bf16_t)(cvt_pk_bf16(f, 0.f) & 0xffffu); }
__device__ __forceinline__ float bf2f(bf16_t h) { return __uint_as_float((unsigned)h << 16); }
__device__ __forceinline__ float bflo(unsigned u) { return __uint_as_float(u << 16); }
__device__ __forceinline__ float bfhi(unsigned u) { return __uint_as_float(u & 0xffff0000u); }
__device__ __forceinline__ float sigm(float x) { return __builtin_amdgcn_rcpf(1.f + __expf(-x)); }
template <int CTRL> __device__ __forceinline__ float dppf(float v) { return __builtin_bit_cast(float, __builtin_amdgcn_update_dpp(0, __builtin_bit_cast(int, v), CTRL, 0xF, 0xF, true)); }
template <int CTRL> __device__ __forceinline__ unsigned dppu(unsigned v) { return (unsigned)__builtin_amdgcn_update_dpp(0, (int)v, CTRL, 0xF, 0xF, true); }
__device__ __forceinline__ float red4(float v) { v += dppf<0xB1>(v); v += dppf<0x4E>(v); return v; }
__device__ __forceinline__ float red8(float v) { v = red4(v); v += dppf<0x141>(v); return v; }
__device__ __forceinline__ float red16(float v) { v = red8(v); v += dppf<0x140>(v); return v; }
__device__ __forceinline__ float rlane(float v, int l) { return __builtin_bit_cast(float, __builtin_amdgcn_readlane(__builtin_bit_cast(int, v), l)); }
__device__ __forceinline__ float wave_sum(float v) { v = red16(v); return rlane(v, 0) + rlane(v, 16) + rlane(v, 32) + rlane(v, 48); }
__device__ __forceinline__ unsigned wave_max_u32(unsigned v) {
    v = max(v, dppu<0xB1>(v)); v = max(v, dppu<0x4E>(v)); v = max(v, dppu<0x141>(v)); v = max(v, dppu<0x140>(v));
    unsigned a = (unsigned)__builtin_amdgcn_readlane((int)v, 0), b = (unsigned)__builtin_amdgcn_readlane((int)v, 16), c = (unsigned)__builtin_amdgcn_readlane((int)v, 32), d = (unsigned)__builtin_amdgcn_readlane((int)v, 48);
    return max(max(a, b), max(c, d));
}
__device__ __forceinline__ unsigned ordf(float f) { unsigned u = __float_as_uint(f); return (u & 0x80000000u) ? ~u : (u | 0x80000000u); }
__device__ __forceinline__ float unordf(unsigned k) { return __uint_as_float((k & 0x80000000u) ? (k ^ 0x80000000u) : ~k); }

__device__ __forceinline__ int tid_l() { int t = threadIdx.x; asm volatile("" : "+v"(t)); return t; }
template <class T> __device__ __forceinline__ T* lp(T* q) { asm volatile("" : "+s"(q)); return q; }
namespace pg8 {
constexpr int BM = 256, BK = 64, HALF = 128, HTB = HALF * BK * 2, STAGE_BYTES = 8 * HTB, NXCD = 8, WGM = 8;
__device__ __forceinline__ int lds_byte(int r, int c) { const int st = (r >> 4) * 2 + (c >> 5), rr = r & 15, cc = c & 31, ob = rr * 64 + cc * 2; return st * 1024 + (ob ^ (((ob >> 9) & 1) << 5)); }
__device__ __forceinline__ void stage_rc(int b, int& R, int& C) { const int st = b / 1024, sb = b % 1024, swz = sb ^ (((sb >> 9) & 1) << 5); R = (st >> 1) * 16 + swz / 64; C = (st & 1) * 32 + (swz % 64) / 2; }
__device__ __forceinline__ int perm32(int rho) { const int n = rho >> 4, i = rho & 15; return 8 * (i >> 2) + 4 * n + (i & 3); }
struct Unit { int pm, pn; };
struct Gemm { const bf16_t* A; const bf16_t* Bt; int M, N, K, lda, ldb; };
struct StaticOrder {
    int nM, nN, nwg, G, c;
    __device__ void init(int M, int N, int G_, int c_) { nM = M / BM; nN = N / BM; nwg = nM * nN; G = G_; c = c_; }
    __device__ bool next(int i, Unit& u) const {
        const long L = (long)i * G + c; if (L >= nwg) return false;
        int wgid = (int)L; { const int q = nwg / NXCD, r = nwg % NXCD, xcd = wgid % NXCD, off = wgid / NXCD; wgid = (xcd < r ? xcd * (q + 1) : r * (q + 1) + (xcd - r) * q) + off; }
        const int nig = WGM * nN, gid = wgid / nig, fm = gid * WGM, gsz = (nM - fm) < WGM ? (nM - fm) : WGM;
        u.pm = fm + ((wgid % nig) % gsz); u.pn = (wgid % nig) / gsz; return true;
    }
};

__device__ __forceinline__ void store8(bf16_t* p, f32x4 v0, f32x4 v1) {
    u32x4 w; w.x = cvt_pk_bf16(v0[0], v0[1]); w.y = cvt_pk_bf16(v0[2], v0[3]); w.z = cvt_pk_bf16(v1[0], v1[1]); w.w = cvt_pk_bf16(v1[2], v1[3]); *(u32x4*)p = w;
}
__device__ __forceinline__ void load8(const bf16_t* p, f32x4& v0, f32x4& v1) {
    const u32x4 w = *(const u32x4*)p; v0 = (f32x4){bflo(w.x), bfhi(w.x), bflo(w.y), bfhi(w.y)}; v1 = (f32x4){bflo(w.z), bfhi(w.z), bflo(w.w), bfhi(w.w)};
}

template <int mode> struct Epi {
    static constexpr bool PERM = true;
    unsigned char* ws; unsigned char* dob; const float* x; const float* w0; const float* a0;
    __device__ __forceinline__ void operator()(const f32x4 (&acc)[2][2][4][2], const Unit& u, int wr, int wc, int fr, int fq) const {
        const int row0 = u.pm * BM + wr * 64 + fr, cb = u.pn * BM + wc * 32 + 8 * fq;
#pragma unroll
        for (int ai = 0; ai < 2; ++ai)
#pragma unroll
            for (int m = 0; m < 4; ++m) {
                const size_t row = (size_t)(row0 + ai * HALF + m * 16);
#pragma unroll
                for (int bj = 0; bj < 2; ++bj) {
                    const int col = cb + bj * HALF;
                    f32x4 v0 = acc[ai][bj][m][0], v1 = acc[ai][bj][m][1];
                    if (mode == 0) {
                        if (col < 4096) store8((bf16_t*)(ws + OFF_PM) + row * LDPM + col, v0, v1);
                        else if (col < 7680) store8((bf16_t*)(ws + OFF_PR) + row * LDPR + (col - 4096), v0, v1);
                        else {
#pragma unroll
                            for (int j = 0; j < 4; ++j) { v0[j] = sigm(v0[j]); v1[j] = sigm(v1[j]); }
                            store8((bf16_t*)(ws + OFF_PG) + row * LDPG + (col - 7680), v0, v1);
                        }
                    } else if (mode == 1) {
                        if (col < 1024) {
                            const f32x4 b0 = *(const f32x4*)(w0 + col), b1 = *(const f32x4*)(w0 + col + 4);
#pragma unroll
                            for (int j = 0; j < 4; ++j) {
                                float z = -(b0[j] + v0[j]); float sp = fmaxf(z, 0.f) + __logf(1.f + __expf(-fabsf(z))); v0[j] = -__expf(-sp - 0.5f);
                                z = -(b1[j] + v1[j]); sp = fmaxf(z, 0.f) + __logf(1.f + __expf(-fabsf(z))); v1[j] = -__expf(-sp - 0.5f);
                            }
                            store8((bf16_t*)(dob + DO_WLOG) + row * 1024 + col, v0, v1);
                        } else {
                            const int c2 = col - 1024;
                            const f32x4 b0 = *(const f32x4*)(a0 + c2), b1 = *(const f32x4*)(a0 + c2 + 4);
#pragma unroll
                            for (int j = 0; j < 4; ++j) { v0[j] = sigm(b0[j] + v0[j]); v1[j] = sigm(b1[j] + v1[j]); }
                            store8((bf16_t*)(dob + DO_AG) + row * 1024 + c2, v0, v1);
                        }
                    } else if (mode == 2) {
                        store8((bf16_t*)(dob + DO_GG) + row * 1024 + col, v0, v1);
                    } else if (mode == 3) {
                        bf16_t* pp = (bf16_t*)(ws + OFF_PG) + row * LDPG + col; f32x4 g0, g1; load8(pp, g0, g1);
                        store8(pp, g0 * v0, g1 * v1);
                    } else if (mode == 4) {
                        bf16_t* pp = (bf16_t*)(ws + OFF_PG) + row * LDPG + col; f32x4 m0, m1, g0, g1; load8(pp, m0, m1); load8(pp + 2048, g0, g1);
                        store8(pp, m0 + g0 * v0, m1 + g1 * v1);
                    } else if (mode == 5) {
                        const float* xp = x + row * DM + col; float* op = (float*)dob + row * DM + col;
                        const f32x4 x0 = *(const f32x4*)xp, x1 = *(const f32x4*)(xp + 4);
                        *(f32x4*)op = x0 + v0; *(f32x4*)(op + 4) = x1 + v1;
                    } else {
                        store8((bf16_t*)(ws + OFF_Q) + row * DM + col, v0, v1);
                    }
                    asm volatile("" ::: "memory");
                }
            }
    }
};

template <class EpiT> __device__ __forceinline__ void gemm_phase(LAS unsigned char* lds, const Gemm g, const StaticOrder& S, const EpiT& E) {
    const int tid = tid_l(), wid = __builtin_amdgcn_readfirstlane(tid >> 6), lane = tid & 63, wr = wid >> 2, wc = wid & 3, fr = lane & 15, fq = lane >> 4;
    const int K = g.K, nt = K / BK;
    unsigned voffA[2], voffB[2];
#pragma unroll
    for (int i = 0; i < 2; ++i) { int R, C; stage_rc(tid * 16 + i * 8192, R, C); const int Rb = (R & ~31) + perm32(R & 31);
        voffA[i] = (unsigned)(R * g.lda + C) * 2u; voffB[i] = (unsigned)(Rb * g.ldb + C) * 2u; }
    const size_t kstep = (size_t)(BK * 2);
    const size_t hstepA = (size_t)HALF * g.lda * 2, hstepB = (size_t)HALF * g.ldb * 2;
    const size_t tstepA = 2 * hstepA, tstepB = 2 * hstepB;
    const unsigned ldsw = (unsigned)wid * 1024u;
    const int aoff = lds_byte(wr * 64 + fr, fq * 8), boff = lds_byte(wc * 32 + fr, fq * 8);
#define PG8_SA(b, h) (((b) * 2 + (h)) * HTB)
#define PG8_SB(b, h) ((4 + (b) * 2 + (h)) * HTB)
#define PG8_STAGE(bufoff, gbase, voff) do { _Pragma("unroll") for (int _i = 0; _i < 2; ++_i) \
        __builtin_amdgcn_global_load_lds((const unsigned*)((const char*)(gbase) + (voff)[_i]), (LAS unsigned*)(lds + (bufoff) + ldsw + _i * 8192), 16, 0, 0); } while (0)
#define PG8_LDA(dst, b, h) do { _Pragma("unroll") for (int m = 0; m < 4; ++m) _Pragma("unroll") for (int k = 0; k < 2; ++k) dst[m][k] = *(const LAS bf16x8*)(lds + PG8_SA(b, h) + aoff + m * 2048 + k * 1024); } while (0)
#define PG8_LDB(dst, b, h) do { _Pragma("unroll") for (int n = 0; n < 2; ++n) _Pragma("unroll") for (int k = 0; k < 2; ++k) dst[n][k] = *(const LAS bf16x8*)(lds + PG8_SB(b, h) + boff + n * 2048 + k * 1024); } while (0)
#define PG8_MMA(ai, bj, At, Bt) do { __builtin_amdgcn_s_setprio(1); _Pragma("unroll") for (int m = 0; m < 4; ++m) _Pragma("unroll") for (int n = 0; n < 2; ++n) _Pragma("unroll") for (int k = 0; k < 2; ++k) \
        acc[ai][bj][m][n] = __builtin_amdgcn_mfma_f32_16x16x32_bf16(Bt[n][k], At[m][k], acc[ai][bj][m][n], 0, 0, 0); __builtin_amdgcn_s_setprio(0); } while (0)
#define PG8_WAIT_V(n) asm volatile("s_waitcnt vmcnt(" #n ")" ::: "memory")
#define PG8_WAIT_L(n) asm volatile("s_waitcnt lgkmcnt(" #n ")" ::: "memory")
#define PG8_BAR __builtin_amdgcn_s_barrier()
#define PG8_SCHED __builtin_amdgcn_sched_barrier(0)
    Unit cur, nxt; int ui = 0;
    if (!S.next(0, cur)) return;
    f32x4 acc[2][2][4][2];
#pragma unroll
    for (int a = 0; a < 2; ++a)
#pragma unroll
        for (int b = 0; b < 2; ++b)
#pragma unroll
            for (int m = 0; m < 4; ++m)
#pragma unroll
                for (int n = 0; n < 2; ++n) acc[a][b][m][n] = (f32x4){0.f, 0.f, 0.f, 0.f};
    bf16x8 At[4][2], B0[2][2], B1[2][2];
    const char* cA = (const char*)g.A + (size_t)cur.pm * tstepA; const char* cB = (const char*)g.Bt + (size_t)cur.pn * tstepB;
    PG8_STAGE(PG8_SB(0, 0), cB, voffB); PG8_STAGE(PG8_SA(0, 0), cA, voffA); PG8_STAGE(PG8_SB(0, 1), cB + hstepB, voffB); PG8_STAGE(PG8_SA(0, 1), cA + hstepA, voffA);
    if (wr == 1) PG8_BAR;
    PG8_WAIT_V(4); PG8_BAR;
    PG8_STAGE(PG8_SB(1, 0), cB + kstep, voffB); PG8_STAGE(PG8_SA(1, 0), cA + kstep, voffA); PG8_STAGE(PG8_SB(1, 1), cB + hstepB + kstep, voffB);
    PG8_WAIT_V(6); PG8_BAR;
    for (;;) {
        const bool has_next = S.next(ui + 1, nxt);
        const char* nA = has_next ? (const char*)g.A + (size_t)nxt.pm * tstepA : cA; const char* nB = has_next ? (const char*)g.Bt + (size_t)nxt.pn * tstepB : cB;
        for (int t = 0; t < nt; t += 2) {
            const bool last = (t == nt - 2);
            const char* a1 = cA + (size_t)(t + 1) * kstep;
            const char* a2 = last ? nA : cA + (size_t)(t + 2) * kstep; const char* b2 = last ? nB : cB + (size_t)(t + 2) * kstep;
            const char* a3 = a2 + kstep; const char* b3 = b2 + kstep;
            PG8_LDB(B0, 0, 0); PG8_SCHED; PG8_LDA(At, 0, 0); PG8_STAGE(PG8_SA(1, 1), a1 + hstepA, voffA);
            PG8_WAIT_L(8); PG8_BAR; PG8_WAIT_L(0); PG8_MMA(0, 0, At, B0); PG8_BAR; PG8_SCHED;
            PG8_LDB(B1, 0, 1); PG8_STAGE(PG8_SB(0, 0), b2, voffB);
            PG8_BAR; PG8_WAIT_L(0); PG8_MMA(0, 1, At, B1); PG8_BAR;
            PG8_LDA(At, 0, 1); PG8_STAGE(PG8_SA(0, 0), a2, voffA);
            PG8_BAR; PG8_WAIT_L(0); PG8_MMA(1, 0, At, B0); PG8_BAR; PG8_SCHED;
            PG8_STAGE(PG8_SB(0, 1), b2 + hstepB, voffB);
            PG8_WAIT_V(6); PG8_BAR; PG8_MMA(1, 1, At, B1); PG8_BAR;
            PG8_LDB(B0, 1, 0); PG8_SCHED; PG8_LDA(At, 1, 0); PG8_STAGE(PG8_SA(0, 1), a2 + hstepA, voffA);
            PG8_WAIT_L(8); PG8_BAR; PG8_WAIT_L(0); PG8_MMA(0, 0, At, B0); PG8_BAR; PG8_SCHED;
            PG8_LDB(B1, 1, 1); PG8_STAGE(PG8_SB(1, 0), b3, voffB);
            PG8_BAR; PG8_WAIT_L(0); PG8_MMA(0, 1, At, B1); PG8_BAR;
            PG8_LDA(At, 1, 1); PG8_STAGE(PG8_SA(1, 0), a3, voffA);
            PG8_BAR; PG8_WAIT_L(0); PG8_MMA(1, 0, At, B0); PG8_BAR; PG8_SCHED;
            PG8_STAGE(PG8_SB(1, 1), b3 + hstepB, voffB);
            PG8_WAIT_V(6); PG8_BAR; PG8_MMA(1, 1, At, B1); PG8_BAR;
        }
        E(acc, cur, wr, wc, fr, fq);
        if (!has_next) break;
#pragma unroll
        for (int a = 0; a < 2; ++a)
#pragma unroll
            for (int b = 0; b < 2; ++b)
#pragma unroll
                for (int m = 0; m < 4; ++m)
#pragma unroll
                    for (int n = 0; n < 2; ++n) acc[a][b][m][n] = (f32x4){0.f, 0.f, 0.f, 0.f};
        cur = nxt; cA = nA; cB = nB; ++ui;
    }
    PG8_WAIT_V(0);
    if (wr == 0) PG8_BAR;
    PG8_BAR;
#undef PG8_SA
#undef PG8_SB
#undef PG8_STAGE
#undef PG8_LDA
#undef PG8_LDB
#undef PG8_MMA
#undef PG8_WAIT_V
#undef PG8_WAIT_L
#undef PG8_BAR
#undef PG8_SCHED
}
}

__device__ __forceinline__ void rmsnorm_rows(const float* src, const float* gain, bf16_t* dst, int gw, int nw, int lane) {
    for (int row = gw; row < NT; row += nw) {
        const f32x4* s = (const f32x4*)(src + (size_t)row * DM);
        f32x4 v[8]; float ss = 0.f;
#pragma unroll
        for (int i = 0; i < 8; ++i) { v[i] = s[i * 64 + lane]; ss += v[i][0] * v[i][0] + v[i][1] * v[i][1] + v[i][2] * v[i][2] + v[i][3] * v[i][3]; }
        ss = wave_sum(ss);
        const float r = rsqrtf(ss * (1.f / DM) + 1e-6f);
        u32x2* d = (u32x2*)(dst + (size_t)row * DM);
#pragma unroll
        for (int i = 0; i < 8; ++i) { const f32x4 gg = ((const f32x4*)gain)[i * 64 + lane]; u32x2 o; o.x = cvt_pk_bf16(v[i][0] * r * gg[0], v[i][1] * r * gg[1]); o.y = cvt_pk_bf16(v[i][2] * r * gg[2], v[i][3] * r * gg[3]); d[i * 64 + lane] = o; }
    }
}

__device__ __forceinline__ void tr_tile(const float* src, int ld, int c0, int nvalid, int k0, bf16_t* dst, int ldd, int r0, int kd0, LAS float* tile) {
    const int tid = tid_l();
#pragma unroll
    for (int i = 0; i < 2; ++i) {
        const int k = (tid >> 4) + 32 * i, c4 = (tid & 15) * 4;
        f32x4 v = (f32x4){0.f, 0.f, 0.f, 0.f};
        if (c4 < nvalid) v = *(const f32x4*)(src + (size_t)(k0 + k) * ld + c0 + c4);
        tile[k * 65 + c4] = v[0]; tile[k * 65 + c4 + 1] = v[1]; tile[k * 65 + c4 + 2] = v[2]; tile[k * 65 + c4 + 3] = v[3];
    }
    __syncthreads();
    {
        const int c = tid >> 3, k8 = (tid & 7) * 8;
        float f[8];
#pragma unroll
        for (int j = 0; j < 8; ++j) f[j] = tile[(k8 + j) * 65 + c];
        u32x4 w; w.x = cvt_pk_bf16(f[0], f[1]); w.y = cvt_pk_bf16(f[2], f[3]); w.z = cvt_pk_bf16(f[4], f[5]); w.w = cvt_pk_bf16(f[6], f[7]);
        *(u32x4*)(dst + (size_t)(r0 + c) * ldd + kd0 + k8) = w;
    }
    __syncthreads();
}

__device__ void phase_prep(const KP& p, LAS unsigned char* lds) {
    const int tid = tid_l(), lane = tid & 63, G = gridDim.x, bid = blockIdx.x;
    unsigned char* ws = p.ws;
    rmsnorm_rows(p.x, p.g_mix, (bf16_t*)(ws + OFF_XN), bid * 8 + (tid >> 6), G * 8, lane);
    LAS float* tile = (LAS float*)lds;
    for (int j = bid; j < 8960; j += G) {
        if (j < 5888) {
            const int rt = j >> 5, kt = j & 31; int c0, nv = 64;
            if (rt < 64) c0 = 64 * rt; else if (rt < 119) c0 = 4104 + 64 * (rt - 64); else if (rt == 119) { c0 = 4096; nv = 8; } else c0 = 7624 + 64 * (rt - 120);
            tr_tile(p.w_in, 11720, c0, nv, kt * 64, (bf16_t*)(ws + OFF_WINT), 2048, rt * 64, kt * 64, tile);
        } else if (j < 6400) { const int q = j - 5888, rt = q >> 4, kt = q & 15; tr_tile(p.proj_m, 2048, rt * 64, 64, kt * 64, (bf16_t*)(ws + OFF_PMT), 1024, rt * 64, kt * 64, tile); }
        else if (j < 6912) { const int q = j - 6400, rt = q >> 4, kt = q & 15; tr_tile(p.proj_r, 2048, rt * 64, 64, kt * 64, (bf16_t*)(ws + OFF_PRT), 1024, rt * 64, kt * 64, tile); }
        else if (j < 7936) { const int q = j - 6912, rt = q >> 5, kt = q & 31; tr_tile(p.w_out, 2048, rt * 64, 64, kt * 64, (bf16_t*)(ws + OFF_WOT), 2048, rt * 64, kt * 64, tile); }
        else { const int q = j - 7936, rt = q >> 5, kt = q & 31; tr_tile(p.w_query, 2048, rt * 64, 64, kt * 64, (bf16_t*)(ws + OFF_WQT), 2048, rt * 64, kt * 64, tile); }
    }
    const int gt = bid * 512 + tid, gn = G * 512;
    bf16_t* WAT = (bf16_t*)(ws + OFF_WAT);
    for (int i = gt; i < 2048 * 256; i += gn) { const int r = i >> 8, k = i & 255; float v = 0.f;
        if (r < 1024) { if (k < 96) v = p.w2[k * 1024 + r]; } else { if (k >= 96 && k < 192) v = p.a2[(k - 96) * 1024 + (r - 1024)]; }
        WAT[i] = f2bf(v); }
    bf16_t* G2T = (bf16_t*)(ws + OFF_G2T);
    for (int i = gt; i < 1024 * 256; i += gn) { const int r = i >> 8, k = i & 255; G2T[i] = f2bf(p.g2[k * 1024 + r]); }
    bf16_t* SK = (bf16_t*)(ws + OFF_SUBK);
    for (int i = gt; i < 2 * 128 * 128; i += gn) SK[i] = f2bf(p.sub_keys[i]);
    if (gt == 0) *(unsigned*)(ws + OFF_SUBBAR) = 0u;
}

__device__ __forceinline__ float bfel(const u32x4& w, int e) { const unsigned u = w[e >> 1]; return (e & 1) ? bfhi(u) : bflo(u); }
__device__ void phase_lora_prep(const KP& p) {
    const bf16_t* PR = (const bf16_t*)(p.ws + OFF_PR);
    bf16_t* AL = (bf16_t*)((unsigned char*)p.out + DO_ALORA);
    const int gt = blockIdx.x * 512 + threadIdx.x, gn = gridDim.x * 512;
    for (int i = gt; i < NT * 64; i += gn) {
        const int tok = i >> 6, g = i & 63;
        u32x4 o = (u32x4){0u, 0u, 0u, 0u};
        if (g < 24 || g >= 32) {
            const int sc = (g < 24) ? (3072 + 8 * g) : (3264 + 8 * (g - 32));
            const u32x4 cu = *(const u32x4*)(PR + (size_t)tok * LDPR + sc);
            u32x4 pv = (u32x4){0u, 0u, 0u, 0u};
            if ((tok & (SEQ - 1)) != 0) pv = *(const u32x4*)(PR + (size_t)(tok - 1) * LDPR + sc);
            const f32x4 m0 = *(const f32x4*)(p.mu + sc), m1 = *(const f32x4*)(p.mu + sc + 4);
            float f[8];
#pragma unroll
            for (int q = 0; q < 4; ++q) {
                const float c0 = bflo(cu[q]), c1 = bfhi(cu[q]), p0 = bflo(pv[q]), p1 = bfhi(pv[q]);
                const float mm0 = (q < 2) ? m0[2 * q] : m1[2 * q - 4], mm1 = (q < 2) ? m0[2 * q + 1] : m1[2 * q - 3];
                f[2 * q] = c0 + (p0 - c0) * mm0; f[2 * q + 1] = c1 + (p1 - c1) * mm1;
            }
            if (g < 12) {
#pragma unroll
                for (int q = 0; q < 8; ++q) f[q] = tanhf(f[q]);
            } else if (g >= 32) {
#pragma unroll
                for (int q = 0; q < 8; ++q) f[q] = sigm(f[q]);
            }
            o.x = cvt_pk_bf16(f[0], f[1]); o.y = cvt_pk_bf16(f[2], f[3]); o.z = cvt_pk_bf16(f[4], f[5]); o.w = cvt_pk_bf16(f[6], f[7]);
        }
        *(u32x4*)(AL + (size_t)tok * 512 + 8 * g) = o;
    }
    {
        const bf16_t* PM = (const bf16_t*)(p.ws + OFF_PM);
        bf16_t* QC = (bf16_t*)(p.ws + OFF_QC); bf16_t* KC = (bf16_t*)(p.ws + OFF_KC);
        for (int i = gt; i < (NT / 8) * 256; i += gn) {
            const int tb = i >> 8, col = (i & 255) * 8; const int tok0 = tb * 8, t0 = tok0 & (SEQ - 1);
            f32x4 cw[4][2];
#pragma unroll
            for (int j = 0; j < 4; ++j) { cw[j][0] = *(const f32x4*)(p.conv_w + j * 2048 + col); cw[j][1] = *(const f32x4*)(p.conv_w + j * 2048 + col + 4); }
            u32x4 raw[11];
#pragma unroll
            for (int q = 0; q < 11; ++q) { const bool neg = (t0 - 3 + q) < 0; u32x4 v = *(const u32x4*)(PM + (size_t)(tok0 + (neg ? 0 : q - 3)) * LDPM + col); if (neg) v = (u32x4){0u, 0u, 0u, 0u}; raw[q] = v; }
            const float scl = (col < 1024) ? 0.0625f : 1.f;
            bf16_t* dst = (col < 1024) ? (QC + (size_t)tok0 * 1024 + col) : (KC + (size_t)tok0 * 1024 + (col - 1024));
#pragma unroll
            for (int r = 0; r < 8; ++r) {
                float o[8];
#pragma unroll
                for (int e = 0; e < 8; ++e) {
                    const float c0 = (e < 4) ? cw[0][0][e] : cw[0][1][e - 4], c1 = (e < 4) ? cw[1][0][e] : cw[1][1][e - 4], c2 = (e < 4) ? cw[2][0][e] : cw[2][1][e - 4], c3 = (e < 4) ? cw[3][0][e] : cw[3][1][e - 4];
                    float sv = c0 * bfel(raw[r], e) + c1 * bfel(raw[r + 1], e) + c2 * bfel(raw[r + 2], e) + c3 * bfel(raw[r + 3], e);
                    o[e] = sv * sigm(sv) * scl;
                }
                u32x4 pk; pk.x = cvt_pk_bf16(o[0], o[1]); pk.y = cvt_pk_bf16(o[2], o[3]); pk.z = cvt_pk_bf16(o[4], o[5]); pk.w = cvt_pk_bf16(o[6], o[7]);
                *(u32x4*)(dst + (size_t)r * 1024) = pk;
            }
        }
    }
    {
        const int lane = threadIdx.x & 63, gw = blockIdx.x * 8 + (threadIdx.x >> 6), nw = gridDim.x * 8;
        float* GB = (float*)((unsigned char*)p.out + DO_GB); float* GA = (float*)((unsigned char*)p.out + DO_GA); float* GW = (float*)((unsigned char*)p.out + DO_GW);
        for (int task = gw; task < 1024; task += nw) {
            const int bh = task >> 6, c = task & 63, bb = bh >> 2, h = bh & 3; const size_t tok = (size_t)bb * SEQ + c * 64 + lane;
            const float iv = bf2f(PR[tok * LDPR + 3520 + h]) + p.b_i[h], fv = bf2f(PR[tok * LDPR + 3524 + h]) + p.b_f[h];
            float lf = fminf(fv, 0.f) - __logf(1.f + __expf(-fabsf(fv)));
#pragma unroll
            for (int d = 1; d < 64; d <<= 1) { const float y = __shfl_up(lf, d); if (lane >= d) lf += y; }
            const float bl = rlane(lf, 63);
            const int o = bh * SEQ + c * 64 + lane;
            GB[o] = lf; GA[o] = iv - lf; GW[o] = __expf(bl - lf + iv);
        }
    }
}

constexpr size_t OFF_YRAW = OFF_WINT, OFF_BON = OFF_WINT + 32 * MiB;
struct RwOps { f32x4 a0, a1, q0, q1, w0, w1, b0, b1, k0, k1; float v, br, kr; };
__device__ __forceinline__ f32x2_t lo2(f32x4 v) { return __builtin_shufflevector(v, v, 0, 1); }
__device__ __forceinline__ f32x2_t hi2(f32x4 v) { return __builtin_shufflevector(v, v, 2, 3); }
__device__ __forceinline__ f32x2_t fma2(f32x2_t a, f32x2_t b, f32x2_t c) { return __builtin_elementwise_fma(a, b, c); }
__device__ void rwkv_scan(const KP& p, int blk, LAS unsigned char* lds) {
    const int tid0 = tid_l();
    const int bh = blk >> 1, half = blk & 1, b = bh >> 4, h = bh & 15;
    constexpr int BUFB = 53760;
    const bf16_t* PR = (const bf16_t*)(p.ws + OFF_PR);
    const bf16_t* WLOG = (const bf16_t*)((const unsigned char*)p.out + DO_WLOG);
    const bf16_t* AG = (const bf16_t*)((const unsigned char*)p.out + DO_AG);
    bf16_t* YRAW = (bf16_t*)(p.ws + OFF_YRAW); float* BON = (float*)(p.ws + OFF_BON);
    const size_t tokbase = (size_t)b * SEQ;
    if (tid0 < 256) {
        const int rowl = tid0 >> 3, j8 = (tid0 & 7) * 8, row = 32 * half + rowl;
        f32x2_t S2[4];
#pragma unroll
        for (int k = 0; k < 4; ++k) S2[k] = (f32x2_t){0.f, 0.f};
        __syncthreads();
        for (int c = 0; c < 128; ++c) {
            const LAS float* bp = (const LAS float*)(lds + (c & 1) * BUFB);
            LAS float* yb = (LAS float*)(lds + (c & 1) * BUFB + 49408);
#define RW_LD(O, s) do { const LAS float* q_ = bp + (s) * 64 + j8; O.a0 = *(const LAS f32x4*)(q_); O.a1 = *(const LAS f32x4*)(q_ + 4); O.b0 = *(const LAS f32x4*)(q_ + 2048); O.b1 = *(const LAS f32x4*)(q_ + 2052); \
            O.w0 = *(const LAS f32x4*)(q_ + 4096); O.w1 = *(const LAS f32x4*)(q_ + 4100); O.k0 = *(const LAS f32x4*)(q_ + 6144); O.k1 = *(const LAS f32x4*)(q_ + 6148); \
            O.q0 = *(const LAS f32x4*)(q_ + 8192); O.q1 = *(const LAS f32x4*)(q_ + 8196); O.v = bp[10240 + (s) * 64 + row]; O.br = bp[12288 + (s)]; O.kr = bp[12320 + (s)]; } while (0)
#define RW_STEP(O, s) do { \
            f32x2_t pa = S2[0] * lo2(O.a0); f32x2_t py = S2[0] * lo2(O.q0); \
            pa = fma2(S2[1], hi2(O.a0), pa); py = fma2(S2[1], hi2(O.q0), py); pa = fma2(S2[2], lo2(O.a1), pa); py = fma2(S2[2], lo2(O.q1), py); \
            pa = fma2(S2[3], hi2(O.a1), pa); py = fma2(S2[3], hi2(O.q1), py); \
            float sa = pa.x + pa.y, yy = py.x + py.y; \
            sa += dppf<0xB1>(sa); yy += dppf<0xB1>(yy); sa += dppf<0x4E>(sa); yy += dppf<0x4E>(yy); sa += dppf<0x141>(sa); yy += dppf<0x141>(yy); \
            const f32x2_t sa2 = (f32x2_t){sa, sa}, vv2 = (f32x2_t){O.v, O.v}; \
            S2[0] = fma2(S2[0], lo2(O.w0), fma2(vv2, lo2(O.k0), sa2 * lo2(O.b0))); S2[1] = fma2(S2[1], hi2(O.w0), fma2(vv2, hi2(O.k0), sa2 * hi2(O.b0))); \
            S2[2] = fma2(S2[2], lo2(O.w1), fma2(vv2, lo2(O.k1), sa2 * lo2(O.b1))); S2[3] = fma2(S2[3], hi2(O.w1), fma2(vv2, hi2(O.k1), sa2 * hi2(O.b1))); \
            if ((tid0 & 7) == 0) yb[(s) * 32 + rowl] = yy + sa * O.br + O.v * O.kr; } while (0)
            RwOps o0, o1;
            RW_LD(o0, 0);
#pragma unroll 1
            for (int s = 0; s < 32; s += 2) {
                RW_LD(o1, s + 1);
                RW_STEP(o0, s);
                { const int sn = (s + 2 < 32) ? s + 2 : 31; RW_LD(o0, sn); }
                RW_STEP(o1, s + 1);
            }
#undef RW_LD
#undef RW_STEP
            __syncthreads();
        }
    } else {
        const int ht = tid0 - 256, tt = ht >> 3, cg8 = (ht & 7) * 8, ch = h * 64 + cg8;
        float mur[8], muk[8], muv[8], kkc[8], kac[8], rkc[8];
#pragma unroll
        for (int e = 0; e < 8; ++e) { mur[e] = p.mu[ch + e]; muk[e] = p.mu[1024 + ch + e]; muv[e] = p.mu[2048 + ch + e]; kkc[e] = p.k_k[ch + e]; kac[e] = p.k_a[ch + e]; rkc[e] = p.r_k[ch + e]; }
        for (int c = -1; c < 128; ++c) {
            if (c >= 1) {
                const LAS float* yb = (const LAS float*)(lds + ((c - 1) & 1) * BUFB + 49408);
                const int r4 = (ht & 7) * 4; const f32x4 y4 = *(const LAS f32x4*)(yb + tt * 32 + r4);
                u32x2 ov; ov.x = cvt_pk_bf16(y4[0], y4[1]); ov.y = cvt_pk_bf16(y4[2], y4[3]);
                *(u32x2*)(YRAW + (tokbase + (size_t)(c - 1) * 32 + tt) * 1024 + h * 64 + 32 * half + r4) = ov;
            }
            if (c + 1 < 128) {
                const int cn = c + 1, t = cn * 32 + tt; const size_t tok = tokbase + t;
                LAS float* bp = (LAS float*)(lds + (cn & 1) * BUFB);
                const bf16_t* pr_ = PR + tok * LDPR + ch;
                const u32x4 r4 = *(const u32x4*)pr_, k4 = *(const u32x4*)(pr_ + 1024), v4 = *(const u32x4*)(pr_ + 2048);
                u32x4 pr4 = (u32x4){0u, 0u, 0u, 0u}, pk4 = pr4, pv4 = pr4;
                if (t > 0) { pr4 = *(const u32x4*)(pr_ - LDPR); pk4 = *(const u32x4*)(pr_ - LDPR + 1024); pv4 = *(const u32x4*)(pr_ - LDPR + 2048); }
                const u32x4 w4 = *(const u32x4*)(WLOG + tok * 1024 + ch), a4 = *(const u32x4*)(AG + tok * 1024 + ch);
                float r[8], k[8], v[8], kk[8], av[8], dec[8];
                float n2 = 0.f;
#pragma unroll
                for (int e = 0; e < 8; ++e) {
                    const float rc = bfel(r4, e), kc = bfel(k4, e), vc = bfel(v4, e);
                    r[e] = rc + (bfel(pr4, e) - rc) * mur[e]; k[e] = kc + (bfel(pk4, e) - kc) * muk[e]; v[e] = vc + (bfel(pv4, e) - vc) * muv[e];
                    kk[e] = k[e] * kkc[e]; n2 += kk[e] * kk[e]; av[e] = bfel(a4, e); dec[e] = __expf(bfel(w4, e));
                }
                n2 = red8(n2);
                const float inv = 1.f / fmaxf(sqrtf(n2), 1e-12f);
                float br = 0.f, kr = 0.f, bon = 0.f;
                f32x4 oa[2], ob[2], ow[2], ok[2], oq[2], ovv[2];
#pragma unroll
                for (int e = 0; e < 8; ++e) {
                    const float kn = kk[e] * inv, k3 = k[e] * (1.f + (av[e] - 1.f) * kac[e]), bb = kn * av[e];
                    oa[e >> 2][e & 3] = -kn; ob[e >> 2][e & 3] = bb; ow[e >> 2][e & 3] = dec[e]; ok[e >> 2][e & 3] = k3; oq[e >> 2][e & 3] = dec[e] * r[e]; ovv[e >> 2][e & 3] = v[e];
                    br += bb * r[e]; kr += k3 * r[e]; bon += r[e] * k3 * rkc[e];
                }
                br = red8(br); kr = red8(kr); bon = red8(bon);
                LAS float* q_ = bp + tt * 64 + cg8;
#pragma unroll
                for (int i = 0; i < 2; ++i) { *(LAS f32x4*)(q_ + 4 * i) = oa[i]; *(LAS f32x4*)(q_ + 2048 + 4 * i) = ob[i]; *(LAS f32x4*)(q_ + 4096 + 4 * i) = ow[i]; *(LAS f32x4*)(q_ + 6144 + 4 * i) = ok[i];
                    *(LAS f32x4*)(q_ + 8192 + 4 * i) = oq[i]; *(LAS f32x4*)(q_ + 10240 + 4 * i) = ovv[i]; }
                if ((ht & 7) == 0) { bp[12288 + tt] = br; bp[12320 + tt] = kr; if (half == 0) BON[tok * 16 + h] = bon; }
            }
            __syncthreads();
        }
        {
            const LAS float* yb = (const LAS float*)(lds + (127 & 1) * BUFB + 49408);
            const int r4 = (ht & 7) * 4; const f32x4 y4 = *(const LAS f32x4*)(yb + tt * 32 + r4);
            u32x2 ov; ov.x = cvt_pk_bf16(y4[0], y4[1]); ov.y = cvt_pk_bf16(y4[2], y4[3]);
            *(u32x2*)(YRAW + (tokbase + (size_t)127 * 32 + tt) * 1024 + h * 64 + 32 * half + r4) = ov;
        }
    }
}

__device__ void phase_rwkv_post(const KP& p) {
    const bf16_t* PR = (const bf16_t*)(p.ws + OFF_PR);
    const bf16_t* GG = (const bf16_t*)((const unsigned char*)p.out + DO_GG);
    bf16_t* YR = (bf16_t*)(p.ws + OFF_YRAW); const float* BON = (const float*)(p.ws + OFF_BON);
    const int gt = blockIdx.x * 512 + tid_l(), gn = gridDim.x * 512;
    for (int i = gt; i < NT * 256; i += gn) {
        const int tok = i >> 8, h = (i >> 4) & 15, ch = h * 64 + (i & 15) * 4;
        const u32x2 y2 = *(const u32x2*)(YR + (size_t)tok * 1024 + ch), v2 = *(const u32x2*)(PR + (size_t)tok * LDPR + 2048 + ch), g2 = *(const u32x2*)(GG + (size_t)tok * 1024 + ch);
        u32x2 pv2 = (u32x2){0u, 0u};
        if ((tok & (SEQ - 1)) != 0) pv2 = *(const u32x2*)(PR + (size_t)(tok - 1) * LDPR + 2048 + ch);
        const float bon = BON[tok * 16 + h];
        const f32x4 muv = *(const f32x4*)(p.mu + 2048 + ch), lnw = *(const f32x4*)(p.ln_w + ch), lnb = *(const f32x4*)(p.ln_b + ch);
        const f32x4 y = (f32x4){bflo(y2.x), bfhi(y2.x), bflo(y2.y), bfhi(y2.y)}, vc = (f32x4){bflo(v2.x), bfhi(v2.x), bflo(v2.y), bfhi(v2.y)}, vp = (f32x4){bflo(pv2.x), bfhi(pv2.x), bflo(pv2.y), bfhi(pv2.y)};
        const f32x4 g = (f32x4){bflo(g2.x), bfhi(g2.x), bflo(g2.y), bfhi(g2.y)};
        const f32x4 v = vc + (vp - vc) * muv;
        const float mean = red16(y[0] + y[1] + y[2] + y[3]) * (1.f / 64.f);
        const f32x4 d = y - mean;
        const float var = red16(d[0] * d[0] + d[1] * d[1] + d[2] * d[2] + d[3] * d[3]) * (1.f / 64.f);
        const float rs = rsqrtf(var + 64e-5f);
        const f32x4 res = (d * rs * lnw + lnb + bon * v) * g;
        u32x2 ov; ov.x = cvt_pk_bf16(res[0], res[1]); ov.y = cvt_pk_bf16(res[2], res[3]);
        *(u32x2*)(YR + (size_t)tok * 1024 + ch) = ov;
    }
}

typedef short v4i16_t __attribute__((ext_vector_type(4)));
__device__ __forceinline__ bf16x8 tr_frag(const LAS unsigned char* base, int stride_b, int krow0, int ncol0, int lane) {
    const int g = lane >> 4, q = (lane & 15) >> 2, pp = lane & 3;
    const LAS unsigned char* a0 = base + (krow0 + 8 * g + q) * stride_b + (ncol0 + 4 * pp) * 2;
    const v4i16_t x = __builtin_amdgcn_ds_read_tr16_b64_v4i16((LAS v4i16_t*)a0), y = __builtin_amdgcn_ds_read_tr16_b64_v4i16((LAS v4i16_t*)(a0 + 4 * stride_b));
    return (bf16x8){x[0], x[1], x[2], x[3], y[0], y[1], y[2], y[3]};
}
__device__ void mlstm_run(const KP& p, int item, LAS unsigned char* lds) {
    const int tid0 = tid_l();
    const int bh = item >> 3, b = bh >> 2, h = bh & 3, dv0 = (item & 7) * 32;
    const size_t tokbase = (size_t)b * SEQ;
    LAS bf16_t* Qs = (LAS bf16_t*)(lds + 0);
    LAS bf16_t* Ks = (LAS bf16_t*)(lds + 33792);
    LAS bf16_t* Vs = (LAS bf16_t*)(lds + 67584);
    LAS bf16_t* Vws = (LAS bf16_t*)(lds + 74752);
    LAS bf16_t* Ss = (LAS bf16_t*)(lds + 81920);
    LAS bf16_t* CT0 = (LAS bf16_t*)(lds + 91136);
    LAS bf16_t* Os = (LAS bf16_t*)(lds + 141824);
    LAS float* BC = (LAS float*)(lds + 146944);
    LAS float* GAs = (LAS float*)(lds + 147200);
    const bf16_t* QC = (const bf16_t*)(p.ws + OFF_QC); const bf16_t* KC = (const bf16_t*)(p.ws + OFF_KC);
    bf16_t* PM = (bf16_t*)(p.ws + OFF_PM);
    const float* GB = (const float*)((const unsigned char*)p.out + DO_GB); const float* GA = (const float*)((const unsigned char*)p.out + DO_GA); const float* GW = (const float*)((const unsigned char*)p.out + DO_GW);
    for (int i = tid0; i < 2 * 48 * 264 / 2; i += 512) ((LAS unsigned*)CT0)[i] = 0u;
    for (int i = tid0; i < 2 * 64 * 56 / 2; i += 512) ((LAS unsigned*)Vs)[i] = 0u;
    __syncthreads();
    if (tid0 < 64) Vs[tid0 * 56 + 32] = (bf16_t)0x3F80;
    f32x4 cacc[6];
#pragma unroll
    for (int i = 0; i < 6; ++i) cacc[i] = (f32x4){0.f, 0.f, 0.f, 0.f};
    u32x4 q4[4], k4[4], vo4; float gb = 0.f, ga = 0.f, gwv = 0.f;
#define ML_LOAD(c, TID) do { const int row_ = (TID) >> 3, pc_ = (TID) & 7; const size_t tk_ = tokbase + (size_t)(c) * 64; \
        const bf16_t* qp_ = QC + (tk_ + row_) * 1024 + h * 256 + pc_ * 32; const bf16_t* kp_ = KC + (tk_ + row_) * 1024 + h * 256 + pc_ * 32; \
        _Pragma("unroll") for (int i_ = 0; i_ < 4; ++i_) { q4[i_] = *(const u32x4*)(qp_ + 8 * i_); k4[i_] = *(const u32x4*)(kp_ + 8 * i_); } \
        const int sg_ = (TID) & 255, s_ = sg_ >> 2, g_ = sg_ & 3; \
        vo4 = *(const u32x4*)(PM + (tk_ + s_) * LDPM + ((TID) < 256 ? 2048 : 3072) + h * 256 + dv0 + 8 * g_); \
        gwv = GW[bh * SEQ + (c) * 64 + s_]; \
        if ((TID) < 64) { gb = GB[bh * SEQ + (c) * 64 + (TID)]; ga = GA[bh * SEQ + (c) * 64 + (TID)]; } } while (0)
    ML_LOAD(0, tid0);
    __syncthreads();
    int cur = 0;
    for (int c = 0; c < 64; ++c) {
        int tid = tid0; asm volatile("" : "+v"(tid));
        const int lane = tid & 63, w = tid >> 6, fr = lane & 15, fq = lane >> 4;
        LAS bf16_t* CTc = CT0 + cur * (48 * 264); LAS bf16_t* CTn = CT0 + (cur ^ 1) * (48 * 264);
        {
            const int row = tid >> 3, pc = tid & 7;
#pragma unroll
            for (int i = 0; i < 4; ++i) { *(LAS u32x4*)(Qs + row * 264 + pc * 32 + 8 * i) = q4[i]; *(LAS u32x4*)(Ks + row * 264 + pc * 32 + 8 * i) = k4[i]; }
            const int sg = tid & 255, s = sg >> 2, g = sg & 3;
            if (tid < 256) {
                *(LAS u32x4*)(Vs + s * 56 + 8 * g) = vo4;
                u32x4 wv;
#pragma unroll
                for (int e = 0; e < 4; ++e) wv[e] = cvt_pk_bf16(bflo(vo4[e]) * gwv, bfhi(vo4[e]) * gwv);
                *(LAS u32x4*)(Vws + s * 56 + 8 * g) = wv;
                if (g == 0) Vws[s * 56 + 32] = f2bf(gwv);
            } else {
                if (c > 0) { const u32x4 yv = *(const LAS u32x4*)(Os + s * 40 + 8 * g); *(u32x4*)(PM + (tokbase + (size_t)(c - 1) * 64 + s) * LDPM + 3072 + h * 256 + dv0 + 8 * g) = yv; }
                *(LAS u32x4*)(Os + s * 40 + 8 * g) = vo4;
            }
            if (tid < 64) { BC[tid] = gb; GAs[tid] = ga; }
        }
        asm volatile("" ::: "memory");
        if (c + 1 < 64) ML_LOAD(c + 1, tid);
        asm volatile("" ::: "memory");
        __syncthreads();
        {
            const int mt = w >> 1, ntb = (w & 1) * 2;
            f32x4 s0 = (f32x4){0.f, 0.f, 0.f, 0.f}, s1 = s0;
#pragma unroll
            for (int ks = 0; ks < 8; ++ks) {
                const bf16x8 a = *(const LAS bf16x8*)(Qs + (16 * mt + fr) * 264 + 32 * ks + 8 * fq);
                const bf16x8 b0 = *(const LAS bf16x8*)(Ks + (16 * ntb + fr) * 264 + 32 * ks + 8 * fq);
                const bf16x8 b1 = *(const LAS bf16x8*)(Ks + (16 * (ntb + 1) + fr) * 264 + 32 * ks + 8 * fq);
                s0 = __builtin_amdgcn_mfma_f32_16x16x32_bf16(a, b0, s0, 0, 0, 0);
                s1 = __builtin_amdgcn_mfma_f32_16x16x32_bf16(a, b1, s1, 0, 0, 0);
            }
            const int sA = 16 * ntb + fr, sB = sA + 16;
            const float gA = GAs[sA], gB = GAs[sB];
#pragma unroll
            for (int j = 0; j < 4; ++j) {
                const int t = 16 * mt + 4 * fq + j; const float bt = BC[t];
                const float vA = (sA <= t) ? s0[j] * __expf(bt + gA) : 0.f, vB = (sB <= t) ? s1[j] * __expf(bt + gB) : 0.f;
                Ss[t * 72 + sA] = f2bf(vA); Ss[t * 72 + sB] = f2bf(vB);
            }
        }
        __syncthreads();
        {
            const int mt = w >> 1, nt = w & 1;
            f32x4 aA = (f32x4){0.f, 0.f, 0.f, 0.f}, aB = aA, xA = aA, xB = aA;
#pragma unroll
            for (int ks = 0; ks < 2; ++ks) {
                const bf16x8 a = *(const LAS bf16x8*)(Ss + (16 * mt + fr) * 72 + 32 * ks + 8 * fq);
                const bf16x8 bm = tr_frag((const LAS unsigned char*)Vs, 112, 32 * ks, 16 * nt, lane);
                const bf16x8 bx = tr_frag((const LAS unsigned char*)Vs, 112, 32 * ks, 32, lane);
                aA = __builtin_amdgcn_mfma_f32_16x16x32_bf16(a, bm, aA, 0, 0, 0);
                xA = __builtin_amdgcn_mfma_f32_16x16x32_bf16(a, bx, xA, 0, 0, 0);
            }
#pragma unroll
            for (int ks = 0; ks < 8; ++ks) {
                const bf16x8 a = *(const LAS bf16x8*)(Qs + (16 * mt + fr) * 264 + 32 * ks + 8 * fq);
                const bf16x8 bm = *(const LAS bf16x8*)(CTc + (16 * nt + fr) * 264 + 32 * ks + 8 * fq);
                const bf16x8 bx = *(const LAS bf16x8*)(CTc + (32 + fr) * 264 + 32 * ks + 8 * fq);
                aB = __builtin_amdgcn_mfma_f32_16x16x32_bf16(a, bm, aB, 0, 0, 0);
                xB = __builtin_amdgcn_mfma_f32_16x16x32_bf16(a, bx, xB, 0, 0, 0);
            }
#pragma unroll
            for (int j = 0; j < 4; ++j) {
                const int t = 16 * mt + 4 * fq + j; const float eb = __expf(BC[t]);
                const float num = aA[j] + eb * aB[j];
                const float den = __shfl(xA[j] + eb * xB[j], lane & 48);
                const float hv = num / fmaxf(fabsf(den), 1.f);
                LAS bf16_t* op = Os + t * 40 + 16 * nt + fr;
                *op = f2bf(hv * sigm(bf2f(*op)));
            }
            const float decay = __expf(BC[63]);
            bf16x8 bw[3][2];
#pragma unroll
            for (int n3 = 0; n3 < 3; ++n3)
#pragma unroll
                for (int ks = 0; ks < 2; ++ks) bw[n3][ks] = tr_frag((const LAS unsigned char*)Vws, 112, 32 * ks, 16 * n3, lane);
#pragma unroll
            for (int m2 = 0; m2 < 2; ++m2) {
                const int mtk = 2 * w + m2;
                const bf16x8 ka0 = tr_frag((const LAS unsigned char*)Ks, 528, 0, 16 * mtk, lane), ka1 = tr_frag((const LAS unsigned char*)Ks, 528, 32, 16 * mtk, lane);
#pragma unroll
                for (int n3 = 0; n3 < 3; ++n3) {
                    f32x4 cc = cacc[m2 * 3 + n3] * decay;
                    cc = __builtin_amdgcn_mfma_f32_16x16x32_bf16(ka0, bw[n3][0], cc, 0, 0, 0);
                    cc = __builtin_amdgcn_mfma_f32_16x16x32_bf16(ka1, bw[n3][1], cc, 0, 0, 0);
                    cacc[m2 * 3 + n3] = cc;
                    u32x2 pk; pk.x = cvt_pk_bf16(cc[0], cc[1]); pk.y = cvt_pk_bf16(cc[2], cc[3]);
                    *(LAS u32x2*)(CTn + (16 * n3 + fr) * 264 + 16 * mtk + 4 * fq) = pk;
                }
            }
        }
        cur ^= 1;
        __syncthreads();
    }
    if (tid0 >= 256) { const int sg = tid0 & 255, s = sg >> 2, g = sg & 3; const u32x4 yv = *(const LAS u32x4*)(Os + s * 40 + 8 * g);
        *(u32x4*)(PM + (tokbase + (size_t)63 * 64 + s) * LDPM + 3072 + h * 256 + dv0 + 8 * g) = yv; }
#undef ML_LOAD
}

__device__ void phase_norm2(const KP& p) {
    const int tid = tid_l(), lane = tid & 63, G = gridDim.x, bid = blockIdx.x;
    rmsnorm_rows(p.out, p.g_ffn, (bf16_t*)(p.ws + OFF_XN2), bid * 8 + (tid >> 6), G * 8, lane);
}
__device__ void convert_tables(const KP& p, int gw, int nw) {
    const int lane = tid_l() & 63;
    for (int tb = 0; tb < 2; ++tb) {
        const float* src = tb ? p.peer_v : p.peer_u; unsigned char* dst = p.ws + (tb ? OFF_PV : OFF_PU); float* sc = (float*)(p.ws + (tb ? OFF_SCV : OFF_SCU));
        for (int row = gw; row < 16384; row += nw) {
            const float* sp = src + (size_t)row * DM + lane * 16;
            f32x4 v[8]; float am = 0.f;
#pragma unroll
            for (int i = 0; i < 2; ++i)
#pragma unroll
                for (int q = 0; q < 4; ++q) { v[i * 4 + q] = *(const f32x4*)(sp + i * 1024 + q * 4);
                    am = fmaxf(am, fmaxf(fmaxf(fabsf(v[i * 4 + q][0]), fabsf(v[i * 4 + q][1])), fmaxf(fabsf(v[i * 4 + q][2]), fabsf(v[i * 4 + q][3])))); }
            const unsigned amu = wave_max_u32(__float_as_uint(am));
            const float amax = __uint_as_float(amu);
            float scl = 1.f;
            if (amax > 0.f) scl = exp2f(floorf(log2f(240.f / amax)));
            if (lane == 0) sc[row] = 1.f / scl;
#pragma unroll
            for (int i = 0; i < 2; ++i) { u32x4 o;
#pragma unroll
                for (int q = 0; q < 4; ++q) { const f32x4 t = v[i * 4 + q] * scl; int w = __builtin_amdgcn_cvt_pk_fp8_f32(t[0], t[1], 0, false); w = __builtin_amdgcn_cvt_pk_fp8_f32(t[2], t[3], w, true); o[q] = (unsigned)w; }
                *(u32x4*)(dst + (size_t)row * 8192 + i * 1024 + lane * 16) = o; }
        }
    }
}

__device__ void phase_peer(const KP& p, LAS unsigned char* lds) {
    const int tid = tid_l(), lane = tid & 63, w = tid >> 6, fr = lane & 15, fq = lane >> 4;
    LAS unsigned* KEYS = (LAS unsigned*)lds;
    LAS int* TI = (LAS int*)(lds + 32768);
    LAS float* TG = (LAS float*)(lds + 49152);
    const bf16_t* Q = (const bf16_t*)(p.ws + OFF_Q);
    const bf16_t* SK = (const bf16_t*)(p.ws + OFF_SUBK);
    const bf16_t* XN2 = (const bf16_t*)(p.ws + OFF_XN2);
    const unsigned char* PU = p.ws + OFF_PU; const unsigned char* PV = p.ws + OFF_PV;
    const float* SCU = (const float*)(p.ws + OFF_SCU); const float* SCV = (const float*)(p.ws + OFF_SCV);
    float* out = p.out;
    LAS int* IJ = (LAS int*)(lds + 65536);
    int ci[4], cj[4]; bool cv[4];
#pragma unroll
    for (int m = 0; m < 4; ++m) { const int e = m * 16 + fr; int i = 0, base = 0;
        for (; i < 16; ++i) { const int cnt = 16 / (i + 1); if (e < base + cnt) break; base += cnt; }
        cv[m] = i < 16; ci[m] = cv[m] ? i : 0; cj[m] = cv[m] ? e - base : 0;
        if (w == 0 && fq == 0) IJ[e] = cv[m] ? ci[m] * 16 + cj[m] : 0; }
    const int pp_ = w >> 2, ntb = (w & 3) * 2;
    bf16x8 bfr[2][4];
#pragma unroll
    for (int n = 0; n < 2; ++n)
#pragma unroll
        for (int ks = 0; ks < 4; ++ks) bfr[n][ks] = *(const bf16x8*)(SK + (size_t)(pp_ * 128 + 16 * (ntb + n) + fr) * 128 + 32 * ks + 8 * fq);
    __syncthreads();
    for (int tile = blockIdx.x; tile < NT / 32; tile += gridDim.x) {
        const int tk0 = tile * 32;
        bf16x8 afn[2][4];
#pragma unroll
        for (int mt = 0; mt < 2; ++mt)
#pragma unroll
            for (int ks = 0; ks < 4; ++ks) afn[mt][ks] = *(const bf16x8*)(Q + (size_t)(tk0 + 16 * mt + fr) * DM + pp_ * 128 + 32 * ks + 8 * fq);
        for (int h = 0; h < 8; ++h) {
            {
                bf16x8 af[2][4];
#pragma unroll
                for (int mt = 0; mt < 2; ++mt)
#pragma unroll
                    for (int ks = 0; ks < 4; ++ks) af[mt][ks] = afn[mt][ks];
                if (h + 1 < 8) {
#pragma unroll
                    for (int mt = 0; mt < 2; ++mt)
#pragma unroll
                        for (int ks = 0; ks < 4; ++ks) afn[mt][ks] = *(const bf16x8*)(Q + (size_t)(tk0 + 16 * mt + fr) * DM + (h + 1) * 256 + pp_ * 128 + 32 * ks + 8 * fq);
                }
                f32x4 acc[2][2];
#pragma unroll
                for (int a_ = 0; a_ < 2; ++a_)
#pragma unroll
                    for (int b_ = 0; b_ < 2; ++b_) acc[a_][b_] = (f32x4){0.f, 0.f, 0.f, 0.f};
#pragma unroll
                for (int ks = 0; ks < 4; ++ks)
#pragma unroll
                    for (int mt = 0; mt < 2; ++mt)
#pragma unroll
                        for (int n = 0; n < 2; ++n) acc[mt][n] = __builtin_amdgcn_mfma_f32_16x16x32_bf16(af[mt][ks], bfr[n][ks], acc[mt][n], 0, 0, 0);
#pragma unroll
                for (int mt = 0; mt < 2; ++mt)
#pragma unroll
                    for (int n = 0; n < 2; ++n)
#pragma unroll
                        for (int j = 0; j < 4; ++j) { const int tokl = 16 * mt + 4 * fq + j, key = 16 * (ntb + n) + fr;
                            KEYS[(tokl * 2 + pp_) * 128 + key] = (ordf(acc[mt][n][j]) & ~0x7Fu) | (unsigned)key; }
            }
            __syncthreads();
            {
                const int tokl = 4 * w + fq, rb = lane & 48;
                unsigned top[2];
#pragma unroll
                for (int pp = 0; pp < 2; ++pp) {
                    unsigned kx[8];
#pragma unroll
                    for (int m = 0; m < 8; ++m) kx[m] = KEYS[(tokl * 2 + pp) * 128 + fr + 16 * m];
                    unsigned tp = 0u;
                    for (int it = 0; it < 16; ++it) {
                        unsigned M = max(max(max(kx[0], kx[1]), max(kx[2], kx[3])), max(max(kx[4], kx[5]), max(kx[6], kx[7])));
                        M = max(M, dppu<0xB1>(M)); M = max(M, dppu<0x4E>(M)); M = max(M, dppu<0x141>(M)); M = max(M, dppu<0x140>(M));
                        if (fr == it) tp = M;
#pragma unroll
                        for (int m = 0; m < 8; ++m) kx[m] = (kx[m] == M) ? 0u : kx[m];
                    }
                    top[pp] = tp;
                }
                unsigned cnd[4];
#pragma unroll
                for (int m = 0; m < 4; ++m) {
                    const float v1 = unordf((unsigned)__shfl((int)top[0], rb + ci[m]) & ~0x7Fu), v2 = unordf((unsigned)__shfl((int)top[1], rb + cj[m]) & ~0x7Fu);
                    cnd[m] = cv[m] ? ((ordf(v1 + v2) & ~0x3Fu) | (unsigned)(m * 16 + fr)) : 0u;
                }
                unsigned best = 0u;
                for (int it = 0; it < 16; ++it) {
                    unsigned M = max(max(cnd[0], cnd[1]), max(cnd[2], cnd[3]));
                    M = max(M, dppu<0xB1>(M)); M = max(M, dppu<0x4E>(M)); M = max(M, dppu<0x141>(M)); M = max(M, dppu<0x140>(M));
                    if (fr == it) best = M;
#pragma unroll
                    for (int m = 0; m < 4; ++m) cnd[m] = (cnd[m] == M) ? 0u : cnd[m];
                }
                const int ij = IJ[best & 0x3Fu];
                const float bv = unordf(best & ~0x3Fu);
                const int e1 = __shfl((int)top[0], rb + (ij >> 4)) & 0x7F, e2 = __shfl((int)top[1], rb + (ij & 15)) & 0x7F;
                const float mx = __shfl(bv, rb);
                const float ev = __expf(bv - mx);
                const float sum = red16(ev);
                TI[tokl * 128 + h * 16 + fr] = e1 * 128 + e2; TG[tokl * 128 + h * 16 + fr] = ev / sum;
            }
            __syncthreads();
        }
        for (int q = 0; q < 4; ++q) {
            const int tokl = 4 * w + q; const size_t tok = (size_t)tk0 + tokl;
            float xv[32], acc[32];
#pragma unroll
            for (int i = 0; i < 2; ++i)
#pragma unroll
                for (int hh = 0; hh < 2; ++hh) { const u32x4 x4 = *(const u32x4*)(XN2 + tok * DM + i * 1024 + lane * 16 + hh * 8);
#pragma unroll
                    for (int e = 0; e < 4; ++e) { xv[i * 16 + hh * 8 + 2 * e] = bflo(x4[e]); xv[i * 16 + hh * 8 + 2 * e + 1] = bfhi(x4[e]); } }
#pragma unroll
            for (int i = 0; i < 32; ++i) acc[i] = 0.f;
#pragma unroll 4
            for (int e = 0; e < 128; ++e) {
                const int idx = __builtin_amdgcn_readfirstlane(TI[tokl * 128 + e]);
                const float gate = __builtin_bit_cast(float, __builtin_amdgcn_readfirstlane(__builtin_bit_cast(int, TG[tokl * 128 + e])));
                const unsigned char* up = PU + (size_t)idx * 8192 + lane * 16; const unsigned char* vp = PV + (size_t)idx * 8192 + lane * 16;
                u32x4 u4[2], v4[2];
                u4[0] = *(const u32x4*)up; u4[1] = *(const u32x4*)(up + 1024); v4[0] = *(const u32x4*)vp; v4[1] = *(const u32x4*)(vp + 1024);
                const float su = SCU[idx], sv = SCV[idx];
                float d0 = 0.f, d1 = 0.f, d2 = 0.f, d3 = 0.f;
#pragma unroll
                for (int i = 0; i < 2; ++i)
#pragma unroll
                    for (int k = 0; k < 4; ++k) { const f32x2_t lo = __builtin_amdgcn_cvt_pk_f32_fp8((int)u4[i][k], false), hi = __builtin_amdgcn_cvt_pk_f32_fp8((int)u4[i][k], true);
                        d0 += xv[i * 16 + 4 * k] * lo.x; d1 += xv[i * 16 + 4 * k + 1] * lo.y; d2 += xv[i * 16 + 4 * k + 2] * hi.x; d3 += xv[i * 16 + 4 * k + 3] * hi.y; }
                const float act = wave_sum((d0 + d1) + (d2 + d3)) * su;
                const float coef = gate * 0.5f * act * (1.f + erff(act * 0.70710678118f)) * sv;
#pragma unroll
                for (int i = 0; i < 2; ++i)
#pragma unroll
                    for (int k = 0; k < 4; ++k) { const f32x2_t lo = __builtin_amdgcn_cvt_pk_f32_fp8((int)v4[i][k], false), hi = __builtin_amdgcn_cvt_pk_f32_fp8((int)v4[i][k], true);
                        acc[i * 16 + 4 * k] += coef * lo.x; acc[i * 16 + 4 * k + 1] += coef * lo.y; acc[i * 16 + 4 * k + 2] += coef * hi.x; acc[i * 16 + 4 * k + 3] += coef * hi.y; }
            }
            float ss = 0.f;
            float* orow = out + tok * DM + lane * 16;
#pragma unroll
            for (int i = 0; i < 2; ++i)
#pragma unroll
                for (int k = 0; k < 4; ++k) { const f32x4 h0 = *(const f32x4*)(orow + i * 1024 + 4 * k);
#pragma unroll
                    for (int j = 0; j < 4; ++j) { acc[i * 16 + 4 * k + j] += h0[j]; ss += acc[i * 16 + 4 * k + j] * acc[i * 16 + 4 * k + j]; } }
            ss = wave_sum(ss);
            const float r = rsqrtf(ss * (1.f / DM) + 1e-6f);
#pragma unroll
            for (int i = 0; i < 2; ++i)
#pragma unroll
                for (int k = 0; k < 4; ++k) { const f32x4 g0 = *(const f32x4*)(p.g_final + i * 1024 + lane * 16 + 4 * k); f32x4 o0;
#pragma unroll
                    for (int j = 0; j < 4; ++j) o0[j] = acc[i * 16 + 4 * k + j] * r * g0[j];
                    *(f32x4*)(orow + i * 1024 + 4 * k) = o0; }
        }
        __syncthreads();
    }
}

__global__ void __launch_bounds__(512) fwd_megakernel(KP p) {
    extern __shared__ __attribute__((aligned(16))) unsigned char smem[];
    LAS unsigned char* lds = (LAS unsigned char*)smem;
    cg::grid_group grid = cg::this_grid();
#define GRID_SYNC() do { asm volatile("s_waitcnt vmcnt(0) lgkmcnt(0)" ::: "memory"); __syncthreads(); grid.sync(); asm volatile("" ::: "memory"); } while (0)
    const int G = gridDim.x, bid = blockIdx.x;
    unsigned char* ws = p.ws; unsigned char* dob = (unsigned char*)p.out;

#define RUN_GEMM(MODE, ...) do { unsigned char* ws = lp(p.ws); unsigned char* dob = lp((unsigned char*)p.out); const pg8::Gemm g_ = pg8::Gemm{__VA_ARGS__}; pg8::StaticOrder S_; S_.init(g_.M, g_.N, G, bid); \
        const pg8::Epi<MODE> E_{ws, dob, p.x, p.w0, p.a0}; pg8::gemm_phase(lds, g_, S_, E_); } while (0)
    phase_prep(p, lds);
    GRID_SYNC();
    RUN_GEMM(0, (const bf16_t*)(ws + OFF_XN), (const bf16_t*)(ws + OFF_WINT), NT, N1, 2048, 2048, 2048);
    GRID_SYNC();
    phase_lora_prep(p);
    GRID_SYNC();
    RUN_GEMM(1, (const bf16_t*)(dob + DO_ALORA), (const bf16_t*)(ws + OFF_WAT), NT, 2048, 256, 512, 256);
    RUN_GEMM(2, (const bf16_t*)(dob + DO_ALORA) + 256, (const bf16_t*)(ws + OFF_G2T), NT, 1024, 256, 512, 256);
    GRID_SYNC();
    if (bid < 128) rwkv_scan(p, bid, lds);
    else {
        mlstm_run(p, bid - 128, lds);
        convert_tables(p, (bid - 128) * 8 + (tid_l() >> 6), 1024);
        __builtin_amdgcn_fence(__ATOMIC_RELEASE, "agent"); __syncthreads();
        if (threadIdx.x == 0) { unsigned* cnt = (unsigned*)(p.ws + OFF_SUBBAR); __hip_atomic_fetch_add(cnt, 1u, __ATOMIC_RELAXED, __HIP_MEMORY_SCOPE_AGENT);
            while (__hip_atomic_load(cnt, __ATOMIC_RELAXED, __HIP_MEMORY_SCOPE_AGENT) < 128u) __builtin_amdgcn_s_sleep(2); }
        __syncthreads(); __builtin_amdgcn_fence(__ATOMIC_ACQUIRE, "agent");
        { unsigned char* ws = lp(p.ws); unsigned char* dob = lp((unsigned char*)p.out); const pg8::Gemm g_ = pg8::Gemm{(const bf16_t*)(ws + OFF_PM) + 3072, (const bf16_t*)(ws + OFF_PMT), NT, 2048, 1024, LDPM, 1024};
          pg8::StaticOrder S_; S_.init(g_.M, g_.N, 128, bid - 128); const pg8::Epi<3> E_{ws, dob, p.x, p.w0, p.a0}; pg8::gemm_phase(lds, g_, S_, E_); }
    }
    GRID_SYNC();
    phase_rwkv_post(p);
    GRID_SYNC();
    RUN_GEMM(4, (const bf16_t*)(ws + OFF_YR), (const bf16_t*)(ws + OFF_PRT), NT, 2048, 1024, 1024, 1024);
    GRID_SYNC();
    RUN_GEMM(5, (const bf16_t*)(ws + OFF_PG), (const bf16_t*)(ws + OFF_WOT), NT, 2048, 2048, LDPG, 2048);
    GRID_SYNC();
    phase_norm2(p);
    GRID_SYNC();
    RUN_GEMM(6, (const bf16_t*)(ws + OFF_XN2), (const bf16_t*)(ws + OFF_WQT), NT, 2048, 2048, 2048, 2048);
    GRID_SYNC();
    phase_peer(p, lds);
}

extern "C" void kernel_launch(void* const* d_in, const int* in_sizes, int n_in, void* d_out, int out_size, void* d_ws, size_t ws_size, hipStream_t stream) {
    static int grid_blocks = 0;
    if (grid_blocks == 0) {
        if (n_in != 26 || out_size != NT * DM || ws_size < WS_NEED) { fprintf(stderr, "kernel_launch: unexpected shapes: n_in %d out %d ws %zu (need %zu)\n", n_in, out_size, ws_size, (size_t)WS_NEED); grid_blocks = -1; return; }
        int dev = 0, cus = 0, per_cu = 0;
        hipGetDevice(&dev);
        hipDeviceGetAttribute(&cus, hipDeviceAttributeMultiprocessorCount, dev);
        if (hipFuncSetAttribute((const void*)fwd_megakernel, hipFuncAttributeMaxDynamicSharedMemorySize, LDS_BYTES) != hipSuccess) { fprintf(stderr, "kernel_launch: hipFuncSetAttribute failed\n"); grid_blocks = -1; return; }
        hipOccupancyMaxActiveBlocksPerMultiprocessor(&per_cu, (const void*)fwd_megakernel, 512, LDS_BYTES);
        if (per_cu < 1) { fprintf(stderr, "kernel_launch: occupancy query says %d blocks per CU\n", per_cu); per_cu = 1; }
        (void)hipGetLastError();
        grid_blocks = cus * 1;
    }
    if (grid_blocks < 0) return;
    KP p{};
    const float** pp = (const float**)&p;
    for (int i = 0; i < 26; ++i) pp[i] = (const float*)d_in[i];
    p.out = (float*)d_out; p.ws = (unsigned char*)d_ws;
    void* args[] = {&p};
    hipError_t e = hipLaunchCooperativeKernel((void*)fwd_megakernel, dim3(grid_blocks), dim3(512), args, LDS_BYTES, stream);
    if (e != hipSuccess) fprintf(stderr, "cooperative launch failed: %s (grid %d)\n", hipGetErrorString(e), grid_blocks);
}
```

```cpp
#include <hip/hip_runtime.h>
#include <hip/hip_cooperative_groups.h>
#include <cstdio>
namespace cg = cooperative_groups;

#define LAS __attribute__((address_space(3)))
typedef unsigned short bf16_t;
typedef short bf16x8 __attribute__((ext_vector_type(8)));
typedef float f32x4 __attribute__((ext_vector_type(4)));
typedef unsigned u32x4 __attribute__((ext_vector_type(4)));
typedef unsigned u32x2 __attribute__((ext_vector_type(2)));

constexpr int NT = 16384, SEQ = 4096, DM = 2048;
constexpr int LDPM = 4096, LDPR = 3584, LDPG = 4096, N1 = 11776;
constexpr size_t MiB = 1024ull * 1024ull;
constexpr size_t OFF_PM = 0, OFF_PR = 128 * MiB, OFF_PG = 240 * MiB, OFF_XN = 368 * MiB, OFF_WINT = 432 * MiB, OFF_WTS = 478 * MiB;
constexpr size_t OFF_PMT = OFF_WTS, OFF_PRT = OFF_WTS + 4 * MiB, OFF_WOT = OFF_WTS + 8 * MiB, OFF_WQT = OFF_WTS + 16 * MiB, OFF_WAT = OFF_WTS + 24 * MiB,
                 OFF_G2T = OFF_WTS + 25 * MiB, OFF_SUBK = OFF_WTS + 25 * MiB + 512 * 1024, WS_NEED = OFF_WTS + 26 * MiB;
constexpr size_t OFF_QC = OFF_XN, OFF_KC = OFF_XN + 32 * MiB, OFF_YR = OFF_WINT, OFF_Q = OFF_XN, OFF_XN2 = OFF_PR, OFF_PU = OFF_PM, OFF_PV = OFF_PM + 2048, OFF_SUBBAR = OFF_SUBK + 192 * 1024, OFF_XBAR = OFF_SUBBAR + 256,
                 OFF_SCU = OFF_SUBK + 64 * 1024, OFF_SCV = OFF_SCU + 64 * 1024;
constexpr size_t DO_WLOG = 0, DO_AG = 32 * MiB, DO_GG = 64 * MiB, DO_ALORA = 96 * MiB, DO_GB = 112 * MiB, DO_GA = DO_GB + 256 * 1024, DO_GW = DO_GA + 256 * 1024;
constexpr int LDS_BYTES = 150528;
#define XCD_BAR_WORDS 3456

struct KP {
    const float *x, *g_mix, *w_in, *conv_w, *b_i, *b_f, *mu, *w0, *w2, *a0, *a2, *g2, *k_k, *k_a, *r_k, *ln_w, *ln_b, *proj_m, *proj_r, *w_out, *g_ffn,
        *w_query, *sub_keys, *peer_u, *peer_v, *g_final;
    float* out; unsigned char* ws;
};

typedef __bf16 bf16x2_t __attribute__((ext_vector_type(2)));
typedef float f32x2_t __attribute__((ext_vector_type(2)));
__device__ __forceinline__ unsigned cvt_pk_bf16(float lo, float hi) { f32x2_t v = {lo, hi}; bf16x2_t b = __builtin_convertvector(v, bf16x2_t); return __builtin_bit_cast(unsigned, b); }
__device__ __forceinline__ bf16_t f2bf(float f) { return (bf16_t)(cvt_pk_bf16(f, 0.f) & 0xffffu); }
__device__ __forceinline__ float bf2f(bf16_t h) { return __uint_as_float((unsigned)h << 16); }
__device__ __forceinline__ float bflo(unsigned u) { return __uint_as_float(u << 16); }
__device__ __forceinline__ float bfhi(unsigned u) { return __uint_as_float(u & 0xffff0000u); }
__device__ __forceinline__ float sigm(float x) { return __builtin_amdgcn_rcpf(1.f + __expf(-x)); }
template <int CTRL> __device__ __forceinline__ float dppf(float v) { return __builtin_bit_cast(float, __builtin_amdgcn_update_dpp(0, __builtin_bit_cast(int, v), CTRL, 0xF, 0xF, true)); }
template <int CTRL> __device__ __forceinline__ unsigned dppu(unsigned v) { return (unsigned)__builtin_amdgcn_update_dpp(0, (int)v, CTRL, 0xF, 0xF, true); }
__device__ __forceinline__ float red4(float v) { v += dppf<0xB1>(v); v += dppf<0x4E>(v); return v; }
__device__ __forceinline__ float red8(float v) { v = red4(v); v += dppf<0x141>(v); return v; }
__device__ __forceinline__ float red16(float v) { v = red8(v); v += dppf<0x140>(v); return v; }
__device__ __forceinline__ float rlane(float v, int l) { return __builtin_bit_cast(float, __builtin_amdgcn_readlane(__builtin_bit_cast(int, v), l)); }
__device__ __forceinline__ float wave_sum(float v) { v = red16(v); return rlane(v, 0) + rlane(v, 16) + rlane(v, 32) + rlane(v, 48); }
__device__ __forceinline__ unsigned wave_max_u32(unsigned v) {
    v = max(v, dppu<0xB1>(v)); v = max(v, dppu<0x4E>(v)); v = max(v, dppu<0x141>(v)); v = max(v, dppu<0x140>(v));
    unsigned a = (unsigned)__builtin_amdgcn_readlane((int)v, 0), b = (unsigned)__builtin_amdgcn_readlane((int)v, 16), c = (unsigned)__builtin_amdgcn_readlane((int)v, 32), d = (unsigned)__builtin_amdgcn_readlane((int)v, 48);
    return max(max(a, b), max(c, d));
}
__device__ __forceinline__ unsigned ordf(float f) { unsigned u = __float_as_uint(f); return (u & 0x80000000u) ? ~u : (u | 0x80000000u); }
__device__ __forceinline__ float unordf(unsigned k) { return __uint_as_float((k & 0x80000000u) ? (k ^ 0x80000000u) : ~k); }

__device__ __forceinline__ int tid_l() { int t = threadIdx.x; asm volatile("" : "+v"(t)); return t; }
template <class T> __device__ __forceinline__ T* lp(T* q) { asm volatile("" : "+s"(q)); return q; }
namespace pg8 {
constexpr int BM = 256, BK = 64, HALF = 128, HTB = HALF * BK * 2, STAGE_BYTES = 8 * HTB, NXCD = 8, WGM = 8;
__device__ __forceinline__ int lds_byte(int r, int c) { const int st = (r >> 4) * 2 + (c >> 5), rr = r & 15, cc = c & 31, ob = rr * 64 + cc * 2; return st * 1024 + (ob ^ (((ob >> 9) & 1) << 5)); }
__device__ __forceinline__ void stage_rc(int b, int& R, int& C) { const int st = b / 1024, sb = b % 1024, swz = sb ^ (((sb >> 9) & 1) << 5); R = (st >> 1) * 16 + swz / 64; C = (st & 1) * 32 + (swz % 64) / 2; }
__device__ __forceinline__ int perm32(int rho) { const int n = rho >> 4, i = rho & 15; return 8 * (i >> 2) + 4 * n + (i & 3); }
struct Unit { int pm, pn; };
struct Gemm { const bf16_t* A; const bf16_t* Bt; int M, N, K, lda, ldb; };
struct StaticOrder {
    int nM, nN, nwg, G, c;
    __device__ void init(int M, int N, int G_, int c_) { nM = M / BM; nN = N / BM; nwg = nM * nN; G = G_; c = c_; }
    __device__ bool next(int i, Unit& u) const {
        const long L = (long)i * G + c; if (L >= nwg) return false;
        int wgid = (int)L; { const int q = nwg / NXCD, r = nwg % NXCD, xcd = wgid % NXCD, off = wgid / NXCD; wgid = (xcd < r ? xcd * (q + 1) : r * (q + 1) + (xcd - r) * q) + off; }
        const int nig = WGM * nN, gid = wgid / nig, fm = gid * WGM, gsz = (nM - fm) < WGM ? (nM - fm) : WGM;
        u.pm = fm + ((wgid % nig) % gsz); u.pn = (wgid % nig) / gsz; return true;
    }
};

__device__ __forceinline__ void store8(bf16_t* p, f32x4 v0, f32x4 v1) {
    u32x4 w; w.x = cvt_pk_bf16(v0[0], v0[1]); w.y = cvt_pk_bf16(v0[2], v0[3]); w.z = cvt_pk_bf16(v1[0], v1[1]); w.w = cvt_pk_bf16(v1[2], v1[3]); *(u32x4*)p = w;
}
__device__ __forceinline__ void load8(const bf16_t* p, f32x4& v0, f32x4& v1) {
    const u32x4 w = *(const u32x4*)p; v0 = (f32x4){bflo(w.x), bfhi(w.x), bflo(w.y), bfhi(w.y)}; v1 = (f32x4){bflo(w.z), bfhi(w.z), bflo(w.w), bfhi(w.w)};
}

template <int mode> struct Epi {
    static constexpr bool PERM = true;
    unsigned char* ws; unsigned char* dob; const float* x; const float* w0; const float* a0;
    __device__ __forceinline__ void operator()(const f32x4 (&acc)[2][2][4][2], const Unit& u, int wr, int wc, int fr, int fq) const {
        const int row0 = u.pm * BM + wr * 64 + fr, cb = u.pn * BM + wc * 32 + 8 * fq;
#pragma unroll
        for (int ai = 0; ai < 2; ++ai)
#pragma unroll
            for (int m = 0; m < 4; ++m) {
                const size_t row = (size_t)(row0 + ai * HALF + m * 16);
#pragma unroll
                for (int bj = 0; bj < 2; ++bj) {
                    const int col = cb + bj * HALF;
                    f32x4 v0 = acc[ai][bj][m][0], v1 = acc[ai][bj][m][1];
                    if (mode == 0) {
                        if (col < 4096) store8((bf16_t*)(ws + OFF_PM) + row * LDPM + col, v0, v1);
                        else if (col < 7680) store8((bf16_t*)(ws + OFF_PR) + row * LDPR + (col - 4096), v0, v1);
                        else {
#pragma unroll
                            for (int j = 0; j < 4; ++j) { v0[j] = sigm(v0[j]); v1[j] = sigm(v1[j]); }
                            store8((bf16_t*)(ws + OFF_PG) + row * LDPG + (col - 7680), v0, v1);
                        }
                    } else if (mode == 1) {
                        if (col < 1024) {
                            const f32x4 b0 = *(const f32x4*)(w0 + col), b1 = *(const f32x4*)(w0 + col + 4);
#pragma unroll
                            for (int j = 0; j < 4; ++j) {
                                float z = -(b0[j] + v0[j]); float sp = fmaxf(z, 0.f) + __logf(1.f + __expf(-fabsf(z))); v0[j] = -__expf(-sp - 0.5f);
                                z = -(b1[j] + v1[j]); sp = fmaxf(z, 0.f) + __logf(1.f + __expf(-fabsf(z))); v1[j] = -__expf(-sp - 0.5f);
                            }
                            store8((bf16_t*)(dob + DO_WLOG) + row * 1024 + col, v0, v1);
                        } else {
                            const int c2 = col - 1024;
                            const f32x4 b0 = *(const f32x4*)(a0 + c2), b1 = *(const f32x4*)(a0 + c2 + 4);
#pragma unroll
                            for (int j = 0; j < 4; ++j) { v0[j] = sigm(b0[j] + v0[j]); v1[j] = sigm(b1[j] + v1[j]); }
                            store8((bf16_t*)(dob + DO_AG) + row * 1024 + c2, v0, v1);
                        }
                    } else if (mode == 2) {
                        store8((bf16_t*)(dob + DO_GG) + row * 1024 + col, v0, v1);
                    } else if (mode == 3) {
                        bf16_t* pp = (bf16_t*)(ws + OFF_PG) + row * LDPG + col; f32x4 g0, g1; load8(pp, g0, g1);
                        store8(pp, g0 * v0, g1 * v1);
                    } else if (mode == 4) {
                        bf16_t* pp = (bf16_t*)(ws + OFF_PG) + row * LDPG + col; f32x4 m0, m1, g0, g1; load8(pp, m0, m1); load8(pp + 2048, g0, g1);
                        store8(pp, m0 + g0 * v0, m1 + g1 * v1);
                    } else if (mode == 5) {
                        const float* xp = x + row * DM + col; float* op = (float*)dob + row * DM + col;
                        const f32x4 x0 = *(const f32x4*)xp, x1 = *(const f32x4*)(xp + 4);
                        *(f32x4*)op = x0 + v0; *(f32x4*)(op + 4) = x1 + v1;
                    } else {
                        store8((bf16_t*)(ws + OFF_Q) + row * DM + col, v0, v1);
                    }
                    asm volatile("" ::: "memory");
                }
            }
    }
};

template <class EpiT> __device__ __forceinline__ void gemm_phase(LAS unsigned char* lds, const Gemm g, const StaticOrder& S, const EpiT& E) {
    const int tid = tid_l(), wid = __builtin_amdgcn_readfirstlane(tid >> 6), lane = tid & 63, wr = wid >> 2, wc = wid & 3, fr = lane & 15, fq = lane >> 4;
    const int K = g.K, nt = K / BK;
    unsigned voffA[2], voffB[2];
#pragma unroll
    for (int i = 0; i < 2; ++i) { int R, C; stage_rc(tid * 16 + i * 8192, R, C); const int Rb = (R & ~31) + perm32(R & 31);
        voffA[i] = (unsigned)(R * g.lda + C) * 2u; voffB[i] = (unsigned)(Rb * g.ldb + C) * 2u; }
    const size_t kstep = (size_t)(BK * 2);
    const size_t hstepA = (size_t)HALF * g.lda * 2, hstepB = (size_t)HALF * g.ldb * 2;
    const size_t tstepA = 2 * hstepA, tstepB = 2 * hstepB;
    const unsigned ldsw = (unsigned)wid * 1024u;
    const int aoff = lds_byte(wr * 64 + fr, fq * 8), boff = lds_byte(wc * 32 + fr, fq * 8);
#define PG8_SA(b, h) (((b) * 2 + (h)) * HTB)
#define PG8_SB(b, h) ((4 + (b) * 2 + (h)) * HTB)
#define PG8_STAGE(bufoff, gbase, voff) do { _Pragma("unroll") for (int _i = 0; _i < 2; ++_i) \
        __builtin_amdgcn_global_load_lds((const unsigned*)((const char*)(gbase) + (voff)[_i]), (LAS unsigned*)(lds + (bufoff) + ldsw + _i * 8192), 16, 0, 0); } while (0)
#define PG8_LDA(dst, b, h) do { _Pragma("unroll") for (int m = 0; m < 4; ++m) _Pragma("unroll") for (int k = 0; k < 2; ++k) dst[m][k] = *(const LAS bf16x8*)(lds + PG8_SA(b, h) + aoff + m * 2048 + k * 1024); } while (0)
#define PG8_LDB(dst, b, h) do { _Pragma("unroll") for (int n = 0; n < 2; ++n) _Pragma("unroll") for (int k = 0; k < 2; ++k) dst[n][k] = *(const LAS bf16x8*)(lds + PG8_SB(b, h) + boff + n * 2048 + k * 1024); } while (0)
#define PG8_MMA(ai, bj, At, Bt) do { __builtin_amdgcn_s_setprio(1); _Pragma("unroll") for (int m = 0; m < 4; ++m) _Pragma("unroll") for (int n = 0; n < 2; ++n) _Pragma("unroll") for (int k = 0; k < 2; ++k) \
        acc[ai][bj][m][n] = __builtin_amdgcn_mfma_f32_16x16x32_bf16(Bt[n][k], At[m][k], acc[ai][bj][m][n], 0, 0, 0); __builtin_amdgcn_s_setprio(0); } while (0)
#define PG8_WAIT_V(n) asm volatile("s_waitcnt vmcnt(" #n ")" ::: "memory")
#define PG8_WAIT_L(n) asm volatile("s_waitcnt lgkmcnt(" #n ")" ::: "memory")
#define PG8_BAR __builtin_amdgcn_s_barrier()
#define PG8_SCHED __builtin_amdgcn_sched_barrier(0)
    Unit cur, nxt; int ui = 0;
    if (!S.next(0, cur)) return;
    f32x4 acc[2][2][4][2];
#pragma unroll
    for (int a = 0; a < 2; ++a)
#pragma unroll
        for (int b = 0; b < 2; ++b)
#pragma unroll
            for (int m = 0; m < 4; ++m)
#pragma unroll
                for (int n = 0; n < 2; ++n) acc[a][b][m][n] = (f32x4){0.f, 0.f, 0.f, 0.f};
    bf16x8 At[4][2], B0[2][2], B1[2][2];
    const char* cA = (const char*)g.A + (size_t)cur.pm * tstepA; const char* cB = (const char*)g.Bt + (size_t)cur.pn * tstepB;
    PG8_STAGE(PG8_SB(0, 0), cB, voffB); PG8_STAGE(PG8_SA(0, 0), cA, voffA); PG8_STAGE(PG8_SB(0, 1), cB + hstepB, voffB); PG8_STAGE(PG8_SA(0, 1), cA + hstepA, voffA);
    if (wr == 1) PG8_BAR;
    PG8_WAIT_V(4); PG8_BAR;
    PG8_STAGE(PG8_SB(1, 0), cB + kstep, voffB); PG8_STAGE(PG8_SA(1, 0), cA + kstep, voffA); PG8_STAGE(PG8_SB(1, 1), cB + hstepB + kstep, voffB);
    PG8_WAIT_V(6); PG8_BAR;
    for (;;) {
        const bool has_next = S.next(ui + 1, nxt);
        const char* nA = has_next ? (const char*)g.A + (size_t)nxt.pm * tstepA : cA; const char* nB = has_next ? (const char*)g.Bt + (size_t)nxt.pn * tstepB : cB;
        for (int t = 0; t < nt; t += 2) {
            const bool last = (t == nt - 2);
            const char* a1 = cA + (size_t)(t + 1) * kstep;
            const char* a2 = last ? nA : cA + (size_t)(t + 2) * kstep; const char* b2 = last ? nB : cB + (size_t)(t + 2) * kstep;
            const char* a3 = a2 + kstep; const char* b3 = b2 + kstep;
            PG8_LDB(B0, 0, 0); PG8_SCHED; PG8_LDA(At, 0, 0); PG8_STAGE(PG8_SA(1, 1), a1 + hstepA, voffA);
            PG8_WAIT_L(8); PG8_BAR; PG8_WAIT_L(0); PG8_MMA(0, 0, At, B0); PG8_BAR; PG8_SCHED;
            PG8_LDB(B1, 0, 1); PG8_STAGE(PG8_SB(0, 0), b2, voffB);
            PG8_BAR; PG8_WAIT_L(0); PG8_MMA(0, 1, At, B1); PG8_BAR;
            PG8_LDA(At, 0, 1); PG8_STAGE(PG8_SA(0, 0), a2, voffA);
            PG8_BAR; PG8_WAIT_L(0); PG8_MMA(1, 0, At, B0); PG8_BAR; PG8_SCHED;
            PG8_STAGE(PG8_SB(0, 1), b2 + hstepB, voffB);
            PG8_WAIT_V(6); PG8_BAR; PG8_MMA(1, 1, At, B1); PG8_BAR;
            PG8_LDB(B0, 1, 0); PG8_SCHED; PG8_LDA(At, 1, 0); PG8_STAGE(PG8_SA(0, 1), a2 + hstepA, voffA);
            PG8_WAIT_L(8); PG8_BAR; PG8_WAIT_L(0); PG8_MMA(0, 0, At, B0); PG8_BAR; PG8_SCHED;
            PG8_LDB(B1, 1, 1); PG8_STAGE(PG8_SB(1, 0), b3, voffB);
            PG8_BAR; PG8_WAIT_L(0); PG8_MMA(0, 1, At, B1); PG8_BAR;
            PG8_LDA(At, 1, 1); PG8_STAGE(PG8_SA(1, 0), a3, voffA);
            PG8_BAR; PG8_WAIT_L(0); PG8_MMA(1, 0, At, B0); PG8_BAR; PG8_SCHED;
            PG8_STAGE(PG8_SB(1, 1), b3 + hstepB, voffB);
            PG8_WAIT_V(6); PG8_BAR; PG8_MMA(1, 1, At, B1); PG8_BAR;
        }
        E(acc, cur, wr, wc, fr, fq);
        if (!has_next) break;
#pragma unroll
        for (int a = 0; a < 2; ++a)
#pragma unroll
            for (int b = 0; b < 2; ++b)
#pragma unroll
                for (int m = 0; m < 4; ++m)
#pragma unroll
                    for (int n = 0; n < 2; ++n) acc[a][b][m][n] = (f32x4){0.f, 0.f, 0.f, 0.f};
        cur = nxt; cA = nA; cB = nB; ++ui;
    }
    PG8_WAIT_V(0);
    if (wr == 0) PG8_BAR;
    PG8_BAR;
#undef PG8_SA
#undef PG8_SB
#undef PG8_STAGE
#undef PG8_LDA
#undef PG8_LDB
#undef PG8_MMA
#undef PG8_WAIT_V
#undef PG8_WAIT_L
#undef PG8_BAR
#undef PG8_SCHED
}
}

__device__ __forceinline__ void rmsnorm_rows(const float* src, const float* gain, bf16_t* dst, int gw, int nw, int lane) {
    for (int row = gw; row < NT; row += nw) {
        const f32x4* s = (const f32x4*)(src + (size_t)row * DM);
        f32x4 v[8]; float ss = 0.f;
#pragma unroll
        for (int i = 0; i < 8; ++i) { v[i] = s[i * 64 + lane]; ss += v[i][0] * v[i][0] + v[i][1] * v[i][1] + v[i][2] * v[i][2] + v[i][3] * v[i][3]; }
        ss = wave_sum(ss);
        const float r = rsqrtf(ss * (1.f / DM) + 1e-6f);
        u32x2* d = (u32x2*)(dst + (size_t)row * DM);
#pragma unroll
        for (int i = 0; i < 8; ++i) { const f32x4 gg = ((const f32x4*)gain)[i * 64 + lane]; u32x2 o; o.x = cvt_pk_bf16(v[i][0] * r * gg[0], v[i][1] * r * gg[1]); o.y = cvt_pk_bf16(v[i][2] * r * gg[2], v[i][3] * r * gg[3]); d[i * 64 + lane] = o; }
    }
}

__device__ __forceinline__ void tr_tile(const float* src, int ld, int c0, int nvalid, int k0, bf16_t* dst, int ldd, int r0, int kd0, LAS float* tile) {
    const int tid = tid_l();
#pragma unroll
    for (int i = 0; i < 2; ++i) {
        const int k = (tid >> 4) + 32 * i, c4 = (tid & 15) * 4;
        f32x4 v = (f32x4){0.f, 0.f, 0.f, 0.f};
        if (c4 < nvalid) v = *(const f32x4*)(src + (size_t)(k0 + k) * ld + c0 + c4);
        tile[k * 65 + c4] = v[0]; tile[k * 65 + c4 + 1] = v[1]; tile[k * 65 + c4 + 2] = v[2]; tile[k * 65 + c4 + 3] = v[3];
    }
    __syncthreads();
    {
        const int c = tid >> 3, k8 = (tid & 7) * 8;
        float f[8];
#pragma unroll
        for (int j = 0; j < 8; ++j) f[j] = tile[(k8 + j) * 65 + c];
        u32x4 w; w.x = cvt_pk_bf16(f[0], f[1]); w.y = cvt_pk_bf16(f[2], f[3]); w.z = cvt_pk_bf16(f[4], f[5]); w.w = cvt_pk_bf16(f[6], f[7]);
        *(u32x4*)(dst + (size_t)(r0 + c) * ldd + kd0 + k8) = w;
    }
    __syncthreads();
}

__device__ void phase_prep(const KP& p, LAS unsigned char* lds) {
    const int tid = tid_l(), lane = tid & 63, G = gridDim.x, bid = blockIdx.x;
    unsigned char* ws = p.ws;
    rmsnorm_rows(p.x, p.g_mix, (bf16_t*)(ws + OFF_XN), bid * 8 + (tid >> 6), G * 8, lane);
    LAS float* tile = (LAS float*)lds;
    for (int j = bid; j < 8960; j += G) {
        if (j < 5888) {
            const int rt = j >> 5, kt = j & 31; int c0, nv = 64;
            if (rt < 64) c0 = 64 * rt; else if (rt < 119) c0 = 4104 + 64 * (rt - 64); else if (rt == 119) { c0 = 4096; nv = 8; } else c0 = 7624 + 64 * (rt - 120);
            tr_tile(p.w_in, 11720, c0, nv, kt * 64, (bf16_t*)(ws + OFF_WINT), 2048, rt * 64, kt * 64, tile);
        } else if (j < 6400) { const int q = j - 5888, rt = q >> 4, kt = q & 15; tr_tile(p.proj_m, 2048, rt * 64, 64, kt * 64, (bf16_t*)(ws + OFF_PMT), 1024, rt * 64, kt * 64, tile); }
        else if (j < 6912) { const int q = j - 6400, rt = q >> 4, kt = q & 15; tr_tile(p.proj_r, 2048, rt * 64, 64, kt * 64, (bf16_t*)(ws + OFF_PRT), 1024, rt * 64, kt * 64, tile); }
        else if (j < 7936) { const int q = j - 6912, rt = q >> 5, kt = q & 31; tr_tile(p.w_out, 2048, rt * 64, 64, kt * 64, (bf16_t*)(ws + OFF_WOT), 2048, rt * 64, kt * 64, tile); }
        else { const int q = j - 7936, rt = q >> 5, kt = q & 31; tr_tile(p.w_query, 2048, rt * 64, 64, kt * 64, (bf16_t*)(ws + OFF_WQT), 2048, rt * 64, kt * 64, tile); }
    }
    const int gt = bid * 512 + tid, gn = G * 512;
    bf16_t* WAT = (bf16_t*)(ws + OFF_WAT);
    for (int i = gt; i < 2048 * 256; i += gn) { const int r = i >> 8, k = i & 255; float v = 0.f;
        if (r < 1024) { if (k < 96) v = p.w2[k * 1024 + r]; } else { if (k >= 96 && k < 192) v = p.a2[(k - 96) * 1024 + (r - 1024)]; }
        WAT[i] = f2bf(v); }
    bf16_t* G2T = (bf16_t*)(ws + OFF_G2T);
    for (int i = gt; i < 1024 * 256; i += gn) { const int r = i >> 8, k = i & 255; G2T[i] = f2bf(p.g2[k * 1024 + r]); }
    bf16_t* SK = (bf16_t*)(ws + OFF_SUBK);
    for (int i = gt; i < 2 * 128 * 128; i += gn) SK[i] = f2bf(p.sub_keys[i]);
    if (gt == 0) *(unsigned*)(ws + OFF_SUBBAR) = 0u;
    for (int i = gt; i < XCD_BAR_WORDS; i += gn) ((unsigned*)(ws + OFF_XBAR))[i] = 0u;
}

__device__ __forceinline__ float bfel(const u32x4& w, int e) { const unsigned u = w[e >> 1]; return (e & 1) ? bfhi(u) : bflo(u); }
__device__ void phase_lora_prep(const KP& p) {
    const bf16_t* PR = (const bf16_t*)(p.ws + OFF_PR);
    bf16_t* AL = (bf16_t*)((unsigned char*)p.out + DO_ALORA);
    const int gt = blockIdx.x * 512 + threadIdx.x, gn = gridDim.x * 512;
    for (int i = gt; i < NT * 64; i += gn) {
        const int tok = i >> 6, g = i & 63;
        u32x4 o = (u32x4){0u, 0u, 0u, 0u};
        if (g < 24 || g >= 32) {
            const int sc = (g < 24) ? (3072 + 8 * g) : (3264 + 8 * (g - 32));
            const u32x4 cu = *(const u32x4*)(PR + (size_t)tok * LDPR + sc);
            u32x4 pv = (u32x4){0u, 0u, 0u, 0u};
            if ((tok & (SEQ - 1)) != 0) pv = *(const u32x4*)(PR + (size_t)(tok - 1) * LDPR + sc);
            const f32x4 m0 = *(const f32x4*)(p.mu + sc), m1 = *(const f32x4*)(p.mu + sc + 4);
            float f[8];
#pragma unroll
            for (int q = 0; q < 4; ++q) {
                const float c0 = bflo(cu[q]), c1 = bfhi(cu[q]), p0 = bflo(pv[q]), p1 = bfhi(pv[q]);
                const float mm0 = (q < 2) ? m0[2 * q] : m1[2 * q - 4], mm1 = (q < 2) ? m0[2 * q + 1] : m1[2 * q - 3];
                f[2 * q] = c0 + (p0 - c0) * mm0; f[2 * q + 1] = c1 + (p1 - c1) * mm1;
            }
            if (g < 12) {
#pragma unroll
                for (int q = 0; q < 8; ++q) f[q] = tanhf(f[q]);
            } else if (g >= 32) {
#pragma unroll
                for (int q = 0; q < 8; ++q) f[q] = sigm(f[q]);
            }
            o.x = cvt_pk_bf16(f[0], f[1]); o.y = cvt_pk_bf16(f[2], f[3]); o.z = cvt_pk_bf16(f[4], f[5]); o.w = cvt_pk_bf16(f[6], f[7]);
        }
        *(u32x4*)(AL + (size_t)tok * 512 + 8 * g) = o;
    }
    {
        const bf16_t* PM = (const bf16_t*)(p.ws + OFF_PM);
        bf16_t* QC = (bf16_t*)(p.ws + OFF_QC); bf16_t* KC = (bf16_t*)(p.ws + OFF_KC);
        for (int i = gt; i < (NT / 8) * 256; i += gn) {
            const int tb = i >> 8, col = (i & 255) * 8; const int tok0 = tb * 8, t0 = tok0 & (SEQ - 1);
            f32x4 cw[4][2];
#pragma unroll
            for (int j = 0; j < 4; ++j) { cw[j][0] = *(const f32x4*)(p.conv_w + j * 2048 + col); cw[j][1] = *(const f32x4*)(p.conv_w + j * 2048 + col + 4); }
            u32x4 raw[11];
#pragma unroll
            for (int q = 0; q < 11; ++q) { const bool neg = (t0 - 3 + q) < 0; u32x4 v = *(const u32x4*)(PM + (size_t)(tok0 + (neg ? 0 : q - 3)) * LDPM + col); if (neg) v = (u32x4){0u, 0u, 0u, 0u}; raw[q] = v; }
            const float scl = (col < 1024) ? 0.0625f : 1.f;
            bf16_t* dst = (col < 1024) ? (QC + (size_t)tok0 * 1024 + col) : (KC + (size_t)tok0 * 1024 + (col - 1024));
#pragma unroll
            for (int r = 0; r < 8; ++r) {
                float o[8];
#pragma unroll
                for (int e = 0; e < 8; ++e) {
                    const float c0 = (e < 4) ? cw[0][0][e] : cw[0][1][e - 4], c1 = (e < 4) ? cw[1][0][e] : cw[1][1][e - 4], c2 = (e < 4) ? cw[2][0][e] : cw[2][1][e - 4], c3 = (e < 4) ? cw[3][0][e] : cw[3][1][e - 4];
                    float sv = c0 * bfel(raw[r], e) + c1 * bfel(raw[r + 1], e) + c2 * bfel(raw[r + 2], e) + c3 * bfel(raw[r + 3], e);
                    o[e] = sv * sigm(sv) * scl;
                }
                u32x4 pk; pk.x = cvt_pk_bf16(o[0], o[1]); pk.y = cvt_pk_bf16(o[2], o[3]); pk.z = cvt_pk_bf16(o[4], o[5]); pk.w = cvt_pk_bf16(o[6], o[7]);
                *(u32x4*)(dst + (size_t)r * 1024) = pk;
            }
        }
    }
    {
        const int lane = threadIdx.x & 63, gw = blockIdx.x * 8 + (threadIdx.x >> 6), nw = gridDim.x * 8;
        float* GB = (float*)((unsigned char*)p.out + DO_GB); float* GA = (float*)((unsigned char*)p.out + DO_GA); float* GW = (float*)((unsigned char*)p.out + DO_GW);
        for (int task = gw; task < 1024; task += nw) {
            const int bh = task >> 6, c = task & 63, bb = bh >> 2, h = bh & 3; const size_t tok = (size_t)bb * SEQ + c * 64 + lane;
            const float iv = bf2f(PR[tok * LDPR + 3520 + h]) + p.b_i[h], fv = bf2f(PR[tok * LDPR + 3524 + h]) + p.b_f[h];
            float lf = fminf(fv, 0.f) - __logf(1.f + __expf(-fabsf(fv)));
#pragma unroll
            for (int d = 1; d < 64; d <<= 1) { const float y = __shfl_up(lf, d); if (lane >= d) lf += y; }
            const float bl = rlane(lf, 63);
            const int o = bh * SEQ + c * 64 + lane;
            GB[o] = lf; GA[o] = iv - lf; GW[o] = __expf(bl - lf + iv);
        }
    }
}

constexpr size_t OFF_YRAW = OFF_WINT, OFF_BON = OFF_WINT + 32 * MiB;
struct RwOps { f32x4 a0, a1, q0, q1, w0, w1, b0, b1, k0, k1; float v, br, kr; };
__device__ __forceinline__ f32x2_t lo2(f32x4 v) { return __builtin_shufflevector(v, v, 0, 1); }
__device__ __forceinline__ f32x2_t hi2(f32x4 v) { return __builtin_shufflevector(v, v, 2, 3); }
__device__ __forceinline__ f32x2_t fma2(f32x2_t a, f32x2_t b, f32x2_t c) { return __builtin_elementwise_fma(a, b, c); }
__device__ void rwkv_scan(const KP& p, int blk, LAS unsigned char* lds) {
    const int tid0 = tid_l();
    const int bh = blk >> 1, half = blk & 1, b = bh >> 4, h = bh & 15;
    constexpr int BUFB = 53760;
    const bf16_t* PR = (const bf16_t*)(p.ws + OFF_PR);
    const bf16_t* WLOG = (const bf16_t*)((const unsigned char*)p.out + DO_WLOG);
    const bf16_t* AG = (const bf16_t*)((const unsigned char*)p.out + DO_AG);
    bf16_t* YRAW = (bf16_t*)(p.ws + OFF_YRAW); float* BON = (float*)(p.ws + OFF_BON);
    const size_t tokbase = (size_t)b * SEQ;
    if (tid0 < 256) {
        const int rowl = tid0 >> 3, j8 = (tid0 & 7) * 8, row = 32 * half + rowl;
        f32x2_t S2[4];
#pragma unroll
        for (int k = 0; k < 4; ++k) S2[k] = (f32x2_t){0.f, 0.f};
        __syncthreads();
        for (int c = 0; c < 128; ++c) {
            const LAS float* bp = (const LAS float*)(lds + (c & 1) * BUFB);
            LAS float* yb = (LAS float*)(lds + (c & 1) * BUFB + 49408);
#define RW_LD(O, s) do { const LAS float* q_ = bp + (s) * 64 + j8; O.a0 = *(const LAS f32x4*)(q_); O.a1 = *(const LAS f32x4*)(q_ + 4); O.b0 = *(const LAS f32x4*)(q_ + 2048); O.b1 = *(const LAS f32x4*)(q_ + 2052); \
            O.w0 = *(const LAS f32x4*)(q_ + 4096); O.w1 = *(const LAS f32x4*)(q_ + 4100); O.k0 = *(const LAS f32x4*)(q_ + 6144); O.k1 = *(const LAS f32x4*)(q_ + 6148); \
            O.q0 = *(const LAS f32x4*)(q_ + 8192); O.q1 = *(const LAS f32x4*)(q_ + 8196); O.v = bp[10240 + (s) * 64 + row]; O.br = bp[12288 + (s)]; O.kr = bp[12320 + (s)]; } while (0)
#define RW_STEP(O, s) do { \
            f32x2_t pa = S2[0] * lo2(O.a0); f32x2_t py = S2[0] * lo2(O.q0); \
            pa = fma2(S2[1], hi2(O.a0), pa); py = fma2(S2[1], hi2(O.q0), py); pa = fma2(S2[2], lo2(O.a1), pa); py = fma2(S2[2], lo2(O.q1), py); \
            pa = fma2(S2[3], hi2(O.a1), pa); py = fma2(S2[3], hi2(O.q1), py); \
            float sa = pa.x + pa.y, yy = py.x + py.y; \
            sa += dppf<0xB1>(sa); yy += dppf<0xB1>(yy); sa += dppf<0x4E>(sa); yy += dppf<0x4E>(yy); sa += dppf<0x141>(sa); yy += dppf<0x141>(yy); \
            const f32x2_t sa2 = (f32x2_t){sa, sa}, vv2 = (f32x2_t){O.v, O.v}; \
            S2[0] = fma2(S2[0], lo2(O.w0), fma2(vv2, lo2(O.k0), sa2 * lo2(O.b0))); S2[1] = fma2(S2[1], hi2(O.w0), fma2(vv2, hi2(O.k0), sa2 * hi2(O.b0))); \
            S2[2] = fma2(S2[2], lo2(O.w1), fma2(vv2, lo2(O.k1), sa2 * lo2(O.b1))); S2[3] = fma2(S2[3], hi2(O.w1), fma2(vv2, hi2(O.k1), sa2 * hi2(O.b1))); \
            if ((tid0 & 7) == 0) yb[(s) * 32 + rowl] = yy + sa * O.br + O.v * O.kr; } while (0)
            RwOps o0, o1;
            RW_LD(o0, 0);
#pragma unroll 1
            for (int s = 0; s < 32; s += 2) {
                RW_LD(o1, s + 1);
                RW_STEP(o0, s);
                { const int sn = (s + 2 < 32) ? s + 2 : 31; RW_LD(o0, sn); }
                RW_STEP(o1, s + 1);
            }
#undef RW_LD
#undef RW_STEP
            __syncthreads();
        }
    } else {
        const int ht = tid0 - 256, tt = ht >> 3, cg8 = (ht & 7) * 8, ch = h * 64 + cg8;
        float mur[8], muk[8], muv[8], kkc[8], kac[8], rkc[8];
#pragma unroll
        for (int e = 0; e < 8; ++e) { mur[e] = p.mu[ch + e]; muk[e] = p.mu[1024 + ch + e]; muv[e] = p.mu[2048 + ch + e]; kkc[e] = p.k_k[ch + e]; kac[e] = p.k_a[ch + e]; rkc[e] = p.r_k[ch + e]; }
        for (int c = -1; c < 128; ++c) {
            if (c >= 1) {
                const LAS float* yb = (const LAS float*)(lds + ((c - 1) & 1) * BUFB + 49408);
                const int r4 = (ht & 7) * 4; const f32x4 y4 = *(const LAS f32x4*)(yb + tt * 32 + r4);
                u32x2 ov; ov.x = cvt_pk_bf16(y4[0], y4[1]); ov.y = cvt_pk_bf16(y4[2], y4[3]);
                *(u32x2*)(YRAW + (tokbase + (size_t)(c - 1) * 32 + tt) * 1024 + h * 64 + 32 * half + r4) = ov;
            }
            if (c + 1 < 128) {
                const int cn = c + 1, t = cn * 32 + tt; const size_t tok = tokbase + t;
                LAS float* bp = (LAS float*)(lds + (cn & 1) * BUFB);
                const bf16_t* pr_ = PR + tok * LDPR + ch;
                const u32x4 r4 = *(const u32x4*)pr_, k4 = *(const u32x4*)(pr_ + 1024), v4 = *(const u32x4*)(pr_ + 2048);
                u32x4 pr4 = (u32x4){0u, 0u, 0u, 0u}, pk4 = pr4, pv4 = pr4;
                if (t > 0) { pr4 = *(const u32x4*)(pr_ - LDPR); pk4 = *(const u32x4*)(pr_ - LDPR + 1024); pv4 = *(const u32x4*)(pr_ - LDPR + 2048); }
                const u32x4 w4 = *(const u32x4*)(WLOG + tok * 1024 + ch), a4 = *(const u32x4*)(AG + tok * 1024 + ch);
                float r[8], k[8], v[8], kk[8], av[8], dec[8];
                float n2 = 0.f;
#pragma unroll
                for (int e = 0; e < 8; ++e) {
                    const float rc = bfel(r4, e), kc = bfel(k4, e), vc = bfel(v4, e);
                    r[e] = rc + (bfel(pr4, e) - rc) * mur[e]; k[e] = kc + (bfel(pk4, e) - kc) * muk[e]; v[e] = vc + (bfel(pv4, e) - vc) * muv[e];
                    kk[e] = k[e] * kkc[e]; n2 += kk[e] * kk[e]; av[e] = bfel(a4, e); dec[e] = __expf(bfel(w4, e));
                }
                n2 = red8(n2);
                const float inv = 1.f / fmaxf(sqrtf(n2), 1e-12f);
                float br = 0.f, kr = 0.f, bon = 0.f;
                f32x4 oa[2], ob[2], ow[2], ok[2], oq[2], ovv[2];
#pragma unroll
                for (int e = 0; e < 8; ++e) {
                    const float kn = kk[e] * inv, k3 = k[e] * (1.f + (av[e] - 1.f) * kac[e]), bb = kn * av[e];
                    oa[e >> 2][e & 3] = -kn; ob[e >> 2][e & 3] = bb; ow[e >> 2][e & 3] = dec[e]; ok[e >> 2][e & 3] = k3; oq[e >> 2][e & 3] = dec[e] * r[e]; ovv[e >> 2][e & 3] = v[e];
                    br += bb * r[e]; kr += k3 * r[e]; bon += r[e] * k3 * rkc[e];
                }
                br = red8(br); kr = red8(kr); bon = red8(bon);
                LAS float* q_ = bp + tt * 64 + cg8;
#pragma unroll
                for (int i = 0; i < 2; ++i) { *(LAS f32x4*)(q_ + 4 * i) = oa[i]; *(LAS f32x4*)(q_ + 2048 + 4 * i) = ob[i]; *(LAS f32x4*)(q_ + 4096 + 4 * i) = ow[i]; *(LAS f32x4*)(q_ + 6144 + 4 * i) = ok[i];
                    *(LAS f32x4*)(q_ + 8192 + 4 * i) = oq[i]; *(LAS f32x4*)(q_ + 10240 + 4 * i) = ovv[i]; }
                if ((ht & 7) == 0) { bp[12288 + tt] = br; bp[12320 + tt] = kr; if (half == 0) BON[tok * 16 + h] = bon; }
            }
            __syncthreads();
        }
        {
            const LAS float* yb = (const LAS float*)(lds + (127 & 1) * BUFB + 49408);
            const int r4 = (ht & 7) * 4; const f32x4 y4 = *(const LAS f32x4*)(yb + tt * 32 + r4);
            u32x2 ov; ov.x = cvt_pk_bf16(y4[0], y4[1]); ov.y = cvt_pk_bf16(y4[2], y4[3]);
            *(u32x2*)(YRAW + (tokbase + (size_t)127 * 32 + tt) * 1024 + h * 64 + 32 * half + r4) = ov;
        }
    }
}

__device__ void phase_rwkv_post(const KP& p) {
    const bf16_t* PR = (const bf16_t*)(p.ws + OFF_PR);
    const bf16_t* GG = (const bf16_t*)((const unsigned char*)p.out + DO_GG);
    bf16_t* YR = (bf16_t*)(p.ws + OFF_YRAW); const float* BON = (const float*)(p.ws + OFF_BON);
    const int gt = blockIdx.x * 512 + tid_l(), gn = gridDim.x * 512;
    for (int i = gt; i < NT * 256; i += gn) {
        const int tok = i >> 8, h = (i >> 4) & 15, ch = h * 64 + (i & 15) * 4;
        const u32x2 y2 = *(const u32x2*)(YR + (size_t)tok * 1024 + ch), v2 = *(const u32x2*)(PR + (size_t)tok * LDPR + 2048 + ch), g2 = *(const u32x2*)(GG + (size_t)tok * 1024 + ch);
        u32x2 pv2 = (u32x2){0u, 0u};
        if ((tok & (SEQ - 1)) != 0) pv2 = *(const u32x2*)(PR + (size_t)(tok - 1) * LDPR + 2048 + ch);
        const float bon = BON[tok * 16 + h];
        const f32x4 muv = *(const f32x4*)(p.mu + 2048 + ch), lnw = *(const f32x4*)(p.ln_w + ch), lnb = *(const f32x4*)(p.ln_b + ch);
        const f32x4 y = (f32x4){bflo(y2.x), bfhi(y2.x), bflo(y2.y), bfhi(y2.y)}, vc = (f32x4){bflo(v2.x), bfhi(v2.x), bflo(v2.y), bfhi(v2.y)}, vp = (f32x4){bflo(pv2.x), bfhi(pv2.x), bflo(pv2.y), bfhi(pv2.y)};
        const f32x4 g = (f32x4){bflo(g2.x), bfhi(g2.x), bflo(g2.y), bfhi(g2.y)};
        const f32x4 v = vc + (vp - vc) * muv;
        const float mean = red16(y[0] + y[1] + y[2] + y[3]) * (1.f / 64.f);
        const f32x4 d = y - mean;
        const float var = red16(d[0] * d[0] + d[1] * d[1] + d[2] * d[2] + d[3] * d[3]) * (1.f / 64.f);
        const float rs = rsqrtf(var + 64e-5f);
        const f32x4 res = (d * rs * lnw + lnb + bon * v) * g;
        u32x2 ov; ov.x = cvt_pk_bf16(res[0], res[1]); ov.y = cvt_pk_bf16(res[2], res[3]);
        *(u32x2*)(YR + (size_t)tok * 1024 + ch) = ov;
    }
}

typedef short v4i16_t __attribute__((ext_vector_type(4)));
__device__ __forceinline__ bf16x8 tr_frag(const LAS unsigned char* base, int stride_b, int krow0, int ncol0, int lane) {
    const int g = lane >> 4, q = (lane & 15) >> 2, pp = lane & 3;
    const LAS unsigned char* a0 = base + (krow0 + 8 * g + q) * stride_b + (ncol0 + 4 * pp) * 2;
    const v4i16_t x = __builtin_amdgcn_ds_read_tr16_b64_v4i16((LAS v4i16_t*)a0), y = __builtin_amdgcn_ds_read_tr16_b64_v4i16((LAS v4i16_t*)(a0 + 4 * stride_b));
    return (bf16x8){x[0], x[1], x[2], x[3], y[0], y[1], y[2], y[3]};
}
__device__ void mlstm_run(const KP& p, int item, LAS unsigned char* lds) {
    const int tid0 = tid_l();
    const int bh = item >> 3, b = bh >> 2, h = bh & 3, dv0 = (item & 7) * 32;
    const size_t tokbase = (size_t)b * SEQ;
    LAS bf16_t* Qs = (LAS bf16_t*)(lds + 0);
    LAS bf16_t* Ks = (LAS bf16_t*)(lds + 33792);
    LAS bf16_t* Vs = (LAS bf16_t*)(lds + 67584);
    LAS bf16_t* Vws = (LAS bf16_t*)(lds + 74752);
    LAS bf16_t* Ss = (LAS bf16_t*)(lds + 81920);
    LAS bf16_t* CT0 = (LAS bf16_t*)(lds + 91136);
    LAS bf16_t* Os = (LAS bf16_t*)(lds + 141824);
    LAS float* BC = (LAS float*)(lds + 146944);
    LAS float* GAs = (LAS float*)(lds + 147200);
    const bf16_t* QC = (const bf16_t*)(p.ws + OFF_QC); const bf16_t* KC = (const bf16_t*)(p.ws + OFF_KC);
    bf16_t* PM = (bf16_t*)(p.ws + OFF_PM);
    const float* GB = (const float*)((const unsigned char*)p.out + DO_GB); const float* GA = (const float*)((const unsigned char*)p.out + DO_GA); const float* GW = (const float*)((const unsigned char*)p.out + DO_GW);
    for (int i = tid0; i < 2 * 48 * 264 / 2; i += 512) ((LAS unsigned*)CT0)[i] = 0u;
    for (int i = tid0; i < 2 * 64 * 56 / 2; i += 512) ((LAS unsigned*)Vs)[i] = 0u;
    __syncthreads();
    if (tid0 < 64) Vs[tid0 * 56 + 32] = (bf16_t)0x3F80;
    f32x4 cacc[6];
#pragma unroll
    for (int i = 0; i < 6; ++i) cacc[i] = (f32x4){0.f, 0.f, 0.f, 0.f};
    u32x4 q4[4], k4[4], vo4; float gb = 0.f, ga = 0.f, gwv = 0.f;
#define ML_LOAD(c, TID) do { const int row_ = (TID) >> 3, pc_ = (TID) & 7; const size_t tk_ = tokbase + (size_t)(c) * 64; \
        const bf16_t* qp_ = QC + (tk_ + row_) * 1024 + h * 256 + pc_ * 32; const bf16_t* kp_ = KC + (tk_ + row_) * 1024 + h * 256 + pc_ * 32; \
        _Pragma("unroll") for (int i_ = 0; i_ < 4; ++i_) { q4[i_] = *(const u32x4*)(qp_ + 8 * i_); k4[i_] = *(const u32x4*)(kp_ + 8 * i_); } \
        const int sg_ = (TID) & 255, s_ = sg_ >> 2, g_ = sg_ & 3; \
        vo4 = *(const u32x4*)(PM + (tk_ + s_) * LDPM + ((TID) < 256 ? 2048 : 3072) + h * 256 + dv0 + 8 * g_); \
        gwv = GW[bh * SEQ + (c) * 64 + s_]; \
        if ((TID) < 64) { gb = GB[bh * SEQ + (c) * 64 + (TID)]; ga = GA[bh * SEQ + (c) * 64 + (TID)]; } } while (0)
    ML_LOAD(0, tid0);
    __syncthreads();
    int cur = 0;
    for (int c = 0; c < 64; ++c) {
        int tid = tid0; asm volatile("" : "+v"(tid));
        const int lane = tid & 63, w = tid >> 6, fr = lane & 15, fq = lane >> 4;
        LAS bf16_t* CTc = CT0 + cur * (48 * 264); LAS bf16_t* CTn = CT0 + (cur ^ 1) * (48 * 264);
        {
            const int row = tid >> 3, pc = tid & 7;
#pragma unroll
            for (int i = 0; i < 4; ++i) { *(LAS u32x4*)(Qs + row * 264 + pc * 32 + 8 * i) = q4[i]; *(LAS u32x4*)(Ks + row * 264 + pc * 32 + 8 * i) = k4[i]; }
            const int sg = tid & 255, s = sg >> 2, g = sg & 3;
            if (tid < 256) {
                *(LAS u32x4*)(Vs + s * 56 + 8 * g) = vo4;
                u32x4 wv;
#pragma unroll
                for (int e = 0; e < 4; ++e) wv[e] = cvt_pk_bf16(bflo(vo4[e]) * gwv, bfhi(vo4[e]) * gwv);
                *(LAS u32x4*)(Vws + s * 56 + 8 * g) = wv;
                if (g == 0) Vws[s * 56 + 32] = f2bf(gwv);
            } else {
                if (c > 0) { const u32x4 yv = *(const LAS u32x4*)(Os + s * 40 + 8 * g); *(u32x4*)(PM + (tokbase + (size_t)(c - 1) * 64 + s) * LDPM + 3072 + h * 256 + dv0 + 8 * g) = yv; }
                *(LAS u32x4*)(Os + s * 40 + 8 * g) = vo4;
            }
            if (tid < 64) { BC[tid] = gb; GAs[tid] = ga; }
        }
        asm volatile("" ::: "memory");
        if (c + 1 < 64) ML_LOAD(c + 1, tid);
        asm volatile("" ::: "memory");
        __syncthreads();
        {
            const int mt = w >> 1, ntb = (w & 1) * 2;
            f32x4 s0 = (f32x4){0.f, 0.f, 0.f, 0.f}, s1 = s0;
#pragma unroll
            for (int ks = 0; ks < 8; ++ks) {
                const bf16x8 a = *(const LAS bf16x8*)(Qs + (16 * mt + fr) * 264 + 32 * ks + 8 * fq);
                const bf16x8 b0 = *(const LAS bf16x8*)(Ks + (16 * ntb + fr) * 264 + 32 * ks + 8 * fq);
                const bf16x8 b1 = *(const LAS bf16x8*)(Ks + (16 * (ntb + 1) + fr) * 264 + 32 * ks + 8 * fq);
                s0 = __builtin_amdgcn_mfma_f32_16x16x32_bf16(a, b0, s0, 0, 0, 0);
                s1 = __builtin_amdgcn_mfma_f32_16x16x32_bf16(a, b1, s1, 0, 0, 0);
            }
            const int sA = 16 * ntb + fr, sB = sA + 16;
            const float gA = GAs[sA], gB = GAs[sB];
#pragma unroll
            for (int j = 0; j < 4; ++j) {
                const int t = 16 * mt + 4 * fq + j; const float bt = BC[t];
                const float vA = (sA <= t) ? s0[j] * __expf(bt + gA) : 0.f, vB = (sB <= t) ? s1[j] * __expf(bt + gB) : 0.f;
                Ss[t * 72 + sA] = f2bf(vA); Ss[t * 72 + sB] = f2bf(vB);
            }
        }
        __syncthreads();
        {
            const int mt = w >> 1, nt = w & 1;
            f32x4 aA = (f32x4){0.f, 0.f, 0.f, 0.f}, aB = aA, xA = aA, xB = aA;
#pragma unroll
            for (int ks = 0; ks < 2; ++ks) {
                const bf16x8 a = *(const LAS bf16x8*)(Ss + (16 * mt + fr) * 72 + 32 * ks + 8 * fq);
                const bf16x8 bm = tr_frag((const LAS unsigned char*)Vs, 112, 32 * ks, 16 * nt, lane);
                const bf16x8 bx = tr_frag((const LAS unsigned char*)Vs, 112, 32 * ks, 32, lane);
                aA = __builtin_amdgcn_mfma_f32_16x16x32_bf16(a, bm, aA, 0, 0, 0);
                xA = __builtin_amdgcn_mfma_f32_16x16x32_bf16(a, bx, xA, 0, 0, 0);
            }
#pragma unroll
            for (int ks = 0; ks < 8; ++ks) {
                const bf16x8 a = *(const LAS bf16x8*)(Qs + (16 * mt + fr) * 264 + 32 * ks + 8 * fq);
                const bf16x8 bm = *(const LAS bf16x8*)(CTc + (16 * nt + fr) * 264 + 32 * ks + 8 * fq);
                const bf16x8 bx = *(const LAS bf16x8*)(CTc + (32 + fr) * 264 + 32 * ks + 8 * fq);
                aB = __builtin_amdgcn_mfma_f32_16x16x32_bf16(a, bm, aB, 0, 0, 0);
                xB = __builtin_amdgcn_mfma_f32_16x16x32_bf16(a, bx, xB, 0, 0, 0);
            }
#pragma unroll
            for (int j = 0; j < 4; ++j) {
                const int t = 16 * mt + 4 * fq + j; const float eb = __expf(BC[t]);
                const float num = aA[j] + eb * aB[j];
                const float den = __shfl(xA[j] + eb * xB[j], lane & 48);
                const float hv = num / fmaxf(fabsf(den), 1.f);
                LAS bf16_t* op = Os + t * 40 + 16 * nt + fr;
                *op = f2bf(hv * sigm(bf2f(*op)));
            }
            const float decay = __expf(BC[63]);
            bf16x8 bw[3][2];
#pragma unroll
            for (int n3 = 0; n3 < 3; ++n3)
#pragma unroll
                for (int ks = 0; ks < 2; ++ks) bw[n3][ks] = tr_frag((const LAS unsigned char*)Vws, 112, 32 * ks, 16 * n3, lane);
#pragma unroll
            for (int m2 = 0; m2 < 2; ++m2) {
                const int mtk = 2 * w + m2;
                const bf16x8 ka0 = tr_frag((const LAS unsigned char*)Ks, 528, 0, 16 * mtk, lane), ka1 = tr_frag((const LAS unsigned char*)Ks, 528, 32, 16 * mtk, lane);
#pragma unroll
                for (int n3 = 0; n3 < 3; ++n3) {
                    f32x4 cc = cacc[m2 * 3 + n3] * decay;
                    cc = __builtin_amdgcn_mfma_f32_16x16x32_bf16(ka0, bw[n3][0], cc, 0, 0, 0);
                    cc = __builtin_amdgcn_mfma_f32_16x16x32_bf16(ka1, bw[n3][1], cc, 0, 0, 0);
                    cacc[m2 * 3 + n3] = cc;
                    u32x2 pk; pk.x = cvt_pk_bf16(cc[0], cc[1]); pk.y = cvt_pk_bf16(cc[2], cc[3]);
                    *(LAS u32x2*)(CTn + (16 * n3 + fr) * 264 + 16 * mtk + 4 * fq) = pk;
                }
            }
        }
        cur ^= 1;
        __syncthreads();
    }
    if (tid0 >= 256) { const int sg = tid0 & 255, s = sg >> 2, g = sg & 3; const u32x4 yv = *(const LAS u32x4*)(Os + s * 40 + 8 * g);
        *(u32x4*)(PM + (tokbase + (size_t)63 * 64 + s) * LDPM + 3072 + h * 256 + dv0 + 8 * g) = yv; }
#undef ML_LOAD
}

__device__ void phase_norm2(const KP& p) {
    const int tid = tid_l(), lane = tid & 63, G = gridDim.x, bid = blockIdx.x;
    rmsnorm_rows(p.out, p.g_ffn, (bf16_t*)(p.ws + OFF_XN2), bid * 8 + (tid >> 6), G * 8, lane);
}
__device__ void convert_tables(const KP& p, int gw, int nw) {
    const int lane = tid_l() & 63;
    for (int tb = 0; tb < 2; ++tb) {
        const float* src = tb ? p.peer_v : p.peer_u; unsigned char* dst = p.ws + (tb ? OFF_PV : OFF_PU); float* sc = (float*)(p.ws + (tb ? OFF_SCV : OFF_SCU));
        for (int row = gw; row < 16384; row += nw) {
            const float* sp = src + (size_t)row * DM + lane * 16;
            f32x4 v[8]; float am = 0.f;
#pragma unroll
            for (int i = 0; i < 2; ++i)
#pragma unroll
                for (int q = 0; q < 4; ++q) { v[i * 4 + q] = *(const f32x4*)(sp + i * 1024 + q * 4);
                    am = fmaxf(am, fmaxf(fmaxf(fabsf(v[i * 4 + q][0]), fabsf(v[i * 4 + q][1])), fmaxf(fabsf(v[i * 4 + q][2]), fabsf(v[i * 4 + q][3])))); }
            const unsigned amu = wave_max_u32(__float_as_uint(am));
            const float amax = __uint_as_float(amu);
            float scl = 1.f;
            if (amax > 0.f) scl = exp2f(floorf(log2f(240.f / amax)));
            if (lane == 0) sc[row] = 1.f / scl;
#pragma unroll
            for (int i = 0; i < 2; ++i) { u32x4 o;
#pragma unroll
                for (int q = 0; q < 4; ++q) { const f32x4 t = v[i * 4 + q] * scl; int w = __builtin_amdgcn_cvt_pk_fp8_f32(t[0], t[1], 0, false); w = __builtin_amdgcn_cvt_pk_fp8_f32(t[2], t[3], w, true); o[q] = (unsigned)w; }
                *(u32x4*)(dst + (size_t)row * 8192 + i * 1024 + lane * 16) = o; }
        }
    }
}

__device__ void phase_peer(const KP& p, LAS unsigned char* lds) {
    const int tid = tid_l(), lane = tid & 63, w = tid >> 6, fr = lane & 15, fq = lane >> 4;
    LAS unsigned* KEYS = (LAS unsigned*)lds;
    LAS int* TI = (LAS int*)(lds + 32768);
    LAS float* TG = (LAS float*)(lds + 49152);
    const bf16_t* Q = (const bf16_t*)(p.ws + OFF_Q);
    const bf16_t* SK = (const bf16_t*)(p.ws + OFF_SUBK);
    const bf16_t* XN2 = (const bf16_t*)(p.ws + OFF_XN2);
    const unsigned char* PU = p.ws + OFF_PU; const unsigned char* PV = p.ws + OFF_PV;
    const float* SCU = (const float*)(p.ws + OFF_SCU); const float* SCV = (const float*)(p.ws + OFF_SCV);
    float* out = p.out;
    LAS int* IJ = (LAS int*)(lds + 65536);
    int ci[4], cj[4]; bool cv[4];
#pragma unroll
    for (int m = 0; m < 4; ++m) { const int e = m * 16 + fr; int i = 0, base = 0;
        for (; i < 16; ++i) { const int cnt = 16 / (i + 1); if (e < base + cnt) break; base += cnt; }
        cv[m] = i < 16; ci[m] = cv[m] ? i : 0; cj[m] = cv[m] ? e - base : 0;
        if (w == 0 && fq == 0) IJ[e] = cv[m] ? ci[m] * 16 + cj[m] : 0; }
    const int pp_ = w >> 2, ntb = (w & 3) * 2;
    bf16x8 bfr[2][4];
#pragma unroll
    for (int n = 0; n < 2; ++n)
#pragma unroll
        for (int ks = 0; ks < 4; ++ks) bfr[n][ks] = *(const bf16x8*)(SK + (size_t)(pp_ * 128 + 16 * (ntb + n) + fr) * 128 + 32 * ks + 8 * fq);
    __syncthreads();
    for (int tile = blockIdx.x; tile < NT / 32; tile += gridDim.x) {
        const int tk0 = tile * 32;
        bf16x8 afn[2][4];
#pragma unroll
        for (int mt = 0; mt < 2; ++mt)
#pragma unroll
            for (int ks = 0; ks < 4; ++ks) afn[mt][ks] = *(const bf16x8*)(Q + (size_t)(tk0 + 16 * mt + fr) * DM + pp_ * 128 + 32 * ks + 8 * fq);
        for (int h = 0; h < 8; ++h) {
            {
                bf16x8 af[2][4];
#pragma unroll
                for (int mt = 0; mt < 2; ++mt)
#pragma unroll
                    for (int ks = 0; ks < 4; ++ks) af[mt][ks] = afn[mt][ks];
                if (h + 1 < 8) {
#pragma unroll
                    for (int mt = 0; mt < 2; ++mt)
#pragma unroll
                        for (int ks = 0; ks < 4; ++ks) afn[mt][ks] = *(const bf16x8*)(Q + (size_t)(tk0 + 16 * mt + fr) * DM + (h + 1) * 256 + pp_ * 128 + 32 * ks + 8 * fq);
                }
                f32x4 acc[2][2];
#pragma unroll
                for (int a_ = 0; a_ < 2; ++a_)
#pragma unroll
                    for (int b_ = 0; b_ < 2; ++b_) acc[a_][b_] = (f32x4){0.f, 0.f, 0.f, 0.f};
#pragma unroll
                for (int ks = 0; ks < 4; ++ks)
#pragma unroll
                    for (int mt = 0; mt < 2; ++mt)
#pragma unroll
                        for (int n = 0; n < 2; ++n) acc[mt][n] = __builtin_amdgcn_mfma_f32_16x16x32_bf16(af[mt][ks], bfr[n][ks], acc[mt][n], 0, 0, 0);
#pragma unroll
                for (int mt = 0; mt < 2; ++mt)
#pragma unroll
                    for (int n = 0; n < 2; ++n)
#pragma unroll
                        for (int j = 0; j < 4; ++j) { const int tokl = 16 * mt + 4 * fq + j, key = 16 * (ntb + n) + fr;
                            KEYS[(tokl * 2 + pp_) * 128 + key] = (ordf(acc[mt][n][j]) & ~0x7Fu) | (unsigned)key; }
            }
            __syncthreads();
            {
                const int tokl = 4 * w + fq, rb = lane & 48;
                unsigned top[2];
#pragma unroll
                for (int pp = 0; pp < 2; ++pp) {
                    unsigned kx[8];
#pragma unroll
                    for (int m = 0; m < 8; ++m) kx[m] = KEYS[(tokl * 2 + pp) * 128 + fr + 16 * m];
                    unsigned tp = 0u;
                    for (int it = 0; it < 16; ++it) {
                        unsigned M = max(max(max(kx[0], kx[1]), max(kx[2], kx[3])), max(max(kx[4], kx[5]), max(kx[6], kx[7])));
                        M = max(M, dppu<0xB1>(M)); M = max(M, dppu<0x4E>(M)); M = max(M, dppu<0x141>(M)); M = max(M, dppu<0x140>(M));
                        if (fr == it) tp = M;
#pragma unroll
                        for (int m = 0; m < 8; ++m) kx[m] = (kx[m] == M) ? 0u : kx[m];
                    }
                    top[pp] = tp;
                }
                unsigned cnd[4];
#pragma unroll
                for (int m = 0; m < 4; ++m) {
                    const float v1 = unordf((unsigned)__shfl((int)top[0], rb + ci[m]) & ~0x7Fu), v2 = unordf((unsigned)__shfl((int)top[1], rb + cj[m]) & ~0x7Fu);
                    cnd[m] = cv[m] ? ((ordf(v1 + v2) & ~0x3Fu) | (unsigned)(m * 16 + fr)) : 0u;
                }
                unsigned best = 0u;
                for (int it = 0; it < 16; ++it) {
                    unsigned M = max(max(cnd[0], cnd[1]), max(cnd[2], cnd[3]));
                    M = max(M, dppu<0xB1>(M)); M = max(M, dppu<0x4E>(M)); M = max(M, dppu<0x141>(M)); M = max(M, dppu<0x140>(M));
                    if (fr == it) best = M;
#pragma unroll
                    for (int m = 0; m < 4; ++m) cnd[m] = (cnd[m] == M) ? 0u : cnd[m];
                }
                const int ij = IJ[best & 0x3Fu];
                const float bv = unordf(best & ~0x3Fu);
                const int e1 = __shfl((int)top[0], rb + (ij >> 4)) & 0x7F, e2 = __shfl((int)top[1], rb + (ij & 15)) & 0x7F;
                const float mx = __shfl(bv, rb);
                const float ev = __expf(bv - mx);
                const float sum = red16(ev);
                TI[tokl * 128 + h * 16 + fr] = e1 * 128 + e2; TG[tokl * 128 + h * 16 + fr] = ev / sum;
            }
            __syncthreads();
        }
        for (int q = 0; q < 4; ++q) {
            const int tokl = 4 * w + q; const size_t tok = (size_t)tk0 + tokl;
            float xv[32], acc[32];
#pragma unroll
            for (int i = 0; i < 2; ++i)
#pragma unroll
                for (int hh = 0; hh < 2; ++hh) { const u32x4 x4 = *(const u32x4*)(XN2 + tok * DM + i * 1024 + lane * 16 + hh * 8);
#pragma unroll
                    for (int e = 0; e < 4; ++e) { xv[i * 16 + hh * 8 + 2 * e] = bflo(x4[e]); xv[i * 16 + hh * 8 + 2 * e + 1] = bfhi(x4[e]); } }
#pragma unroll
            for (int i = 0; i < 32; ++i) acc[i] = 0.f;
#pragma unroll 4
            for (int e = 0; e < 128; ++e) {
                const int idx = __builtin_amdgcn_readfirstlane(TI[tokl * 128 + e]);
                const float gate = __builtin_bit_cast(float, __builtin_amdgcn_readfirstlane(__builtin_bit_cast(int, TG[tokl * 128 + e])));
                const unsigned char* up = PU + (size_t)idx * 8192 + lane * 16; const unsigned char* vp = PV + (size_t)idx * 8192 + lane * 16;
                u32x4 u4[2], v4[2];
                u4[0] = *(const u32x4*)up; u4[1] = *(const u32x4*)(up + 1024); v4[0] = *(const u32x4*)vp; v4[1] = *(const u32x4*)(vp + 1024);
                const float su = SCU[idx], sv = SCV[idx];
                float d0 = 0.f, d1 = 0.f, d2 = 0.f, d3 = 0.f;
#pragma unroll
                for (int i = 0; i < 2; ++i)
#pragma unroll
                    for (int k = 0; k < 4; ++k) { const f32x2_t lo = __builtin_amdgcn_cvt_pk_f32_fp8((int)u4[i][k], false), hi = __builtin_amdgcn_cvt_pk_f32_fp8((int)u4[i][k], true);
                        d0 += xv[i * 16 + 4 * k] * lo.x; d1 += xv[i * 16 + 4 * k + 1] * lo.y; d2 += xv[i * 16 + 4 * k + 2] * hi.x; d3 += xv[i * 16 + 4 * k + 3] * hi.y; }
                const float act = wave_sum((d0 + d1) + (d2 + d3)) * su;
                const float coef = gate * 0.5f * act * (1.f + erff(act * 0.70710678118f)) * sv;
#pragma unroll
                for (int i = 0; i < 2; ++i)
#pragma unroll
                    for (int k = 0; k < 4; ++k) { const f32x2_t lo = __builtin_amdgcn_cvt_pk_f32_fp8((int)v4[i][k], false), hi = __builtin_amdgcn_cvt_pk_f32_fp8((int)v4[i][k], true);
                        acc[i * 16 + 4 * k] += coef * lo.x; acc[i * 16 + 4 * k + 1] += coef * lo.y; acc[i * 16 + 4 * k + 2] += coef * hi.x; acc[i * 16 + 4 * k + 3] += coef * hi.y; }
            }
            float ss = 0.f;
            float* orow = out + tok * DM + lane * 16;
#pragma unroll
            for (int i = 0; i < 2; ++i)
#pragma unroll
                for (int k = 0; k < 4; ++k) { const f32x4 h0 = *(const f32x4*)(orow + i * 1024 + 4 * k);
#pragma unroll
                    for (int j = 0; j < 4; ++j) { acc[i * 16 + 4 * k + j] += h0[j]; ss += acc[i * 16 + 4 * k + j] * acc[i * 16 + 4 * k + j]; } }
            ss = wave_sum(ss);
            const float r = rsqrtf(ss * (1.f / DM) + 1e-6f);
#pragma unroll
            for (int i = 0; i < 2; ++i)
#pragma unroll
                for (int k = 0; k < 4; ++k) { const f32x4 g0 = *(const f32x4*)(p.g_final + i * 1024 + lane * 16 + 4 * k); f32x4 o0;
#pragma unroll
                    for (int j = 0; j < 4; ++j) o0[j] = acc[i * 16 + 4 * k + j] * r * g0[j];
                    *(f32x4*)(orow + i * 1024 + 4 * k) = o0; }
        }
        __syncthreads();
    }
}

#define XB_TMO      128
#define XB_XCNT(j)  (256  + 64 * (j))
#define XB_XSUB(j)  (1280 + 64 * (j))
#define XB_XGEN(j)  (2304 + 64 * (j))
#define XB_TOP      3328
#define XB_TOPGEN   3392
#define XB_SPIN_CAP (1u << 18)
__device__ __forceinline__ unsigned xb_ld(unsigned* p)              { return __hip_atomic_load(p, __ATOMIC_RELAXED, __HIP_MEMORY_SCOPE_AGENT); }
__device__ __forceinline__ unsigned xb_add(unsigned* p, unsigned v) { return __hip_atomic_fetch_add(p, v, __ATOMIC_RELAXED, __HIP_MEMORY_SCOPE_AGENT); }
__device__ __forceinline__ unsigned xb_xcc_id() { return (unsigned)__builtin_amdgcn_s_getreg((3 << 11) | 20) & 0xFu; }
#define XB_SPIN(cond, bar) do { unsigned _sp = 0; while (cond) { __builtin_amdgcn_s_sleep(1); \
    if ((++_sp & 255u) == 0u) { if (xb_ld(&(bar)[XB_TMO])) break; if (_sp > XB_SPIN_CAP) { atomicAdd(&(bar)[XB_TMO], 1u); break; } } } } while (0)
struct XcdBarrier { unsigned* bar; unsigned x; volatile LAS unsigned* st; };
__device__ __forceinline__ XcdBarrier xcd_barrier_post(unsigned* bar, volatile LAS unsigned* st) {
    XcdBarrier b; b.bar = bar; b.x = xb_xcc_id(); b.st = st;
    if (threadIdx.x == 0) (void)xb_add(&bar[XB_XCNT(b.x)], 1u);
    return b;
}
__device__ __forceinline__ void xcd_barrier_complete(unsigned* bar, unsigned x, unsigned& nloc, unsigned& nx) {
    const unsigned G = gridDim.x * gridDim.y * gridDim.z;
    unsigned sum, cnt, mine, sp = 0u;
    for (;;) {
        sum = 0u; cnt = 0u; mine = 0u;
#pragma unroll
        for (unsigned j = 0; j < 16; ++j) { const unsigned c = xb_ld(&bar[XB_XCNT(j)]); sum += c; cnt += (c > 0u) ? 1u : 0u; mine = (j == x) ? c : mine; }
        if (sum == G) break;
        __builtin_amdgcn_s_sleep(1);
        if ((++sp & 255u) == 0u) { if (xb_ld(&bar[XB_TMO])) break; if (sp > XB_SPIN_CAP) { atomicAdd(&bar[XB_TMO], 1u); break; } }
    }
    nloc = mine > 0u ? mine : 1u; nx = cnt > 0u ? cnt : 1u;
}
__device__ __forceinline__ void xcd_barrier(const XcdBarrier& b) {
    asm volatile("s_waitcnt vmcnt(0)" ::: "memory");
    __syncthreads();
    if (threadIdx.x == 0) {
        unsigned* bar = b.bar;
        __builtin_amdgcn_s_waitcnt(0);
        unsigned nloc = b.st[0], nx = b.st[1];
        if (nloc == 0u) { xcd_barrier_complete(bar, b.x, nloc, nx); b.st[0] = nloc; b.st[1] = nx; }
        const unsigned old = xb_add(&bar[XB_XSUB(b.x)], 1u);
        const unsigned gen = old / nloc;
        if (old + 1u == (gen + 1u) * nloc) {
            __builtin_amdgcn_fence(__ATOMIC_RELEASE, "agent");
            asm volatile("s_waitcnt vmcnt(0)" ::: "memory");
            const unsigned og = xb_add(&bar[XB_TOP], 1u);
            const unsigned tg = og / nx;
            if (og + 1u == (tg + 1u) * nx) xb_add(&bar[XB_TOPGEN], 1u);
            else XB_SPIN(xb_ld(&bar[XB_TOPGEN]) == tg, bar);
            __builtin_amdgcn_fence(__ATOMIC_ACQUIRE, "agent");
            xb_add(&bar[XB_XGEN(b.x)], 1u);
            asm volatile("s_waitcnt vmcnt(0)" ::: "memory");
        } else {
            XB_SPIN(xb_ld(&bar[XB_XGEN(b.x)]) == gen, bar);
            __builtin_amdgcn_fence(__ATOMIC_ACQUIRE, "agent");
            asm volatile("s_waitcnt vmcnt(0)" ::: "memory");
        }
    }
    __syncthreads();
}

__global__ void __launch_bounds__(512) fwd_megakernel(KP p) {
    extern __shared__ __attribute__((aligned(16))) unsigned char smem[];
    LAS unsigned char* lds = (LAS unsigned char*)smem;
    cg::grid_group grid = cg::this_grid();
#define GRID_SYNC() do { asm volatile("s_waitcnt vmcnt(0) lgkmcnt(0)" ::: "memory"); __syncthreads(); grid.sync(); asm volatile("" ::: "memory"); } while (0)
    const int G = gridDim.x, bid = blockIdx.x;
    unsigned char* ws = p.ws; unsigned char* dob = (unsigned char*)p.out;

#define RUN_GEMM(MODE, ...) do { unsigned char* ws = lp(p.ws); unsigned char* dob = lp((unsigned char*)p.out); const pg8::Gemm g_ = pg8::Gemm{__VA_ARGS__}; pg8::StaticOrder S_; S_.init(g_.M, g_.N, G, bid); \
        const pg8::Epi<MODE> E_{ws, dob, p.x, p.w0, p.a0}; pg8::gemm_phase(lds, g_, S_, E_); } while (0)
    volatile LAS unsigned* xst = (volatile LAS unsigned*)(lds + 150512);
    if (threadIdx.x < 4) xst[threadIdx.x] = 0u;
    phase_prep(p, lds);
    GRID_SYNC();
    const XcdBarrier xbar = xcd_barrier_post((unsigned*)(p.ws + OFF_XBAR), xst);
#define XSYNC() do { xcd_barrier(xbar); asm volatile("" ::: "memory"); } while (0)
    RUN_GEMM(0, (const bf16_t*)(ws + OFF_XN), (const bf16_t*)(ws + OFF_WINT), NT, N1, 2048, 2048, 2048);
    XSYNC();
    phase_lora_prep(p);
    XSYNC();
    RUN_GEMM(1, (const bf16_t*)(dob + DO_ALORA), (const bf16_t*)(ws + OFF_WAT), NT, 2048, 256, 512, 256);
    RUN_GEMM(2, (const bf16_t*)(dob + DO_ALORA) + 256, (const bf16_t*)(ws + OFF_G2T), NT, 1024, 256, 512, 256);
    XSYNC();
    if (bid < 128) rwkv_scan(p, bid, lds);
    else {
        mlstm_run(p, bid - 128, lds);
        convert_tables(p, (bid - 128) * 8 + (tid_l() >> 6), 1024);
        __builtin_amdgcn_fence(__ATOMIC_RELEASE, "agent"); __syncthreads();
        if (threadIdx.x == 0) { unsigned* cnt = (unsigned*)(p.ws + OFF_SUBBAR); __hip_atomic_fetch_add(cnt, 1u, __ATOMIC_RELAXED, __HIP_MEMORY_SCOPE_AGENT);
            while (__hip_atomic_load(cnt, __ATOMIC_RELAXED, __HIP_MEMORY_SCOPE_AGENT) < 128u) __builtin_amdgcn_s_sleep(2); }
        __syncthreads(); __builtin_amdgcn_fence(__ATOMIC_ACQUIRE, "agent");
        { unsigned char* ws = lp(p.ws); unsigned char* dob = lp((unsigned char*)p.out); const pg8::Gemm g_ = pg8::Gemm{(const bf16_t*)(ws + OFF_PM) + 3072, (const bf16_t*)(ws + OFF_PMT), NT, 2048, 1024, LDPM, 1024};
          pg8::StaticOrder S_; S_.init(g_.M, g_.N, 128, bid - 128); const pg8::Epi<3> E_{ws, dob, p.x, p.w0, p.a0}; pg8::gemm_phase(lds, g_, S_, E_); }
    }
    XSYNC();
    phase_rwkv_post(p);
    XSYNC();
    RUN_GEMM(4, (const bf16_t*)(ws + OFF_YR), (const bf16_t*)(ws + OFF_PRT), NT, 2048, 1024, 1024, 1024);
    XSYNC();
    RUN_GEMM(5, (const bf16_t*)(ws + OFF_PG), (const bf16_t*)(ws + OFF_WOT), NT, 2048, 2048, LDPG, 2048);
    XSYNC();
    phase_norm2(p);
    XSYNC();
    RUN_GEMM(6, (const bf16_t*)(ws + OFF_XN2), (const bf16_t*)(ws + OFF_WQT), NT, 2048, 2048, 2048, 2048);
    XSYNC();
    phase_peer(p, lds);
}

extern "C" void kernel_launch(void* const* d_in, const int* in_sizes, int n_in, void* d_out, int out_size, void* d_ws, size_t ws_size, hipStream_t stream) {
    static int grid_blocks = 0;
    if (grid_blocks == 0) {
        if (n_in != 26 || out_size != NT * DM || ws_size < WS_NEED) { fprintf(stderr, "kernel_launch: unexpected shapes: n_in %d out %d ws %zu (need %zu)\n", n_in, out_size, ws_size, (size_t)WS_NEED); grid_blocks = -1; return; }
        int dev = 0, cus = 0, per_cu = 0;
        hipGetDevice(&dev);
        hipDeviceGetAttribute(&cus, hipDeviceAttributeMultiprocessorCount, dev);
        if (hipFuncSetAttribute((const void*)fwd_megakernel, hipFuncAttributeMaxDynamicSharedMemorySize, LDS_BYTES) != hipSuccess) { fprintf(stderr, "kernel_launch: hipFuncSetAttribute failed\n"); grid_blocks = -1; return; }
        hipOccupancyMaxActiveBlocksPerMultiprocessor(&per_cu, (const void*)fwd_megakernel, 512, LDS_BYTES);
        if (per_cu < 1) { fprintf(stderr, "kernel_launch: occupancy query says %d blocks per CU\n", per_cu); per_cu = 1; }
        (void)hipGetLastError();
        grid_blocks = cus * 1;
    }
    if (grid_blocks < 0) return;
    KP p{};
    const float** pp = (const float**)&p;
    for (int i = 0; i < 26; ++i) pp[i] = (const float*)d_in[i];
    p.out = (float*)d_out; p.ws = (unsigned char*)d_ws;
    void* args[] = {&p};
    hipError_t e = hipLaunchCooperativeKernel((void*)fwd_megakernel, dim3(grid_blocks), dim3(512), args, LDS_BYTES, stream);
    if (e != hipSuccess) fprintf(stderr, "cooperative launch failed: %s (grid %d)\n", hipGetErrorString(e), grid_blocks);
}
```

```cpp
#include <hip/hip_runtime.h>
#include <hip/hip_cooperative_groups.h>
#include <cstdio>
namespace cg = cooperative_groups;

#define LAS __attribute__((address_space(3)))
typedef unsigned short bf16_t;
typedef short bf16x8 __attribute__((ext_vector_type(8)));
typedef float f32x4 __attribute__((ext_vector_type(4)));
typedef unsigned u32x4 __attribute__((ext_vector_type(4)));
typedef unsigned u32x2 __attribute__((ext_vector_type(2)));

constexpr int NT = 16384, SEQ = 4096, DM = 2048;
constexpr int LDPM = 4096, LDPR = 3584, LDPG = 4096, N1 = 11776;
constexpr size_t MiB = 1024ull * 1024ull;
constexpr size_t OFF_PM = 0, OFF_PR = 128 * MiB, OFF_PG = 240 * MiB, OFF_XN = 368 * MiB, OFF_WINT = 432 * MiB, OFF_WTS = 478 * MiB;
constexpr size_t OFF_PMT = OFF_WTS, OFF_PRT = OFF_WTS + 4 * MiB, OFF_WOT = OFF_WTS + 8 * MiB, OFF_WQT = OFF_WTS + 16 * MiB, OFF_WAT = OFF_WTS + 24 * MiB,
                 OFF_G2T = OFF_WTS + 25 * MiB, OFF_SUBK = OFF_WTS + 25 * MiB + 512 * 1024, WS_NEED = OFF_WTS + 26 * MiB;
constexpr size_t OFF_QC = OFF_XN, OFF_KC = OFF_XN + 32 * MiB, OFF_YR = OFF_WINT, OFF_Q = OFF_XN, OFF_XN2 = OFF_PR, OFF_PU = OFF_PM, OFF_PV = OFF_PM + 2048, OFF_SUBBAR = OFF_SUBK + 192 * 1024, OFF_XBAR = OFF_SUBBAR + 256,
                 OFF_SCU = OFF_SUBK + 64 * 1024, OFF_SCV = OFF_SCU + 64 * 1024;
constexpr size_t DO_WLOG = 0, DO_AG = 32 * MiB, DO_GG = 64 * MiB, DO_ALORA = 96 * MiB, DO_GB = 112 * MiB, DO_GA = DO_GB + 256 * 1024, DO_GW = DO_GA + 256 * 1024;
constexpr int LDS_BYTES = 150528;
#define XCD_BAR_WORDS 3456

struct KP {
    const float *x, *g_mix, *w_in, *conv_w, *b_i, *b_f, *mu, *w0, *w2, *a0, *a2, *g2, *k_k, *k_a, *r_k, *ln_w, *ln_b, *proj_m, *proj_r, *w_out, *g_ffn,
        *w_query, *sub_keys, *peer_u, *peer_v, *g_final;
    float* out; unsigned char* ws;
};

typedef __bf16 bf16x2_t __attribute__((ext_vector_type(2)));
typedef float f32x2_t __attribute__((ext_vector_type(2)));
__device__ __forceinline__ unsigned cvt_pk_bf16(float lo, float hi) { f32x2_t v = {lo, hi}; bf16x2_t b = __builtin_convertvector(v, bf16x2_t); return __builtin_bit_cast(unsigned, b); }
__device__ __forceinline__ bf16_t f2bf(float f) { return (bf16_t)(cvt_pk_bf16(f, 0.f) & 0xffffu); }
__device__ __forceinline__ float bf2f(bf16_t h) { return __uint_as_float((unsigned)h << 16); }
__device__ __forceinline__ float bflo(unsigned u) { return __uint_as_float(u << 16); }
__device__ __forceinline__ float bfhi(unsigned u) { return __uint_as_float(u & 0xffff0000u); }
__device__ __forceinline__ float sigm(float x) { return __builtin_amdgcn_rcpf(1.f + __expf(-x)); }
template <int CTRL> __device__ __forceinline__ float dppf(float v) { return __builtin_bit_cast(float, __builtin_amdgcn_update_dpp(0, __builtin_bit_cast(int, v), CTRL, 0xF, 0xF, true)); }
template <int CTRL> __device__ __forceinline__ unsigned dppu(unsigned v) { return (unsigned)__builtin_amdgcn_update_dpp(0, (int)v, CTRL, 0xF, 0xF, true); }
__device__ __forceinline__ float red4(float v) { v += dppf<0xB1>(v); v += dppf<0x4E>(v); return v; }
__device__ __forceinline__ float red8(float v) { v = red4(v); v += dppf<0x141>(v); return v; }
__device__ __forceinline__ float red16(float v) { v = red8(v); v += dppf<0x140>(v); return v; }
__device__ __forceinline__ float rlane(float v, int l) { return __builtin_bit_cast(float, __builtin_amdgcn_readlane(__builtin_bit_cast(int, v), l)); }
__device__ __forceinline__ float wave_sum(float v) { v = red16(v); return rlane(v, 0) + rlane(v, 16) + rlane(v, 32) + rlane(v, 48); }
__device__ __forceinline__ unsigned wave_max_u32(unsigned v) {
    v = max(v, dppu<0xB1>(v)); v = max(v, dppu<0x4E>(v)); v = max(v, dppu<0x141>(v)); v = max(v, dppu<0x140>(v));
    unsigned a = (unsigned)__builtin_amdgcn_readlane((int)v, 0), b = (unsigned)__builtin_amdgcn_readlane((int)v, 16), c = (unsigned)__builtin_amdgcn_readlane((int)v, 32), d = (unsigned)__builtin_amdgcn_readlane((int)v, 48);
    return max(max(a, b), max(c, d));
}
__device__ __forceinline__ unsigned ordf(float f) { unsigned u = __float_as_uint(f); return (u & 0x80000000u) ? ~u : (u | 0x80000000u); }
__device__ __forceinline__ float unordf(unsigned k) { return __uint_as_float((k & 0x80000000u) ? (k ^ 0x80000000u) : ~k); }

__device__ __forceinline__ int tid_l() { int t = threadIdx.x; asm volatile("" : "+v"(t)); return t; }
template <class T> __device__ __forceinline__ T* lp(T* q) { asm volatile("" : "+s"(q)); return q; }
namespace pg8 {
constexpr int BM = 256, BK = 64, HALF = 128, HTB = HALF * BK * 2, STAGE_BYTES = 8 * HTB, NXCD = 8, WGM = 8;
__device__ __forceinline__ int lds_byte(int r, int c) { const int st = (r >> 4) * 2 + (c >> 5), rr = r & 15, cc = c & 31, ob = rr * 64 + cc * 2; return st * 1024 + (ob ^ (((ob >> 9) & 1) << 5)); }
__device__ __forceinline__ void stage_rc(int b, int& R, int& C) { const int st = b / 1024, sb = b % 1024, swz = sb ^ (((sb >> 9) & 1) << 5); R = (st >> 1) * 16 + swz / 64; C = (st & 1) * 32 + (swz % 64) / 2; }
__device__ __forceinline__ int perm32(int rho) { const int n = rho >> 4, i = rho & 15; return 8 * (i >> 2) + 4 * n + (i & 3); }
struct Unit { int pm, pn; };
struct Gemm { const bf16_t* A; const bf16_t* Bt; int M, N, K, lda, ldb; };
struct StaticOrder {
    int nM, nN, nwg, G, c;
    __device__ void init(int M, int N, int G_, int c_) { nM = M / BM; nN = N / BM; nwg = nM * nN; G = G_; c = c_; }
    __device__ bool next(int i, Unit& u) const {
        const long L = (long)i * G + c; if (L >= nwg) return false;
        int wgid = (int)L; { const int q = nwg / NXCD, r = nwg % NXCD, xcd = wgid % NXCD, off = wgid / NXCD; wgid = (xcd < r ? xcd * (q + 1) : r * (q + 1) + (xcd - r) * q) + off; }
        const int nig = WGM * nN, gid = wgid / nig, fm = gid * WGM, gsz = (nM - fm) < WGM ? (nM - fm) : WGM;
        u.pm = fm + ((wgid % nig) % gsz); u.pn = (wgid % nig) / gsz; return true;
    }
};

__device__ __forceinline__ void store8(bf16_t* p, f32x4 v0, f32x4 v1) {
    u32x4 w; w.x = cvt_pk_bf16(v0[0], v0[1]); w.y = cvt_pk_bf16(v0[2], v0[3]); w.z = cvt_pk_bf16(v1[0], v1[1]); w.w = cvt_pk_bf16(v1[2], v1[3]); *(u32x4*)p = w;
}
__device__ __forceinline__ void load8(const bf16_t* p, f32x4& v0, f32x4& v1) {
    const u32x4 w = *(const u32x4*)p; v0 = (f32x4){bflo(w.x), bfhi(w.x), bflo(w.y), bfhi(w.y)}; v1 = (f32x4){bflo(w.z), bfhi(w.z), bflo(w.w), bfhi(w.w)};
}

template <int mode> struct Epi {
    static constexpr bool PERM = true;
    unsigned char* ws; unsigned char* dob; const float* x; const float* w0; const float* a0;
    __device__ __forceinline__ void operator()(const f32x4 (&acc)[2][2][4][2], const Unit& u, int wr, int wc, int fr, int fq) const {
        const int row0 = u.pm * BM + wr * 64 + fr, cb = u.pn * BM + wc * 32 + 8 * fq;
#pragma unroll
        for (int ai = 0; ai < 2; ++ai)
#pragma unroll
            for (int m = 0; m < 4; ++m) {
                const size_t row = (size_t)(row0 + ai * HALF + m * 16);
#pragma unroll
                for (int bj = 0; bj < 2; ++bj) {
                    const int col = cb + bj * HALF;
                    f32x4 v0 = acc[ai][bj][m][0], v1 = acc[ai][bj][m][1];
                    if (mode == 0) {
                        if (col < 4096) store8((bf16_t*)(ws + OFF_PM) + row * LDPM + col, v0, v1);
                        else if (col < 7680) store8((bf16_t*)(ws + OFF_PR) + row * LDPR + (col - 4096), v0, v1);
                        else {
#pragma unroll
                            for (int j = 0; j < 4; ++j) { v0[j] = sigm(v0[j]); v1[j] = sigm(v1[j]); }
                            store8((bf16_t*)(ws + OFF_PG) + row * LDPG + (col - 7680), v0, v1);
                        }
                    } else if (mode == 1) {
                        if (col < 1024) {
                            const f32x4 b0 = *(const f32x4*)(w0 + col), b1 = *(const f32x4*)(w0 + col + 4);
#pragma unroll
                            for (int j = 0; j < 4; ++j) {
                                float z = -(b0[j] + v0[j]); float sp = fmaxf(z, 0.f) + __logf(1.f + __expf(-fabsf(z))); v0[j] = -__expf(-sp - 0.5f);
                                z = -(b1[j] + v1[j]); sp = fmaxf(z, 0.f) + __logf(1.f + __expf(-fabsf(z))); v1[j] = -__expf(-sp - 0.5f);
                            }
                            store8((bf16_t*)(dob + DO_WLOG) + row * 1024 + col, v0, v1);
                        } else {
                            const int c2 = col - 1024;
                            const f32x4 b0 = *(const f32x4*)(a0 + c2), b1 = *(const f32x4*)(a0 + c2 + 4);
#pragma unroll
                            for (int j = 0; j < 4; ++j) { v0[j] = sigm(b0[j] + v0[j]); v1[j] = sigm(b1[j] + v1[j]); }
                            store8((bf16_t*)(dob + DO_AG) + row * 1024 + c2, v0, v1);
                        }
                    } else if (mode == 2) {
                        store8((bf16_t*)(dob + DO_GG) + row * 1024 + col, v0, v1);
                    } else if (mode == 3) {
                        bf16_t* pp = (bf16_t*)(ws + OFF_PG) + row * LDPG + col; f32x4 g0, g1; load8(pp, g0, g1);
                        store8(pp, g0 * v0, g1 * v1);
                    } else if (mode == 4) {
                        bf16_t* pp = (bf16_t*)(ws + OFF_PG) + row * LDPG + col; f32x4 m0, m1, g0, g1; load8(pp, m0, m1); load8(pp + 2048, g0, g1);
                        store8(pp, m0 + g0 * v0, m1 + g1 * v1);
                    } else if (mode == 5) {
                        const float* xp = x + row * DM + col; float* op = (float*)dob + row * DM + col;
                        const f32x4 x0 = *(const f32x4*)xp, x1 = *(const f32x4*)(xp + 4);
                        *(f32x4*)op = x0 + v0; *(f32x4*)(op + 4) = x1 + v1;
                    } else {
                        store8((bf16_t*)(ws + OFF_Q) + row * DM + col, v0, v1);
                    }
                    asm volatile("" ::: "memory");
                }
            }
    }
};

template <class EpiT> __device__ __forceinline__ void gemm_phase(LAS unsigned char* lds, const Gemm g, const StaticOrder& S, const EpiT& E) {
    const int tid = tid_l(), wid = __builtin_amdgcn_readfirstlane(tid >> 6), lane = tid & 63, wr = wid >> 2, wc = wid & 3, fr = lane & 15, fq = lane >> 4;
    const int K = g.K, nt = K / BK;
    unsigned voffA[2], voffB[2];
#pragma unroll
    for (int i = 0; i < 2; ++i) { int R, C; stage_rc(tid * 16 + i * 8192, R, C); const int Rb = (R & ~31) + perm32(R & 31);
        voffA[i] = (unsigned)(R * g.lda + C) * 2u; voffB[i] = (unsigned)(Rb * g.ldb + C) * 2u; }
    const size_t kstep = (size_t)(BK * 2);
    const size_t hstepA = (size_t)HALF * g.lda * 2, hstepB = (size_t)HALF * g.ldb * 2;
    const size_t tstepA = 2 * hstepA, tstepB = 2 * hstepB;
    const unsigned ldsw = (unsigned)wid * 1024u;
    const int aoff = lds_byte(wr * 64 + fr, fq * 8), boff = lds_byte(wc * 32 + fr, fq * 8);
#define PG8_SA(b, h) (((b) * 2 + (h)) * HTB)
#define PG8_SB(b, h) ((4 + (b) * 2 + (h)) * HTB)
#define PG8_STAGE(bufoff, gbase, voff) do { _Pragma("unroll") for (int _i = 0; _i < 2; ++_i) \
        __builtin_amdgcn_global_load_lds((const unsigned*)((const char*)(gbase) + (voff)[_i]), (LAS unsigned*)(lds + (bufoff) + ldsw + _i * 8192), 16, 0, 0); } while (0)
#define PG8_LDA(dst, b, h) do { _Pragma("unroll") for (int m = 0; m < 4; ++m) _Pragma("unroll") for (int k = 0; k < 2; ++k) dst[m][k] = *(const LAS bf16x8*)(lds + PG8_SA(b, h) + aoff + m * 2048 + k * 1024); } while (0)
#define PG8_LDB(dst, b, h) do { _Pragma("unroll") for (int n = 0; n < 2; ++n) _Pragma("unroll") for (int k = 0; k < 2; ++k) dst[n][k] = *(const LAS bf16x8*)(lds + PG8_SB(b, h) + boff + n * 2048 + k * 1024); } while (0)
#define PG8_MMA(ai, bj, At, Bt) do { __builtin_amdgcn_s_setprio(1); _Pragma("unroll") for (int m = 0; m < 4; ++m) _Pragma("unroll") for (int n = 0; n < 2; ++n) _Pragma("unroll") for (int k = 0; k < 2; ++k) \
        acc[ai][bj][m][n] = __builtin_amdgcn_mfma_f32_16x16x32_bf16(Bt[n][k], At[m][k], acc[ai][bj][m][n], 0, 0, 0); __builtin_amdgcn_s_setprio(0); } while (0)
#define PG8_WAIT_V(n) asm volatile("s_waitcnt vmcnt(" #n ")" ::: "memory")
#define PG8_WAIT_L(n) asm volatile("s_waitcnt lgkmcnt(" #n ")" ::: "memory")
#define PG8_BAR __builtin_amdgcn_s_barrier()
#define PG8_SCHED __builtin_amdgcn_sched_barrier(0)
    Unit cur, nxt; int ui = 0;
    if (!S.next(0, cur)) return;
    f32x4 acc[2][2][4][2];
#pragma unroll
    for (int a = 0; a < 2; ++a)
#pragma unroll
        for (int b = 0; b < 2; ++b)
#pragma unroll
            for (int m = 0; m < 4; ++m)
#pragma unroll
                for (int n = 0; n < 2; ++n) acc[a][b][m][n] = (f32x4){0.f, 0.f, 0.f, 0.f};
    bf16x8 At[4][2], B0[2][2], B1[2][2];
    const char* cA = (const char*)g.A + (size_t)cur.pm * tstepA; const char* cB = (const char*)g.Bt + (size_t)cur.pn * tstepB;
    PG8_STAGE(PG8_SB(0, 0), cB, voffB); PG8_STAGE(PG8_SA(0, 0), cA, voffA); PG8_STAGE(PG8_SB(0, 1), cB + hstepB, voffB); PG8_STAGE(PG8_SA(0, 1), cA + hstepA, voffA);
    if (wr == 1) PG8_BAR;
    PG8_WAIT_V(4); PG8_BAR;
    PG8_STAGE(PG8_SB(1, 0), cB + kstep, voffB); PG8_STAGE(PG8_SA(1, 0), cA + kstep, voffA); PG8_STAGE(PG8_SB(1, 1), cB + hstepB + kstep, voffB);
    PG8_WAIT_V(6); PG8_BAR;
    for (;;) {
        const bool has_next = S.next(ui + 1, nxt);
        const char* nA = has_next ? (const char*)g.A + (size_t)nxt.pm * tstepA : cA; const char* nB = has_next ? (const char*)g.Bt + (size_t)nxt.pn * tstepB : cB;
        for (int t = 0; t < nt; t += 2) {
            const bool last = (t == nt - 2);
            const char* a1 = cA + (size_t)(t + 1) * kstep;
            const char* a2 = last ? nA : cA + (size_t)(t + 2) * kstep; const char* b2 = last ? nB : cB + (size_t)(t + 2) * kstep;
            const char* a3 = a2 + kstep; const char* b3 = b2 + kstep;
            PG8_LDB(B0, 0, 0); PG8_SCHED; PG8_LDA(At, 0, 0); PG8_STAGE(PG8_SA(1, 1), a1 + hstepA, voffA);
            PG8_WAIT_L(8); PG8_BAR; PG8_WAIT_L(0); PG8_MMA(0, 0, At, B0); PG8_BAR; PG8_SCHED;
            PG8_LDB(B1, 0, 1); PG8_STAGE(PG8_SB(0, 0), b2, voffB);
            PG8_BAR; PG8_WAIT_L(0); PG8_MMA(0, 1, At, B1); PG8_BAR;
            PG8_LDA(At, 0, 1); PG8_STAGE(PG8_SA(0, 0), a2, voffA);
            PG8_BAR; PG8_WAIT_L(0); PG8_MMA(1, 0, At, B0); PG8_BAR; PG8_SCHED;
            PG8_STAGE(PG8_SB(0, 1), b2 + hstepB, voffB);
            PG8_WAIT_V(6); PG8_BAR; PG8_MMA(1, 1, At, B1); PG8_BAR;
            PG8_LDB(B0, 1, 0); PG8_SCHED; PG8_LDA(At, 1, 0); PG8_STAGE(PG8_SA(0, 1), a2 + hstepA, voffA);
            PG8_WAIT_L(8); PG8_BAR; PG8_WAIT_L(0); PG8_MMA(0, 0, At, B0); PG8_BAR; PG8_SCHED;
            PG8_LDB(B1, 1, 1); PG8_STAGE(PG8_SB(1, 0), b3, voffB);
            PG8_BAR; PG8_WAIT_L(0); PG8_MMA(0, 1, At, B1); PG8_BAR;
            PG8_LDA(At, 1, 1); PG8_STAGE(PG8_SA(1, 0), a3, voffA);
            PG8_BAR; PG8_WAIT_L(0); PG8_MMA(1, 0, At, B0); PG8_BAR; PG8_SCHED;
            PG8_STAGE(PG8_SB(1, 1), b3 + hstepB, voffB);
            PG8_WAIT_V(6); PG8_BAR; PG8_MMA(1, 1, At, B1); PG8_BAR;
        }
        E(acc, cur, wr, wc, fr, fq);
        if (!has_next) break;
#pragma unroll
        for (int a = 0; a < 2; ++a)
#pragma unroll
            for (int b = 0; b < 2; ++b)
#pragma unroll
                for (int m = 0; m < 4; ++m)
#pragma unroll
                    for (int n = 0; n < 2; ++n) acc[a][b][m][n] = (f32x4){0.f, 0.f, 0.f, 0.f};
        cur = nxt; cA = nA; cB = nB; ++ui;
    }
    PG8_WAIT_V(0);
    if (wr == 0) PG8_BAR;
    PG8_BAR;
#undef PG8_SA
#undef PG8_SB
#undef PG8_STAGE
#undef PG8_LDA
#undef PG8_LDB
#undef PG8_MMA
#undef PG8_WAIT_V
#undef PG8_WAIT_L
#undef PG8_BAR
#undef PG8_SCHED
}
}

__device__ __forceinline__ void rmsnorm_rows(const float* src, const float* gain, bf16_t* dst, int gw, int nw, int lane) {
    for (int row = gw; row < NT; row += nw) {
        const f32x4* s = (const f32x4*)(src + (size_t)row * DM);
        f32x4 v[8]; float ss = 0.f;
#pragma unroll
        for (int i = 0; i < 8; ++i) { v[i] = s[i * 64 + lane]; ss += v[i][0] * v[i][0] + v[i][1] * v[i][1] + v[i][2] * v[i][2] + v[i][3] * v[i][3]; }
        ss = wave_sum(ss);
        const float r = rsqrtf(ss * (1.f / DM) + 1e-6f);
        u32x2* d = (u32x2*)(dst + (size_t)row * DM);
#pragma unroll
        for (int i = 0; i < 8; ++i) { const f32x4 gg = ((const f32x4*)gain)[i * 64 + lane]; u32x2 o; o.x = cvt_pk_bf16(v[i][0] * r * gg[0], v[i][1] * r * gg[1]); o.y = cvt_pk_bf16(v[i][2] * r * gg[2], v[i][3] * r * gg[3]); d[i * 64 + lane] = o; }
    }
}

__device__ __forceinline__ void tr_tile(const float* src, int ld, int c0, int nvalid, int k0, bf16_t* dst, int ldd, int r0, int kd0, LAS float* tile) {
    const int tid = tid_l();
#pragma unroll
    for (int i = 0; i < 2; ++i) {
        const int k = (tid >> 4) + 32 * i, c4 = (tid & 15) * 4;
        f32x4 v = (f32x4){0.f, 0.f, 0.f, 0.f};
        if (c4 < nvalid) v = *(const f32x4*)(src + (size_t)(k0 + k) * ld + c0 + c4);
        tile[k * 65 + c4] = v[0]; tile[k * 65 + c4 + 1] = v[1]; tile[k * 65 + c4 + 2] = v[2]; tile[k * 65 + c4 + 3] = v[3];
    }
    __syncthreads();
    {
        const int c = tid >> 3, k8 = (tid & 7) * 8;
        float f[8];
#pragma unroll
        for (int j = 0; j < 8; ++j) f[j] = tile[(k8 + j) * 65 + c];
        u32x4 w; w.x = cvt_pk_bf16(f[0], f[1]); w.y = cvt_pk_bf16(f[2], f[3]); w.z = cvt_pk_bf16(f[4], f[5]); w.w = cvt_pk_bf16(f[6], f[7]);
        *(u32x4*)(dst + (size_t)(r0 + c) * ldd + kd0 + k8) = w;
    }
    __syncthreads();
}

__device__ void phase_prep(const KP& p, LAS unsigned char* lds) {
    const int tid = tid_l(), lane = tid & 63, G = gridDim.x, bid = blockIdx.x;
    unsigned char* ws = p.ws;
    rmsnorm_rows(p.x, p.g_mix, (bf16_t*)(ws + OFF_XN), bid * 8 + (tid >> 6), G * 8, lane);
    LAS float* tile = (LAS float*)lds;
    for (int j = bid; j < 8960; j += G) {
        if (j < 5888) {
            const int rt = j >> 5, kt = j & 31; int c0, nv = 64;
            if (rt < 64) c0 = 64 * rt; else if (rt < 119) c0 = 4104 + 64 * (rt - 64); else if (rt == 119) { c0 = 4096; nv = 8; } else c0 = 7624 + 64 * (rt - 120);
            tr_tile(p.w_in, 11720, c0, nv, kt * 64, (bf16_t*)(ws + OFF_WINT), 2048, rt * 64, kt * 64, tile);
        } else if (j < 6400) { const int q = j - 5888, rt = q >> 4, kt = q & 15; tr_tile(p.proj_m, 2048, rt * 64, 64, kt * 64, (bf16_t*)(ws + OFF_PMT), 1024, rt * 64, kt * 64, tile); }
        else if (j < 6912) { const int q = j - 6400, rt = q >> 4, kt = q & 15; tr_tile(p.proj_r, 2048, rt * 64, 64, kt * 64, (bf16_t*)(ws + OFF_PRT), 1024, rt * 64, kt * 64, tile); }
        else if (j < 7936) { const int q = j - 6912, rt = q >> 5, kt = q & 31; tr_tile(p.w_out, 2048, rt * 64, 64, kt * 64, (bf16_t*)(ws + OFF_WOT), 2048, rt * 64, kt * 64, tile); }
        else { const int q = j - 7936, rt = q >> 5, kt = q & 31; tr_tile(p.w_query, 2048, rt * 64, 64, kt * 64, (bf16_t*)(ws + OFF_WQT), 2048, rt * 64, kt * 64, tile); }
    }
    const int gt = bid * 512 + tid, gn = G * 512;
    bf16_t* WAT = (bf16_t*)(ws + OFF_WAT);
    for (int i = gt; i < 2048 * 256; i += gn) { const int r = i >> 8, k = i & 255; float v = 0.f;
        if (r < 1024) { if (k < 96) v = p.w2[k * 1024 + r]; } else { if (k >= 96 && k < 192) v = p.a2[(k - 96) * 1024 + (r - 1024)]; }
        WAT[i] = f2bf(v); }
    bf16_t* G2T = (bf16_t*)(ws + OFF_G2T);
    for (int i = gt; i < 1024 * 256; i += gn) { const int r = i >> 8, k = i & 255; G2T[i] = f2bf(p.g2[k * 1024 + r]); }
    bf16_t* SK = (bf16_t*)(ws + OFF_SUBK);
    for (int i = gt; i < 2 * 128 * 128; i += gn) SK[i] = f2bf(p.sub_keys[i]);
    if (gt == 0) *(unsigned*)(ws + OFF_SUBBAR) = 0u;
    for (int i = gt; i < XCD_BAR_WORDS; i += gn) ((unsigned*)(ws + OFF_XBAR))[i] = 0u;
}

__device__ __forceinline__ float bfel(const u32x4& w, int e) { const unsigned u = w[e >> 1]; return (e & 1) ? bfhi(u) : bflo(u); }
__device__ void phase_lora_prep(const KP& p) {
    const bf16_t* PR = (const bf16_t*)(p.ws + OFF_PR);
    bf16_t* AL = (bf16_t*)((unsigned char*)p.out + DO_ALORA);
    const int gt = blockIdx.x * 512 + threadIdx.x, gn = gridDim.x * 512;
    for (int i = gt; i < NT * 64; i += gn) {
        const int tok = i >> 6, g = i & 63;
        u32x4 o = (u32x4){0u, 0u, 0u, 0u};
        if (g < 24 || g >= 32) {
            const int sc = (g < 24) ? (3072 + 8 * g) : (3264 + 8 * (g - 32));
            const u32x4 cu = *(const u32x4*)(PR + (size_t)tok * LDPR + sc);
            u32x4 pv = (u32x4){0u, 0u, 0u, 0u};
            if ((tok & (SEQ - 1)) != 0) pv = *(const u32x4*)(PR + (size_t)(tok - 1) * LDPR + sc);
            const f32x4 m0 = *(const f32x4*)(p.mu + sc), m1 = *(const f32x4*)(p.mu + sc + 4);
            float f[8];
#pragma unroll
            for (int q = 0; q < 4; ++q) {
                const float c0 = bflo(cu[q]), c1 = bfhi(cu[q]), p0 = bflo(pv[q]), p1 = bfhi(pv[q]);
                const float mm0 = (q < 2) ? m0[2 * q] : m1[2 * q - 4], mm1 = (q < 2) ? m0[2 * q + 1] : m1[2 * q - 3];
                f[2 * q] = c0 + (p0 - c0) * mm0; f[2 * q + 1] = c1 + (p1 - c1) * mm1;
            }
            if (g < 12) {
#pragma unroll
                for (int q = 0; q < 8; ++q) f[q] = tanhf(f[q]);
            } else if (g >= 32) {
#pragma unroll
                for (int q = 0; q < 8; ++q) f[q] = sigm(f[q]);
            }
            o.x = cvt_pk_bf16(f[0], f[1]); o.y = cvt_pk_bf16(f[2], f[3]); o.z = cvt_pk_bf16(f[4], f[5]); o.w = cvt_pk_bf16(f[6], f[7]);
        }
        *(u32x4*)(AL + (size_t)tok * 512 + 8 * g) = o;
    }
    {
        const bf16_t* PM = (const bf16_t*)(p.ws + OFF_PM);
        bf16_t* QC = (bf16_t*)(p.ws + OFF_QC); bf16_t* KC = (bf16_t*)(p.ws + OFF_KC);
        for (int i = gt; i < (NT / 8) * 256; i += gn) {
            const int tb = i >> 8, col = (i & 255) * 8; const int tok0 = tb * 8, t0 = tok0 & (SEQ - 1);
            f32x4 cw[4][2];
#pragma unroll
            for (int j = 0; j < 4; ++j) { cw[j][0] = *(const f32x4*)(p.conv_w + j * 2048 + col); cw[j][1] = *(const f32x4*)(p.conv_w + j * 2048 + col + 4); }
            u32x4 raw[11];
#pragma unroll
            for (int q = 0; q < 11; ++q) { const bool neg = (t0 - 3 + q) < 0; u32x4 v = *(const u32x4*)(PM + (size_t)(tok0 + (neg ? 0 : q - 3)) * LDPM + col); if (neg) v = (u32x4){0u, 0u, 0u, 0u}; raw[q] = v; }
            const float scl = (col < 1024) ? 0.0625f : 1.f;
            bf16_t* dst = (col < 1024) ? (QC + (size_t)tok0 * 1024 + col) : (KC + (size_t)tok0 * 1024 + (col - 1024));
#pragma unroll
            for (int r = 0; r < 8; ++r) {
                float o[8];
#pragma unroll
                for (int e = 0; e < 8; ++e) {
                    const float c0 = (e < 4) ? cw[0][0][e] : cw[0][1][e - 4], c1 = (e < 4) ? cw[1][0][e] : cw[1][1][e - 4], c2 = (e < 4) ? cw[2][0][e] : cw[2][1][e - 4], c3 = (e < 4) ? cw[3][0][e] : cw[3][1][e - 4];
                    float sv = c0 * bfel(raw[r], e) + c1 * bfel(raw[r + 1], e) + c2 * bfel(raw[r + 2], e) + c3 * bfel(raw[r + 3], e);
                    o[e] = sv * sigm(sv) * scl;
                }
                u32x4 pk; pk.x = cvt_pk_bf16(o[0], o[1]); pk.y = cvt_pk_bf16(o[2], o[3]); pk.z = cvt_pk_bf16(o[4], o[5]); pk.w = cvt_pk_bf16(o[6], o[7]);
                *(u32x4*)(dst + (size_t)r * 1024) = pk;
            }
        }
    }
    {
        const int lane = threadIdx.x & 63, gw = blockIdx.x * 8 + (threadIdx.x >> 6), nw = gridDim.x * 8;
        float* GB = (float*)((unsigned char*)p.out + DO_GB); float* GA = (float*)((unsigned char*)p.out + DO_GA); float* GW = (float*)((unsigned char*)p.out + DO_GW);
        for (int task = gw; task < 1024; task += nw) {
            const int bh = task >> 6, c = task & 63, bb = bh >> 2, h = bh & 3; const size_t tok = (size_t)bb * SEQ + c * 64 + lane;
            const float iv = bf2f(PR[tok * LDPR + 3520 + h]) + p.b_i[h], fv = bf2f(PR[tok * LDPR + 3524 + h]) + p.b_f[h];
            float lf = fminf(fv, 0.f) - __logf(1.f + __expf(-fabsf(fv)));
#pragma unroll
            for (int d = 1; d < 64; d <<= 1) { const float y = __shfl_up(lf, d); if (lane >= d) lf += y; }
            const float bl = rlane(lf, 63);
            const int o = bh * SEQ + c * 64 + lane;
            GB[o] = lf; GA[o] = iv - lf; GW[o] = __expf(bl - lf + iv);
        }
    }
}

constexpr size_t OFF_YRAW = OFF_WINT, OFF_BON = OFF_WINT + 32 * MiB;
struct RwOps { f32x4 a0, a1, q0, q1, w0, w1, b0, b1, k0, k1; float v, br, kr; };
__device__ __forceinline__ f32x2_t lo2(f32x4 v) { return __builtin_shufflevector(v, v, 0, 1); }
__device__ __forceinline__ f32x2_t hi2(f32x4 v) { return __builtin_shufflevector(v, v, 2, 3); }
__device__ __forceinline__ f32x2_t fma2(f32x2_t a, f32x2_t b, f32x2_t c) { return __builtin_elementwise_fma(a, b, c); }
__device__ void rwkv_scan(const KP& p, int blk, LAS unsigned char* lds) {
    const int tid0 = tid_l();
    const int bh = blk >> 1, half = blk & 1, b = bh >> 4, h = bh & 15;
    constexpr int BUFB = 53760;
    const bf16_t* PR = (const bf16_t*)(p.ws + OFF_PR);
    const bf16_t* WLOG = (const bf16_t*)((const unsigned char*)p.out + DO_WLOG);
    const bf16_t* AG = (const bf16_t*)((const unsigned char*)p.out + DO_AG);
    bf16_t* YRAW = (bf16_t*)(p.ws + OFF_YRAW); float* BON = (float*)(p.ws + OFF_BON);
    const size_t tokbase = (size_t)b * SEQ;
    if (tid0 < 256) {
        const int rowl = tid0 >> 3, j8 = (tid0 & 7) * 8, row = 32 * half + rowl;
        f32x2_t S2[4];
#pragma unroll
        for (int k = 0; k < 4; ++k) S2[k] = (f32x2_t){0.f, 0.f};
        __syncthreads();
        for (int c = 0; c < 128; ++c) {
            const LAS float* bp = (const LAS float*)(lds + (c & 1) * BUFB);
            LAS float* yb = (LAS float*)(lds + (c & 1) * BUFB + 49408);
#define RW_LD(O, s) do { const LAS float* q_ = bp + (s) * 64 + j8; O.a0 = *(const LAS f32x4*)(q_); O.a1 = *(const LAS f32x4*)(q_ + 4); O.b0 = *(const LAS f32x4*)(q_ + 2048); O.b1 = *(const LAS f32x4*)(q_ + 2052); \
            O.w0 = *(const LAS f32x4*)(q_ + 4096); O.w1 = *(const LAS f32x4*)(q_ + 4100); O.k0 = *(const LAS f32x4*)(q_ + 6144); O.k1 = *(const LAS f32x4*)(q_ + 6148); \
            O.q0 = *(const LAS f32x4*)(q_ + 8192); O.q1 = *(const LAS f32x4*)(q_ + 8196); O.v = bp[10240 + (s) * 64 + row]; O.br = bp[12288 + (s)]; O.kr = bp[12320 + (s)]; } while (0)
#define RW_STEP(O, s) do { \
            f32x2_t pa = S2[0] * lo2(O.a0); f32x2_t py = S2[0] * lo2(O.q0); \
            pa = fma2(S2[1], hi2(O.a0), pa); py = fma2(S2[1], hi2(O.q0), py); pa = fma2(S2[2], lo2(O.a1), pa); py = fma2(S2[2], lo2(O.q1), py); \
            pa = fma2(S2[3], hi2(O.a1), pa); py = fma2(S2[3], hi2(O.q1), py); \
            float sa = pa.x + pa.y, yy = py.x + py.y; \
            sa += dppf<0xB1>(sa); yy += dppf<0xB1>(yy); sa += dppf<0x4E>(sa); yy += dppf<0x4E>(yy); sa += dppf<0x141>(sa); yy += dppf<0x141>(yy); \
            const f32x2_t sa2 = (f32x2_t){sa, sa}, vv2 = (f32x2_t){O.v, O.v}; \
            S2[0] = fma2(S2[0], lo2(O.w0), fma2(vv2, lo2(O.k0), sa2 * lo2(O.b0))); S2[1] = fma2(S2[1], hi2(O.w0), fma2(vv2, hi2(O.k0), sa2 * hi2(O.b0))); \
            S2[2] = fma2(S2[2], lo2(O.w1), fma2(vv2, lo2(O.k1), sa2 * lo2(O.b1))); S2[3] = fma2(S2[3], hi2(O.w1), fma2(vv2, hi2(O.k1), sa2 * hi2(O.b1))); \
            if ((tid0 & 7) == 0) yb[(s) * 32 + rowl] = yy + sa * O.br + O.v * O.kr; } while (0)
            RwOps o0, o1;
            RW_LD(o0, 0);
#pragma unroll 1
            for (int s = 0; s < 32; s += 2) {
                RW_LD(o1, s + 1);
                RW_STEP(o0, s);
                { const int sn = (s + 2 < 32) ? s + 2 : 31; RW_LD(o0, sn); }
                RW_STEP(o1, s + 1);
            }
#undef RW_LD
#undef RW_STEP
            __syncthreads();
        }
    } else {
        const int ht = tid0 - 256, tt = ht >> 3, cg8 = (ht & 7) * 8, ch = h * 64 + cg8;
        float mur[8], muk[8], muv[8], kkc[8], kac[8], rkc[8];
#pragma unroll
        for (int e = 0; e < 8; ++e) { mur[e] = p.mu[ch + e]; muk[e] = p.mu[1024 + ch + e]; muv[e] = p.mu[2048 + ch + e]; kkc[e] = p.k_k[ch + e]; kac[e] = p.k_a[ch + e]; rkc[e] = p.r_k[ch + e]; }
        for (int c = -1; c < 128; ++c) {
            if (c >= 1) {
                const LAS float* yb = (const LAS float*)(lds + ((c - 1) & 1) * BUFB + 49408);
                const int r4 = (ht & 7) * 4; const f32x4 y4 = *(const LAS f32x4*)(yb + tt * 32 + r4);
                u32x2 ov; ov.x = cvt_pk_bf16(y4[0], y4[1]); ov.y = cvt_pk_bf16(y4[2], y4[3]);
                *(u32x2*)(YRAW + (tokbase + (size_t)(c - 1) * 32 + tt) * 1024 + h * 64 + 32 * half + r4) = ov;
            }
            if (c + 1 < 128) {
                const int cn = c + 1, t = cn * 32 + tt; const size_t tok = tokbase + t;
                LAS float* bp = (LAS float*)(lds + (cn & 1) * BUFB);
                const bf16_t* pr_ = PR + tok * LDPR + ch;
                const u32x4 r4 = *(const u32x4*)pr_, k4 = *(const u32x4*)(pr_ + 1024), v4 = *(const u32x4*)(pr_ + 2048);
                u32x4 pr4 = (u32x4){0u, 0u, 0u, 0u}, pk4 = pr4, pv4 = pr4;
                if (t > 0) { pr4 = *(const u32x4*)(pr_ - LDPR); pk4 = *(const u32x4*)(pr_ - LDPR + 1024); pv4 = *(const u32x4*)(pr_ - LDPR + 2048); }
                const u32x4 w4 = *(const u32x4*)(WLOG + tok * 1024 + ch), a4 = *(const u32x4*)(AG + tok * 1024 + ch);
                float r[8], k[8], v[8], kk[8], av[8], dec[8];
                float n2 = 0.f;
#pragma unroll
                for (int e = 0; e < 8; ++e) {
                    const float rc = bfel(r4, e), kc = bfel(k4, e), vc = bfel(v4, e);
                    r[e] = rc + (bfel(pr4, e) - rc) * mur[e]; k[e] = kc + (bfel(pk4, e) - kc) * muk[e]; v[e] = vc + (bfel(pv4, e) - vc) * muv[e];
                    kk[e] = k[e] * kkc[e]; n2 += kk[e] * kk[e]; av[e] = bfel(a4, e); dec[e] = __expf(bfel(w4, e));
                }
                n2 = red8(n2);
                const float inv = 1.f / fmaxf(sqrtf(n2), 1e-12f);
                float br = 0.f, kr = 0.f, bon = 0.f;
                f32x4 oa[2], ob[2], ow[2], ok[2], oq[2], ovv[2];
#pragma unroll
                for (int e = 0; e < 8; ++e) {
                    const float kn = kk[e] * inv, k3 = k[e] * (1.f + (av[e] - 1.f) * kac[e]), bb = kn * av[e];
                    oa[e >> 2][e & 3] = -kn; ob[e >> 2][e & 3] = bb; ow[e >> 2][e & 3] = dec[e]; ok[e >> 2][e & 3] = k3; oq[e >> 2][e & 3] = dec[e] * r[e]; ovv[e >> 2][e & 3] = v[e];
                    br += bb * r[e]; kr += k3 * r[e]; bon += r[e] * k3 * rkc[e];
                }
                br = red8(br); kr = red8(kr); bon = red8(bon);
                LAS float* q_ = bp + tt * 64 + cg8;
#pragma unroll
                for (int i = 0; i < 2; ++i) { *(LAS f32x4*)(q_ + 4 * i) = oa[i]; *(LAS f32x4*)(q_ + 2048 + 4 * i) = ob[i]; *(LAS f32x4*)(q_ + 4096 + 4 * i) = ow[i]; *(LAS f32x4*)(q_ + 6144 + 4 * i) = ok[i];
                    *(LAS f32x4*)(q_ + 8192 + 4 * i) = oq[i]; *(LAS f32x4*)(q_ + 10240 + 4 * i) = ovv[i]; }
                if ((ht & 7) == 0) { bp[12288 + tt] = br; bp[12320 + tt] = kr; if (half == 0) BON[tok * 16 + h] = bon; }
            }
            __syncthreads();
        }
        {
            const LAS float* yb = (const LAS float*)(lds + (127 & 1) * BUFB + 49408);
            const int r4 = (ht & 7) * 4; const f32x4 y4 = *(const LAS f32x4*)(yb + tt * 32 + r4);
            u32x2 ov; ov.x = cvt_pk_bf16(y4[0], y4[1]); ov.y = cvt_pk_bf16(y4[2], y4[3]);
            *(u32x2*)(YRAW + (tokbase + (size_t)127 * 32 + tt) * 1024 + h * 64 + 32 * half + r4) = ov;
        }
    }
}

__device__ void phase_rwkv_post(const KP& p) {
    const bf16_t* PR = (const bf16_t*)(p.ws + OFF_PR);
    const bf16_t* GG = (const bf16_t*)((const unsigned char*)p.out + DO_GG);
    bf16_t* YR = (bf16_t*)(p.ws + OFF_YRAW); const float* BON = (const float*)(p.ws + OFF_BON);
    const int gt = blockIdx.x * 512 + tid_l(), gn = gridDim.x * 512;
    for (int i = gt; i < NT * 256; i += gn) {
        const int tok = i >> 8, h = (i >> 4) & 15, ch = h * 64 + (i & 15) * 4;
        const u32x2 y2 = *(const u32x2*)(YR + (size_t)tok * 1024 + ch), v2 = *(const u32x2*)(PR + (size_t)tok * LDPR + 2048 + ch), g2 = *(const u32x2*)(GG + (size_t)tok * 1024 + ch);
        u32x2 pv2 = (u32x2){0u, 0u};
        if ((tok & (SEQ - 1)) != 0) pv2 = *(const u32x2*)(PR + (size_t)(tok - 1) * LDPR + 2048 + ch);
        const float bon = BON[tok * 16 + h];
        const f32x4 muv = *(const f32x4*)(p.mu + 2048 + ch), lnw = *(const f32x4*)(p.ln_w + ch), lnb = *(const f32x4*)(p.ln_b + ch);
        const f32x4 y = (f32x4){bflo(y2.x), bfhi(y2.x), bflo(y2.y), bfhi(y2.y)}, vc = (f32x4){bflo(v2.x), bfhi(v2.x), bflo(v2.y), bfhi(v2.y)}, vp = (f32x4){bflo(pv2.x), bfhi(pv2.x), bflo(pv2.y), bfhi(pv2.y)};
        const f32x4 g = (f32x4){bflo(g2.x), bfhi(g2.x), bflo(g2.y), bfhi(g2.y)};
        const f32x4 v = vc + (vp - vc) * muv;
        const float mean = red16(y[0] + y[1] + y[2] + y[3]) * (1.f / 64.f);
        const f32x4 d = y - mean;
        const float var = red16(d[0] * d[0] + d[1] * d[1] + d[2] * d[2] + d[3] * d[3]) * (1.f / 64.f);
        const float rs = rsqrtf(var + 64e-5f);
        const f32x4 res = (d * rs * lnw + lnb + bon * v) * g;
        u32x2 ov; ov.x = cvt_pk_bf16(res[0], res[1]); ov.y = cvt_pk_bf16(res[2], res[3]);
        *(u32x2*)(YR + (size_t)tok * 1024 + ch) = ov;
    }
}

typedef short v4i16_t __attribute__((ext_vector_type(4)));
__device__ __forceinline__ bf16x8 tr_frag(const LAS unsigned char* base, int stride_b, int krow0, int ncol0, int lane) {
    const int g = lane >> 4, q = (lane & 15) >> 2, pp = lane & 3;
    const LAS unsigned char* a0 = base + (krow0 + 8 * g + q) * stride_b + (ncol0 + 4 * pp) * 2;
    const v4i16_t x = __builtin_amdgcn_ds_read_tr16_b64_v4i16((LAS v4i16_t*)a0), y = __builtin_amdgcn_ds_read_tr16_b64_v4i16((LAS v4i16_t*)(a0 + 4 * stride_b));
    return (bf16x8){x[0], x[1], x[2], x[3], y[0], y[1], y[2], y[3]};
}
__device__ void mlstm_run(const KP& p, int item, LAS unsigned char* lds) {
    const int tid0 = tid_l();
    const int bh = item >> 3, b = bh >> 2, h = bh & 3, dv0 = (item & 7) * 32;
    const size_t tokbase = (size_t)b * SEQ;
    LAS bf16_t* Qs = (LAS bf16_t*)(lds + 0);
    LAS bf16_t* Ks = (LAS bf16_t*)(lds + 33792);
    LAS bf16_t* Vs = (LAS bf16_t*)(lds + 67584);
    LAS bf16_t* Vws = (LAS bf16_t*)(lds + 74752);
    LAS bf16_t* Ss = (LAS bf16_t*)(lds + 81920);
    LAS bf16_t* CT0 = (LAS bf16_t*)(lds + 91136);
    LAS bf16_t* Os = (LAS bf16_t*)(lds + 141824);
    LAS float* BC = (LAS float*)(lds + 146944);
    LAS float* GAs = (LAS float*)(lds + 147200);
    const bf16_t* QC = (const bf16_t*)(p.ws + OFF_QC); const bf16_t* KC = (const bf16_t*)(p.ws + OFF_KC);
    bf16_t* PM = (bf16_t*)(p.ws + OFF_PM);
    const float* GB = (const float*)((const unsigned char*)p.out + DO_GB); const float* GA = (const float*)((const unsigned char*)p.out + DO_GA); const float* GW = (const float*)((const unsigned char*)p.out + DO_GW);
    for (int i = tid0; i < 2 * 48 * 264 / 2; i += 512) ((LAS unsigned*)CT0)[i] = 0u;
    for (int i = tid0; i < 2 * 64 * 56 / 2; i += 512) ((LAS unsigned*)Vs)[i] = 0u;
    __syncthreads();
    if (tid0 < 64) Vs[tid0 * 56 + 32] = (bf16_t)0x3F80;
    f32x4 cacc[6];
#pragma unroll
    for (int i = 0; i < 6; ++i) cacc[i] = (f32x4){0.f, 0.f, 0.f, 0.f};
    u32x4 q4[4], k4[4], vo4; float gb = 0.f, ga = 0.f, gwv = 0.f;
#define ML_LOAD(c, TID) do { const int row_ = (TID) >> 3, pc_ = (TID) & 7; const size_t tk_ = tokbase + (size_t)(c) * 64; \
        const bf16_t* qp_ = QC + (tk_ + row_) * 1024 + h * 256 + pc_ * 32; const bf16_t* kp_ = KC + (tk_ + row_) * 1024 + h * 256 + pc_ * 32; \
        _Pragma("unroll") for (int i_ = 0; i_ < 4; ++i_) { q4[i_] = *(const u32x4*)(qp_ + 8 * i_); k4[i_] = *(const u32x4*)(kp_ + 8 * i_); } \
        const int sg_ = (TID) & 255, s_ = sg_ >> 2, g_ = sg_ & 3; \
        vo4 = *(const u32x4*)(PM + (tk_ + s_) * LDPM + ((TID) < 256 ? 2048 : 3072) + h * 256 + dv0 + 8 * g_); \
        gwv = GW[bh * SEQ + (c) * 64 + s_]; \
        if ((TID) < 64) { gb = GB[bh * SEQ + (c) * 64 + (TID)]; ga = GA[bh * SEQ + (c) * 64 + (TID)]; } } while (0)
    ML_LOAD(0, tid0);
    __syncthreads();
    int cur = 0;
    for (int c = 0; c < 64; ++c) {
        int tid = tid0; asm volatile("" : "+v"(tid));
        const int lane = tid & 63, w = tid >> 6, fr = lane & 15, fq = lane >> 4;
        LAS bf16_t* CTc = CT0 + cur * (48 * 264); LAS bf16_t* CTn = CT0 + (cur ^ 1) * (48 * 264);
        {
            const int row = tid >> 3, pc = tid & 7;
#pragma unroll
            for (int i = 0; i < 4; ++i) { *(LAS u32x4*)(Qs + row * 264 + pc * 32 + 8 * i) = q4[i]; *(LAS u32x4*)(Ks + row * 264 + pc * 32 + 8 * i) = k4[i]; }
            const int sg = tid & 255, s = sg >> 2, g = sg & 3;
            if (tid < 256) {
                *(LAS u32x4*)(Vs + s * 56 + 8 * g) = vo4;
                u32x4 wv;
#pragma unroll
                for (int e = 0; e < 4; ++e) wv[e] = cvt_pk_bf16(bflo(vo4[e]) * gwv, bfhi(vo4[e]) * gwv);
                *(LAS u32x4*)(Vws + s * 56 + 8 * g) = wv;
                if (g == 0) Vws[s * 56 + 32] = f2bf(gwv);
            } else {
                if (c > 0) { const u32x4 yv = *(const LAS u32x4*)(Os + s * 40 + 8 * g); *(u32x4*)(PM + (tokbase + (size_t)(c - 1) * 64 + s) * LDPM + 3072 + h * 256 + dv0 + 8 * g) = yv; }
                *(LAS u32x4*)(Os + s * 40 + 8 * g) = vo4;
            }
            if (tid < 64) { BC[tid] = gb; GAs[tid] = ga; }
        }
        asm volatile("" ::: "memory");
        if (c + 1 < 64) ML_LOAD(c + 1, tid);
        asm volatile("" ::: "memory");
        __syncthreads();
        {
            const int mt = w >> 1, ntb = (w & 1) * 2;
            f32x4 s0 = (f32x4){0.f, 0.f, 0.f, 0.f}, s1 = s0;
#pragma unroll
            for (int ks = 0; ks < 8; ++ks) {
                const bf16x8 a = *(const LAS bf16x8*)(Qs + (16 * mt + fr) * 264 + 32 * ks + 8 * fq);
                const bf16x8 b0 = *(const LAS bf16x8*)(Ks + (16 * ntb + fr) * 264 + 32 * ks + 8 * fq);
                const bf16x8 b1 = *(const LAS bf16x8*)(Ks + (16 * (ntb + 1) + fr) * 264 + 32 * ks + 8 * fq);
                s0 = __builtin_amdgcn_mfma_f32_16x16x32_bf16(a, b0, s0, 0, 0, 0);
                s1 = __builtin_amdgcn_mfma_f32_16x16x32_bf16(a, b1, s1, 0, 0, 0);
            }
            const int sA = 16 * ntb + fr, sB = sA + 16;
            const float gA = GAs[sA], gB = GAs[sB];
#pragma unroll
            for (int j = 0; j < 4; ++j) {
                const int t = 16 * mt + 4 * fq + j; const float bt = BC[t];
                const float vA = (sA <= t) ? s0[j] * __expf(bt + gA) : 0.f, vB = (sB <= t) ? s1[j] * __expf(bt + gB) : 0.f;
                Ss[t * 72 + sA] = f2bf(vA); Ss[t * 72 + sB] = f2bf(vB);
            }
        }
        __syncthreads();
        {
            const int mt = w >> 1, nt = w & 1;
            f32x4 aA = (f32x4){0.f, 0.f, 0.f, 0.f}, aB = aA, xA = aA, xB = aA;
#pragma unroll
            for (int ks = 0; ks < 2; ++ks) {
                const bf16x8 a = *(const LAS bf16x8*)(Ss + (16 * mt + fr) * 72 + 32 * ks + 8 * fq);
                const bf16x8 bm = tr_frag((const LAS unsigned char*)Vs, 112, 32 * ks, 16 * nt, lane);
                const bf16x8 bx = tr_frag((const LAS unsigned char*)Vs, 112, 32 * ks, 32, lane);
                aA = __builtin_amdgcn_mfma_f32_16x16x32_bf16(a, bm, aA, 0, 0, 0);
                xA = __builtin_amdgcn_mfma_f32_16x16x32_bf16(a, bx, xA, 0, 0, 0);
            }
#pragma unroll
            for (int ks = 0; ks < 8; ++ks) {
                const bf16x8 a = *(const LAS bf16x8*)(Qs + (16 * mt + fr) * 264 + 32 * ks + 8 * fq);
                const bf16x8 bm = *(const LAS bf16x8*)(CTc + (16 * nt + fr) * 264 + 32 * ks + 8 * fq);
                const bf16x8 bx = *(const LAS bf16x8*)(CTc + (32 + fr) * 264 + 32 * ks + 8 * fq);
                aB = __builtin_amdgcn_mfma_f32_16x16x32_bf16(a, bm, aB, 0, 0, 0);
                xB = __builtin_amdgcn_mfma_f32_16x16x32_bf16(a, bx, xB, 0, 0, 0);
            }
#pragma unroll
            for (int j = 0; j < 4; ++j) {
                const int t = 16 * mt + 4 * fq + j; const float eb = __expf(BC[t]);
                const float num = aA[j] + eb * aB[j];
                const float den = __shfl(xA[j] + eb * xB[j], lane & 48);
                const float hv = num / fmaxf(fabsf(den), 1.f);
                LAS bf16_t* op = Os + t * 40 + 16 * nt + fr;
                *op = f2bf(hv * sigm(bf2f(*op)));
            }
            const float decay = __expf(BC[63]);
            bf16x8 bw[3][2];
#pragma unroll
            for (int n3 = 0; n3 < 3; ++n3)
#pragma unroll
                for (int ks = 0; ks < 2; ++ks) bw[n3][ks] = tr_frag((const LAS unsigned char*)Vws, 112, 32 * ks, 16 * n3, lane);
#pragma unroll
            for (int m2 = 0; m2 < 2; ++m2) {
                const int mtk = 2 * w + m2;
                const bf16x8 ka0 = tr_frag((const LAS unsigned char*)Ks, 528, 0, 16 * mtk, lane), ka1 = tr_frag((const LAS unsigned char*)Ks, 528, 32, 16 * mtk, lane);
#pragma unroll
                for (int n3 = 0; n3 < 3; ++n3) {
                    f32x4 cc = cacc[m2 * 3 + n3] * decay;
                    cc = __builtin_amdgcn_mfma_f32_16x16x32_bf16(ka0, bw[n3][0], cc, 0, 0, 0);
                    cc = __builtin_amdgcn_mfma_f32_16x16x32_bf16(ka1, bw[n3][1], cc, 0, 0, 0);
                    cacc[m2 * 3 + n3] = cc;
                    u32x2 pk; pk.x = cvt_pk_bf16(cc[0], cc[1]); pk.y = cvt_pk_bf16(cc[2], cc[3]);
                    *(LAS u32x2*)(CTn + (16 * n3 + fr) * 264 + 16 * mtk + 4 * fq) = pk;
                }
            }
        }
        cur ^= 1;
        __syncthreads();
    }
    if (tid0 >= 256) { const int sg = tid0 & 255, s = sg >> 2, g = sg & 3; const u32x4 yv = *(const LAS u32x4*)(Os + s * 40 + 8 * g);
        *(u32x4*)(PM + (tokbase + (size_t)63 * 64 + s) * LDPM + 3072 + h * 256 + dv0 + 8 * g) = yv; }
#undef ML_LOAD
}

__device__ void phase_norm2(const KP& p) {
    const int tid = tid_l(), lane = tid & 63, G = gridDim.x, bid = blockIdx.x;
    rmsnorm_rows(p.out, p.g_ffn, (bf16_t*)(p.ws + OFF_XN2), bid * 8 + (tid >> 6), G * 8, lane);
}
typedef float v16f_t __attribute__((ext_vector_type(16)));
typedef float v32f_t __attribute__((ext_vector_type(32)));
typedef unsigned v6u_t __attribute__((ext_vector_type(6)));
__device__ void convert_tables(const KP& p, int gw, int nw) {
    const int lane = tid_l() & 63;
    for (int tb = 0; tb < 2; ++tb) {
        const float* src = tb ? p.peer_v : p.peer_u; unsigned char* dst = p.ws + (tb ? OFF_PV : OFF_PU); float* sc = (float*)(p.ws + (tb ? OFF_SCV : OFF_SCU));
        for (int row = gw; row < 16384; row += nw) {
            const float* sp = src + (size_t)row * DM + lane * 32;
            f32x4 v[8]; float am = 0.f;
#pragma unroll
            for (int q = 0; q < 8; ++q) { v[q] = *(const f32x4*)(sp + q * 4);
                am = fmaxf(am, fmaxf(fmaxf(fabsf(v[q][0]), fabsf(v[q][1])), fmaxf(fabsf(v[q][2]), fabsf(v[q][3])))); }
            const unsigned amu = wave_max_u32(__float_as_uint(am));
            const float amax = __uint_as_float(amu);
            float scl = 1.f;
            if (amax > 0.f) scl = exp2f(floorf(log2f(7.5f / amax)));
            if (lane == 0) sc[row] = 1.f / scl;
            v16f_t xa, xb;
#pragma unroll
            for (int q = 0; q < 4; ++q)
#pragma unroll
                for (int j = 0; j < 4; ++j) { xa[q * 4 + j] = v[q][j] * scl; xb[q * 4 + j] = v[4 + q][j] * scl; }
            const v6u_t pk = __builtin_amdgcn_cvt_scalef32_2xpk16_fp6_f32(xa, xb, 1.0f);
            unsigned char* dp = dst + (size_t)row * 8192 + lane * 8;
#pragma unroll
            for (int k = 0; k < 3; ++k) { u32x2 o; o.x = pk[2 * k]; o.y = pk[2 * k + 1]; *(u32x2*)(dp + k * 512) = o; }
        }
    }
}

__device__ void phase_peer(const KP& p, LAS unsigned char* lds) {
    const int tid = tid_l(), lane = tid & 63, w = tid >> 6, fr = lane & 15, fq = lane >> 4;
    LAS unsigned* KEYS = (LAS unsigned*)lds;
    LAS int* TI = (LAS int*)(lds + 32768);
    LAS float* TG = (LAS float*)(lds + 49152);
    const bf16_t* Q = (const bf16_t*)(p.ws + OFF_Q);
    const bf16_t* SK = (const bf16_t*)(p.ws + OFF_SUBK);
    const bf16_t* XN2 = (const bf16_t*)(p.ws + OFF_XN2);
    const unsigned char* PU = p.ws + OFF_PU; const unsigned char* PV = p.ws + OFF_PV;
    const float* SCU = (const float*)(p.ws + OFF_SCU); const float* SCV = (const float*)(p.ws + OFF_SCV);
    float* out = p.out;
    LAS int* IJ = (LAS int*)(lds + 65536);
    int ci[4], cj[4]; bool cv[4];
#pragma unroll
    for (int m = 0; m < 4; ++m) { const int e = m * 16 + fr; int i = 0, base = 0;
        for (; i < 16; ++i) { const int cnt = 16 / (i + 1); if (e < base + cnt) break; base += cnt; }
        cv[m] = i < 16; ci[m] = cv[m] ? i : 0; cj[m] = cv[m] ? e - base : 0;
        if (w == 0 && fq == 0) IJ[e] = cv[m] ? ci[m] * 16 + cj[m] : 0; }
    const int pp_ = w >> 2, ntb = (w & 3) * 2;
    bf16x8 bfr[2][4];
#pragma unroll
    for (int n = 0; n < 2; ++n)
#pragma unroll
        for (int ks = 0; ks < 4; ++ks) bfr[n][ks] = *(const bf16x8*)(SK + (size_t)(pp_ * 128 + 16 * (ntb + n) + fr) * 128 + 32 * ks + 8 * fq);
    __syncthreads();
    LAS float* xs = (LAS float*)(lds + 66048) + w * 2048;
    int soff[32];
    {
        v16f_t ta, tb;
#pragma unroll
        for (int i = 0; i < 16; ++i) { ta[i] = 0.125f * i; tb[i] = (i < 8) ? 2.f + 0.25f * i : 4.f + 0.5f * (i - 8); }
        const v6u_t pk = __builtin_amdgcn_cvt_scalef32_2xpk16_fp6_f32(ta, tb, 1.0f);
        const v32f_t un = __builtin_amdgcn_cvt_scalef32_pk32_f32_fp6(pk, 1.0f);
#pragma unroll
        for (int m = 0; m < 32; ++m) { const float val = un[m]; const float c = val < 2.f ? val * 8.f : (val < 4.f ? 16.f + (val - 2.f) * 4.f : 24.f + (val - 4.f) * 2.f);
            soff[m] = 32 * lane + ((int)(c + 0.5f) & 31); }
    }
    for (int tile = blockIdx.x; tile < NT / 32; tile += gridDim.x) {
        const int tk0 = tile * 32;
        bf16x8 afn[2][4];
#pragma unroll
        for (int mt = 0; mt < 2; ++mt)
#pragma unroll
            for (int ks = 0; ks < 4; ++ks) afn[mt][ks] = *(const bf16x8*)(Q + (size_t)(tk0 + 16 * mt + fr) * DM + pp_ * 128 + 32 * ks + 8 * fq);
        for (int h = 0; h < 8; ++h) {
            {
                bf16x8 af[2][4];
#pragma unroll
                for (int mt = 0; mt < 2; ++mt)
#pragma unroll
                    for (int ks = 0; ks < 4; ++ks) af[mt][ks] = afn[mt][ks];
                if (h + 1 < 8) {
#pragma unroll
                    for (int mt = 0; mt < 2; ++mt)
#pragma unroll
                        for (int ks = 0; ks < 4; ++ks) afn[mt][ks] = *(const bf16x8*)(Q + (size_t)(tk0 + 16 * mt + fr) * DM + (h + 1) * 256 + pp_ * 128 + 32 * ks + 8 * fq);
                }
                f32x4 acc[2][2];
#pragma unroll
                for (int a_ = 0; a_ < 2; ++a_)
#pragma unroll
                    for (int b_ = 0; b_ < 2; ++b_) acc[a_][b_] = (f32x4){0.f, 0.f, 0.f, 0.f};
#pragma unroll
                for (int ks = 0; ks < 4; ++ks)
#pragma unroll
                    for (int mt = 0; mt < 2; ++mt)
#pragma unroll
                        for (int n = 0; n < 2; ++n) acc[mt][n] = __builtin_amdgcn_mfma_f32_16x16x32_bf16(af[mt][ks], bfr[n][ks], acc[mt][n], 0, 0, 0);
#pragma unroll
                for (int mt = 0; mt < 2; ++mt)
#pragma unroll
                    for (int n = 0; n < 2; ++n)
#pragma unroll
                        for (int j = 0; j < 4; ++j) { const int tokl = 16 * mt + 4 * fq + j, key = 16 * (ntb + n) + fr;
                            KEYS[(tokl * 2 + pp_) * 128 + key] = (ordf(acc[mt][n][j]) & ~0x7Fu) | (unsigned)key; }
            }
            __syncthreads();
            {
                const int tokl = 4 * w + fq, rb = lane & 48;
                unsigned top[2];
#pragma unroll
                for (int pp = 0; pp < 2; ++pp) {
                    unsigned kx[8];
#pragma unroll
                    for (int m = 0; m < 8; ++m) kx[m] = KEYS[(tokl * 2 + pp) * 128 + fr + 16 * m];
                    unsigned tp = 0u;
                    for (int it = 0; it < 16; ++it) {
                        unsigned M = max(max(max(kx[0], kx[1]), max(kx[2], kx[3])), max(max(kx[4], kx[5]), max(kx[6], kx[7])));
                        M = max(M, dppu<0xB1>(M)); M = max(M, dppu<0x4E>(M)); M = max(M, dppu<0x141>(M)); M = max(M, dppu<0x140>(M));
                        if (fr == it) tp = M;
#pragma unroll
                        for (int m = 0; m < 8; ++m) kx[m] = (kx[m] == M) ? 0u : kx[m];
                    }
                    top[pp] = tp;
                }
                unsigned cnd[4];
#pragma unroll
                for (int m = 0; m < 4; ++m) {
                    const float v1 = unordf((unsigned)__shfl((int)top[0], rb + ci[m]) & ~0x7Fu), v2 = unordf((unsigned)__shfl((int)top[1], rb + cj[m]) & ~0x7Fu);
                    cnd[m] = cv[m] ? ((ordf(v1 + v2) & ~0x3Fu) | (unsigned)(m * 16 + fr)) : 0u;
                }
                unsigned best = 0u;
                for (int it = 0; it < 16; ++it) {
                    unsigned M = max(max(cnd[0], cnd[1]), max(cnd[2], cnd[3]));
                    M = max(M, dppu<0xB1>(M)); M = max(M, dppu<0x4E>(M)); M = max(M, dppu<0x141>(M)); M = max(M, dppu<0x140>(M));
                    if (fr == it) best = M;
#pragma unroll
                    for (int m = 0; m < 4; ++m) cnd[m] = (cnd[m] == M) ? 0u : cnd[m];
                }
                const int ij = IJ[best & 0x3Fu];
                const float bv = unordf(best & ~0x3Fu);
                const int e1 = __shfl((int)top[0], rb + (ij >> 4)) & 0x7F, e2 = __shfl((int)top[1], rb + (ij & 15)) & 0x7F;
                const float mx = __shfl(bv, rb);
                const float ev = __expf(bv - mx);
                const float sum = red16(ev);
                TI[tokl * 128 + h * 16 + fr] = e1 * 128 + e2; TG[tokl * 128 + h * 16 + fr] = ev / sum;
            }
            __syncthreads();
        }
        for (int q = 0; q < 4; ++q) {
            const int tokl = 4 * w + q; const size_t tok = (size_t)tk0 + tokl;
#pragma unroll
            for (int i = 0; i < 4; ++i) { const u32x4 x4 = *(const u32x4*)(XN2 + tok * DM + i * 512 + lane * 8);
                *(LAS f32x4*)(xs + i * 512 + lane * 8) = (f32x4){bflo(x4[0]), bfhi(x4[0]), bflo(x4[1]), bfhi(x4[1])}; *(LAS f32x4*)(xs + i * 512 + lane * 8 + 4) = (f32x4){bflo(x4[2]), bfhi(x4[2]), bflo(x4[3]), bfhi(x4[3])}; }
            float xv[32], acc[32];
#pragma unroll
            for (int m = 0; m < 32; ++m) { xv[m] = xs[soff[m]]; acc[m] = 0.f; }
#pragma unroll 2
            for (int e = 0; e < 128; ++e) {
                const int idx = __builtin_amdgcn_readfirstlane(TI[tokl * 128 + e]);
                const float gate = __builtin_bit_cast(float, __builtin_amdgcn_readfirstlane(__builtin_bit_cast(int, TG[tokl * 128 + e])));
                const unsigned char* up = PU + (size_t)idx * 8192 + lane * 8; const unsigned char* vp = PV + (size_t)idx * 8192 + lane * 8;
                const u32x2 u0 = *(const u32x2*)up, u1 = *(const u32x2*)(up + 512), u2 = *(const u32x2*)(up + 1024);
                const u32x2 v0 = *(const u32x2*)vp, v1 = *(const u32x2*)(vp + 512), v2 = *(const u32x2*)(vp + 1024);
                const float su = SCU[idx], sv = SCV[idx];
                const v32f_t uf = __builtin_amdgcn_cvt_scalef32_pk32_f32_fp6((v6u_t){u0.x, u0.y, u1.x, u1.y, u2.x, u2.y}, 1.0f);
                float d0 = 0.f, d1 = 0.f, d2 = 0.f, d3 = 0.f;
#pragma unroll
                for (int m = 0; m < 8; ++m) { d0 += xv[4 * m] * uf[4 * m]; d1 += xv[4 * m + 1] * uf[4 * m + 1]; d2 += xv[4 * m + 2] * uf[4 * m + 2]; d3 += xv[4 * m + 3] * uf[4 * m + 3]; }
                const float act = wave_sum((d0 + d1) + (d2 + d3)) * su;
                const float coef = gate * 0.5f * act * (1.f + erff(act * 0.70710678118f)) * sv;
                const v32f_t vf = __builtin_amdgcn_cvt_scalef32_pk32_f32_fp6((v6u_t){v0.x, v0.y, v1.x, v1.y, v2.x, v2.y}, 1.0f);
#pragma unroll
                for (int m = 0; m < 32; ++m) acc[m] += coef * vf[m];
            }
#pragma unroll
            for (int m = 0; m < 32; ++m) xs[soff[m]] = acc[m];
            float ss = 0.f;
            float* orow = out + tok * DM;
            f32x4 hv[8];
#pragma unroll
            for (int i = 0; i < 8; ++i) { const f32x4 pa = *(const LAS f32x4*)(xs + i * 256 + lane * 4); const f32x4 h0 = *(const f32x4*)(orow + i * 256 + lane * 4);
                hv[i] = pa + h0; ss += hv[i][0] * hv[i][0] + hv[i][1] * hv[i][1] + hv[i][2] * hv[i][2] + hv[i][3] * hv[i][3]; }
            ss = wave_sum(ss);
            const float r = rsqrtf(ss * (1.f / DM) + 1e-6f);
#pragma unroll
            for (int i = 0; i < 8; ++i) { const f32x4 g0 = *(const f32x4*)(p.g_final + i * 256 + lane * 4); *(f32x4*)(orow + i * 256 + lane * 4) = hv[i] * r * g0; }
        }
        __syncthreads();
    }
}

#define XB_TMO      128
#define XB_XCNT(j)  (256  + 64 * (j))
#define XB_XSUB(j)  (1280 + 64 * (j))
#define XB_XGEN(j)  (2304 + 64 * (j))
#define XB_TOP      3328
#define XB_TOPGEN   3392
#define XB_SPIN_CAP (1u << 18)
__device__ __forceinline__ unsigned xb_ld(unsigned* p)              { return __hip_atomic_load(p, __ATOMIC_RELAXED, __HIP_MEMORY_SCOPE_AGENT); }
__device__ __forceinline__ unsigned xb_add(unsigned* p, unsigned v) { return __hip_atomic_fetch_add(p, v, __ATOMIC_RELAXED, __HIP_MEMORY_SCOPE_AGENT); }
__device__ __forceinline__ unsigned xb_xcc_id() { return (unsigned)__builtin_amdgcn_s_getreg((3 << 11) | 20) & 0xFu; }
#define XB_SPIN(cond, bar) do { unsigned _sp = 0; while (cond) { __builtin_amdgcn_s_sleep(1); \
    if ((++_sp & 255u) == 0u) { if (xb_ld(&(bar)[XB_TMO])) break; if (_sp > XB_SPIN_CAP) { atomicAdd(&(bar)[XB_TMO], 1u); break; } } } } while (0)
struct XcdBarrier { unsigned* bar; unsigned x; volatile LAS unsigned* st; };
__device__ __forceinline__ XcdBarrier xcd_barrier_post(unsigned* bar, volatile LAS unsigned* st) {
    XcdBarrier b; b.bar = bar; b.x = xb_xcc_id(); b.st = st;
    if (threadIdx.x == 0) (void)xb_add(&bar[XB_XCNT(b.x)], 1u);
    return b;
}
__device__ __forceinline__ void xcd_barrier_complete(unsigned* bar, unsigned x, unsigned& nloc, unsigned& nx) {
    const unsigned G = gridDim.x * gridDim.y * gridDim.z;
    unsigned sum, cnt, mine, sp = 0u;
    for (;;) {
        sum = 0u; cnt = 0u; mine = 0u;
#pragma unroll
        for (unsigned j = 0; j < 16; ++j) { const unsigned c = xb_ld(&bar[XB_XCNT(j)]); sum += c; cnt += (c > 0u) ? 1u : 0u; mine = (j == x) ? c : mine; }
        if (sum == G) break;
        __builtin_amdgcn_s_sleep(1);
        if ((++sp & 255u) == 0u) { if (xb_ld(&bar[XB_TMO])) break; if (sp > XB_SPIN_CAP) { atomicAdd(&bar[XB_TMO], 1u); break; } }
    }
    nloc = mine > 0u ? mine : 1u; nx = cnt > 0u ? cnt : 1u;
}
__device__ __forceinline__ void xcd_barrier(const XcdBarrier& b) {
    asm volatile("s_waitcnt vmcnt(0)" ::: "memory");
    __syncthreads();
    if (threadIdx.x == 0) {
        unsigned* bar = b.bar;
        __builtin_amdgcn_s_waitcnt(0);
        unsigned nloc = b.st[0], nx = b.st[1];
        if (nloc == 0u) { xcd_barrier_complete(bar, b.x, nloc, nx); b.st[0] = nloc; b.st[1] = nx; }
        const unsigned old = xb_add(&bar[XB_XSUB(b.x)], 1u);
        const unsigned gen = old / nloc;
        if (old + 1u == (gen + 1u) * nloc) {
            __builtin_amdgcn_fence(__ATOMIC_RELEASE, "agent");
            asm volatile("s_waitcnt vmcnt(0)" ::: "memory");
            const unsigned og = xb_add(&bar[XB_TOP], 1u);
            const unsigned tg = og / nx;
            if (og + 1u == (tg + 1u) * nx) xb_add(&bar[XB_TOPGEN], 1u);
            else XB_SPIN(xb_ld(&bar[XB_TOPGEN]) == tg, bar);
            __builtin_amdgcn_fence(__ATOMIC_ACQUIRE, "agent");
            xb_add(&bar[XB_XGEN(b.x)], 1u);
            asm volatile("s_waitcnt vmcnt(0)" ::: "memory");
        } else {
            XB_SPIN(xb_ld(&bar[XB_XGEN(b.x)]) == gen, bar);
            __builtin_amdgcn_fence(__ATOMIC_ACQUIRE, "agent");
            asm volatile("s_waitcnt vmcnt(0)" ::: "memory");
        }
    }
    __syncthreads();
}

__global__ void __launch_bounds__(512) fwd_megakernel(KP p) {
    extern __shared__ __attribute__((aligned(16))) unsigned char smem[];
    LAS unsigned char* lds = (LAS unsigned char*)smem;
    cg::grid_group grid = cg::this_grid();
#define GRID_SYNC() do { asm volatile("s_waitcnt vmcnt(0) lgkmcnt(0)" ::: "memory"); __syncthreads(); grid.sync(); asm volatile("" ::: "memory"); } while (0)
    const int G = gridDim.x, bid = blockIdx.x;
    unsigned char* ws = p.ws; unsigned char* dob = (unsigned char*)p.out;

#define RUN_GEMM(MODE, ...) do { unsigned char* ws = lp(p.ws); unsigned char* dob = lp((unsigned char*)p.out); const pg8::Gemm g_ = pg8::Gemm{__VA_ARGS__}; pg8::StaticOrder S_; S_.init(g_.M, g_.N, G, bid); \
        const pg8::Epi<MODE> E_{ws, dob, p.x, p.w0, p.a0}; pg8::gemm_phase(lds, g_, S_, E_); } while (0)
    volatile LAS unsigned* xst = (volatile LAS unsigned*)(lds + 150512);
    if (threadIdx.x < 4) xst[threadIdx.x] = 0u;
    phase_prep(p, lds);
    GRID_SYNC();
    const XcdBarrier xbar = xcd_barrier_post((unsigned*)(p.ws + OFF_XBAR), xst);
#define XSYNC() do { xcd_barrier(xbar); asm volatile("" ::: "memory"); } while (0)
    RUN_GEMM(0, (const bf16_t*)(ws + OFF_XN), (const bf16_t*)(ws + OFF_WINT), NT, N1, 2048, 2048, 2048);
    XSYNC();
    phase_lora_prep(p);
    XSYNC();
    RUN_GEMM(1, (const bf16_t*)(dob + DO_ALORA), (const bf16_t*)(ws + OFF_WAT), NT, 2048, 256, 512, 256);
    RUN_GEMM(2, (const bf16_t*)(dob + DO_ALORA) + 256, (const bf16_t*)(ws + OFF_G2T), NT, 1024, 256, 512, 256);
    XSYNC();
    if (bid < 128) rwkv_scan(p, bid, lds);
    else {
        mlstm_run(p, bid - 128, lds);
        convert_tables(p, (bid - 128) * 8 + (tid_l() >> 6), 1024);
        __builtin_amdgcn_fence(__ATOMIC_RELEASE, "agent"); __syncthreads();
        if (threadIdx.x == 0) { unsigned* cnt = (unsigned*)(p.ws + OFF_SUBBAR); __hip_atomic_fetch_add(cnt, 1u, __ATOMIC_RELAXED, __HIP_MEMORY_SCOPE_AGENT);
            while (__hip_atomic_load(cnt, __ATOMIC_RELAXED, __HIP_MEMORY_SCOPE_AGENT) < 128u) __builtin_amdgcn_s_sleep(2); }
        __syncthreads(); __builtin_amdgcn_fence(__ATOMIC_ACQUIRE, "agent");
        { unsigned char* ws = lp(p.ws); unsigned char* dob = lp((unsigned char*)p.out); const pg8::Gemm g_ = pg8::Gemm{(const bf16_t*)(ws + OFF_PM) + 3072, (const bf16_t*)(ws + OFF_PMT), NT, 2048, 1024, LDPM, 1024};
          pg8::StaticOrder S_; S_.init(g_.M, g_.N, 128, bid - 128); const pg8::Epi<3> E_{ws, dob, p.x, p.w0, p.a0}; pg8::gemm_phase(lds, g_, S_, E_); }
    }
    XSYNC();
    phase_rwkv_post(p);
    XSYNC();
    RUN_GEMM(4, (const bf16_t*)(ws + OFF_YR), (const bf16_t*)(ws + OFF_PRT), NT, 2048, 1024, 1024, 1024);
    XSYNC();
    RUN_GEMM(5, (const bf16_t*)(ws + OFF_PG), (const bf16_t*)(ws + OFF_WOT), NT, 2048, 2048, LDPG, 2048);
    XSYNC();
    phase_norm2(p);
    XSYNC();
    RUN_GEMM(6, (const bf16_t*)(ws + OFF_XN2), (const bf16_t*)(ws + OFF_WQT), NT, 2048, 2048, 2048, 2048);
    XSYNC();
    phase_peer(p, lds);
}

extern "C" void kernel_launch(void* const* d_in, const int* in_sizes, int n_in, void* d_out, int out_size, void* d_ws, size_t ws_size, hipStream_t stream) {
    static int grid_blocks = 0;
    if (grid_blocks == 0) {
        if (n_in != 26 || out_size != NT * DM || ws_size < WS_NEED) { fprintf(stderr, "kernel_launch: unexpected shapes: n_in %d out %d ws %zu (need %zu)\n", n_in, out_size, ws_size, (size_t)WS_NEED); grid_blocks = -1; return; }
        int dev = 0, cus = 0, per_cu = 0;
        hipGetDevice(&dev);
        hipDeviceGetAttribute(&cus, hipDeviceAttributeMultiprocessorCount, dev);
        if (hipFuncSetAttribute((const void*)fwd_megakernel, hipFuncAttributeMaxDynamicSharedMemorySize, LDS_BYTES) != hipSuccess) { fprintf(stderr, "kernel_launch: hipFuncSetAttribute failed\n"); grid_blocks = -1; return; }
        hipOccupancyMaxActiveBlocksPerMultiprocessor(&per_cu, (const void*)fwd_megakernel, 512, LDS_BYTES);
        if (per_cu < 1) { fprintf(stderr, "kernel_launch: occupancy query says %d blocks per CU\n", per_cu); per_cu = 1; }
        (void)hipGetLastError();
        grid_blocks = cus * 1;
    }
    if (grid_blocks < 0) return;
    KP p{};
    const float** pp = (const float**)&p;
    for (int i = 0; i < 26; ++i) pp[i] = (const float*)d_in[i];
    p.out = (float*)d_out; p.ws = (unsigned char*)d_ws;
    void* args[] = {&p};
    hipError_t e = hipLaunchCooperativeKernel((void*)fwd_megakernel, dim3(grid_blocks), dim3(512), args, LDS_BYTES, stream);
    if (e != hipSuccess) fprintf(stderr, "cooperative launch failed: %s (grid %d)\n", hipGetErrorString(e), grid_blocks);
}
```

```cpp
#include <hip/hip_runtime.h>
#include <hip/hip_cooperative_groups.h>
#include <cstdio>
namespace cg = cooperative_groups;

#define LAS __attribute__((address_space(3)))
typedef unsigned short bf16_t;
typedef short bf16x8 __attribute__((ext_vector_type(8)));
typedef float f32x4 __attribute__((ext_vector_type(4)));
typedef unsigned u32x4 __attribute__((ext_vector_type(4)));
typedef unsigned u32x2 __attribute__((ext_vector_type(2)));

constexpr int NT = 16384, SEQ = 4096, DM = 2048;
constexpr int LDPM = 4096, LDPR = 3584, LDPG = 4096, N1 = 11776;
constexpr size_t MiB = 1024ull * 1024ull;
constexpr size_t OFF_PM = 0, OFF_PR = 128 * MiB, OFF_PG = 240 * MiB, OFF_XN = 368 * MiB, OFF_WINT = 432 * MiB, OFF_WTS = 478 * MiB;
constexpr size_t OFF_PMT = OFF_WTS, OFF_PRT = OFF_WTS + 4 * MiB, OFF_WOT = OFF_WTS + 8 * MiB, OFF_WQT = OFF_WTS + 16 * MiB, OFF_WAT = OFF_WTS + 24 * MiB,
                 OFF_G2T = OFF_WTS + 25 * MiB, OFF_SUBK = OFF_WTS + 25 * MiB + 512 * 1024, WS_NEED = OFF_WTS + 26 * MiB;
constexpr size_t OFF_QC = OFF_XN, OFF_KC = OFF_XN + 32 * MiB, OFF_YR = OFF_WINT, OFF_Q = OFF_XN, OFF_XN2 = OFF_PR, OFF_PU = OFF_PM, OFF_PV = OFF_PM + 2048, OFF_SUBBAR = OFF_SUBK + 192 * 1024, OFF_XBAR = OFF_SUBBAR + 256,
                 OFF_SCU = OFF_SUBK + 64 * 1024, OFF_SCV = OFF_SCU + 64 * 1024;
constexpr size_t DO_WLOG = 0, DO_AG = 32 * MiB, DO_GG = 64 * MiB, DO_ALORA = 96 * MiB, DO_GB = 112 * MiB, DO_GA = DO_GB + 256 * 1024, DO_GW = DO_GA + 256 * 1024;
constexpr int LDS_BYTES = 150528;
#define XCD_BAR_WORDS 3456

struct KP {
    const float *x, *g_mix, *w_in, *conv_w, *b_i, *b_f, *mu, *w0, *w2, *a0, *a2, *g2, *k_k, *k_a, *r_k, *ln_w, *ln_b, *proj_m, *proj_r, *w_out, *g_ffn,
        *w_query, *sub_keys, *peer_u, *peer_v, *g_final;
    float* out; unsigned char* ws;
};

typedef __bf16 bf16x2_t __attribute__((ext_vector_type(2)));
typedef float f32x2_t __attribute__((ext_vector_type(2)));
__device__ __forceinline__ unsigned cvt_pk_bf16(float lo, float hi) { f32x2_t v = {lo, hi}; bf16x2_t b = __builtin_convertvector(v, bf16x2_t); return __builtin_bit_cast(unsigned, b); }
__device__ __forceinline__ bf16_t f2bf(float f) { return (bf16_t)(cvt_pk_bf16(f, 0.f) & 0xffffu); }
__device__ __forceinline__ float bf2f(bf16_t h) { return __uint_as_float((unsigned)h << 16); }
__device__ __forceinline__ float bflo(unsigned u) { return __uint_as_float(u << 16); }
__device__ __forceinline__ float bfhi(unsigned u) { return __uint_as_float(u & 0xffff0000u); }
__device__ __forceinline__ float sigm(float x) { return __builtin_amdgcn_rcpf(1.f + __expf(-x)); }
template <int CTRL> __device__ __forceinline__ float dppf(float v) { return __builtin_bit_cast(float, __builtin_amdgcn_update_dpp(0, __builtin_bit_cast(int, v), CTRL, 0xF, 0xF, true)); }
template <int CTRL> __device__ __forceinline__ unsigned dppu(unsigned v) { return (unsigned)__builtin_amdgcn_update_dpp(0, (int)v, CTRL, 0xF, 0xF, true); }
__device__ __forceinline__ float red4(float v) { v += dppf<0xB1>(v); v += dppf<0x4E>(v); return v; }
__device__ __forceinline__ float red8(float v) { v = red4(v); v += dppf<0x141>(v); return v; }
__device__ __forceinline__ float red16(float v) { v = red8(v); v += dppf<0x140>(v); return v; }
__device__ __forceinline__ float rlane(float v, int l) { return __builtin_bit_cast(float, __builtin_amdgcn_readlane(__builtin_bit_cast(int, v), l)); }
__device__ __forceinline__ float wave_sum(float v) { v = red16(v); return rlane(v, 0) + rlane(v, 16) + rlane(v, 32) + rlane(v, 48); }
__device__ __forceinline__ unsigned wave_max_u32(unsigned v) {
    v = max(v, dppu<0xB1>(v)); v = max(v, dppu<0x4E>(v)); v = max(v, dppu<0x141>(v)); v = max(v, dppu<0x140>(v));
    unsigned a = (unsigned)__builtin_amdgcn_readlane((int)v, 0), b = (unsigned)__builtin_amdgcn_readlane((int)v, 16), c = (unsigned)__builtin_amdgcn_readlane((int)v, 32), d = (unsigned)__builtin_amdgcn_readlane((int)v, 48);
    return max(max(a, b), max(c, d));
}
__device__ __forceinline__ unsigned ordf(float f) { unsigned u = __float_as_uint(f); return (u & 0x80000000u) ? ~u : (u | 0x80000000u); }
__device__ __forceinline__ float unordf(unsigned k) { return __uint_as_float((k & 0x80000000u) ? (k ^ 0x80000000u) : ~k); }

__device__ __forceinline__ int tid_l() { int t = threadIdx.x; asm volatile("" : "+v"(t)); return t; }
template <class T> __device__ __forceinline__ T* lp(T* q) { asm volatile("" : "+s"(q)); return q; }
namespace pg8 {
constexpr int BM = 256, BK = 64, HALF = 128, HTB = HALF * BK * 2, STAGE_BYTES = 8 * HTB, NXCD = 8, WGM = 8;
__device__ __forceinline__ int lds_byte(int r, int c) { const int st = (r >> 4) * 2 + (c >> 5), rr = r & 15, cc = c & 31, ob = rr * 64 + cc * 2; return st * 1024 + (ob ^ (((ob >> 9) & 1) << 5)); }
__device__ __forceinline__ void stage_rc(int b, int& R, int& C) { const int st = b / 1024, sb = b % 1024, swz = sb ^ (((sb >> 9) & 1) << 5); R = (st >> 1) * 16 + swz / 64; C = (st & 1) * 32 + (swz % 64) / 2; }
__device__ __forceinline__ int perm32(int rho) { const int n = rho >> 4, i = rho & 15; return 8 * (i >> 2) + 4 * n + (i & 3); }
struct Unit { int pm, pn; };
struct Gemm { const bf16_t* A; const bf16_t* Bt; int M, N, K, lda, ldb; };
struct StaticOrder {
    int nM, nN, nwg, G, c;
    __device__ void init(int M, int N, int G_, int c_) { nM = M / BM; nN = N / BM; nwg = nM * nN; G = G_; c = c_; }
    __device__ bool next(int i, Unit& u) const {
        const long L = (long)i * G + c; if (L >= nwg) return false;
        int wgid = (int)L; { const int q = nwg / NXCD, r = nwg % NXCD, xcd = wgid % NXCD, off = wgid / NXCD; wgid = (xcd < r ? xcd * (q + 1) : r * (q + 1) + (xcd - r) * q) + off; }
        const int nig = WGM * nN, gid = wgid / nig, fm = gid * WGM, gsz = (nM - fm) < WGM ? (nM - fm) : WGM;
        u.pm = fm + ((wgid % nig) % gsz); u.pn = (wgid % nig) / gsz; return true;
    }
};

__device__ __forceinline__ void store8(bf16_t* p, f32x4 v0, f32x4 v1) {
    u32x4 w; w.x = cvt_pk_bf16(v0[0], v0[1]); w.y = cvt_pk_bf16(v0[2], v0[3]); w.z = cvt_pk_bf16(v1[0], v1[1]); w.w = cvt_pk_bf16(v1[2], v1[3]); *(u32x4*)p = w;
}
__device__ __forceinline__ void load8(const bf16_t* p, f32x4& v0, f32x4& v1) {
    const u32x4 w = *(const u32x4*)p; v0 = (f32x4){bflo(w.x), bfhi(w.x), bflo(w.y), bfhi(w.y)}; v1 = (f32x4){bflo(w.z), bfhi(w.z), bflo(w.w), bfhi(w.w)};
}

template <int mode> struct Epi {
    static constexpr bool PERM = true;
    unsigned char* ws; unsigned char* dob; const float* x; const float* w0; const float* a0;
    __device__ __forceinline__ void operator()(const f32x4 (&acc)[2][2][4][2], const Unit& u, int wr, int wc, int fr, int fq) const {
        const int row0 = u.pm * BM + wr * 64 + fr, cb = u.pn * BM + wc * 32 + 8 * fq;
#pragma unroll
        for (int ai = 0; ai < 2; ++ai)
#pragma unroll
            for (int m = 0; m < 4; ++m) {
                const size_t row = (size_t)(row0 + ai * HALF + m * 16);
#pragma unroll
                for (int bj = 0; bj < 2; ++bj) {
                    const int col = cb + bj * HALF;
                    f32x4 v0 = acc[ai][bj][m][0], v1 = acc[ai][bj][m][1];
                    if (mode == 0) {
                        if (col < 4096) store8((bf16_t*)(ws + OFF_PM) + row * LDPM + col, v0, v1);
                        else if (col < 7680) store8((bf16_t*)(ws + OFF_PR) + row * LDPR + (col - 4096), v0, v1);
                        else {
#pragma unroll
                            for (int j = 0; j < 4; ++j) { v0[j] = sigm(v0[j]); v1[j] = sigm(v1[j]); }
                            store8((bf16_t*)(ws + OFF_PG) + row * LDPG + (col - 7680), v0, v1);
                        }
                    } else if (mode == 1) {
                        if (col < 1024) {
                            const f32x4 b0 = *(const f32x4*)(w0 + col), b1 = *(const f32x4*)(w0 + col + 4);
#pragma unroll
                            for (int j = 0; j < 4; ++j) {
                                float z = -(b0[j] + v0[j]); float sp = fmaxf(z, 0.f) + __logf(1.f + __expf(-fabsf(z))); v0[j] = -__expf(-sp - 0.5f);
                                z = -(b1[j] + v1[j]); sp = fmaxf(z, 0.f) + __logf(1.f + __expf(-fabsf(z))); v1[j] = -__expf(-sp - 0.5f);
                            }
                            store8((bf16_t*)(dob + DO_WLOG) + row * 1024 + col, v0, v1);
                        } else {
                            const int c2 = col - 1024;
                            const f32x4 b0 = *(const f32x4*)(a0 + c2), b1 = *(const f32x4*)(a0 + c2 + 4);
#pragma unroll
                            for (int j = 0; j < 4; ++j) { v0[j] = sigm(b0[j] + v0[j]); v1[j] = sigm(b1[j] + v1[j]); }
                            store8((bf16_t*)(dob + DO_AG) + row * 1024 + c2, v0, v1);
                        }
                    } else if (mode == 2) {
                        store8((bf16_t*)(dob + DO_GG) + row * 1024 + col, v0, v1);
                    } else if (mode == 3) {
                        bf16_t* pp = (bf16_t*)(ws + OFF_PG) + row * LDPG + col; f32x4 g0, g1; load8(pp, g0, g1);
                        store8(pp, g0 * v0, g1 * v1);
                    } else if (mode == 4) {
                        bf16_t* pp = (bf16_t*)(ws + OFF_PG) + row * LDPG + col; f32x4 m0, m1, g0, g1; load8(pp, m0, m1); load8(pp + 2048, g0, g1);
                        store8(pp, m0 + g0 * v0, m1 + g1 * v1);
                    } else if (mode == 5) {
                        const float* xp = x + row * DM + col; float* op = (float*)dob + row * DM + col;
                        const f32x4 x0 = *(const f32x4*)xp, x1 = *(const f32x4*)(xp + 4);
                        *(f32x4*)op = x0 + v0; *(f32x4*)(op + 4) = x1 + v1;
                    } else {
                        store8((bf16_t*)(ws + OFF_Q) + row * DM + col, v0, v1);
                    }
                    asm volatile("" ::: "memory");
                }
            }
    }
};

template <class EpiT> __device__ __forceinline__ void gemm_phase(LAS unsigned char* lds, const Gemm g, const StaticOrder& S, const EpiT& E) {
    const int tid = tid_l(), wid = __builtin_amdgcn_readfirstlane(tid >> 6), lane = tid & 63, wr = wid >> 2, wc = wid & 3, fr = lane & 15, fq = lane >> 4;
    const int K = g.K, nt = K / BK;
    unsigned voffA[2], voffB[2];
#pragma unroll
    for (int i = 0; i < 2; ++i) { int R, C; stage_rc(tid * 16 + i * 8192, R, C); const int Rb = (R & ~31) + perm32(R & 31);
        voffA[i] = (unsigned)(R * g.lda + C) * 2u; voffB[i] = (unsigned)(Rb * g.ldb + C) * 2u; }
    const size_t kstep = (size_t)(BK * 2);
    const size_t hstepA = (size_t)HALF * g.lda * 2, hstepB = (size_t)HALF * g.ldb * 2;
    const size_t tstepA = 2 * hstepA, tstepB = 2 * hstepB;
    const unsigned ldsw = (unsigned)wid * 1024u;
    const int aoff = lds_byte(wr * 64 + fr, fq * 8), boff = lds_byte(wc * 32 + fr, fq * 8);
#define PG8_SA(b, h) (((b) * 2 + (h)) * HTB)
#define PG8_SB(b, h) ((4 + (b) * 2 + (h)) * HTB)
#define PG8_STAGE(bufoff, gbase, voff) do { _Pragma("unroll") for (int _i = 0; _i < 2; ++_i) \
        __builtin_amdgcn_global_load_lds((const unsigned*)((const char*)(gbase) + (voff)[_i]), (LAS unsigned*)(lds + (bufoff) + ldsw + _i * 8192), 16, 0, 0); } while (0)
#define PG8_LDA(dst, b, h) do { _Pragma("unroll") for (int m = 0; m < 4; ++m) _Pragma("unroll") for (int k = 0; k < 2; ++k) dst[m][k] = *(const LAS bf16x8*)(lds + PG8_SA(b, h) + aoff + m * 2048 + k * 1024); } while (0)
#define PG8_LDB(dst, b, h) do { _Pragma("unroll") for (int n = 0; n < 2; ++n) _Pragma("unroll") for (int k = 0; k < 2; ++k) dst[n][k] = *(const LAS bf16x8*)(lds + PG8_SB(b, h) + boff + n * 2048 + k * 1024); } while (0)
#define PG8_MMA(ai, bj, At, Bt) do { __builtin_amdgcn_s_setprio(1); _Pragma("unroll") for (int m = 0; m < 4; ++m) _Pragma("unroll") for (int n = 0; n < 2; ++n) _Pragma("unroll") for (int k = 0; k < 2; ++k) \
        acc[ai][bj][m][n] = __builtin_amdgcn_mfma_f32_16x16x32_bf16(Bt[n][k], At[m][k], acc[ai][bj][m][n], 0, 0, 0); __builtin_amdgcn_s_setprio(0); } while (0)
#define PG8_WAIT_V(n) asm volatile("s_waitcnt vmcnt(" #n ")" ::: "memory")
#define PG8_WAIT_L(n) asm volatile("s_waitcnt lgkmcnt(" #n ")" ::: "memory")
#define PG8_BAR __builtin_amdgcn_s_barrier()
#define PG8_SCHED __builtin_amdgcn_sched_barrier(0)
    Unit cur, nxt; int ui = 0;
    if (!S.next(0, cur)) return;
    f32x4 acc[2][2][4][2];
#pragma unroll
    for (int a = 0; a < 2; ++a)
#pragma unroll
        for (int b = 0; b < 2; ++b)
#pragma unroll
            for (int m = 0; m < 4; ++m)
#pragma unroll
                for (int n = 0; n < 2; ++n) acc[a][b][m][n] = (f32x4){0.f, 0.f, 0.f, 0.f};
    bf16x8 At[4][2], B0[2][2], B1[2][2];
    const char* cA = (const char*)g.A + (size_t)cur.pm * tstepA; const char* cB = (const char*)g.Bt + (size_t)cur.pn * tstepB;
    PG8_STAGE(PG8_SB(0, 0), cB, voffB); PG8_STAGE(PG8_SA(0, 0), cA, voffA); PG8_STAGE(PG8_SB(0, 1), cB + hstepB, voffB); PG8_STAGE(PG8_SA(0, 1), cA + hstepA, voffA);
    if (wr == 1) PG8_BAR;
    PG8_WAIT_V(4); PG8_BAR;
    PG8_STAGE(PG8_SB(1, 0), cB + kstep, voffB); PG8_STAGE(PG8_SA(1, 0), cA + kstep, voffA); PG8_STAGE(PG8_SB(1, 1), cB + hstepB + kstep, voffB);
    PG8_WAIT_V(6); PG8_BAR;
    for (;;) {
        const bool has_next = S.next(ui + 1, nxt);
        const char* nA = has_next ? (const char*)g.A + (size_t)nxt.pm * tstepA : cA; const char* nB = has_next ? (const char*)g.Bt + (size_t)nxt.pn * tstepB : cB;
        for (int t = 0; t < nt; t += 2) {
            const bool last = (t == nt - 2);
            const char* a1 = cA + (size_t)(t + 1) * kstep;
            const char* a2 = last ? nA : cA + (size_t)(t + 2) * kstep; const char* b2 = last ? nB : cB + (size_t)(t + 2) * kstep;
            const char* a3 = a2 + kstep; const char* b3 = b2 + kstep;
            PG8_LDB(B0, 0, 0); PG8_SCHED; PG8_LDA(At, 0, 0); PG8_STAGE(PG8_SA(1, 1), a1 + hstepA, voffA);
            PG8_WAIT_L(8); PG8_BAR; PG8_WAIT_L(0); PG8_MMA(0, 0, At, B0); PG8_BAR; PG8_SCHED;
            PG8_LDB(B1, 0, 1); PG8_STAGE(PG8_SB(0, 0), b2, voffB);
            PG8_BAR; PG8_WAIT_L(0); PG8_MMA(0, 1, At, B1); PG8_BAR;
            PG8_LDA(At, 0, 1); PG8_STAGE(PG8_SA(0, 0), a2, voffA);
            PG8_BAR; PG8_WAIT_L(0); PG8_MMA(1, 0, At, B0); PG8_BAR; PG8_SCHED;
            PG8_STAGE(PG8_SB(0, 1), b2 + hstepB, voffB);
            PG8_WAIT_V(6); PG8_BAR; PG8_MMA(1, 1, At, B1); PG8_BAR;
            PG8_LDB(B0, 1, 0); PG8_SCHED; PG8_LDA(At, 1, 0); PG8_STAGE(PG8_SA(0, 1), a2 + hstepA, voffA);
            PG8_WAIT_L(8); PG8_BAR; PG8_WAIT_L(0); PG8_MMA(0, 0, At, B0); PG8_BAR; PG8_SCHED;
            PG8_LDB(B1, 1, 1); PG8_STAGE(PG8_SB(1, 0), b3, voffB);
            PG8_BAR; PG8_WAIT_L(0); PG8_MMA(0, 1, At, B1); PG8_BAR;
            PG8_LDA(At, 1, 1); PG8_STAGE(PG8_SA(1, 0), a3, voffA);
            PG8_BAR; PG8_WAIT_L(0); PG8_MMA(1, 0, At, B0); PG8_BAR; PG8_SCHED;
            PG8_STAGE(PG8_SB(1, 1), b3 + hstepB, voffB);
            PG8_WAIT_V(6); PG8_BAR; PG8_MMA(1, 1, At, B1); PG8_BAR;
        }
        E(acc, cur, wr, wc, fr, fq);
        if (!has_next) break;
#pragma unroll
        for (int a = 0; a < 2; ++a)
#pragma unroll
            for (int b = 0; b < 2; ++b)
#pragma unroll
                for (int m = 0; m < 4; ++m)
#pragma unroll
                    for (int n = 0; n < 2; ++n) acc[a][b][m][n] = (f32x4){0.f, 0.f, 0.f, 0.f};
        cur = nxt; cA = nA; cB = nB; ++ui;
    }
    PG8_WAIT_V(0);
    if (wr == 0) PG8_BAR;
    PG8_BAR;
#undef PG8_SA
#undef PG8_SB
#undef PG8_STAGE
#undef PG8_LDA
#undef PG8_LDB
#undef PG8_MMA
#undef PG8_WAIT_V
#undef PG8_WAIT_L
#undef PG8_BAR
#undef PG8_SCHED
}
}

__device__ __forceinline__ void rmsnorm_rows(const float* src, const float* gain, bf16_t* dst, int gw, int nw, int lane) {
    for (int row = gw; row < NT; row += nw) {
        const f32x4* s = (const f32x4*)(src + (size_t)row * DM);
        f32x4 v[8]; float ss = 0.f;
#pragma unroll
        for (int i = 0; i < 8; ++i) { v[i] = s[i * 64 + lane]; ss += v[i][0] * v[i][0] + v[i][1] * v[i][1] + v[i][2] * v[i][2] + v[i][3] * v[i][3]; }
        ss = wave_sum(ss);
        const float r = rsqrtf(ss * (1.f / DM) + 1e-6f);
        u32x2* d = (u32x2*)(dst + (size_t)row * DM);
#pragma unroll
        for (int i = 0; i < 8; ++i) { const f32x4 gg = ((const f32x4*)gain)[i * 64 + lane]; u32x2 o; o.x = cvt_pk_bf16(v[i][0] * r * gg[0], v[i][1] * r * gg[1]); o.y = cvt_pk_bf16(v[i][2] * r * gg[2], v[i][3] * r * gg[3]); d[i * 64 + lane] = o; }
    }
}

__device__ __forceinline__ void tr_tile(const float* src, int ld, int c0, int nvalid, int k0, bf16_t* dst, int ldd, int r0, int kd0, LAS float* tile) {
    const int tid = tid_l();
#pragma unroll
    for (int i = 0; i < 2; ++i) {
        const int k = (tid >> 4) + 32 * i, c4 = (tid & 15) * 4;
        f32x4 v = (f32x4){0.f, 0.f, 0.f, 0.f};
        if (c4 < nvalid) v = *(const f32x4*)(src + (size_t)(k0 + k) * ld + c0 + c4);
        tile[k * 65 + c4] = v[0]; tile[k * 65 + c4 + 1] = v[1]; tile[k * 65 + c4 + 2] = v[2]; tile[k * 65 + c4 + 3] = v[3];
    }
    __syncthreads();
    {
        const int c = tid >> 3, k8 = (tid & 7) * 8;
        float f[8];
#pragma unroll
        for (int j = 0; j < 8; ++j) f[j] = tile[(k8 + j) * 65 + c];
        u32x4 w; w.x = cvt_pk_bf16(f[0], f[1]); w.y = cvt_pk_bf16(f[2], f[3]); w.z = cvt_pk_bf16(f[4], f[5]); w.w = cvt_pk_bf16(f[6], f[7]);
        *(u32x4*)(dst + (size_t)(r0 + c) * ldd + kd0 + k8) = w;
    }
    __syncthreads();
}

__device__ void phase_prep(const KP& p, LAS unsigned char* lds) {
    const int tid = tid_l(), lane = tid & 63, G = gridDim.x, bid = blockIdx.x;
    unsigned char* ws = p.ws;
    rmsnorm_rows(p.x, p.g_mix, (bf16_t*)(ws + OFF_XN), bid * 8 + (tid >> 6), G * 8, lane);
    LAS float* tile = (LAS float*)lds;
    for (int j = bid; j < 8960; j += G) {
        if (j < 5888) {
            const int rt = j >> 5, kt = j & 31; int c0, nv = 64;
            if (rt < 64) c0 = 64 * rt; else if (rt < 119) c0 = 4104 + 64 * (rt - 64); else if (rt == 119) { c0 = 4096; nv = 8; } else c0 = 7624 + 64 * (rt - 120);
            tr_tile(p.w_in, 11720, c0, nv, kt * 64, (bf16_t*)(ws + OFF_WINT), 2048, rt * 64, kt * 64, tile);
        } else if (j < 6400) { const int q = j - 5888, rt = q >> 4, kt = q & 15; tr_tile(p.proj_m, 2048, rt * 64, 64, kt * 64, (bf16_t*)(ws + OFF_PMT), 1024, rt * 64, kt * 64, tile); }
        else if (j < 6912) { const int q = j - 6400, rt = q >> 4, kt = q & 15; tr_tile(p.proj_r, 2048, rt * 64, 64, kt * 64, (bf16_t*)(ws + OFF_PRT), 1024, rt * 64, kt * 64, tile); }
        else if (j < 7936) { const int q = j - 6912, rt = q >> 5, kt = q & 31; tr_tile(p.w_out, 2048, rt * 64, 64, kt * 64, (bf16_t*)(ws + OFF_WOT), 2048, rt * 64, kt * 64, tile); }
        else { const int q = j - 7936, rt = q >> 5, kt = q & 31; tr_tile(p.w_query, 2048, rt * 64, 64, kt * 64, (bf16_t*)(ws + OFF_WQT), 2048, rt * 64, kt * 64, tile); }
    }
    const int gt = bid * 512 + tid, gn = G * 512;
    bf16_t* WAT = (bf16_t*)(ws + OFF_WAT);
    for (int i = gt; i < 2048 * 256; i += gn) { const int r = i >> 8, k = i & 255; float v = 0.f;
        if (r < 1024) { if (k < 96) v = p.w2[k * 1024 + r]; } else { if (k >= 96 && k < 192) v = p.a2[(k - 96) * 1024 + (r - 1024)]; }
        WAT[i] = f2bf(v); }
    bf16_t* G2T = (bf16_t*)(ws + OFF_G2T);
    for (int i = gt; i < 1024 * 256; i += gn) { const int r = i >> 8, k = i & 255; G2T[i] = f2bf(p.g2[k * 1024 + r]); }
    bf16_t* SK = (bf16_t*)(ws + OFF_SUBK);
    for (int i = gt; i < 2 * 128 * 128; i += gn) SK[i] = f2bf(p.sub_keys[i]);
    if (gt == 0) *(unsigned*)(ws + OFF_SUBBAR) = 0u;
    for (int i = gt; i < XCD_BAR_WORDS; i += gn) ((unsigned*)(ws + OFF_XBAR))[i] = 0u;
}

__device__ __forceinline__ float bfel(const u32x4& w, int e) { const unsigned u = w[e >> 1]; return (e & 1) ? bfhi(u) : bflo(u); }
__device__ void phase_lora_prep(const KP& p) {
    const bf16_t* PR = (const bf16_t*)(p.ws + OFF_PR);
    bf16_t* AL = (bf16_t*)((unsigned char*)p.out + DO_ALORA);
    const int gt = blockIdx.x * 512 + threadIdx.x, gn = gridDim.x * 512;
    for (int i = gt; i < NT * 64; i += gn) {
        const int tok = i >> 6, g = i & 63;
        u32x4 o = (u32x4){0u, 0u, 0u, 0u};
        if (g < 24 || g >= 32) {
            const int sc = (g < 24) ? (3072 + 8 * g) : (3264 + 8 * (g - 32));
            const u32x4 cu = *(const u32x4*)(PR + (size_t)tok * LDPR + sc);
            u32x4 pv = (u32x4){0u, 0u, 0u, 0u};
            if ((tok & (SEQ - 1)) != 0) pv = *(const u32x4*)(PR + (size_t)(tok - 1) * LDPR + sc);
            const f32x4 m0 = *(const f32x4*)(p.mu + sc), m1 = *(const f32x4*)(p.mu + sc + 4);
            float f[8];
#pragma unroll
            for (int q = 0; q < 4; ++q) {
                const float c0 = bflo(cu[q]), c1 = bfhi(cu[q]), p0 = bflo(pv[q]), p1 = bfhi(pv[q]);
                const float mm0 = (q < 2) ? m0[2 * q] : m1[2 * q - 4], mm1 = (q < 2) ? m0[2 * q + 1] : m1[2 * q - 3];
                f[2 * q] = c0 + (p0 - c0) * mm0; f[2 * q + 1] = c1 + (p1 - c1) * mm1;
            }
            if (g < 12) {
#pragma unroll
                for (int q = 0; q < 8; ++q) f[q] = tanhf(f[q]);
            } else if (g >= 32) {
#pragma unroll
                for (int q = 0; q < 8; ++q) f[q] = sigm(f[q]);
            }
            o.x = cvt_pk_bf16(f[0], f[1]); o.y = cvt_pk_bf16(f[2], f[3]); o.z = cvt_pk_bf16(f[4], f[5]); o.w = cvt_pk_bf16(f[6], f[7]);
        }
        *(u32x4*)(AL + (size_t)tok * 512 + 8 * g) = o;
    }
    {
        const bf16_t* PM = (const bf16_t*)(p.ws + OFF_PM);
        bf16_t* QC = (bf16_t*)(p.ws + OFF_QC); bf16_t* KC = (bf16_t*)(p.ws + OFF_KC);
        for (int i = gt; i < (NT / 8) * 256; i += gn) {
            const int tb = i >> 8, col = (i & 255) * 8; const int tok0 = tb * 8, t0 = tok0 & (SEQ - 1);
            f32x4 cw[4][2];
#pragma unroll
            for (int j = 0; j < 4; ++j) { cw[j][0] = *(const f32x4*)(p.conv_w + j * 2048 + col); cw[j][1] = *(const f32x4*)(p.conv_w + j * 2048 + col + 4); }
            u32x4 raw[11];
#pragma unroll
            for (int q = 0; q < 11; ++q) { const bool neg = (t0 - 3 + q) < 0; u32x4 v = *(const u32x4*)(PM + (size_t)(tok0 + (neg ? 0 : q - 3)) * LDPM + col); if (neg) v = (u32x4){0u, 0u, 0u, 0u}; raw[q] = v; }
            const float scl = (col < 1024) ? 0.0625f : 1.f;
            bf16_t* dst = (col < 1024) ? (QC + (size_t)tok0 * 1024 + col) : (KC + (size_t)tok0 * 1024 + (col - 1024));
#pragma unroll
            for (int r = 0; r < 8; ++r) {
                float o[8];
#pragma unroll
                for (int e = 0; e < 8; ++e) {
                    const float c0 = (e < 4) ? cw[0][0][e] : cw[0][1][e - 4], c1 = (e < 4) ? cw[1][0][e] : cw[1][1][e - 4], c2 = (e < 4) ? cw[2][0][e] : cw[2][1][e - 4], c3 = (e < 4) ? cw[3][0][e] : cw[3][1][e - 4];
                    float sv = c0 * bfel(raw[r], e) + c1 * bfel(raw[r + 1], e) + c2 * bfel(raw[r + 2], e) + c3 * bfel(raw[r + 3], e);
                    o[e] = sv * sigm(sv) * scl;
                }
                u32x4 pk; pk.x = cvt_pk_bf16(o[0], o[1]); pk.y = cvt_pk_bf16(o[2], o[3]); pk.z = cvt_pk_bf16(o[4], o[5]); pk.w = cvt_pk_bf16(o[6], o[7]);
                *(u32x4*)(dst + (size_t)r * 1024) = pk;
            }
        }
    }
    {
        const int lane = threadIdx.x & 63, gw = blockIdx.x * 8 + (threadIdx.x >> 6), nw = gridDim.x * 8;
        float* GB = (float*)((unsigned char*)p.out + DO_GB); float* GA = (float*)((unsigned char*)p.out + DO_GA); float* GW = (float*)((unsigned char*)p.out + DO_GW);
        for (int task = gw; task < 1024; task += nw) {
            const int bh = task >> 6, c = task & 63, bb = bh >> 2, h = bh & 3; const size_t tok = (size_t)bb * SEQ + c * 64 + lane;
            const float iv = bf2f(PR[tok * LDPR + 3520 + h]) + p.b_i[h], fv = bf2f(PR[tok * LDPR + 3524 + h]) + p.b_f[h];
            float lf = fminf(fv, 0.f) - __logf(1.f + __expf(-fabsf(fv)));
#pragma unroll
            for (int d = 1; d < 64; d <<= 1) { const float y = __shfl_up(lf, d); if (lane >= d) lf += y; }
            const float bl = rlane(lf, 63);
            const int o = bh * SEQ + c * 64 + lane;
            GB[o] = lf; GA[o] = iv - lf; GW[o] = __expf(bl - lf + iv);
        }
    }
}

constexpr size_t OFF_YRAW = OFF_WINT, OFF_BON = OFF_WINT + 32 * MiB;
struct RwOps { f32x4 a0, a1, q0, q1, w0, w1, b0, b1, k0, k1; float v, br, kr; };
__device__ __forceinline__ f32x2_t lo2(f32x4 v) { return __builtin_shufflevector(v, v, 0, 1); }
__device__ __forceinline__ f32x2_t hi2(f32x4 v) { return __builtin_shufflevector(v, v, 2, 3); }
__device__ __forceinline__ f32x2_t fma2(f32x2_t a, f32x2_t b, f32x2_t c) { return __builtin_elementwise_fma(a, b, c); }
__device__ void rwkv_scan(const KP& p, int blk, LAS unsigned char* lds) {
    const int tid0 = tid_l();
    const int bh = blk >> 1, half = blk & 1, b = bh >> 4, h = bh & 15;
    constexpr int BUFB = 53760;
    const bf16_t* PR = (const bf16_t*)(p.ws + OFF_PR);
    const bf16_t* WLOG = (const bf16_t*)((const unsigned char*)p.out + DO_WLOG);
    const bf16_t* AG = (const bf16_t*)((const unsigned char*)p.out + DO_AG);
    bf16_t* YRAW = (bf16_t*)(p.ws + OFF_YRAW); float* BON = (float*)(p.ws + OFF_BON);
    const size_t tokbase = (size_t)b * SEQ;
    if (tid0 < 256) {
        const int rowl = tid0 >> 3, j8 = (tid0 & 7) * 8, row = 32 * half + rowl;
        f32x2_t S2[4];
#pragma unroll
        for (int k = 0; k < 4; ++k) S2[k] = (f32x2_t){0.f, 0.f};
        __syncthreads();
        for (int c = 0; c < 128; ++c) {
            const LAS float* bp = (const LAS float*)(lds + (c & 1) * BUFB);
            LAS float* yb = (LAS float*)(lds + (c & 1) * BUFB + 49408);
#define RW_LD(O, s) do { const LAS float* q_ = bp + (s) * 64 + j8; O.a0 = *(const LAS f32x4*)(q_); O.a1 = *(const LAS f32x4*)(q_ + 4); O.b0 = *(const LAS f32x4*)(q_ + 2048); O.b1 = *(const LAS f32x4*)(q_ + 2052); \
            O.w0 = *(const LAS f32x4*)(q_ + 4096); O.w1 = *(const LAS f32x4*)(q_ + 4100); O.k0 = *(const LAS f32x4*)(q_ + 6144); O.k1 = *(const LAS f32x4*)(q_ + 6148); \
            O.q0 = *(const LAS f32x4*)(q_ + 8192); O.q1 = *(const LAS f32x4*)(q_ + 8196); O.v = bp[10240 + (s) * 64 + row]; O.br = bp[12288 + (s)]; O.kr = bp[12320 + (s)]; } while (0)
#define RW_STEP(O, s) do { \
            f32x2_t pa = S2[0] * lo2(O.a0); f32x2_t py = S2[0] * lo2(O.q0); \
            pa = fma2(S2[1], hi2(O.a0), pa); py = fma2(S2[1], hi2(O.q0), py); pa = fma2(S2[2], lo2(O.a1), pa); py = fma2(S2[2], lo2(O.q1), py); \
            pa = fma2(S2[3], hi2(O.a1), pa); py = fma2(S2[3], hi2(O.q1), py); \
            float sa = pa.x + pa.y, yy = py.x + py.y; \
            sa += dppf<0xB1>(sa); yy += dppf<0xB1>(yy); sa += dppf<0x4E>(sa); yy += dppf<0x4E>(yy); sa += dppf<0x141>(sa); yy += dppf<0x141>(yy); \
            const f32x2_t sa2 = (f32x2_t){sa, sa}, vv2 = (f32x2_t){O.v, O.v}; \
            S2[0] = fma2(S2[0], lo2(O.w0), fma2(vv2, lo2(O.k0), sa2 * lo2(O.b0))); S2[1] = fma2(S2[1], hi2(O.w0), fma2(vv2, hi2(O.k0), sa2 * hi2(O.b0))); \
            S2[2] = fma2(S2[2], lo2(O.w1), fma2(vv2, lo2(O.k1), sa2 * lo2(O.b1))); S2[3] = fma2(S2[3], hi2(O.w1), fma2(vv2, hi2(O.k1), sa2 * hi2(O.b1))); \
            if ((tid0 & 7) == 0) yb[(s) * 32 + rowl] = yy + sa * O.br + O.v * O.kr; } while (0)
            RwOps o0, o1;
            RW_LD(o0, 0);
#pragma unroll 1
            for (int s = 0; s < 32; s += 2) {
                RW_LD(o1, s + 1);
                RW_STEP(o0, s);
                { const int sn = (s + 2 < 32) ? s + 2 : 31; RW_LD(o0, sn); }
                RW_STEP(o1, s + 1);
            }
#undef RW_LD
#undef RW_STEP
            __syncthreads();
        }
    } else {
        const int ht = tid0 - 256, tt = ht >> 3, cg8 = (ht & 7) * 8, ch = h * 64 + cg8;
        float mur[8], muk[8], muv[8], kkc[8], kac[8], rkc[8];
#pragma unroll
        for (int e = 0; e < 8; ++e) { mur[e] = p.mu[ch + e]; muk[e] = p.mu[1024 + ch + e]; muv[e] = p.mu[2048 + ch + e]; kkc[e] = p.k_k[ch + e]; kac[e] = p.k_a[ch + e]; rkc[e] = p.r_k[ch + e]; }
        for (int c = -1; c < 128; ++c) {
            if (c >= 1) {
                const LAS float* yb = (const LAS float*)(lds + ((c - 1) & 1) * BUFB + 49408);
                const int r4 = (ht & 7) * 4; const f32x4 y4 = *(const LAS f32x4*)(yb + tt * 32 + r4);
                u32x2 ov; ov.x = cvt_pk_bf16(y4[0], y4[1]); ov.y = cvt_pk_bf16(y4[2], y4[3]);
                *(u32x2*)(YRAW + (tokbase + (size_t)(c - 1) * 32 + tt) * 1024 + h * 64 + 32 * half + r4) = ov;
            }
            if (c + 1 < 128) {
                const int cn = c + 1, t = cn * 32 + tt; const size_t tok = tokbase + t;
                LAS float* bp = (LAS float*)(lds + (cn & 1) * BUFB);
                const bf16_t* pr_ = PR + tok * LDPR + ch;
                const u32x4 r4 = *(const u32x4*)pr_, k4 = *(const u32x4*)(pr_ + 1024), v4 = *(const u32x4*)(pr_ + 2048);
                u32x4 pr4 = (u32x4){0u, 0u, 0u, 0u}, pk4 = pr4, pv4 = pr4;
                if (t > 0) { pr4 = *(const u32x4*)(pr_ - LDPR); pk4 = *(const u32x4*)(pr_ - LDPR + 1024); pv4 = *(const u32x4*)(pr_ - LDPR + 2048); }
                const u32x4 w4 = *(const u32x4*)(WLOG + tok * 1024 + ch), a4 = *(const u32x4*)(AG + tok * 1024 + ch);
                float r[8], k[8], v[8], kk[8], av[8], dec[8];
                float n2 = 0.f;
#pragma unroll
                for (int e = 0; e < 8; ++e) {
                    const float rc = bfel(r4, e), kc = bfel(k4, e), vc = bfel(v4, e);
                    r[e] = rc + (bfel(pr4, e) - rc) * mur[e]; k[e] = kc + (bfel(pk4, e) - kc) * muk[e]; v[e] = vc + (bfel(pv4, e) - vc) * muv[e];
                    kk[e] = k[e] * kkc[e]; n2 += kk[e] * kk[e]; av[e] = bfel(a4, e); dec[e] = __expf(bfel(w4, e));
                }
                n2 = red8(n2);
                const float inv = 1.f / fmaxf(sqrtf(n2), 1e-12f);
                float br = 0.f, kr = 0.f, bon = 0.f;
                f32x4 oa[2], ob[2], ow[2], ok[2], oq[2], ovv[2];
#pragma unroll
                for (int e = 0; e < 8; ++e) {
                    const float kn = kk[e] * inv, k3 = k[e] * (1.f + (av[e] - 1.f) * kac[e]), bb = kn * av[e];
                    oa[e >> 2][e & 3] = -kn; ob[e >> 2][e & 3] = bb; ow[e >> 2][e & 3] = dec[e]; ok[e >> 2][e & 3] = k3; oq[e >> 2][e & 3] = dec[e] * r[e]; ovv[e >> 2][e & 3] = v[e];
                    br += bb * r[e]; kr += k3 * r[e]; bon += r[e] * k3 * rkc[e];
                }
                br = red8(br); kr = red8(kr); bon = red8(bon);
                LAS float* q_ = bp + tt * 64 + cg8;
#pragma unroll
                for (int i = 0; i < 2; ++i) { *(LAS f32x4*)(q_ + 4 * i) = oa[i]; *(LAS f32x4*)(q_ + 2048 + 4 * i) = ob[i]; *(LAS f32x4*)(q_ + 4096 + 4 * i) = ow[i]; *(LAS f32x4*)(q_ + 6144 + 4 * i) = ok[i];
                    *(LAS f32x4*)(q_ + 8192 + 4 * i) = oq[i]; *(LAS f32x4*)(q_ + 10240 + 4 * i) = ovv[i]; }
                if ((ht & 7) == 0) { bp[12288 + tt] = br; bp[12320 + tt] = kr; if (half == 0) BON[tok * 16 + h] = bon; }
            }
            __syncthreads();
        }
        {
            const LAS float* yb = (const LAS float*)(lds + (127 & 1) * BUFB + 49408);
            const int r4 = (ht & 7) * 4; const f32x4 y4 = *(const LAS f32x4*)(yb + tt * 32 + r4);
            u32x2 ov; ov.x = cvt_pk_bf16(y4[0], y4[1]); ov.y = cvt_pk_bf16(y4[2], y4[3]);
            *(u32x2*)(YRAW + (tokbase + (size_t)127 * 32 + tt) * 1024 + h * 64 + 32 * half + r4) = ov;
        }
    }
}

__device__ void phase_rwkv_post(const KP& p) {
    const bf16_t* PR = (const bf16_t*)(p.ws + OFF_PR);
    const bf16_t* GG = (const bf16_t*)((const unsigned char*)p.out + DO_GG);
    bf16_t* YR = (bf16_t*)(p.ws + OFF_YRAW); const float* BON = (const float*)(p.ws + OFF_BON);
    const int gt = blockIdx.x * 512 + tid_l(), gn = gridDim.x * 512;
    for (int i = gt; i < NT * 256; i += gn) {
        const int tok = i >> 8, h = (i >> 4) & 15, ch = h * 64 + (i & 15) * 4;
        const u32x2 y2 = *(const u32x2*)(YR + (size_t)tok * 1024 + ch), v2 = *(const u32x2*)(PR + (size_t)tok * LDPR + 2048 + ch), g2 = *(const u32x2*)(GG + (size_t)tok * 1024 + ch);
        u32x2 pv2 = (u32x2){0u, 0u};
        if ((tok & (SEQ - 1)) != 0) pv2 = *(const u32x2*)(PR + (size_t)(tok - 1) * LDPR + 2048 + ch);
        const float bon = BON[tok * 16 + h];
        const f32x4 muv = *(const f32x4*)(p.mu + 2048 + ch), lnw = *(const f32x4*)(p.ln_w + ch), lnb = *(const f32x4*)(p.ln_b + ch);
        const f32x4 y = (f32x4){bflo(y2.x), bfhi(y2.x), bflo(y2.y), bfhi(y2.y)}, vc = (f32x4){bflo(v2.x), bfhi(v2.x), bflo(v2.y), bfhi(v2.y)}, vp = (f32x4){bflo(pv2.x), bfhi(pv2.x), bflo(pv2.y), bfhi(pv2.y)};
        const f32x4 g = (f32x4){bflo(g2.x), bfhi(g2.x), bflo(g2.y), bfhi(g2.y)};
        const f32x4 v = vc + (vp - vc) * muv;
        const float mean = red16(y[0] + y[1] + y[2] + y[3]) * (1.f / 64.f);
        const f32x4 d = y - mean;
        const float var = red16(d[0] * d[0] + d[1] * d[1] + d[2] * d[2] + d[3] * d[3]) * (1.f / 64.f);
        const float rs = rsqrtf(var + 64e-5f);
        const f32x4 res = (d * rs * lnw + lnb + bon * v) * g;
        u32x2 ov; ov.x = cvt_pk_bf16(res[0], res[1]); ov.y = cvt_pk_bf16(res[2], res[3]);
        *(u32x2*)(YR + (size_t)tok * 1024 + ch) = ov;
    }
}

typedef short v4i16_t __attribute__((ext_vector_type(4)));
__device__ __forceinline__ bf16x8 tr_frag(const LAS unsigned char* base, int stride_b, int krow0, int ncol0, int lane) {
    const int g = lane >> 4, q = (lane & 15) >> 2, pp = lane & 3;
    const LAS unsigned char* a0 = base + (krow0 + 8 * g + q) * stride_b + (ncol0 + 4 * pp) * 2;
    const v4i16_t x = __builtin_amdgcn_ds_read_tr16_b64_v4i16((LAS v4i16_t*)a0), y = __builtin_amdgcn_ds_read_tr16_b64_v4i16((LAS v4i16_t*)(a0 + 4 * stride_b));
    return (bf16x8){x[0], x[1], x[2], x[3], y[0], y[1], y[2], y[3]};
}
__device__ void mlstm_run(const KP& p, int item, LAS unsigned char* lds) {
    const int tid0 = tid_l();
    const int bh = item >> 3, b = bh >> 2, h = bh & 3, dv0 = (item & 7) * 32;
    const size_t tokbase = (size_t)b * SEQ;
    LAS bf16_t* Qs = (LAS bf16_t*)(lds + 0);
    LAS bf16_t* Ks = (LAS bf16_t*)(lds + 33792);
    LAS bf16_t* Vs = (LAS bf16_t*)(lds + 67584);
    LAS bf16_t* Vws = (LAS bf16_t*)(lds + 74752);
    LAS bf16_t* Ss = (LAS bf16_t*)(lds + 81920);
    LAS bf16_t* CT0 = (LAS bf16_t*)(lds + 91136);
    LAS bf16_t* Os = (LAS bf16_t*)(lds + 141824);
    LAS float* BC = (LAS float*)(lds + 146944);
    LAS float* GAs = (LAS float*)(lds + 147200);
    const bf16_t* QC = (const bf16_t*)(p.ws + OFF_QC); const bf16_t* KC = (const bf16_t*)(p.ws + OFF_KC);
    bf16_t* PM = (bf16_t*)(p.ws + OFF_PM);
    const float* GB = (const float*)((const unsigned char*)p.out + DO_GB); const float* GA = (const float*)((const unsigned char*)p.out + DO_GA); const float* GW = (const float*)((const unsigned char*)p.out + DO_GW);
    for (int i = tid0; i < 2 * 48 * 264 / 2; i += 512) ((LAS unsigned*)CT0)[i] = 0u;
    for (int i = tid0; i < 2 * 64 * 56 / 2; i += 512) ((LAS unsigned*)Vs)[i] = 0u;
    __syncthreads();
    if (tid0 < 64) Vs[tid0 * 56 + 32] = (bf16_t)0x3F80;
    f32x4 cacc[6];
#pragma unroll
    for (int i = 0; i < 6; ++i) cacc[i] = (f32x4){0.f, 0.f, 0.f, 0.f};
    u32x4 q4[4], k4[4], vo4; float gb = 0.f, ga = 0.f, gwv = 0.f;
#define ML_LOAD(c, TID) do { const int row_ = (TID) >> 3, pc_ = (TID) & 7; const size_t tk_ = tokbase + (size_t)(c) * 64; \
        const bf16_t* qp_ = QC + (tk_ + row_) * 1024 + h * 256 + pc_ * 32; const bf16_t* kp_ = KC + (tk_ + row_) * 1024 + h * 256 + pc_ * 32; \
        _Pragma("unroll") for (int i_ = 0; i_ < 4; ++i_) { q4[i_] = *(const u32x4*)(qp_ + 8 * i_); k4[i_] = *(const u32x4*)(kp_ + 8 * i_); } \
        const int sg_ = (TID) & 255, s_ = sg_ >> 2, g_ = sg_ & 3; \
        vo4 = *(const u32x4*)(PM + (tk_ + s_) * LDPM + ((TID) < 256 ? 2048 : 3072) + h * 256 + dv0 + 8 * g_); \
        gwv = GW[bh * SEQ + (c) * 64 + s_]; \
        if ((TID) < 64) { gb = GB[bh * SEQ + (c) * 64 + (TID)]; ga = GA[bh * SEQ + (c) * 64 + (TID)]; } } while (0)
    ML_LOAD(0, tid0);
    __syncthreads();
    int cur = 0;
    for (int c = 0; c < 64; ++c) {
        int tid = tid0; asm volatile("" : "+v"(tid));
        const int lane = tid & 63, w = tid >> 6, fr = lane & 15, fq = lane >> 4;
        LAS bf16_t* CTc = CT0 + cur * (48 * 264); LAS bf16_t* CTn = CT0 + (cur ^ 1) * (48 * 264);
        {
            const int row = tid >> 3, pc = tid & 7;
#pragma unroll
            for (int i = 0; i < 4; ++i) { *(LAS u32x4*)(Qs + row * 264 + pc * 32 + 8 * i) = q4[i]; *(LAS u32x4*)(Ks + row * 264 + pc * 32 + 8 * i) = k4[i]; }
            const int sg = tid & 255, s = sg >> 2, g = sg & 3;
            if (tid < 256) {
                *(LAS u32x4*)(Vs + s * 56 + 8 * g) = vo4;
                u32x4 wv;
#pragma unroll
                for (int e = 0; e < 4; ++e) wv[e] = cvt_pk_bf16(bflo(vo4[e]) * gwv, bfhi(vo4[e]) * gwv);
                *(LAS u32x4*)(Vws + s * 56 + 8 * g) = wv;
                if (g == 0) Vws[s * 56 + 32] = f2bf(gwv);
            } else {
                if (c > 0) { const u32x4 yv = *(const LAS u32x4*)(Os + s * 40 + 8 * g); *(u32x4*)(PM + (tokbase + (size_t)(c - 1) * 64 + s) * LDPM + 3072 + h * 256 + dv0 + 8 * g) = yv; }
                *(LAS u32x4*)(Os + s * 40 + 8 * g) = vo4;
            }
            if (tid < 64) { BC[tid] = gb; GAs[tid] = ga; }
        }
        asm volatile("" ::: "memory");
        if (c + 1 < 64) ML_LOAD(c + 1, tid);
        asm volatile("" ::: "memory");
        __syncthreads();
        {
            const int mt = w >> 1, ntb = (w & 1) * 2;
            f32x4 s0 = (f32x4){0.f, 0.f, 0.f, 0.f}, s1 = s0;
#pragma unroll
            for (int ks = 0; ks < 8; ++ks) {
                const bf16x8 a = *(const LAS bf16x8*)(Qs + (16 * mt + fr) * 264 + 32 * ks + 8 * fq);
                const bf16x8 b0 = *(const LAS bf16x8*)(Ks + (16 * ntb + fr) * 264 + 32 * ks + 8 * fq);
                const bf16x8 b1 = *(const LAS bf16x8*)(Ks + (16 * (ntb + 1) + fr) * 264 + 32 * ks + 8 * fq);
                s0 = __builtin_amdgcn_mfma_f32_16x16x32_bf16(a, b0, s0, 0, 0, 0);
                s1 = __builtin_amdgcn_mfma_f32_16x16x32_bf16(a, b1, s1, 0, 0, 0);
            }
            const int sA = 16 * ntb + fr, sB = sA + 16;
            const float gA = GAs[sA], gB = GAs[sB];
#pragma unroll
            for (int j = 0; j < 4; ++j) {
                const int t = 16 * mt + 4 * fq + j; const float bt = BC[t];
                const float vA = (sA <= t) ? s0[j] * __expf(bt + gA) : 0.f, vB = (sB <= t) ? s1[j] * __expf(bt + gB) : 0.f;
                Ss[t * 72 + sA] = f2bf(vA); Ss[t * 72 + sB] = f2bf(vB);
            }
        }
        __syncthreads();
        {
            const int mt = w >> 1, nt = w & 1;
            f32x4 aA = (f32x4){0.f, 0.f, 0.f, 0.f}, aB = aA, xA = aA, xB = aA;
#pragma unroll
            for (int ks = 0; ks < 2; ++ks) {
                const bf16x8 a = *(const LAS bf16x8*)(Ss + (16 * mt + fr) * 72 + 32 * ks + 8 * fq);
                const bf16x8 bm = tr_frag((const LAS unsigned char*)Vs, 112, 32 * ks, 16 * nt, lane);
                const bf16x8 bx = tr_frag((const LAS unsigned char*)Vs, 112, 32 * ks, 32, lane);
                aA = __builtin_amdgcn_mfma_f32_16x16x32_bf16(a, bm, aA, 0, 0, 0);
                xA = __builtin_amdgcn_mfma_f32_16x16x32_bf16(a, bx, xA, 0, 0, 0);
            }
#pragma unroll
            for (int ks = 0; ks < 8; ++ks) {
                const bf16x8 a = *(const LAS bf16x8*)(Qs + (16 * mt + fr) * 264 + 32 * ks + 8 * fq);
                const bf16x8 bm = *(const LAS bf16x8*)(CTc + (16 * nt + fr) * 264 + 32 * ks + 8 * fq);
                const bf16x8 bx = *(const LAS bf16x8*)(CTc + (32 + fr) * 264 + 32 * ks + 8 * fq);
                aB = __builtin_amdgcn_mfma_f32_16x16x32_bf16(a, bm, aB, 0, 0, 0);
                xB = __builtin_amdgcn_mfma_f32_16x16x32_bf16(a, bx, xB, 0, 0, 0);
            }
#pragma unroll
            for (int j = 0; j < 4; ++j) {
                const int t = 16 * mt + 4 * fq + j; const float eb = __expf(BC[t]);
                const float num = aA[j] + eb * aB[j];
                const float den = __shfl(xA[j] + eb * xB[j], lane & 48);
                const float hv = num / fmaxf(fabsf(den), 1.f);
                LAS bf16_t* op = Os + t * 40 + 16 * nt + fr;
                *op = f2bf(hv * sigm(bf2f(*op)));
            }
            const float decay = __expf(BC[63]);
            bf16x8 bw[3][2];
#pragma unroll
            for (int n3 = 0; n3 < 3; ++n3)
#pragma unroll
                for (int ks = 0; ks < 2; ++ks) bw[n3][ks] = tr_frag((const LAS unsigned char*)Vws, 112, 32 * ks, 16 * n3, lane);
#pragma unroll
            for (int m2 = 0; m2 < 2; ++m2) {
                const int mtk = 2 * w + m2;
                const bf16x8 ka0 = tr_frag((const LAS unsigned char*)Ks, 528, 0, 16 * mtk, lane), ka1 = tr_frag((const LAS unsigned char*)Ks, 528, 32, 16 * mtk, lane);
#pragma unroll
                for (int n3 = 0; n3 < 3; ++n3) {
                    f32x4 cc = cacc[m2 * 3 + n3] * decay;
                    cc = __builtin_amdgcn_mfma_f32_16x16x32_bf16(ka0, bw[n3][0], cc, 0, 0, 0);
                    cc = __builtin_amdgcn_mfma_f32_16x16x32_bf16(ka1, bw[n3][1], cc, 0, 0, 0);
                    cacc[m2 * 3 + n3] = cc;
                    u32x2 pk; pk.x = cvt_pk_bf16(cc[0], cc[1]); pk.y = cvt_pk_bf16(cc[2], cc[3]);
                    *(LAS u32x2*)(CTn + (16 * n3 + fr) * 264 + 16 * mtk + 4 * fq) = pk;
                }
            }
        }
        cur ^= 1;
        __syncthreads();
    }
    if (tid0 >= 256) { const int sg = tid0 & 255, s = sg >> 2, g = sg & 3; const u32x4 yv = *(const LAS u32x4*)(Os + s * 40 + 8 * g);
        *(u32x4*)(PM + (tokbase + (size_t)63 * 64 + s) * LDPM + 3072 + h * 256 + dv0 + 8 * g) = yv; }
#undef ML_LOAD
}

__device__ void phase_norm2(const KP& p) {
    const int tid = tid_l(), lane = tid & 63, G = gridDim.x, bid = blockIdx.x;
    rmsnorm_rows(p.out, p.g_ffn, (bf16_t*)(p.ws + OFF_XN2), bid * 8 + (tid >> 6), G * 8, lane);
}
typedef float v16f_t __attribute__((ext_vector_type(16)));
typedef float v32f_t __attribute__((ext_vector_type(32)));
typedef unsigned v6u_t __attribute__((ext_vector_type(6)));
__device__ void convert_tables(const KP& p, int gw, int nw) {
    const int lane = tid_l() & 63;
    for (int tb = 0; tb < 2; ++tb) {
        const float* src = tb ? p.peer_v : p.peer_u; unsigned char* dst = p.ws + (tb ? OFF_PV : OFF_PU); float* sc = (float*)(p.ws + (tb ? OFF_SCV : OFF_SCU));
        for (int row = gw; row < 16384; row += nw) {
            const float* sp = src + (size_t)row * DM + lane * 32;
            f32x4 v[8]; float am = 0.f;
#pragma unroll
            for (int q = 0; q < 8; ++q) { v[q] = *(const f32x4*)(sp + q * 4);
                am = fmaxf(am, fmaxf(fmaxf(fabsf(v[q][0]), fabsf(v[q][1])), fmaxf(fabsf(v[q][2]), fabsf(v[q][3])))); }
            const unsigned amu = wave_max_u32(__float_as_uint(am));
            const float amax = __uint_as_float(amu);
            float scl = 1.f;
            if (amax > 0.f) scl = exp2f(floorf(log2f(7.5f / amax)));
            if (lane == 0) sc[row] = 1.f / scl;
            v16f_t xa, xb;
#pragma unroll
            for (int q = 0; q < 4; ++q)
#pragma unroll
                for (int j = 0; j < 4; ++j) { xa[q * 4 + j] = v[q][j] * scl; xb[q * 4 + j] = v[4 + q][j] * scl; }
            const v6u_t pk = __builtin_amdgcn_cvt_scalef32_2xpk16_fp6_f32(xa, xb, 1.0f);
            unsigned char* dp = dst + (size_t)row * 8192 + lane * 8;
#pragma unroll
            for (int k = 0; k < 3; ++k) { u32x2 o; o.x = pk[2 * k]; o.y = pk[2 * k + 1]; *(u32x2*)(dp + k * 512) = o; }
        }
    }
}

__device__ void phase_peer(const KP& p, LAS unsigned char* lds) {
    const int tid = tid_l(), lane = tid & 63, w = tid >> 6, fr = lane & 15, fq = lane >> 4;
    LAS unsigned* KEYS = (LAS unsigned*)lds;
    LAS int* TI = (LAS int*)(lds + 32768);
    LAS float* TG = (LAS float*)(lds + 49152);
    const bf16_t* Q = (const bf16_t*)(p.ws + OFF_Q);
    const bf16_t* SK = (const bf16_t*)(p.ws + OFF_SUBK);
    const bf16_t* XN2 = (const bf16_t*)(p.ws + OFF_XN2);
    const unsigned char* PU = p.ws + OFF_PU; const unsigned char* PV = p.ws + OFF_PV;
    const float* SCU = (const float*)(p.ws + OFF_SCU); const float* SCV = (const float*)(p.ws + OFF_SCV);
    float* out = p.out;
    LAS int* IJ = (LAS int*)(lds + 65536);
    int ci[4], cj[4]; bool cv[4];
#pragma unroll
    for (int m = 0; m < 4; ++m) { const int e = m * 16 + fr; int i = 0, base = 0;
        for (; i < 16; ++i) { const int cnt = 16 / (i + 1); if (e < base + cnt) break; base += cnt; }
        cv[m] = i < 16; ci[m] = cv[m] ? i : 0; cj[m] = cv[m] ? e - base : 0;
        if (w == 0 && fq == 0) IJ[e] = cv[m] ? ci[m] * 16 + cj[m] : 0; }
    const int pp_ = w >> 2, ntb = (w & 3) * 2;
    __syncthreads();
    LAS float* xs = (LAS float*)(lds + 66048) + w * 2048;
    LAS int* PERM = (LAS int*)(lds + 65792);
    {
        v16f_t ta, tb;
#pragma unroll
        for (int i = 0; i < 16; ++i) { ta[i] = 0.125f * i; tb[i] = (i < 8) ? 2.f + 0.25f * i : 4.f + 0.5f * (i - 8); }
        const v6u_t pk = __builtin_amdgcn_cvt_scalef32_2xpk16_fp6_f32(ta, tb, 1.0f);
        const v32f_t un = __builtin_amdgcn_cvt_scalef32_pk32_f32_fp6(pk, 1.0f);
#pragma unroll
        for (int m = 0; m < 32; ++m) { const float val = un[m]; const float c = val < 2.f ? val * 8.f : (val < 4.f ? 16.f + (val - 2.f) * 4.f : 24.f + (val - 4.f) * 2.f);
            if (tid == 0) PERM[m] = ((int)(c + 0.5f) & 31); }
    }
    __syncthreads();
    for (int tile = blockIdx.x; tile < NT / 32; tile += gridDim.x) {
        const int tk0 = tile * 32;
        bf16x8 bfr[2][4];
#pragma unroll
        for (int n = 0; n < 2; ++n)
#pragma unroll
            for (int ks = 0; ks < 4; ++ks) bfr[n][ks] = *(const bf16x8*)(SK + (size_t)(pp_ * 128 + 16 * (ntb + n) + fr) * 128 + 32 * ks + 8 * fq);
        bf16x8 afn[2][4];
#pragma unroll
        for (int mt = 0; mt < 2; ++mt)
#pragma unroll
            for (int ks = 0; ks < 4; ++ks) afn[mt][ks] = *(const bf16x8*)(Q + (size_t)(tk0 + 16 * mt + fr) * DM + pp_ * 128 + 32 * ks + 8 * fq);
        for (int h = 0; h < 8; ++h) {
            {
                bf16x8 af[2][4];
#pragma unroll
                for (int mt = 0; mt < 2; ++mt)
#pragma unroll
                    for (int ks = 0; ks < 4; ++ks) af[mt][ks] = afn[mt][ks];
                if (h + 1 < 8) {
#pragma unroll
                    for (int mt = 0; mt < 2; ++mt)
#pragma unroll
                        for (int ks = 0; ks < 4; ++ks) afn[mt][ks] = *(const bf16x8*)(Q + (size_t)(tk0 + 16 * mt + fr) * DM + (h + 1) * 256 + pp_ * 128 + 32 * ks + 8 * fq);
                }
                f32x4 acc[2][2];
#pragma unroll
                for (int a_ = 0; a_ < 2; ++a_)
#pragma unroll
                    for (int b_ = 0; b_ < 2; ++b_) acc[a_][b_] = (f32x4){0.f, 0.f, 0.f, 0.f};
#pragma unroll
                for (int ks = 0; ks < 4; ++ks)
#pragma unroll
                    for (int mt = 0; mt < 2; ++mt)
#pragma unroll
                        for (int n = 0; n < 2; ++n) acc[mt][n] = __builtin_amdgcn_mfma_f32_16x16x32_bf16(af[mt][ks], bfr[n][ks], acc[mt][n], 0, 0, 0);
#pragma unroll
                for (int mt = 0; mt < 2; ++mt)
#pragma unroll
                    for (int n = 0; n < 2; ++n)
#pragma unroll
                        for (int j = 0; j < 4; ++j) { const int tokl = 16 * mt + 4 * fq + j, key = 16 * (ntb + n) + fr;
                            KEYS[(tokl * 2 + pp_) * 128 + key] = (ordf(acc[mt][n][j]) & ~0x7Fu) | (unsigned)key; }
            }
            __syncthreads();
            {
                const int tokl = 4 * w + fq, rb = lane & 48;
                unsigned top[2];
#pragma unroll
                for (int pp = 0; pp < 2; ++pp) {
                    unsigned kx[8];
#pragma unroll
                    for (int m = 0; m < 8; ++m) kx[m] = KEYS[(tokl * 2 + pp) * 128 + fr + 16 * m];
                    unsigned tp = 0u;
                    for (int it = 0; it < 16; ++it) {
                        unsigned M = max(max(max(kx[0], kx[1]), max(kx[2], kx[3])), max(max(kx[4], kx[5]), max(kx[6], kx[7])));
                        M = max(M, dppu<0xB1>(M)); M = max(M, dppu<0x4E>(M)); M = max(M, dppu<0x141>(M)); M = max(M, dppu<0x140>(M));
                        if (fr == it) tp = M;
#pragma unroll
                        for (int m = 0; m < 8; ++m) kx[m] = (kx[m] == M) ? 0u : kx[m];
                    }
                    top[pp] = tp;
                }
                unsigned cnd[4];
#pragma unroll
                for (int m = 0; m < 4; ++m) {
                    const float v1 = unordf((unsigned)__shfl((int)top[0], rb + ci[m]) & ~0x7Fu), v2 = unordf((unsigned)__shfl((int)top[1], rb + cj[m]) & ~0x7Fu);
                    cnd[m] = cv[m] ? ((ordf(v1 + v2) & ~0x3Fu) | (unsigned)(m * 16 + fr)) : 0u;
                }
                unsigned best = 0u;
                for (int it = 0; it < 16; ++it) {
                    unsigned M = max(max(cnd[0], cnd[1]), max(cnd[2], cnd[3]));
                    M = max(M, dppu<0xB1>(M)); M = max(M, dppu<0x4E>(M)); M = max(M, dppu<0x141>(M)); M = max(M, dppu<0x140>(M));
                    if (fr == it) best = M;
#pragma unroll
                    for (int m = 0; m < 4; ++m) cnd[m] = (cnd[m] == M) ? 0u : cnd[m];
                }
                const int ij = IJ[best & 0x3Fu];
                const float bv = unordf(best & ~0x3Fu);
                const int e1 = __shfl((int)top[0], rb + (ij >> 4)) & 0x7F, e2 = __shfl((int)top[1], rb + (ij & 15)) & 0x7F;
                const float mx = __shfl(bv, rb);
                const float ev = __expf(bv - mx);
                const float sum = red16(ev);
                TI[tokl * 128 + h * 16 + fr] = e1 * 128 + e2; TG[tokl * 128 + h * 16 + fr] = ev / sum;
            }
            __syncthreads();
        }
        for (int q = 0; q < 4; ++q) {
            const int tokl = 4 * w + q; const size_t tok = (size_t)tk0 + tokl;
#pragma unroll
            for (int i = 0; i < 4; ++i) { const u32x4 x4 = *(const u32x4*)(XN2 + tok * DM + i * 512 + lane * 8);
                *(LAS f32x4*)(xs + i * 512 + lane * 8) = (f32x4){bflo(x4[0]), bfhi(x4[0]), bflo(x4[1]), bfhi(x4[1])}; *(LAS f32x4*)(xs + i * 512 + lane * 8 + 4) = (f32x4){bflo(x4[2]), bfhi(x4[2]), bflo(x4[3]), bfhi(x4[3])}; }
            float xv[32], acc[32];
#pragma unroll
            for (int m = 0; m < 32; ++m) { xv[m] = xs[32 * lane + PERM[m]]; acc[m] = 0.f; }
#define PE_ISSUE(E, e_) do { const int ee_ = (e_) < 128 ? (e_) : 127; const int idx_ = __builtin_amdgcn_readfirstlane(TI[tokl * 128 + ee_]); \
                E.gate = __builtin_bit_cast(float, __builtin_amdgcn_readfirstlane(__builtin_bit_cast(int, TG[tokl * 128 + ee_]))); \
                const unsigned char* up_ = PU + (size_t)idx_ * 8192 + lane * 8; \
                E.u0 = *(const u32x2*)up_; E.u1 = *(const u32x2*)(up_ + 512); E.u2 = *(const u32x2*)(up_ + 1024); \
                E.v0 = *(const u32x2*)(up_ + 2048); E.v1 = *(const u32x2*)(up_ + 2560); E.v2 = *(const u32x2*)(up_ + 3072); \
                E.su = SCU[idx_]; E.sv = SCV[idx_]; } while (0)
#define PE_COMPUTE(E) do { \
                const v32f_t uf = __builtin_amdgcn_cvt_scalef32_pk32_f32_fp6((v6u_t){E.u0.x, E.u0.y, E.u1.x, E.u1.y, E.u2.x, E.u2.y}, 1.0f); \
                float d0 = 0.f, d1 = 0.f, d2 = 0.f, d3 = 0.f; \
                _Pragma("unroll") for (int m = 0; m < 8; ++m) { d0 += xv[4 * m] * uf[4 * m]; d1 += xv[4 * m + 1] * uf[4 * m + 1]; d2 += xv[4 * m + 2] * uf[4 * m + 2]; d3 += xv[4 * m + 3] * uf[4 * m + 3]; } \
                const float act = wave_sum((d0 + d1) + (d2 + d3)) * E.su; \
                const float coef = E.gate * 0.5f * act * (1.f + erff(act * 0.70710678118f)) * E.sv; \
                const v32f_t vf = __builtin_amdgcn_cvt_scalef32_pk32_f32_fp6((v6u_t){E.v0.x, E.v0.y, E.v1.x, E.v1.y, E.v2.x, E.v2.y}, 1.0f); \
                _Pragma("unroll") for (int m = 0; m < 32; ++m) acc[m] += coef * vf[m]; } while (0)
            {
                struct PeEx { u32x2 u0, u1, u2, v0, v1, v2; float su, sv, gate; };
                PeEx q0, q1;
                PE_ISSUE(q0, 0); PE_ISSUE(q1, 1);
#pragma unroll 1
                for (int e = 0; e < 128; e += 2) {
                    PE_COMPUTE(q0); PE_ISSUE(q0, e + 2);
                    PE_COMPUTE(q1); PE_ISSUE(q1, e + 3);
                }
            }
#undef PE_ISSUE
#undef PE_COMPUTE
#pragma unroll
            for (int m = 0; m < 32; ++m) xs[32 * lane + PERM[m]] = acc[m];
            float ss = 0.f;
            float* orow = out + tok * DM;
            f32x4 hv[8];
#pragma unroll
            for (int i = 0; i < 8; ++i) { const f32x4 pa = *(const LAS f32x4*)(xs + i * 256 + lane * 4); const f32x4 h0 = *(const f32x4*)(orow + i * 256 + lane * 4);
                hv[i] = pa + h0; ss += hv[i][0] * hv[i][0] + hv[i][1] * hv[i][1] + hv[i][2] * hv[i][2] + hv[i][3] * hv[i][3]; }
            ss = wave_sum(ss);
            const float r = rsqrtf(ss * (1.f / DM) + 1e-6f);
#pragma unroll
            for (int i = 0; i < 8; ++i) { const f32x4 g0 = *(const f32x4*)(p.g_final + i * 256 + lane * 4); *(f32x4*)(orow + i * 256 + lane * 4) = hv[i] * r * g0; }
        }
        __syncthreads();
    }
}

#define XB_TMO      128
#define XB_XCNT(j)  (256  + 64 * (j))
#define XB_XSUB(j)  (1280 + 64 * (j))
#define XB_XGEN(j)  (2304 + 64 * (j))
#define XB_TOP      3328
#define XB_TOPGEN   3392
#define XB_SPIN_CAP (1u << 18)
__device__ __forceinline__ unsigned xb_ld(unsigned* p)              { return __hip_atomic_load(p, __ATOMIC_RELAXED, __HIP_MEMORY_SCOPE_AGENT); }
__device__ __forceinline__ unsigned xb_add(unsigned* p, unsigned v) { return __hip_atomic_fetch_add(p, v, __ATOMIC_RELAXED, __HIP_MEMORY_SCOPE_AGENT); }
__device__ __forceinline__ unsigned xb_xcc_id() { return (unsigned)__builtin_amdgcn_s_getreg((3 << 11) | 20) & 0xFu; }
#define XB_SPIN(cond, bar) do { unsigned _sp = 0; while (cond) { __builtin_amdgcn_s_sleep(1); \
    if ((++_sp & 255u) == 0u) { if (xb_ld(&(bar)[XB_TMO])) break; if (_sp > XB_SPIN_CAP) { atomicAdd(&(bar)[XB_TMO], 1u); break; } } } } while (0)
struct XcdBarrier { unsigned* bar; unsigned x; volatile LAS unsigned* st; };
__device__ __forceinline__ XcdBarrier xcd_barrier_post(unsigned* bar, volatile LAS unsigned* st) {
    XcdBarrier b; b.bar = bar; b.x = xb_xcc_id(); b.st = st;
    if (threadIdx.x == 0) (void)xb_add(&bar[XB_XCNT(b.x)], 1u);
    return b;
}
__device__ __forceinline__ void xcd_barrier_complete(unsigned* bar, unsigned x, unsigned& nloc, unsigned& nx) {
    const unsigned G = gridDim.x * gridDim.y * gridDim.z;
    unsigned sum, cnt, mine, sp = 0u;
    for (;;) {
        sum = 0u; cnt = 0u; mine = 0u;
#pragma unroll
        for (unsigned j = 0; j < 16; ++j) { const unsigned c = xb_ld(&bar[XB_XCNT(j)]); sum += c; cnt += (c > 0u) ? 1u : 0u; mine = (j == x) ? c : mine; }
        if (sum == G) break;
        __builtin_amdgcn_s_sleep(1);
        if ((++sp & 255u) == 0u) { if (xb_ld(&bar[XB_TMO])) break; if (sp > XB_SPIN_CAP) { atomicAdd(&bar[XB_TMO], 1u); break; } }
    }
    nloc = mine > 0u ? mine : 1u; nx = cnt > 0u ? cnt : 1u;
}
__device__ __forceinline__ void xcd_barrier(const XcdBarrier& b) {
    asm volatile("s_waitcnt vmcnt(0)" ::: "memory");
    __syncthreads();
    if (threadIdx.x == 0) {
        unsigned* bar = b.bar;
        __builtin_amdgcn_s_waitcnt(0);
        unsigned nloc = b.st[0], nx = b.st[1];
        if (nloc == 0u) { xcd_barrier_complete(bar, b.x, nloc, nx); b.st[0] = nloc; b.st[1] = nx; }
        const unsigned old = xb_add(&bar[XB_XSUB(b.x)], 1u);
        const unsigned gen = old / nloc;
        if (old + 1u == (gen + 1u) * nloc) {
            __builtin_amdgcn_fence(__ATOMIC_RELEASE, "agent");
            asm volatile("s_waitcnt vmcnt(0)" ::: "memory");
            const unsigned og = xb_add(&bar[XB_TOP], 1u);
            const unsigned tg = og / nx;
            if (og + 1u == (tg + 1u) * nx) xb_add(&bar[XB_TOPGEN], 1u);
            else XB_SPIN(xb_ld(&bar[XB_TOPGEN]) == tg, bar);
            __builtin_amdgcn_fence(__ATOMIC_ACQUIRE, "agent");
            xb_add(&bar[XB_XGEN(b.x)], 1u);
            asm volatile("s_waitcnt vmcnt(0)" ::: "memory");
        } else {
            XB_SPIN(xb_ld(&bar[XB_XGEN(b.x)]) == gen, bar);
            __builtin_amdgcn_fence(__ATOMIC_ACQUIRE, "agent");
            asm volatile("s_waitcnt vmcnt(0)" ::: "memory");
        }
    }
    __syncthreads();
}

__global__ void __launch_bounds__(512) fwd_megakernel(KP p) {
    extern __shared__ __attribute__((aligned(16))) unsigned char smem[];
    LAS unsigned char* lds = (LAS unsigned char*)smem;
    cg::grid_group grid = cg::this_grid();
#define GRID_SYNC() do { asm volatile("s_waitcnt vmcnt(0) lgkmcnt(0)" ::: "memory"); __syncthreads(); grid.sync(); asm volatile("" ::: "memory"); } while (0)
    const int G = gridDim.x, bid = blockIdx.x;
    unsigned char* ws = p.ws; unsigned char* dob = (unsigned char*)p.out;

#define RUN_GEMM(MODE, ...) do { unsigned char* ws = lp(p.ws); unsigned char* dob = lp((unsigned char*)p.out); const pg8::Gemm g_ = pg8::Gemm{__VA_ARGS__}; pg8::StaticOrder S_; S_.init(g_.M, g_.N, G, bid); \
        const pg8::Epi<MODE> E_{ws, dob, p.x, p.w0, p.a0}; pg8::gemm_phase(lds, g_, S_, E_); } while (0)
    volatile LAS unsigned* xst = (volatile LAS unsigned*)(lds + 150512);
    if (threadIdx.x < 4) xst[threadIdx.x] = 0u;
    phase_prep(p, lds);
    GRID_SYNC();
    const XcdBarrier xbar = xcd_barrier_post((unsigned*)(p.ws + OFF_XBAR), xst);
#define XSYNC() do { xcd_barrier(xbar); asm volatile("" ::: "memory"); } while (0)
    RUN_GEMM(0, (const bf16_t*)(ws + OFF_XN), (const bf16_t*)(ws + OFF_WINT), NT, N1, 2048, 2048, 2048);
    XSYNC();
    phase_lora_prep(p);
    XSYNC();
    RUN_GEMM(1, (const bf16_t*)(dob + DO_ALORA), (const bf16_t*)(ws + OFF_WAT), NT, 2048, 256, 512, 256);
    RUN_GEMM(2, (const bf16_t*)(dob + DO_ALORA) + 256, (const bf16_t*)(ws + OFF_G2T), NT, 1024, 256, 512, 256);
    XSYNC();
    if (bid < 128) rwkv_scan(p, bid, lds);
    else {
        mlstm_run(p, bid - 128, lds);
        convert_tables(p, (bid - 128) * 8 + (tid_l() >> 6), 1024);
        __builtin_amdgcn_fence(__ATOMIC_RELEASE, "agent"); __syncthreads();
        if (threadIdx.x == 0) { unsigned* cnt = (unsigned*)(p.ws + OFF_SUBBAR); __hip_atomic_fetch_add(cnt, 1u, __ATOMIC_RELAXED, __HIP_MEMORY_SCOPE_AGENT);
            while (__hip_atomic_load(cnt, __ATOMIC_RELAXED, __HIP_MEMORY_SCOPE_AGENT) < 128u) __builtin_amdgcn_s_sleep(2); }
        __syncthreads(); __builtin_amdgcn_fence(__ATOMIC_ACQUIRE, "agent");
        { unsigned char* ws = lp(p.ws); unsigned char* dob = lp((unsigned char*)p.out); const pg8::Gemm g_ = pg8::Gemm{(const bf16_t*)(ws + OFF_PM) + 3072, (const bf16_t*)(ws + OFF_PMT), NT, 2048, 1024, LDPM, 1024};
          pg8::StaticOrder S_; S_.init(g_.M, g_.N, 128, bid - 128); const pg8::Epi<3> E_{ws, dob, p.x, p.w0, p.a0}; pg8::gemm_phase(lds, g_, S_, E_); }
    }
    XSYNC();
    phase_rwkv_post(p);
    XSYNC();
    RUN_GEMM(4, (const bf16_t*)(ws + OFF_YR), (const bf16_t*)(ws + OFF_PRT), NT, 2048, 1024, 1024, 1024);
    XSYNC();
    RUN_GEMM(5, (const bf16_t*)(ws + OFF_PG), (const bf16_t*)(ws + OFF_WOT), NT, 2048, 2048, LDPG, 2048);
    XSYNC();
    phase_norm2(p);
    XSYNC();
    RUN_GEMM(6, (const bf16_t*)(ws + OFF_XN2), (const bf16_t*)(ws + OFF_WQT), NT, 2048, 2048, 2048, 2048);
    XSYNC();
    phase_peer(p, lds);
}

extern "C" void kernel_launch(void* const* d_in, const int* in_sizes, int n_in, void* d_out, int out_size, void* d_ws, size_t ws_size, hipStream_t stream) {
    static int grid_blocks = 0;
    if (grid_blocks == 0) {
        if (n_in != 26 || out_size != NT * DM || ws_size < WS_NEED) { fprintf(stderr, "kernel_launch: unexpected shapes: n_in %d out %d ws %zu (need %zu)\n", n_in, out_size, ws_size, (size_t)WS_NEED); grid_blocks = -1; return; }
        int dev = 0, cus = 0, per_cu = 0;
        hipGetDevice(&dev);
        hipDeviceGetAttribute(&cus, hipDeviceAttributeMultiprocessorCount, dev);
        if (hipFuncSetAttribute((const void*)fwd_megakernel, hipFuncAttributeMaxDynamicSharedMemorySize, LDS_BYTES) != hipSuccess) { fprintf(stderr, "kernel_launch: hipFuncSetAttribute failed\n"); grid_blocks = -1; return; }
        hipOccupancyMaxActiveBlocksPerMultiprocessor(&per_cu, (const void*)fwd_megakernel, 512, LDS_BYTES);
        if (per_cu < 1) { fprintf(stderr, "kernel_launch: occupancy query says %d blocks per CU\n", per_cu); per_cu = 1; }
        (void)hipGetLastError();
        grid_blocks = cus * 1;
    }
    if (grid_blocks < 0) return;
    KP p{};
    const float** pp = (const float**)&p;
    for (int i = 0; i < 26; ++i) pp[i] = (const float*)d_in[i];
    p.out = (float*)d_out; p.ws = (unsigned char*)d_ws;
    void* args[] = {&p};
    hipError_t e = hipLaunchCooperativeKernel((void*)fwd_megakernel, dim3(grid_blocks), dim3(512), args, LDS_BYTES, stream);
    if (e != hipSuccess) fprintf(stderr, "cooperative launch failed: %s (grid %d)\n", hipGetErrorString(e), grid_blocks);
}
```

```cpp
#include <hip/hip_runtime.h>
#include <hip/hip_cooperative_groups.h>
#include <cstdio>
namespace cg = cooperative_groups;

#define LAS __attribute__((address_space(3)))
typedef unsigned short bf16_t;
typedef short bf16x8 __attribute__((ext_vector_type(8)));
typedef float f32x4 __attribute__((ext_vector_type(4)));
typedef unsigned u32x4 __attribute__((ext_vector_type(4)));
typedef unsigned u32x2 __attribute__((ext_vector_type(2)));

constexpr int NT = 16384, SEQ = 4096, DM = 2048;
constexpr int LDPM = 4096, LDPR = 3584, LDPG = 4096, N1 = 11776;
constexpr size_t MiB = 1024ull * 1024ull;
constexpr size_t OFF_PM = 0, OFF_PR = 128 * MiB, OFF_PG = 240 * MiB, OFF_XN = 368 * MiB, OFF_WINT = 432 * MiB, OFF_WTS = 478 * MiB;
constexpr size_t OFF_PMT = OFF_WTS, OFF_PRT = OFF_WTS + 4 * MiB, OFF_WOT = OFF_WTS + 8 * MiB, OFF_WQT = OFF_WTS + 16 * MiB, OFF_WAT = OFF_WTS + 24 * MiB,
                 OFF_G2T = OFF_WTS + 25 * MiB, OFF_SUBK = OFF_WTS + 25 * MiB + 512 * 1024, WS_NEED = OFF_WTS + 26 * MiB;
constexpr size_t OFF_QC = OFF_XN, OFF_KC = OFF_XN + 32 * MiB, OFF_YR = OFF_WINT, OFF_Q = OFF_XN, OFF_XN2 = OFF_PR, OFF_PU = OFF_PM, OFF_PV = OFF_PM + 2048, OFF_SUBBAR = OFF_SUBK + 192 * 1024, OFF_XBAR = OFF_SUBBAR + 256,
                 OFF_SCU = OFF_SUBK + 64 * 1024, OFF_SCV = OFF_SCU + 64 * 1024;
constexpr size_t DO_WLOG = 0, DO_AG = 32 * MiB, DO_GG = 64 * MiB, DO_ALORA = 96 * MiB, DO_GB = 112 * MiB, DO_GA = DO_GB + 256 * 1024, DO_GW = DO_GA + 256 * 1024;
constexpr int LDS_BYTES = 150528;
#define XCD_BAR_WORDS 3456

struct KP {
    const float *x, *g_mix, *w_in, *conv_w, *b_i, *b_f, *mu, *w0, *w2, *a0, *a2, *g2, *k_k, *k_a, *r_k, *ln_w, *ln_b, *proj_m, *proj_r, *w_out, *g_ffn,
        *w_query, *sub_keys, *peer_u, *peer_v, *g_final;
    float* out; unsigned char* ws;
};

typedef __bf16 bf16x2_t __attribute__((ext_vector_type(2)));
typedef float f32x2_t __attribute__((ext_vector_type(2)));
__device__ __forceinline__ unsigned cvt_pk_bf16(float lo, float hi) { f32x2_t v = {lo, hi}; bf16x2_t b = __builtin_convertvector(v, bf16x2_t); return __builtin_bit_cast(unsigned, b); }
__device__ __forceinline__ bf16_t f2bf(float f) { return (bf16_t)(cvt_pk_bf16(f, 0.f) & 0xffffu); }
__device__ __forceinline__ float bf2f(bf16_t h) { return __uint_as_float((unsigned)h << 16); }
__device__ __forceinline__ float bflo(unsigned u) { return __uint_as_float(u << 16); }
__device__ __forceinline__ float bfhi(unsigned u) { return __uint_as_float(u & 0xffff0000u); }
__device__ __forceinline__ float sigm(float x) { return __builtin_amdgcn_rcpf(1.f + __expf(-x)); }
template <int CTRL> __device__ __forceinline__ float dppf(float v) { return __builtin_bit_cast(float, __builtin_amdgcn_update_dpp(0, __builtin_bit_cast(int, v), CTRL, 0xF, 0xF, true)); }
template <int CTRL> __device__ __forceinline__ unsigned dppu(unsigned v) { return (unsigned)__builtin_amdgcn_update_dpp(0, (int)v, CTRL, 0xF, 0xF, true); }
__device__ __forceinline__ float red4(float v) { v += dppf<0xB1>(v); v += dppf<0x4E>(v); return v; }
__device__ __forceinline__ float red8(float v) { v = red4(v); v += dppf<0x141>(v); return v; }
__device__ __forceinline__ float red16(float v) { v = red8(v); v += dppf<0x140>(v); return v; }
__device__ __forceinline__ float rlane(float v, int l) { return __builtin_bit_cast(float, __builtin_amdgcn_readlane(__builtin_bit_cast(int, v), l)); }
__device__ __forceinline__ float wave_sum(float v) { v = red16(v); return rlane(v, 0) + rlane(v, 16) + rlane(v, 32) + rlane(v, 48); }
__device__ __forceinline__ unsigned wave_max_u32(unsigned v) {
    v = max(v, dppu<0xB1>(v)); v = max(v, dppu<0x4E>(v)); v = max(v, dppu<0x141>(v)); v = max(v, dppu<0x140>(v));
    unsigned a = (unsigned)__builtin_amdgcn_readlane((int)v, 0), b = (unsigned)__builtin_amdgcn_readlane((int)v, 16), c = (unsigned)__builtin_amdgcn_readlane((int)v, 32), d = (unsigned)__builtin_amdgcn_readlane((int)v, 48);
    return max(max(a, b), max(c, d));
}
__device__ __forceinline__ unsigned ordf(float f) { unsigned u = __float_as_uint(f); return (u & 0x80000000u) ? ~u : (u | 0x80000000u); }
__device__ __forceinline__ float unordf(unsigned k) { return __uint_as_float((k & 0x80000000u) ? (k ^ 0x80000000u) : ~k); }

__device__ __forceinline__ int tid_l() { int t = threadIdx.x; asm volatile("" : "+v"(t)); return t; }
template <class T> __device__ __forceinline__ T* lp(T* q) { asm volatile("" : "+s"(q)); return q; }
namespace pg8 {
constexpr int BM = 256, BK = 64, HALF = 128, HTB = HALF * BK * 2, STAGE_BYTES = 8 * HTB, NXCD = 8, WGM = 8;
__device__ __forceinline__ int lds_byte(int r, int c) { const int st = (r >> 4) * 2 + (c >> 5), rr = r & 15, cc = c & 31, ob = rr * 64 + cc * 2; return st * 1024 + (ob ^ (((ob >> 9) & 1) << 5)); }
__device__ __forceinline__ void stage_rc(int b, int& R, int& C) { const int st = b / 1024, sb = b % 1024, swz = sb ^ (((sb >> 9) & 1) << 5); R = (st >> 1) * 16 + swz / 64; C = (st & 1) * 32 + (swz % 64) / 2; }
__device__ __forceinline__ int perm32(int rho) { const int n = rho >> 4, i = rho & 15; return 8 * (i >> 2) + 4 * n + (i & 3); }
struct Unit { int pm, pn; };
struct Gemm { const bf16_t* A; const bf16_t* Bt; int M, N, K, lda, ldb; };
struct StaticOrder {
    int nM, nN, nwg, G, c;
    __device__ void init(int M, int N, int G_, int c_) { nM = M / BM; nN = N / BM; nwg = nM * nN; G = G_; c = c_; }
    __device__ bool next(int i, Unit& u) const {
        const long L = (long)i * G + c; if (L >= nwg) return false;
        int wgid = (int)L; { const int q = nwg / NXCD, r = nwg % NXCD, xcd = wgid % NXCD, off = wgid / NXCD; wgid = (xcd < r ? xcd * (q + 1) : r * (q + 1) + (xcd - r) * q) + off; }
        const int nig = WGM * nN, gid = wgid / nig, fm = gid * WGM, gsz = (nM - fm) < WGM ? (nM - fm) : WGM;
        u.pm = fm + ((wgid % nig) % gsz); u.pn = (wgid % nig) / gsz; return true;
    }
};

__device__ __forceinline__ void store8(bf16_t* p, f32x4 v0, f32x4 v1) {
    u32x4 w; w.x = cvt_pk_bf16(v0[0], v0[1]); w.y = cvt_pk_bf16(v0[2], v0[3]); w.z = cvt_pk_bf16(v1[0], v1[1]); w.w = cvt_pk_bf16(v1[2], v1[3]); *(u32x4*)p = w;
}
__device__ __forceinline__ void load8(const bf16_t* p, f32x4& v0, f32x4& v1) {
    const u32x4 w = *(const u32x4*)p; v0 = (f32x4){bflo(w.x), bfhi(w.x), bflo(w.y), bfhi(w.y)}; v1 = (f32x4){bflo(w.z), bfhi(w.z), bflo(w.w), bfhi(w.w)};
}

template <int mode> struct Epi {
    static constexpr bool PERM = true;
    unsigned char* ws; unsigned char* dob; const float* x; const float* w0; const float* a0;
    __device__ __forceinline__ void operator()(const f32x4 (&acc)[2][2][4][2], const Unit& u, int wr, int wc, int fr, int fq) const {
        const int row0 = u.pm * BM + wr * 64 + fr, cb = u.pn * BM + wc * 32 + 8 * fq;
#pragma unroll
        for (int ai = 0; ai < 2; ++ai)
#pragma unroll
            for (int m = 0; m < 4; ++m) {
                const size_t row = (size_t)(row0 + ai * HALF + m * 16);
#pragma unroll
                for (int bj = 0; bj < 2; ++bj) {
                    const int col = cb + bj * HALF;
                    f32x4 v0 = acc[ai][bj][m][0], v1 = acc[ai][bj][m][1];
                    if (mode == 0) {
                        if (col < 4096) store8((bf16_t*)(ws + OFF_PM) + row * LDPM + col, v0, v1);
                        else if (col < 7680) store8((bf16_t*)(ws + OFF_PR) + row * LDPR + (col - 4096), v0, v1);
                        else {
#pragma unroll
                            for (int j = 0; j < 4; ++j) { v0[j] = sigm(v0[j]); v1[j] = sigm(v1[j]); }
                            store8((bf16_t*)(ws + OFF_PG) + row * LDPG + (col - 7680), v0, v1);
                        }
                    } else if (mode == 1) {
                        if (col < 1024) {
                            const f32x4 b0 = *(const f32x4*)(w0 + col), b1 = *(const f32x4*)(w0 + col + 4);
#pragma unroll
                            for (int j = 0; j < 4; ++j) {
                                float z = -(b0[j] + v0[j]); float sp = fmaxf(z, 0.f) + __logf(1.f + __expf(-fabsf(z))); v0[j] = -__expf(-sp - 0.5f);
                                z = -(b1[j] + v1[j]); sp = fmaxf(z, 0.f) + __logf(1.f + __expf(-fabsf(z))); v1[j] = -__expf(-sp - 0.5f);
                            }
                            store8((bf16_t*)(dob + DO_WLOG) + row * 1024 + col, v0, v1);
                        } else {
                            const int c2 = col - 1024;
                            const f32x4 b0 = *(const f32x4*)(a0 + c2), b1 = *(const f32x4*)(a0 + c2 + 4);
#pragma unroll
                            for (int j = 0; j < 4; ++j) { v0[j] = sigm(b0[j] + v0[j]); v1[j] = sigm(b1[j] + v1[j]); }
                            store8((bf16_t*)(dob + DO_AG) + row * 1024 + c2, v0, v1);
                        }
                    } else if (mode == 2) {
                        store8((bf16_t*)(dob + DO_GG) + row * 1024 + col, v0, v1);
                    } else if (mode == 3) {
                        bf16_t* pp = (bf16_t*)(ws + OFF_PG) + row * LDPG + col; f32x4 g0, g1; load8(pp, g0, g1);
                        store8(pp, g0 * v0, g1 * v1);
                    } else if (mode == 4) {
                        bf16_t* pp = (bf16_t*)(ws + OFF_PG) + row * LDPG + col; f32x4 m0, m1, g0, g1; load8(pp, m0, m1); load8(pp + 2048, g0, g1);
                        store8(pp, m0 + g0 * v0, m1 + g1 * v1);
                    } else if (mode == 5) {
                        const float* xp = x + row * DM + col; float* op = (float*)dob + row * DM + col;
                        const f32x4 x0 = *(const f32x4*)xp, x1 = *(const f32x4*)(xp + 4);
                        *(f32x4*)op = x0 + v0; *(f32x4*)(op + 4) = x1 + v1;
                    } else {
                        store8((bf16_t*)(ws + OFF_Q) + row * DM + col, v0, v1);
                    }
                    asm volatile("" ::: "memory");
                }
            }
    }
};

template <class EpiT> __device__ __forceinline__ void gemm_phase(LAS unsigned char* lds, const Gemm g, const StaticOrder& S, const EpiT& E) {
    const int tid = tid_l(), wid = __builtin_amdgcn_readfirstlane(tid >> 6), lane = tid & 63, wr = wid >> 2, wc = wid & 3, fr = lane & 15, fq = lane >> 4;
    const int K = g.K, nt = K / BK;
    unsigned voffA[2], voffB[2];
#pragma unroll
    for (int i = 0; i < 2; ++i) { int R, C; stage_rc(tid * 16 + i * 8192, R, C); const int Rb = (R & ~31) + perm32(R & 31);
        voffA[i] = (unsigned)(R * g.lda + C) * 2u; voffB[i] = (unsigned)(Rb * g.ldb + C) * 2u; }
    const size_t kstep = (size_t)(BK * 2);
    const size_t hstepA = (size_t)HALF * g.lda * 2, hstepB = (size_t)HALF * g.ldb * 2;
    const size_t tstepA = 2 * hstepA, tstepB = 2 * hstepB;
    const unsigned ldsw = (unsigned)wid * 1024u;
    const int aoff = lds_byte(wr * 64 + fr, fq * 8), boff = lds_byte(wc * 32 + fr, fq * 8);
#define PG8_SA(b, h) (((b) * 2 + (h)) * HTB)
#define PG8_SB(b, h) ((4 + (b) * 2 + (h)) * HTB)
#define PG8_STAGE(bufoff, gbase, voff) do { _Pragma("unroll") for (int _i = 0; _i < 2; ++_i) \
        __builtin_amdgcn_global_load_lds((const unsigned*)((const char*)(gbase) + (voff)[_i]), (LAS unsigned*)(lds + (bufoff) + ldsw + _i * 8192), 16, 0, 0); } while (0)
#define PG8_LDA(dst, b, h) do { _Pragma("unroll") for (int m = 0; m < 4; ++m) _Pragma("unroll") for (int k = 0; k < 2; ++k) dst[m][k] = *(const LAS bf16x8*)(lds + PG8_SA(b, h) + aoff + m * 2048 + k * 1024); } while (0)
#define PG8_LDB(dst, b, h) do { _Pragma("unroll") for (int n = 0; n < 2; ++n) _Pragma("unroll") for (int k = 0; k < 2; ++k) dst[n][k] = *(const LAS bf16x8*)(lds + PG8_SB(b, h) + boff + n * 2048 + k * 1024); } while (0)
#define PG8_MMA(ai, bj, At, Bt) do { __builtin_amdgcn_s_setprio(1); _Pragma("unroll") for (int m = 0; m < 4; ++m) _Pragma("unroll") for (int n = 0; n < 2; ++n) _Pragma("unroll") for (int k = 0; k < 2; ++k) \
        acc[ai][bj][m][n] = __builtin_amdgcn_mfma_f32_16x16x32_bf16(Bt[n][k], At[m][k], acc[ai][bj][m][n], 0, 0, 0); __builtin_amdgcn_s_setprio(0); } while (0)
#define PG8_WAIT_V(n) asm volatile("s_waitcnt vmcnt(" #n ")" ::: "memory")
#define PG8_WAIT_L(n) asm volatile("s_waitcnt lgkmcnt(" #n ")" ::: "memory")
#define PG8_BAR __builtin_amdgcn_s_barrier()
#define PG8_SCHED __builtin_amdgcn_sched_barrier(0)
    Unit cur, nxt; int ui = 0;
    if (!S.next(0, cur)) return;
    f32x4 acc[2][2][4][2];
#pragma unroll
    for (int a = 0; a < 2; ++a)
#pragma unroll
        for (int b = 0; b < 2; ++b)
#pragma unroll
            for (int m = 0; m < 4; ++m)
#pragma unroll
                for (int n = 0; n < 2; ++n) acc[a][b][m][n] = (f32x4){0.f, 0.f, 0.f, 0.f};
    bf16x8 At[4][2], B0[2][2], B1[2][2];
    const char* cA = (const char*)g.A + (size_t)cur.pm * tstepA; const char* cB = (const char*)g.Bt + (size_t)cur.pn * tstepB;
    PG8_STAGE(PG8_SB(0, 0), cB, voffB); PG8_STAGE(PG8_SA(0, 0), cA, voffA); PG8_STAGE(PG8_SB(0, 1), cB + hstepB, voffB); PG8_STAGE(PG8_SA(0, 1), cA + hstepA, voffA);
    if (wr == 1) PG8_BAR;
    PG8_WAIT_V(4); PG8_BAR;
    PG8_STAGE(PG8_SB(1, 0), cB + kstep, voffB); PG8_STAGE(PG8_SA(1, 0), cA + kstep, voffA); PG8_STAGE(PG8_SB(1, 1), cB + hstepB + kstep, voffB);
    PG8_WAIT_V(6); PG8_BAR;
    for (;;) {
        const bool has_next = S.next(ui + 1, nxt);
        const char* nA = has_next ? (const char*)g.A + (size_t)nxt.pm * tstepA : cA; const char* nB = has_next ? (const char*)g.Bt + (size_t)nxt.pn * tstepB : cB;
        for (int t = 0; t < nt; t += 2) {
            const bool last = (t == nt - 2);
            const char* a1 = cA + (size_t)(t + 1) * kstep;
            const char* a2 = last ? nA : cA + (size_t)(t + 2) * kstep; const char* b2 = last ? nB : cB + (size_t)(t + 2) * kstep;
            const char* a3 = a2 + kstep; const char* b3 = b2 + kstep;
            PG8_LDB(B0, 0, 0); PG8_SCHED; PG8_LDA(At, 0, 0); PG8_STAGE(PG8_SA(1, 1), a1 + hstepA, voffA);
            PG8_WAIT_L(8); PG8_BAR; PG8_WAIT_L(0); PG8_MMA(0, 0, At, B0); PG8_BAR; PG8_SCHED;
            PG8_LDB(B1, 0, 1); PG8_STAGE(PG8_SB(0, 0), b2, voffB);
            PG8_BAR; PG8_WAIT_L(0); PG8_MMA(0, 1, At, B1); PG8_BAR;
            PG8_LDA(At, 0, 1); PG8_STAGE(PG8_SA(0, 0), a2, voffA);
            PG8_BAR; PG8_WAIT_L(0); PG8_MMA(1, 0, At, B0); PG8_BAR; PG8_SCHED;
            PG8_STAGE(PG8_SB(0, 1), b2 + hstepB, voffB);
            PG8_WAIT_V(6); PG8_BAR; PG8_MMA(1, 1, At, B1); PG8_BAR;
            PG8_LDB(B0, 1, 0); PG8_SCHED; PG8_LDA(At, 1, 0); PG8_STAGE(PG8_SA(0, 1), a2 + hstepA, voffA);
            PG8_WAIT_L(8); PG8_BAR; PG8_WAIT_L(0); PG8_MMA(0, 0, At, B0); PG8_BAR; PG8_SCHED;
            PG8_LDB(B1, 1, 1); PG8_STAGE(PG8_SB(1, 0), b3, voffB);
            PG8_BAR; PG8_WAIT_L(0); PG8_MMA(0, 1, At, B1); PG8_BAR;
            PG8_LDA(At, 1, 1); PG8_STAGE(PG8_SA(1, 0), a3, voffA);
            PG8_BAR; PG8_WAIT_L(0); PG8_MMA(1, 0, At, B0); PG8_BAR; PG8_SCHED;
            PG8_STAGE(PG8_SB(1, 1), b3 + hstepB, voffB);
            PG8_WAIT_V(6); PG8_BAR; PG8_MMA(1, 1, At, B1); PG8_BAR;
        }
        E(acc, cur, wr, wc, fr, fq);
        if (!has_next) break;
#pragma unroll
        for (int a = 0; a < 2; ++a)
#pragma unroll
            for (int b = 0; b < 2; ++b)
#pragma unroll
                for (int m = 0; m < 4; ++m)
#pragma unroll
                    for (int n = 0; n < 2; ++n) acc[a][b][m][n] = (f32x4){0.f, 0.f, 0.f, 0.f};
        cur = nxt; cA = nA; cB = nB; ++ui;
    }
    PG8_WAIT_V(0);
    if (wr == 0) PG8_BAR;
    PG8_BAR;
#undef PG8_SA
#undef PG8_SB
#undef PG8_STAGE
#undef PG8_LDA
#undef PG8_LDB
#undef PG8_MMA
#undef PG8_WAIT_V
#undef PG8_WAIT_L
#undef PG8_BAR
#undef PG8_SCHED
}
}

__device__ __forceinline__ void rmsnorm_rows(const float* src, const float* gain, bf16_t* dst, int gw, int nw, int lane) {
    for (int row = gw; row < NT; row += nw) {
        const f32x4* s = (const f32x4*)(src + (size_t)row * DM);
        f32x4 v[8]; float ss = 0.f;
#pragma unroll
        for (int i = 0; i < 8; ++i) { v[i] = s[i * 64 + lane]; ss += v[i][0] * v[i][0] + v[i][1] * v[i][1] + v[i][2] * v[i][2] + v[i][3] * v[i][3]; }
        ss = wave_sum(ss);
        const float r = rsqrtf(ss * (1.f / DM) + 1e-6f);
        u32x2* d = (u32x2*)(dst + (size_t)row * DM);
#pragma unroll
        for (int i = 0; i < 8; ++i) { const f32x4 gg = ((const f32x4*)gain)[i * 64 + lane]; u32x2 o; o.x = cvt_pk_bf16(v[i][0] * r * gg[0], v[i][1] * r * gg[1]); o.y = cvt_pk_bf16(v[i][2] * r * gg[2], v[i][3] * r * gg[3]); d[i * 64 + lane] = o; }
    }
}

__device__ __forceinline__ void tr_tile(const float* src, int ld, int c0, int nvalid, int k0, bf16_t* dst, int ldd, int r0, int kd0, LAS float* tile, int lane) {
    f32x4 v[16];
    const int c4 = (lane & 15) * 4, kb = lane >> 4;
#pragma unroll
    for (int i = 0; i < 16; ++i) { v[i] = (f32x4){0.f, 0.f, 0.f, 0.f}; if (c4 < nvalid) v[i] = *(const f32x4*)(src + (size_t)(k0 + kb + 4 * i) * ld + c0 + c4); }
#pragma unroll
    for (int i = 0; i < 16; ++i) { const int k = kb + 4 * i; tile[k * 65 + c4] = v[i][0]; tile[k * 65 + c4 + 1] = v[i][1]; tile[k * 65 + c4 + 2] = v[i][2]; tile[k * 65 + c4 + 3] = v[i][3]; }
#pragma unroll
    for (int i = 0; i < 8; ++i) {
        const int c = (lane >> 3) + 8 * i, k8 = (lane & 7) * 8;
        float f[8];
#pragma unroll
        for (int j = 0; j < 8; ++j) f[j] = tile[(k8 + j) * 65 + c];
        u32x4 w; w.x = cvt_pk_bf16(f[0], f[1]); w.y = cvt_pk_bf16(f[2], f[3]); w.z = cvt_pk_bf16(f[4], f[5]); w.w = cvt_pk_bf16(f[6], f[7]);
        *(u32x4*)(dst + (size_t)(r0 + c) * ldd + kd0 + k8) = w;
    }
}

__device__ void phase_prep(const KP& p, LAS unsigned char* lds) {
    const int tid = tid_l(), lane = tid & 63, G = gridDim.x, bid = blockIdx.x;
    unsigned char* ws = p.ws;
    rmsnorm_rows(p.x, p.g_mix, (bf16_t*)(ws + OFF_XN), bid * 8 + (tid >> 6), G * 8, lane);
    LAS float* tile = (LAS float*)lds + (tid >> 6) * (64 * 65 + 16);
    for (int j = bid * 8 + (tid >> 6); j < 8960; j += G * 8) {
        const float* src; bf16_t* dst; int ld = 2048, ldd, c0, nv = 64, rt, kt;
        if (j < 5888) { rt = j >> 5; kt = j & 31; src = p.w_in; ld = 11720; dst = (bf16_t*)(ws + OFF_WINT); ldd = 2048;
            if (rt < 64) c0 = 64 * rt; else if (rt < 119) c0 = 4104 + 64 * (rt - 64); else if (rt == 119) { c0 = 4096; nv = 8; } else c0 = 7624 + 64 * (rt - 120); }
        else if (j < 6400) { const int q = j - 5888; rt = q >> 4; kt = q & 15; src = p.proj_m; dst = (bf16_t*)(ws + OFF_PMT); ldd = 1024; c0 = rt * 64; }
        else if (j < 6912) { const int q = j - 6400; rt = q >> 4; kt = q & 15; src = p.proj_r; dst = (bf16_t*)(ws + OFF_PRT); ldd = 1024; c0 = rt * 64; }
        else if (j < 7936) { const int q = j - 6912; rt = q >> 5; kt = q & 31; src = p.w_out; dst = (bf16_t*)(ws + OFF_WOT); ldd = 2048; c0 = rt * 64; }
        else { const int q = j - 7936; rt = q >> 5; kt = q & 31; src = p.w_query; dst = (bf16_t*)(ws + OFF_WQT); ldd = 2048; c0 = rt * 64; }
        tr_tile(src, ld, c0, nv, kt * 64, dst, ldd, rt * 64, kt * 64, tile, lane);
    }
    const int gt = bid * 512 + tid, gn = G * 512;
    bf16_t* WAT = (bf16_t*)(ws + OFF_WAT);
    for (int i = gt; i < 2048 * 256; i += gn) { const int r = i >> 8, k = i & 255; float v = 0.f;
        if (r < 1024) { if (k < 96) v = p.w2[k * 1024 + r]; } else { if (k >= 96 && k < 192) v = p.a2[(k - 96) * 1024 + (r - 1024)]; }
        WAT[i] = f2bf(v); }
    bf16_t* G2T = (bf16_t*)(ws + OFF_G2T);
    for (int i = gt; i < 1024 * 256; i += gn) { const int r = i >> 8, k = i & 255; G2T[i] = f2bf(p.g2[k * 1024 + r]); }
    bf16_t* SK = (bf16_t*)(ws + OFF_SUBK);
    for (int i = gt; i < 2 * 128 * 128; i += gn) SK[i] = f2bf(p.sub_keys[i]);
    if (gt == 0) *(unsigned*)(ws + OFF_SUBBAR) = 0u;
    for (int i = gt; i < XCD_BAR_WORDS; i += gn) ((unsigned*)(ws + OFF_XBAR))[i] = 0u;
}

__device__ __forceinline__ float bfel(const u32x4& w, int e) { const unsigned u = w[e >> 1]; return (e & 1) ? bfhi(u) : bflo(u); }
__device__ void phase_lora_prep(const KP& p) {
    const bf16_t* PR = (const bf16_t*)(p.ws + OFF_PR);
    bf16_t* AL = (bf16_t*)((unsigned char*)p.out + DO_ALORA);
    const int gt = blockIdx.x * 512 + threadIdx.x, gn = gridDim.x * 512;
    for (int i = gt; i < NT * 64; i += gn) {
        const int tok = i >> 6, g = i & 63;
        u32x4 o = (u32x4){0u, 0u, 0u, 0u};
        if (g < 24 || g >= 32) {
            const int sc = (g < 24) ? (3072 + 8 * g) : (3264 + 8 * (g - 32));
            const u32x4 cu = *(const u32x4*)(PR + (size_t)tok * LDPR + sc);
            u32x4 pv = (u32x4){0u, 0u, 0u, 0u};
            if ((tok & (SEQ - 1)) != 0) pv = *(const u32x4*)(PR + (size_t)(tok - 1) * LDPR + sc);
            const f32x4 m0 = *(const f32x4*)(p.mu + sc), m1 = *(const f32x4*)(p.mu + sc + 4);
            float f[8];
#pragma unroll
            for (int q = 0; q < 4; ++q) {
                const float c0 = bflo(cu[q]), c1 = bfhi(cu[q]), p0 = bflo(pv[q]), p1 = bfhi(pv[q]);
                const float mm0 = (q < 2) ? m0[2 * q] : m1[2 * q - 4], mm1 = (q < 2) ? m0[2 * q + 1] : m1[2 * q - 3];
                f[2 * q] = c0 + (p0 - c0) * mm0; f[2 * q + 1] = c1 + (p1 - c1) * mm1;
            }
            if (g < 12) {
#pragma unroll
                for (int q = 0; q < 8; ++q) f[q] = tanhf(f[q]);
            } else if (g >= 32) {
#pragma unroll
                for (int q = 0; q < 8; ++q) f[q] = sigm(f[q]);
            }
            o.x = cvt_pk_bf16(f[0], f[1]); o.y = cvt_pk_bf16(f[2], f[3]); o.z = cvt_pk_bf16(f[4], f[5]); o.w = cvt_pk_bf16(f[6], f[7]);
        }
        *(u32x4*)(AL + (size_t)tok * 512 + 8 * g) = o;
    }
    {
        const bf16_t* PM = (const bf16_t*)(p.ws + OFF_PM);
        bf16_t* QC = (bf16_t*)(p.ws + OFF_QC); bf16_t* KC = (bf16_t*)(p.ws + OFF_KC);
        for (int i = gt; i < (NT / 8) * 256; i += gn) {
            const int tb = i >> 8, col = (i & 255) * 8; const int tok0 = tb * 8, t0 = tok0 & (SEQ - 1);
            f32x4 cw[4][2];
#pragma unroll
            for (int j = 0; j < 4; ++j) { cw[j][0] = *(const f32x4*)(p.conv_w + j * 2048 + col); cw[j][1] = *(const f32x4*)(p.conv_w + j * 2048 + col + 4); }
            u32x4 raw[11];
#pragma unroll
            for (int q = 0; q < 11; ++q) { const bool neg = (t0 - 3 + q) < 0; u32x4 v = *(const u32x4*)(PM + (size_t)(tok0 + (neg ? 0 : q - 3)) * LDPM + col); if (neg) v = (u32x4){0u, 0u, 0u, 0u}; raw[q] = v; }
            const float scl = (col < 1024) ? 0.0625f : 1.f;
            bf16_t* dst = (col < 1024) ? (QC + (size_t)tok0 * 1024 + col) : (KC + (size_t)tok0 * 1024 + (col - 1024));
#pragma unroll
            for (int r = 0; r < 8; ++r) {
                float o[8];
#pragma unroll
                for (int e = 0; e < 8; ++e) {
                    const float c0 = (e < 4) ? cw[0][0][e] : cw[0][1][e - 4], c1 = (e < 4) ? cw[1][0][e] : cw[1][1][e - 4], c2 = (e < 4) ? cw[2][0][e] : cw[2][1][e - 4], c3 = (e < 4) ? cw[3][0][e] : cw[3][1][e - 4];
                    float sv = c0 * bfel(raw[r], e) + c1 * bfel(raw[r + 1], e) + c2 * bfel(raw[r + 2], e) + c3 * bfel(raw[r + 3], e);
                    o[e] = sv * sigm(sv) * scl;
                }
                u32x4 pk; pk.x = cvt_pk_bf16(o[0], o[1]); pk.y = cvt_pk_bf16(o[2], o[3]); pk.z = cvt_pk_bf16(o[4], o[5]); pk.w = cvt_pk_bf16(o[6], o[7]);
                *(u32x4*)(dst + (size_t)r * 1024) = pk;
            }
        }
    }
    {
        const int lane = threadIdx.x & 63, gw = blockIdx.x * 8 + (threadIdx.x >> 6), nw = gridDim.x * 8;
        float* GB = (float*)((unsigned char*)p.out + DO_GB); float* GA = (float*)((unsigned char*)p.out + DO_GA); float* GW = (float*)((unsigned char*)p.out + DO_GW);
        for (int task = gw; task < 1024; task += nw) {
            const int bh = task >> 6, c = task & 63, bb = bh >> 2, h = bh & 3; const size_t tok = (size_t)bb * SEQ + c * 64 + lane;
            const float iv = bf2f(PR[tok * LDPR + 3520 + h]) + p.b_i[h], fv = bf2f(PR[tok * LDPR + 3524 + h]) + p.b_f[h];
            float lf = fminf(fv, 0.f) - __logf(1.f + __expf(-fabsf(fv)));
#pragma unroll
            for (int d = 1; d < 64; d <<= 1) { const float y = __shfl_up(lf, d); if (lane >= d) lf += y; }
            const float bl = rlane(lf, 63);
            const int o = bh * SEQ + c * 64 + lane;
            GB[o] = lf; GA[o] = iv - lf; GW[o] = __expf(bl - lf + iv);
        }
    }
}

constexpr size_t OFF_YRAW = OFF_WINT, OFF_BON = OFF_WINT + 32 * MiB;
struct RwOps { f32x4 a0, a1, q0, q1, w0, w1, b0, b1, k0, k1; float v, br, kr; };
__device__ __forceinline__ f32x2_t lo2(f32x4 v) { return __builtin_shufflevector(v, v, 0, 1); }
__device__ __forceinline__ f32x2_t hi2(f32x4 v) { return __builtin_shufflevector(v, v, 2, 3); }
__device__ __forceinline__ f32x2_t fma2(f32x2_t a, f32x2_t b, f32x2_t c) { return __builtin_elementwise_fma(a, b, c); }
__device__ void rwkv_scan(const KP& p, int blk, LAS unsigned char* lds) {
    const int tid0 = tid_l();
    const int bh = blk >> 1, half = blk & 1, b = bh >> 4, h = bh & 15;
    constexpr int BUFB = 53760;
    const bf16_t* PR = (const bf16_t*)(p.ws + OFF_PR);
    const bf16_t* WLOG = (const bf16_t*)((const unsigned char*)p.out + DO_WLOG);
    const bf16_t* AG = (const bf16_t*)((const unsigned char*)p.out + DO_AG);
    bf16_t* YRAW = (bf16_t*)(p.ws + OFF_YRAW); float* BON = (float*)(p.ws + OFF_BON);
    const size_t tokbase = (size_t)b * SEQ;
    if (tid0 < 256) {
        const int rowl = tid0 >> 3, j8 = (tid0 & 7) * 8, row = 32 * half + rowl;
        f32x2_t S2[4];
#pragma unroll
        for (int k = 0; k < 4; ++k) S2[k] = (f32x2_t){0.f, 0.f};
        __syncthreads();
        for (int c = 0; c < 128; ++c) {
            const LAS float* bp = (const LAS float*)(lds + (c & 1) * BUFB);
            LAS float* yb = (LAS float*)(lds + (c & 1) * BUFB + 49408);
#define RW_LD(O, s) do { const LAS float* q_ = bp + (s) * 64 + j8; O.a0 = *(const LAS f32x4*)(q_); O.a1 = *(const LAS f32x4*)(q_ + 4); O.b0 = *(const LAS f32x4*)(q_ + 2048); O.b1 = *(const LAS f32x4*)(q_ + 2052); \
            O.w0 = *(const LAS f32x4*)(q_ + 4096); O.w1 = *(const LAS f32x4*)(q_ + 4100); O.k0 = *(const LAS f32x4*)(q_ + 6144); O.k1 = *(const LAS f32x4*)(q_ + 6148); \
            O.q0 = *(const LAS f32x4*)(q_ + 8192); O.q1 = *(const LAS f32x4*)(q_ + 8196); O.v = bp[10240 + (s) * 64 + row]; O.br = bp[12288 + (s)]; O.kr = bp[12320 + (s)]; } while (0)
#define RW_STEP(O, s) do { \
            f32x2_t pa = S2[0] * lo2(O.a0); f32x2_t py = S2[0] * lo2(O.q0); \
            pa = fma2(S2[1], hi2(O.a0), pa); py = fma2(S2[1], hi2(O.q0), py); pa = fma2(S2[2], lo2(O.a1), pa); py = fma2(S2[2], lo2(O.q1), py); \
            pa = fma2(S2[3], hi2(O.a1), pa); py = fma2(S2[3], hi2(O.q1), py); \
            float sa = pa.x + pa.y, yy = py.x + py.y; \
            sa += dppf<0xB1>(sa); yy += dppf<0xB1>(yy); sa += dppf<0x4E>(sa); yy += dppf<0x4E>(yy); sa += dppf<0x141>(sa); yy += dppf<0x141>(yy); \
            const f32x2_t sa2 = (f32x2_t){sa, sa}, vv2 = (f32x2_t){O.v, O.v}; \
            S2[0] = fma2(S2[0], lo2(O.w0), fma2(vv2, lo2(O.k0), sa2 * lo2(O.b0))); S2[1] = fma2(S2[1], hi2(O.w0), fma2(vv2, hi2(O.k0), sa2 * hi2(O.b0))); \
            S2[2] = fma2(S2[2], lo2(O.w1), fma2(vv2, lo2(O.k1), sa2 * lo2(O.b1))); S2[3] = fma2(S2[3], hi2(O.w1), fma2(vv2, hi2(O.k1), sa2 * hi2(O.b1))); \
            if ((tid0 & 7) == 0) yb[(s) * 32 + rowl] = yy + sa * O.br + O.v * O.kr; } while (0)
            RwOps o0, o1;
            RW_LD(o0, 0);
#pragma unroll 1
            for (int s = 0; s < 32; s += 2) {
                RW_LD(o1, s + 1);
                RW_STEP(o0, s);
                { const int sn = (s + 2 < 32) ? s + 2 : 31; RW_LD(o0, sn); }
                RW_STEP(o1, s + 1);
            }
#undef RW_LD
#undef RW_STEP
            __syncthreads();
        }
    } else {
        const int ht = tid0 - 256, tt = ht >> 3, cg8 = (ht & 7) * 8, ch = h * 64 + cg8;
        float mur[8], muk[8], muv[8], kkc[8], kac[8], rkc[8];
#pragma unroll
        for (int e = 0; e < 8; ++e) { mur[e] = p.mu[ch + e]; muk[e] = p.mu[1024 + ch + e]; muv[e] = p.mu[2048 + ch + e]; kkc[e] = p.k_k[ch + e]; kac[e] = p.k_a[ch + e]; rkc[e] = p.r_k[ch + e]; }
        for (int c = -1; c < 128; ++c) {
            if (c >= 1) {
                const LAS float* yb = (const LAS float*)(lds + ((c - 1) & 1) * BUFB + 49408);
                const int r4 = (ht & 7) * 4; const f32x4 y4 = *(const LAS f32x4*)(yb + tt * 32 + r4);
                u32x2 ov; ov.x = cvt_pk_bf16(y4[0], y4[1]); ov.y = cvt_pk_bf16(y4[2], y4[3]);
                *(u32x2*)(YRAW + (tokbase + (size_t)(c - 1) * 32 + tt) * 1024 + h * 64 + 32 * half + r4) = ov;
            }
            if (c + 1 < 128) {
                const int cn = c + 1, t = cn * 32 + tt; const size_t tok = tokbase + t;
                LAS float* bp = (LAS float*)(lds + (cn & 1) * BUFB);
                const bf16_t* pr_ = PR + tok * LDPR + ch;
                const u32x4 r4 = *(const u32x4*)pr_, k4 = *(const u32x4*)(pr_ + 1024), v4 = *(const u32x4*)(pr_ + 2048);
                u32x4 pr4 = (u32x4){0u, 0u, 0u, 0u}, pk4 = pr4, pv4 = pr4;
                if (t > 0) { pr4 = *(const u32x4*)(pr_ - LDPR); pk4 = *(const u32x4*)(pr_ - LDPR + 1024); pv4 = *(const u32x4*)(pr_ - LDPR + 2048); }
                const u32x4 w4 = *(const u32x4*)(WLOG + tok * 1024 + ch), a4 = *(const u32x4*)(AG + tok * 1024 + ch);
                float r[8], k[8], v[8], kk[8], av[8], dec[8];
                float n2 = 0.f;
#pragma unroll
                for (int e = 0; e < 8; ++e) {
                    const float rc = bfel(r4, e), kc = bfel(k4, e), vc = bfel(v4, e);
                    r[e] = rc + (bfel(pr4, e) - rc) * mur[e]; k[e] = kc + (bfel(pk4, e) - kc) * muk[e]; v[e] = vc + (bfel(pv4, e) - vc) * muv[e];
                    kk[e] = k[e] * kkc[e]; n2 += kk[e] * kk[e]; av[e] = bfel(a4, e); dec[e] = __expf(bfel(w4, e));
                }
                n2 = red8(n2);
                const float inv = 1.f / fmaxf(sqrtf(n2), 1e-12f);
                float br = 0.f, kr = 0.f, bon = 0.f;
                f32x4 oa[2], ob[2], ow[2], ok[2], oq[2], ovv[2];
#pragma unroll
                for (int e = 0; e < 8; ++e) {
                    const float kn = kk[e] * inv, k3 = k[e] * (1.f + (av[e] - 1.f) * kac[e]), bb = kn * av[e];
                    oa[e >> 2][e & 3] = -kn; ob[e >> 2][e & 3] = bb; ow[e >> 2][e & 3] = dec[e]; ok[e >> 2][e & 3] = k3; oq[e >> 2][e & 3] = dec[e] * r[e]; ovv[e >> 2][e & 3] = v[e];
                    br += bb * r[e]; kr += k3 * r[e]; bon += r[e] * k3 * rkc[e];
                }
                br = red8(br); kr = red8(kr); bon = red8(bon);
                LAS float* q_ = bp + tt * 64 + cg8;
#pragma unroll
                for (int i = 0; i < 2; ++i) { *(LAS f32x4*)(q_ + 4 * i) = oa[i]; *(LAS f32x4*)(q_ + 2048 + 4 * i) = ob[i]; *(LAS f32x4*)(q_ + 4096 + 4 * i) = ow[i]; *(LAS f32x4*)(q_ + 6144 + 4 * i) = ok[i];
                    *(LAS f32x4*)(q_ + 8192 + 4 * i) = oq[i]; *(LAS f32x4*)(q_ + 10240 + 4 * i) = ovv[i]; }
                if ((ht & 7) == 0) { bp[12288 + tt] = br; bp[12320 + tt] = kr; if (half == 0) BON[tok * 16 + h] = bon; }
            }
            __syncthreads();
        }
        {
            const LAS float* yb = (const LAS float*)(lds + (127 & 1) * BUFB + 49408);
            const int r4 = (ht & 7) * 4; const f32x4 y4 = *(const LAS f32x4*)(yb + tt * 32 + r4);
            u32x2 ov; ov.x = cvt_pk_bf16(y4[0], y4[1]); ov.y = cvt_pk_bf16(y4[2], y4[3]);
            *(u32x2*)(YRAW + (tokbase + (size_t)127 * 32 + tt) * 1024 + h * 64 + 32 * half + r4) = ov;
        }
    }
}

__device__ void phase_rwkv_post(const KP& p) {
    const bf16_t* PR = (const bf16_t*)(p.ws + OFF_PR);
    const bf16_t* GG = (const bf16_t*)((const unsigned char*)p.out + DO_GG);
    bf16_t* YR = (bf16_t*)(p.ws + OFF_YRAW); const float* BON = (const float*)(p.ws + OFF_BON);
    const int gt = blockIdx.x * 512 + tid_l(), gn = gridDim.x * 512;
    for (int i = gt; i < NT * 256; i += gn) {
        const int tok = i >> 8, h = (i >> 4) & 15, ch = h * 64 + (i & 15) * 4;
        const u32x2 y2 = *(const u32x2*)(YR + (size_t)tok * 1024 + ch), v2 = *(const u32x2*)(PR + (size_t)tok * LDPR + 2048 + ch), g2 = *(const u32x2*)(GG + (size_t)tok * 1024 + ch);
        u32x2 pv2 = (u32x2){0u, 0u};
        if ((tok & (SEQ - 1)) != 0) pv2 = *(const u32x2*)(PR + (size_t)(tok - 1) * LDPR + 2048 + ch);
        const float bon = BON[tok * 16 + h];
        const f32x4 muv = *(const f32x4*)(p.mu + 2048 + ch), lnw = *(const f32x4*)(p.ln_w + ch), lnb = *(const f32x4*)(p.ln_b + ch);
        const f32x4 y = (f32x4){bflo(y2.x), bfhi(y2.x), bflo(y2.y), bfhi(y2.y)}, vc = (f32x4){bflo(v2.x), bfhi(v2.x), bflo(v2.y), bfhi(v2.y)}, vp = (f32x4){bflo(pv2.x), bfhi(pv2.x), bflo(pv2.y), bfhi(pv2.y)};
        const f32x4 g = (f32x4){bflo(g2.x), bfhi(g2.x), bflo(g2.y), bfhi(g2.y)};
        const f32x4 v = vc + (vp - vc) * muv;
        const float mean = red16(y[0] + y[1] + y[2] + y[3]) * (1.f / 64.f);
        const f32x4 d = y - mean;
        const float var = red16(d[0] * d[0] + d[1] * d[1] + d[2] * d[2] + d[3] * d[3]) * (1.f / 64.f);
        const float rs = rsqrtf(var + 64e-5f);
        const f32x4 res = (d * rs * lnw + lnb + bon * v) * g;
        u32x2 ov; ov.x = cvt_pk_bf16(res[0], res[1]); ov.y = cvt_pk_bf16(res[2], res[3]);
        *(u32x2*)(YR + (size_t)tok * 1024 + ch) = ov;
    }
}

typedef short v4i16_t __attribute__((ext_vector_type(4)));
__device__ __forceinline__ bf16x8 tr_frag(const LAS unsigned char* base, int stride_b, int krow0, int ncol0, int lane) {
    const int g = lane >> 4, q = (lane & 15) >> 2, pp = lane & 3;
    const LAS unsigned char* a0 = base + (krow0 + 8 * g + q) * stride_b + (ncol0 + 4 * pp) * 2;
    const v4i16_t x = __builtin_amdgcn_ds_read_tr16_b64_v4i16((LAS v4i16_t*)a0), y = __builtin_amdgcn_ds_read_tr16_b64_v4i16((LAS v4i16_t*)(a0 + 4 * stride_b));
    return (bf16x8){x[0], x[1], x[2], x[3], y[0], y[1], y[2], y[3]};
}
__device__ void mlstm_run(const KP& p, int item, LAS unsigned char* lds) {
    const int tid0 = tid_l();
    const int bh = item >> 3, b = bh >> 2, h = bh & 3, dv0 = (item & 7) * 32;
    const size_t tokbase = (size_t)b * SEQ;
    LAS bf16_t* Qs = (LAS bf16_t*)(lds + 0);
    LAS bf16_t* Ks = (LAS bf16_t*)(lds + 33792);
    LAS bf16_t* Vs = (LAS bf16_t*)(lds + 67584);
    LAS bf16_t* Vws = (LAS bf16_t*)(lds + 74752);
    LAS bf16_t* Ss = (LAS bf16_t*)(lds + 81920);
    LAS bf16_t* CT0 = (LAS bf16_t*)(lds + 91136);
    LAS bf16_t* Os = (LAS bf16_t*)(lds + 141824);
    LAS float* BC = (LAS float*)(lds + 146944);
    LAS float* GAs = (LAS float*)(lds + 147200);
    const bf16_t* QC = (const bf16_t*)(p.ws + OFF_QC); const bf16_t* KC = (const bf16_t*)(p.ws + OFF_KC);
    bf16_t* PM = (bf16_t*)(p.ws + OFF_PM);
    const float* GB = (const float*)((const unsigned char*)p.out + DO_GB); const float* GA = (const float*)((const unsigned char*)p.out + DO_GA); const float* GW = (const float*)((const unsigned char*)p.out + DO_GW);
    for (int i = tid0; i < 2 * 48 * 264 / 2; i += 512) ((LAS unsigned*)CT0)[i] = 0u;
    for (int i = tid0; i < 2 * 64 * 56 / 2; i += 512) ((LAS unsigned*)Vs)[i] = 0u;
    __syncthreads();
    if (tid0 < 64) Vs[tid0 * 56 + 32] = (bf16_t)0x3F80;
    f32x4 cacc[6];
#pragma unroll
    for (int i = 0; i < 6; ++i) cacc[i] = (f32x4){0.f, 0.f, 0.f, 0.f};
    u32x4 q4[4], k4[4], vo4; float gb = 0.f, ga = 0.f, gwv = 0.f;
#define ML_LOAD(c, TID) do { const int row_ = (TID) >> 3, pc_ = (TID) & 7; const size_t tk_ = tokbase + (size_t)(c) * 64; \
        const bf16_t* qp_ = QC + (tk_ + row_) * 1024 + h * 256 + pc_ * 32; const bf16_t* kp_ = KC + (tk_ + row_) * 1024 + h * 256 + pc_ * 32; \
        _Pragma("unroll") for (int i_ = 0; i_ < 4; ++i_) { q4[i_] = *(const u32x4*)(qp_ + 8 * i_); k4[i_] = *(const u32x4*)(kp_ + 8 * i_); } \
        const int sg_ = (TID) & 255, s_ = sg_ >> 2, g_ = sg_ & 3; \
        vo4 = *(const u32x4*)(PM + (tk_ + s_) * LDPM + ((TID) < 256 ? 2048 : 3072) + h * 256 + dv0 + 8 * g_); \
        gwv = GW[bh * SEQ + (c) * 64 + s_]; \
        if ((TID) < 64) { gb = GB[bh * SEQ + (c) * 64 + (TID)]; ga = GA[bh * SEQ + (c) * 64 + (TID)]; } } while (0)
    ML_LOAD(0, tid0);
    __syncthreads();
    int cur = 0;
    for (int c = 0; c < 64; ++c) {
        int tid = tid0; asm volatile("" : "+v"(tid));
        const int lane = tid & 63, w = tid >> 6, fr = lane & 15, fq = lane >> 4;
        LAS bf16_t* CTc = CT0 + cur * (48 * 264); LAS bf16_t* CTn = CT0 + (cur ^ 1) * (48 * 264);
        {
            const int row = tid >> 3, pc = tid & 7;
#pragma unroll
            for (int i = 0; i < 4; ++i) { *(LAS u32x4*)(Qs + row * 264 + pc * 32 + 8 * i) = q4[i]; *(LAS u32x4*)(Ks + row * 264 + pc * 32 + 8 * i) = k4[i]; }
            const int sg = tid & 255, s = sg >> 2, g = sg & 3;
            if (tid < 256) {
                *(LAS u32x4*)(Vs + s * 56 + 8 * g) = vo4;
                u32x4 wv;
#pragma unroll
                for (int e = 0; e < 4; ++e) wv[e] = cvt_pk_bf16(bflo(vo4[e]) * gwv, bfhi(vo4[e]) * gwv);
                *(LAS u32x4*)(Vws + s * 56 + 8 * g) = wv;
                if (g == 0) Vws[s * 56 + 32] = f2bf(gwv);
            } else {
                if (c > 0) { const u32x4 yv = *(const LAS u32x4*)(Os + s * 40 + 8 * g); *(u32x4*)(PM + (tokbase + (size_t)(c - 1) * 64 + s) * LDPM + 3072 + h * 256 + dv0 + 8 * g) = yv; }
                *(LAS u32x4*)(Os + s * 40 + 8 * g) = vo4;
            }
            if (tid < 64) { BC[tid] = gb; GAs[tid] = ga; }
        }
        asm volatile("" ::: "memory");
        if (c + 1 < 64) ML_LOAD(c + 1, tid);
        asm volatile("" ::: "memory");
        __syncthreads();
        {
            const int mt = w >> 1, ntb = (w & 1) * 2;
            f32x4 s0 = (f32x4){0.f, 0.f, 0.f, 0.f}, s1 = s0;
#pragma unroll
            for (int ks = 0; ks < 8; ++ks) {
                const bf16x8 a = *(const LAS bf16x8*)(Qs + (16 * mt + fr) * 264 + 32 * ks + 8 * fq);
                const bf16x8 b0 = *(const LAS bf16x8*)(Ks + (16 * ntb + fr) * 264 + 32 * ks + 8 * fq);
                const bf16x8 b1 = *(const LAS bf16x8*)(Ks + (16 * (ntb + 1) + fr) * 264 + 32 * ks + 8 * fq);
                s0 = __builtin_amdgcn_mfma_f32_16x16x32_bf16(a, b0, s0, 0, 0, 0);
                s1 = __builtin_amdgcn_mfma_f32_16x16x32_bf16(a, b1, s1, 0, 0, 0);
            }
            const int sA = 16 * ntb + fr, sB = sA + 16;
            const float gA = GAs[sA], gB = GAs[sB];
#pragma unroll
            for (int j = 0; j < 4; ++j) {
                const int t = 16 * mt + 4 * fq + j; const float bt = BC[t];
                const float vA = (sA <= t) ? s0[j] * __expf(bt + gA) : 0.f, vB = (sB <= t) ? s1[j] * __expf(bt + gB) : 0.f;
                Ss[t * 72 + sA] = f2bf(vA); Ss[t * 72 + sB] = f2bf(vB);
            }
        }
        __syncthreads();
        {
            const int mt = w >> 1, nt = w & 1;
            f32x4 aA = (f32x4){0.f, 0.f, 0.f, 0.f}, aB = aA, xA = aA, xB = aA;
#pragma unroll
            for (int ks = 0; ks < 2; ++ks) {
                const bf16x8 a = *(const LAS bf16x8*)(Ss + (16 * mt + fr) * 72 + 32 * ks + 8 * fq);
                const bf16x8 bm = tr_frag((const LAS unsigned char*)Vs, 112, 32 * ks, 16 * nt, lane);
                const bf16x8 bx = tr_frag((const LAS unsigned char*)Vs, 112, 32 * ks, 32, lane);
                aA = __builtin_amdgcn_mfma_f32_16x16x32_bf16(a, bm, aA, 0, 0, 0);
                xA = __builtin_amdgcn_mfma_f32_16x16x32_bf16(a, bx, xA, 0, 0, 0);
            }
#pragma unroll
            for (int ks = 0; ks < 8; ++ks) {
                const bf16x8 a = *(const LAS bf16x8*)(Qs + (16 * mt + fr) * 264 + 32 * ks + 8 * fq);
                const bf16x8 bm = *(const LAS bf16x8*)(CTc + (16 * nt + fr) * 264 + 32 * ks + 8 * fq);
                const bf16x8 bx = *(const LAS bf16x8*)(CTc + (32 + fr) * 264 + 32 * ks + 8 * fq);
                aB = __builtin_amdgcn_mfma_f32_16x16x32_bf16(a, bm, aB, 0, 0, 0);
                xB = __builtin_amdgcn_mfma_f32_16x16x32_bf16(a, bx, xB, 0, 0, 0);
            }
#pragma unroll
            for (int j = 0; j < 4; ++j) {
                const int t = 16 * mt + 4 * fq + j; const float eb = __expf(BC[t]);
                const float num = aA[j] + eb * aB[j];
                const float den = __shfl(xA[j] + eb * xB[j], lane & 48);
                const float hv = num / fmaxf(fabsf(den), 1.f);
                LAS bf16_t* op = Os + t * 40 + 16 * nt + fr;
                *op = f2bf(hv * sigm(bf2f(*op)));
            }
            const float decay = __expf(BC[63]);
            bf16x8 bw[3][2];
#pragma unroll
            for (int n3 = 0; n3 < 3; ++n3)
#pragma unroll
                for (int ks = 0; ks < 2; ++ks) bw[n3][ks] = tr_frag((const LAS unsigned char*)Vws, 112, 32 * ks, 16 * n3, lane);
#pragma unroll
            for (int m2 = 0; m2 < 2; ++m2) {
                const int mtk = 2 * w + m2;
                const bf16x8 ka0 = tr_frag((const LAS unsigned char*)Ks, 528, 0, 16 * mtk, lane), ka1 = tr_frag((const LAS unsigned char*)Ks, 528, 32, 16 * mtk, lane);
#pragma unroll
                for (int n3 = 0; n3 < 3; ++n3) {
                    f32x4 cc = cacc[m2 * 3 + n3] * decay;
                    cc = __builtin_amdgcn_mfma_f32_16x16x32_bf16(ka0, bw[n3][0], cc, 0, 0, 0);
                    cc = __builtin_amdgcn_mfma_f32_16x16x32_bf16(ka1, bw[n3][1], cc, 0, 0, 0);
                    cacc[m2 * 3 + n3] = cc;
                    u32x2 pk; pk.x = cvt_pk_bf16(cc[0], cc[1]); pk.y = cvt_pk_bf16(cc[2], cc[3]);
                    *(LAS u32x2*)(CTn + (16 * n3 + fr) * 264 + 16 * mtk + 4 * fq) = pk;
                }
            }
        }
        cur ^= 1;
        __syncthreads();
    }
    if (tid0 >= 256) { const int sg = tid0 & 255, s = sg >> 2, g = sg & 3; const u32x4 yv = *(const LAS u32x4*)(Os + s * 40 + 8 * g);
        *(u32x4*)(PM + (tokbase + (size_t)63 * 64 + s) * LDPM + 3072 + h * 256 + dv0 + 8 * g) = yv; }
#undef ML_LOAD
}

__device__ void phase_norm2(const KP& p) {
    const int tid = tid_l(), lane = tid & 63, G = gridDim.x, bid = blockIdx.x;
    rmsnorm_rows(p.out, p.g_ffn, (bf16_t*)(p.ws + OFF_XN2), bid * 8 + (tid >> 6), G * 8, lane);
}
typedef float v16f_t __attribute__((ext_vector_type(16)));
typedef float v32f_t __attribute__((ext_vector_type(32)));
typedef unsigned v6u_t __attribute__((ext_vector_type(6)));
__device__ void convert_tables(const KP& p, int gw, int nw) {
    const int lane = tid_l() & 63;
    for (int tb = 0; tb < 2; ++tb) {
        const float* src = tb ? p.peer_v : p.peer_u; unsigned char* dst = p.ws + (tb ? OFF_PV : OFF_PU); float* sc = (float*)(p.ws + (tb ? OFF_SCV : OFF_SCU));
        for (int row = gw; row < 16384; row += nw) {
            const float* sp = src + (size_t)row * DM + lane * 32;
            f32x4 v[8]; float am = 0.f;
#pragma unroll
            for (int q = 0; q < 8; ++q) { v[q] = *(const f32x4*)(sp + q * 4);
                am = fmaxf(am, fmaxf(fmaxf(fabsf(v[q][0]), fabsf(v[q][1])), fmaxf(fabsf(v[q][2]), fabsf(v[q][3])))); }
            const unsigned amu = wave_max_u32(__float_as_uint(am));
            const float amax = __uint_as_float(amu);
            float scl = 1.f;
            if (amax > 0.f) scl = exp2f(floorf(log2f(7.5f / amax)));
            if (lane == 0) sc[row] = 1.f / scl;
            v16f_t xa, xb;
#pragma unroll
            for (int q = 0; q < 4; ++q)
#pragma unroll
                for (int j = 0; j < 4; ++j) { xa[q * 4 + j] = v[q][j] * scl; xb[q * 4 + j] = v[4 + q][j] * scl; }
            const v6u_t pk = __builtin_amdgcn_cvt_scalef32_2xpk16_fp6_f32(xa, xb, 1.0f);
            unsigned char* dp = dst + (size_t)row * 8192 + lane * 8;
#pragma unroll
            for (int k = 0; k < 3; ++k) { u32x2 o; o.x = pk[2 * k]; o.y = pk[2 * k + 1]; *(u32x2*)(dp + k * 512) = o; }
        }
    }
}

__device__ void phase_peer(const KP& p, LAS unsigned char* lds) {
    const int tid = tid_l(), lane = tid & 63, w = tid >> 6, fr = lane & 15, fq = lane >> 4;
    LAS unsigned* KEYS = (LAS unsigned*)lds;
    LAS int* TI = (LAS int*)(lds + 32768);
    LAS float* TG = (LAS float*)(lds + 49152);
    const bf16_t* Q = (const bf16_t*)(p.ws + OFF_Q);
    const bf16_t* SK = (const bf16_t*)(p.ws + OFF_SUBK);
    const bf16_t* XN2 = (const bf16_t*)(p.ws + OFF_XN2);
    const unsigned char* PU = p.ws + OFF_PU; const unsigned char* PV = p.ws + OFF_PV;
    const float* SCU = (const float*)(p.ws + OFF_SCU); const float* SCV = (const float*)(p.ws + OFF_SCV);
    float* out = p.out;
    LAS int* IJ = (LAS int*)(lds + 65536);
    int ci[4], cj[4]; bool cv[4];
#pragma unroll
    for (int m = 0; m < 4; ++m) { const int e = m * 16 + fr; int i = 0, base = 0;
        for (; i < 16; ++i) { const int cnt = 16 / (i + 1); if (e < base + cnt) break; base += cnt; }
        cv[m] = i < 16; ci[m] = cv[m] ? i : 0; cj[m] = cv[m] ? e - base : 0;
        if (w == 0 && fq == 0) IJ[e] = cv[m] ? ci[m] * 16 + cj[m] : 0; }
    const int pp_ = w >> 2, ntb = (w & 3) * 2;
    __syncthreads();
    LAS float* xs = (LAS float*)(lds + 66048) + w * 2048;
    LAS int* PERM = (LAS int*)(lds + 65792);
    {
        v16f_t ta, tb;
#pragma unroll
        for (int i = 0; i < 16; ++i) { ta[i] = 0.125f * i; tb[i] = (i < 8) ? 2.f + 0.25f * i : 4.f + 0.5f * (i - 8); }
        const v6u_t pk = __builtin_amdgcn_cvt_scalef32_2xpk16_fp6_f32(ta, tb, 1.0f);
        const v32f_t un = __builtin_amdgcn_cvt_scalef32_pk32_f32_fp6(pk, 1.0f);
#pragma unroll
        for (int m = 0; m < 32; ++m) { const float val = un[m]; const float c = val < 2.f ? val * 8.f : (val < 4.f ? 16.f + (val - 2.f) * 4.f : 24.f + (val - 4.f) * 2.f);
            if (tid == 0) PERM[m] = ((int)(c + 0.5f) & 31); }
    }
    __syncthreads();
    for (int tile = blockIdx.x; tile < NT / 32; tile += gridDim.x) {
        const int tk0 = tile * 32;
        bf16x8 bfr[2][4];
#pragma unroll
        for (int n = 0; n < 2; ++n)
#pragma unroll
            for (int ks = 0; ks < 4; ++ks) bfr[n][ks] = *(const bf16x8*)(SK + (size_t)(pp_ * 128 + 16 * (ntb + n) + fr) * 128 + 32 * ks + 8 * fq);
        bf16x8 afn[2][4];
#pragma unroll
        for (int mt = 0; mt < 2; ++mt)
#pragma unroll
            for (int ks = 0; ks < 4; ++ks) afn[mt][ks] = *(const bf16x8*)(Q + (size_t)(tk0 + 16 * mt + fr) * DM + pp_ * 128 + 32 * ks + 8 * fq);
        for (int h = 0; h < 8; ++h) {
            {
                bf16x8 af[2][4];
#pragma unroll
                for (int mt = 0; mt < 2; ++mt)
#pragma unroll
                    for (int ks = 0; ks < 4; ++ks) af[mt][ks] = afn[mt][ks];
                if (h + 1 < 8) {
#pragma unroll
                    for (int mt = 0; mt < 2; ++mt)
#pragma unroll
                        for (int ks = 0; ks < 4; ++ks) afn[mt][ks] = *(const bf16x8*)(Q + (size_t)(tk0 + 16 * mt + fr) * DM + (h + 1) * 256 + pp_ * 128 + 32 * ks + 8 * fq);
                }
                f32x4 acc[2][2];
#pragma unroll
                for (int a_ = 0; a_ < 2; ++a_)
#pragma unroll
                    for (int b_ = 0; b_ < 2; ++b_) acc[a_][b_] = (f32x4){0.f, 0.f, 0.f, 0.f};
#pragma unroll
                for (int ks = 0; ks < 4; ++ks)
#pragma unroll
                    for (int mt = 0; mt < 2; ++mt)
#pragma unroll
                        for (int n = 0; n < 2; ++n) acc[mt][n] = __builtin_amdgcn_mfma_f32_16x16x32_bf16(af[mt][ks], bfr[n][ks], acc[mt][n], 0, 0, 0);
#pragma unroll
                for (int mt = 0; mt < 2; ++mt)
#pragma unroll
                    for (int n = 0; n < 2; ++n)
#pragma unroll
                        for (int j = 0; j < 4; ++j) { const int tokl = 16 * mt + 4 * fq + j, key = 16 * (ntb + n) + fr;
                            KEYS[(tokl * 2 + pp_) * 128 + key] = (ordf(acc[mt][n][j]) & ~0x7Fu) | (unsigned)key; }
            }
            __syncthreads();
            {
                const int tokl = 4 * w + fq, rb = lane & 48;
                unsigned top[2];
#pragma unroll
                for (int pp = 0; pp < 2; ++pp) {
                    unsigned kx[8];
#pragma unroll
                    for (int m = 0; m < 8; ++m) kx[m] = KEYS[(tokl * 2 + pp) * 128 + fr + 16 * m];
                    unsigned tp = 0u;
                    for (int it = 0; it < 16; ++it) {
                        unsigned M = max(max(max(kx[0], kx[1]), max(kx[2], kx[3])), max(max(kx[4], kx[5]), max(kx[6], kx[7])));
                        M = max(M, dppu<0xB1>(M)); M = max(M, dppu<0x4E>(M)); M = max(M, dppu<0x141>(M)); M = max(M, dppu<0x140>(M));
                        if (fr == it) tp = M;
#pragma unroll
                        for (int m = 0; m < 8; ++m) kx[m] = (kx[m] == M) ? 0u : kx[m];
                    }
                    top[pp] = tp;
                }
                unsigned cnd[4];
#pragma unroll
                for (int m = 0; m < 4; ++m) {
                    const float v1 = unordf((unsigned)__shfl((int)top[0], rb + ci[m]) & ~0x7Fu), v2 = unordf((unsigned)__shfl((int)top[1], rb + cj[m]) & ~0x7Fu);
                    cnd[m] = cv[m] ? ((ordf(v1 + v2) & ~0x3Fu) | (unsigned)(m * 16 + fr)) : 0u;
                }
                unsigned best = 0u;
                for (int it = 0; it < 16; ++it) {
                    unsigned M = max(max(cnd[0], cnd[1]), max(cnd[2], cnd[3]));
                    M = max(M, dppu<0xB1>(M)); M = max(M, dppu<0x4E>(M)); M = max(M, dppu<0x141>(M)); M = max(M, dppu<0x140>(M));
                    if (fr == it) best = M;
#pragma unroll
                    for (int m = 0; m < 4; ++m) cnd[m] = (cnd[m] == M) ? 0u : cnd[m];
                }
                const int ij = IJ[best & 0x3Fu];
                const float bv = unordf(best & ~0x3Fu);
                const int e1 = __shfl((int)top[0], rb + (ij >> 4)) & 0x7F, e2 = __shfl((int)top[1], rb + (ij & 15)) & 0x7F;
                const float mx = __shfl(bv, rb);
                const float ev = __expf(bv - mx);
                const float sum = red16(ev);
                TI[tokl * 128 + h * 16 + fr] = e1 * 128 + e2; TG[tokl * 128 + h * 16 + fr] = ev / sum;
            }
            __syncthreads();
        }
        for (int q = 0; q < 4; ++q) {
            const int tokl = 4 * w + q; const size_t tok = (size_t)tk0 + tokl;
#pragma unroll
            for (int i = 0; i < 4; ++i) { const u32x4 x4 = *(const u32x4*)(XN2 + tok * DM + i * 512 + lane * 8);
                *(LAS f32x4*)(xs + i * 512 + lane * 8) = (f32x4){bflo(x4[0]), bfhi(x4[0]), bflo(x4[1]), bfhi(x4[1])}; *(LAS f32x4*)(xs + i * 512 + lane * 8 + 4) = (f32x4){bflo(x4[2]), bfhi(x4[2]), bflo(x4[3]), bfhi(x4[3])}; }
            float xv[32], acc[32];
#pragma unroll
            for (int m = 0; m < 32; ++m) { xv[m] = xs[32 * lane + PERM[m]]; acc[m] = 0.f; }
#define PE_ISSUE(E, e_) do { const int ee_ = (e_) < 128 ? (e_) : 127; const int idx_ = __builtin_amdgcn_readfirstlane(TI[tokl * 128 + ee_]); \
                E.gate = __builtin_bit_cast(float, __builtin_amdgcn_readfirstlane(__builtin_bit_cast(int, TG[tokl * 128 + ee_]))); \
                const unsigned char* up_ = PU + (size_t)idx_ * 8192 + lane * 8; \
                E.u0 = *(const u32x2*)up_; E.u1 = *(const u32x2*)(up_ + 512); E.u2 = *(const u32x2*)(up_ + 1024); \
                E.v0 = *(const u32x2*)(up_ + 2048); E.v1 = *(const u32x2*)(up_ + 2560); E.v2 = *(const u32x2*)(up_ + 3072); \
                E.su = SCU[idx_]; E.sv = SCV[idx_]; } while (0)
#define PE_COMPUTE(E) do { \
                const v32f_t uf = __builtin_amdgcn_cvt_scalef32_pk32_f32_fp6((v6u_t){E.u0.x, E.u0.y, E.u1.x, E.u1.y, E.u2.x, E.u2.y}, 1.0f); \
                float d0 = 0.f, d1 = 0.f, d2 = 0.f, d3 = 0.f; \
                _Pragma("unroll") for (int m = 0; m < 8; ++m) { d0 += xv[4 * m] * uf[4 * m]; d1 += xv[4 * m + 1] * uf[4 * m + 1]; d2 += xv[4 * m + 2] * uf[4 * m + 2]; d3 += xv[4 * m + 3] * uf[4 * m + 3]; } \
                const float act = wave_sum((d0 + d1) + (d2 + d3)) * E.su; \
                const float coef = E.gate * 0.5f * act * (1.f + erff(act * 0.70710678118f)) * E.sv; \
                const v32f_t vf = __builtin_amdgcn_cvt_scalef32_pk32_f32_fp6((v6u_t){E.v0.x, E.v0.y, E.v1.x, E.v1.y, E.v2.x, E.v2.y}, 1.0f); \
                _Pragma("unroll") for (int m = 0; m < 32; ++m) acc[m] += coef * vf[m]; } while (0)
            {
                struct PeEx { u32x2 u0, u1, u2, v0, v1, v2; float su, sv, gate; };
                PeEx q0, q1;
                PE_ISSUE(q0, 0); PE_ISSUE(q1, 1);
#pragma unroll 1
                for (int e = 0; e < 128; e += 2) {
                    PE_COMPUTE(q0); PE_ISSUE(q0, e + 2);
                    PE_COMPUTE(q1); PE_ISSUE(q1, e + 3);
                }
            }
#undef PE_ISSUE
#undef PE_COMPUTE
#pragma unroll
            for (int m = 0; m < 32; ++m) xs[32 * lane + PERM[m]] = acc[m];
            float ss = 0.f;
            float* orow = out + tok * DM;
            f32x4 hv[8];
#pragma unroll
            for (int i = 0; i < 8; ++i) { const f32x4 pa = *(const LAS f32x4*)(xs + i * 256 + lane * 4); const f32x4 h0 = *(const f32x4*)(orow + i * 256 + lane * 4);
                hv[i] = pa + h0; ss += hv[i][0] * hv[i][0] + hv[i][1] * hv[i][1] + hv[i][2] * hv[i][2] + hv[i][3] * hv[i][3]; }
            ss = wave_sum(ss);
            const float r = rsqrtf(ss * (1.f / DM) + 1e-6f);
#pragma unroll
            for (int i = 0; i < 8; ++i) { const f32x4 g0 = *(const f32x4*)(p.g_final + i * 256 + lane * 4); *(f32x4*)(orow + i * 256 + lane * 4) = hv[i] * r * g0; }
        }
        __syncthreads();
    }
}

#define XB_TMO      128
#define XB_XCNT(j)  (256  + 64 * (j))
#define XB_XSUB(j)  (1280 + 64 * (j))
#define XB_XGEN(j)  (2304 + 64 * (j))
#define XB_TOP      3328
#define XB_TOPGEN   3392
#define XB_SPIN_CAP (1u << 18)
__device__ __forceinline__ unsigned xb_ld(unsigned* p)              { return __hip_atomic_load(p, __ATOMIC_RELAXED, __HIP_MEMORY_SCOPE_AGENT); }
__device__ __forceinline__ unsigned xb_add(unsigned* p, unsigned v) { return __hip_atomic_fetch_add(p, v, __ATOMIC_RELAXED, __HIP_MEMORY_SCOPE_AGENT); }
__device__ __forceinline__ unsigned xb_xcc_id() { return (unsigned)__builtin_amdgcn_s_getreg((3 << 11) | 20) & 0xFu; }
#define XB_SPIN(cond, bar) do { unsigned _sp = 0; while (cond) { __builtin_amdgcn_s_sleep(1); \
    if ((++_sp & 255u) == 0u) { if (xb_ld(&(bar)[XB_TMO])) break; if (_sp > XB_SPIN_CAP) { atomicAdd(&(bar)[XB_TMO], 1u); break; } } } } while (0)
struct XcdBarrier { unsigned* bar; unsigned x; volatile LAS unsigned* st; };
__device__ __forceinline__ XcdBarrier xcd_barrier_post(unsigned* bar, volatile LAS unsigned* st) {
    XcdBarrier b; b.bar = bar; b.x = xb_xcc_id(); b.st = st;
    if (threadIdx.x == 0) (void)xb_add(&bar[XB_XCNT(b.x)], 1u);
    return b;
}
__device__ __forceinline__ void xcd_barrier_complete(unsigned* bar, unsigned x, unsigned& nloc, unsigned& nx) {
    const unsigned G = gridDim.x * gridDim.y * gridDim.z;
    unsigned sum, cnt, mine, sp = 0u;
    for (;;) {
        sum = 0u; cnt = 0u; mine = 0u;
#pragma unroll
        for (unsigned j = 0; j < 16; ++j) { const unsigned c = xb_ld(&bar[XB_XCNT(j)]); sum += c; cnt += (c > 0u) ? 1u : 0u; mine = (j == x) ? c : mine; }
        if (sum == G) break;
        __builtin_amdgcn_s_sleep(1);
        if ((++sp & 255u) == 0u) { if (xb_ld(&bar[XB_TMO])) break; if (sp > XB_SPIN_CAP) { atomicAdd(&bar[XB_TMO], 1u); break; } }
    }
    nloc = mine > 0u ? mine : 1u; nx = cnt > 0u ? cnt : 1u;
}
__device__ __forceinline__ void xcd_barrier(const XcdBarrier& b) {
    asm volatile("s_waitcnt vmcnt(0)" ::: "memory");
    __syncthreads();
    if (threadIdx.x == 0) {
        unsigned* bar = b.bar;
        __builtin_amdgcn_s_waitcnt(0);
        unsigned nloc = b.st[0], nx = b.st[1];
        if (nloc == 0u) { xcd_barrier_complete(bar, b.x, nloc, nx); b.st[0] = nloc; b.st[1] = nx; }
        const unsigned old = xb_add(&bar[XB_XSUB(b.x)], 1u);
        const unsigned gen = old / nloc;
        if (old + 1u == (gen + 1u) * nloc) {
            __builtin_amdgcn_fence(__ATOMIC_RELEASE, "agent");
            asm volatile("s_waitcnt vmcnt(0)" ::: "memory");
            const unsigned og = xb_add(&bar[XB_TOP], 1u);
            const unsigned tg = og / nx;
            if (og + 1u == (tg + 1u) * nx) xb_add(&bar[XB_TOPGEN], 1u);
            else XB_SPIN(xb_ld(&bar[XB_TOPGEN]) == tg, bar);
            __builtin_amdgcn_fence(__ATOMIC_ACQUIRE, "agent");
            xb_add(&bar[XB_XGEN(b.x)], 1u);
            asm volatile("s_waitcnt vmcnt(0)" ::: "memory");
        } else {
            XB_SPIN(xb_ld(&bar[XB_XGEN(b.x)]) == gen, bar);
            __builtin_amdgcn_fence(__ATOMIC_ACQUIRE, "agent");
            asm volatile("s_waitcnt vmcnt(0)" ::: "memory");
        }
    }
    __syncthreads();
}

__global__ void __launch_bounds__(512) fwd_megakernel(KP p) {
    extern __shared__ __attribute__((aligned(16))) unsigned char smem[];
    LAS unsigned char* lds = (LAS unsigned char*)smem;
    cg::grid_group grid = cg::this_grid();
#define GRID_SYNC() do { asm volatile("s_waitcnt vmcnt(0) lgkmcnt(0)" ::: "memory"); __syncthreads(); grid.sync(); asm volatile("" ::: "memory"); } while (0)
    const int G = gridDim.x, bid = blockIdx.x;
    unsigned char* ws = p.ws; unsigned char* dob = (unsigned char*)p.out;

#define RUN_GEMM(MODE, ...) do { unsigned char* ws = lp(p.ws); unsigned char* dob = lp((unsigned char*)p.out); const pg8::Gemm g_ = pg8::Gemm{__VA_ARGS__}; pg8::StaticOrder S_; S_.init(g_.M, g_.N, G, bid); \
        const pg8::Epi<MODE> E_{ws, dob, p.x, p.w0, p.a0}; pg8::gemm_phase(lds, g_, S_, E_); } while (0)
    volatile LAS unsigned* xst = (volatile LAS unsigned*)(lds + 150512);
    if (threadIdx.x < 4) xst[threadIdx.x] = 0u;
    phase_prep(p, lds);
    GRID_SYNC();
    const XcdBarrier xbar = xcd_barrier_post((unsigned*)(p.ws + OFF_XBAR), xst);
#define XSYNC() do { xcd_barrier(xbar); asm volatile("" ::: "memory"); } while (0)
    RUN_GEMM(0, (const bf16_t*)(ws + OFF_XN), (const bf16_t*)(ws + OFF_WINT), NT, N1, 2048, 2048, 2048);
    XSYNC();
    phase_lora_prep(p);
    XSYNC();
    RUN_GEMM(1, (const bf16_t*)(dob + DO_ALORA), (const bf16_t*)(ws + OFF_WAT), NT, 2048, 256, 512, 256);
    RUN_GEMM(2, (const bf16_t*)(dob + DO_ALORA) + 256, (const bf16_t*)(ws + OFF_G2T), NT, 1024, 256, 512, 256);
    XSYNC();
    if (bid < 128) rwkv_scan(p, bid, lds);
    else {
        mlstm_run(p, bid - 128, lds);
        convert_tables(p, (bid - 128) * 8 + (tid_l() >> 6), 1024);
        __builtin_amdgcn_fence(__ATOMIC_RELEASE, "agent"); __syncthreads();
        if (threadIdx.x == 0) { unsigned* cnt = (unsigned*)(p.ws + OFF_SUBBAR); __hip_atomic_fetch_add(cnt, 1u, __ATOMIC_RELAXED, __HIP_MEMORY_SCOPE_AGENT);
            while (__hip_atomic_load(cnt, __ATOMIC_RELAXED, __HIP_MEMORY_SCOPE_AGENT) < 128u) __builtin_amdgcn_s_sleep(2); }
        __syncthreads(); __builtin_amdgcn_fence(__ATOMIC_ACQUIRE, "agent");
        { unsigned char* ws = lp(p.ws); unsigned char* dob = lp((unsigned char*)p.out); const pg8::Gemm g_ = pg8::Gemm{(const bf16_t*)(ws + OFF_PM) + 3072, (const bf16_t*)(ws + OFF_PMT), NT, 2048, 1024, LDPM, 1024};
          pg8::StaticOrder S_; S_.init(g_.M, g_.N, 128, bid - 128); const pg8::Epi<3> E_{ws, dob, p.x, p.w0, p.a0}; pg8::gemm_phase(lds, g_, S_, E_); }
    }
    XSYNC();
    phase_rwkv_post(p);
    XSYNC();
    RUN_GEMM(4, (const bf16_t*)(ws + OFF_YR), (const bf16_t*)(ws + OFF_PRT), NT, 2048, 1024, 1024, 1024);
    XSYNC();
    RUN_GEMM(5, (const bf16_t*)(ws + OFF_PG), (const bf16_t*)(ws + OFF_WOT), NT, 2048, 2048, LDPG, 2048);
    XSYNC();
    phase_norm2(p);
    XSYNC();
    RUN_GEMM(6, (const bf16_t*)(ws + OFF_XN2), (const bf16_t*)(ws + OFF_WQT), NT, 2048, 2048, 2048, 2048);
    XSYNC();
    phase_peer(p, lds);
}

extern "C" void kernel_launch(void* const* d_in, const int* in_sizes, int n_in, void* d_out, int out_size, void* d_ws, size_t ws_size, hipStream_t stream) {
    static int grid_blocks = 0;
    if (grid_blocks == 0) {
        if (n_in != 26 || out_size != NT * DM || ws_size < WS_NEED) { fprintf(stderr, "kernel_launch: unexpected shapes: n_in %d out %d ws %zu (need %zu)\n", n_in, out_size, ws_size, (size_t)WS_NEED); grid_blocks = -1; return; }
        int dev = 0, cus = 0, per_cu = 0;
        hipGetDevice(&dev);
        hipDeviceGetAttribute(&cus, hipDeviceAttributeMultiprocessorCount, dev);
        if (hipFuncSetAttribute((const void*)fwd_megakernel, hipFuncAttributeMaxDynamicSharedMemorySize, LDS_BYTES) != hipSuccess) { fprintf(stderr, "kernel_launch: hipFuncSetAttribute failed\n"); grid_blocks = -1; return; }
        hipOccupancyMaxActiveBlocksPerMultiprocessor(&per_cu, (const void*)fwd_megakernel, 512, LDS_BYTES);
        if (per_cu < 1) { fprintf(stderr, "kernel_launch: occupancy query says %d blocks per CU\n", per_cu); per_cu = 1; }
        (void)hipGetLastError();
        grid_blocks = cus * 1;
    }
    if (grid_blocks < 0) return;
    KP p{};
    const float** pp = (const float**)&p;
    for (int i = 0; i < 26; ++i) pp[i] = (const float*)d_in[i];
    p.out = (float*)d_out; p.ws = (unsigned char*)d_ws;
    void* args[] = {&p};
    hipError_t e = hipLaunchCooperativeKernel((void*)fwd_megakernel, dim3(grid_blocks), dim3(512), args, LDS_BYTES, stream);
    if (e != hipSuccess) fprintf(stderr, "cooperative launch failed: %s (grid %d)\n", hipGetErrorString(e), grid_blocks);
}
```

```cpp
#include <hip/hip_runtime.h>
#include <hip/hip_cooperative_groups.h>
#include <cstdio>
namespace cg = cooperative_groups;

#define LAS __attribute__((address_space(3)))
typedef unsigned short bf16_t;
typedef short bf16x8 __attribute__((ext_vector_type(8)));
typedef float f32x4 __attribute__((ext_vector_type(4)));
typedef unsigned u32x4 __attribute__((ext_vector_type(4)));
typedef unsigned u32x2 __attribute__((ext_vector_type(2)));

constexpr int NT = 16384, SEQ = 4096, DM = 2048;
constexpr int LDPM = 4096, LDPR = 3584, LDPG = 4096, N1 = 11776;
constexpr size_t MiB = 1024ull * 1024ull;
constexpr size_t OFF_PM = 0, OFF_PR = 128 * MiB, OFF_PG = 240 * MiB, OFF_XN = 368 * MiB, OFF_WINT = 432 * MiB, OFF_WTS = 478 * MiB;
constexpr size_t OFF_PMT = OFF_WTS, OFF_PRT = OFF_WTS + 4 * MiB, OFF_WOT = OFF_WTS + 8 * MiB, OFF_WQT = OFF_WTS + 16 * MiB, OFF_WAT = OFF_WTS + 24 * MiB,
                 OFF_G2T = OFF_WTS + 25 * MiB, OFF_SUBK = OFF_WTS + 25 * MiB + 512 * 1024, WS_NEED = OFF_WTS + 26 * MiB;
constexpr size_t OFF_QC = OFF_XN, OFF_KC = OFF_XN + 32 * MiB, OFF_YR = OFF_WINT, OFF_Q = OFF_XN, OFF_XN2 = OFF_PR, OFF_PU = OFF_PM, OFF_PV = OFF_PM + 2048, OFF_SUBBAR = OFF_SUBK + 192 * 1024, OFF_XBAR = OFF_SUBBAR + 256,
                 OFF_SCU = OFF_SUBK + 64 * 1024, OFF_SCV = OFF_SCU + 64 * 1024;
constexpr size_t DO_WLOG = 0, DO_AG = 32 * MiB, DO_GG = 64 * MiB, DO_ALORA = 96 * MiB, DO_GB = 112 * MiB, DO_GA = DO_GB + 256 * 1024, DO_GW = DO_GA + 256 * 1024;
constexpr int LDS_BYTES = 150528;
#define XCD_BAR_WORDS 3456

struct KP {
    const float *x, *g_mix, *w_in, *conv_w, *b_i, *b_f, *mu, *w0, *w2, *a0, *a2, *g2, *k_k, *k_a, *r_k, *ln_w, *ln_b, *proj_m, *proj_r, *w_out, *g_ffn,
        *w_query, *sub_keys, *peer_u, *peer_v, *g_final;
    float* out; unsigned char* ws;
};

typedef __bf16 bf16x2_t __attribute__((ext_vector_type(2)));
typedef float f32x2_t __attribute__((ext_vector_type(2)));
__device__ __forceinline__ unsigned cvt_pk_bf16(float lo, float hi) { f32x2_t v = {lo, hi}; bf16x2_t b = __builtin_convertvector(v, bf16x2_t); return __builtin_bit_cast(unsigned, b); }
__device__ __forceinline__ bf16_t f2bf(float f) { return (bf16_t)(cvt_pk_bf16(f, 0.f) & 0xffffu); }
__device__ __forceinline__ float bf2f(bf16_t h) { return __uint_as_float((unsigned)h << 16); }
__device__ __forceinline__ float bflo(unsigned u) { return __uint_as_float(u << 16); }
__device__ __forceinline__ float bfhi(unsigned u) { return __uint_as_float(u & 0xffff0000u); }
__device__ __forceinline__ float sigm(float x) { return __builtin_amdgcn_rcpf(1.f + __expf(-x)); }
template <int CTRL> __device__ __forceinline__ float dppf(float v) { return __builtin_bit_cast(float, __builtin_amdgcn_update_dpp(0, __builtin_bit_cast(int, v), CTRL, 0xF, 0xF, true)); }
template <int CTRL> __device__ __forceinline__ unsigned dppu(unsigned v) { return (unsigned)__builtin_amdgcn_update_dpp(0, (int)v, CTRL, 0xF, 0xF, true); }
__device__ __forceinline__ float red4(float v) { v += dppf<0xB1>(v); v += dppf<0x4E>(v); return v; }
__device__ __forceinline__ float red8(float v) { v = red4(v); v += dppf<0x141>(v); return v; }
__device__ __forceinline__ float red16(float v) { v = red8(v); v += dppf<0x140>(v); return v; }
__device__ __forceinline__ float rlane(float v, int l) { return __builtin_bit_cast(float, __builtin_amdgcn_readlane(__builtin_bit_cast(int, v), l)); }
__device__ __forceinline__ float wave_sum(float v) { v = red16(v); return rlane(v, 0) + rlane(v, 16) + rlane(v, 32) + rlane(v, 48); }
__device__ __forceinline__ unsigned wave_max_u32(unsigned v) {
    v = max(v, dppu<0xB1>(v)); v = max(v, dppu<0x4E>(v)); v = max(v, dppu<0x141>(v)); v = max(v, dppu<0x140>(v));
    unsigned a = (unsigned)__builtin_amdgcn_readlane((int)v, 0), b = (unsigned)__builtin_amdgcn_readlane((int)v, 16), c = (unsigned)__builtin_amdgcn_readlane((int)v, 32), d = (unsigned)__builtin_amdgcn_readlane((int)v, 48);
    return max(max(a, b), max(c, d));
}
__device__ __forceinline__ unsigned ordf(float f) { unsigned u = __float_as_uint(f); return (u & 0x80000000u) ? ~u : (u | 0x80000000u); }
__device__ __forceinline__ float unordf(unsigned k) { return __uint_as_float((k & 0x80000000u) ? (k ^ 0x80000000u) : ~k); }

__device__ __forceinline__ int tid_l() { int t = threadIdx.x; asm volatile("" : "+v"(t)); return t; }
template <class T> __device__ __forceinline__ T* lp(T* q) { asm volatile("" : "+s"(q)); return q; }
namespace pg8 {
constexpr int BM = 256, BK = 64, HALF = 128, HTB = HALF * BK * 2, STAGE_BYTES = 8 * HTB, NXCD = 8, WGM = 8;
__device__ __forceinline__ int lds_byte(int r, int c) { const int st = (r >> 4) * 2 + (c >> 5), rr = r & 15, cc = c & 31, ob = rr * 64 + cc * 2; return st * 1024 + (ob ^ (((ob >> 9) & 1) << 5)); }
__device__ __forceinline__ void stage_rc(int b, int& R, int& C) { const int st = b / 1024, sb = b % 1024, swz = sb ^ (((sb >> 9) & 1) << 5); R = (st >> 1) * 16 + swz / 64; C = (st & 1) * 32 + (swz % 64) / 2; }
__device__ __forceinline__ int perm32(int rho) { const int n = rho >> 4, i = rho & 15; return 8 * (i >> 2) + 4 * n + (i & 3); }
struct Unit { int pm, pn; };
struct Gemm { const bf16_t* A; const bf16_t* Bt; int M, N, K, lda, ldb; };
struct StaticOrder {
    int nM, nN, nwg, G, c;
    __device__ void init(int M, int N, int G_, int c_) { nM = M / BM; nN = N / BM; nwg = nM * nN; G = G_; c = c_; }
    __device__ bool next(int i, Unit& u) const {
        const long L = (long)i * G + c; if (L >= nwg) return false;
        int wgid = (int)L; { const int q = nwg / NXCD, r = nwg % NXCD, xcd = wgid % NXCD, off = wgid / NXCD; wgid = (xcd < r ? xcd * (q + 1) : r * (q + 1) + (xcd - r) * q) + off; }
        const int nig = WGM * nN, gid = wgid / nig, fm = gid * WGM, gsz = (nM - fm) < WGM ? (nM - fm) : WGM;
        u.pm = fm + ((wgid % nig) % gsz); u.pn = (wgid % nig) / gsz; return true;
    }
};

__device__ __forceinline__ void store8(bf16_t* p, f32x4 v0, f32x4 v1) {
    u32x4 w; w.x = cvt_pk_bf16(v0[0], v0[1]); w.y = cvt_pk_bf16(v0[2], v0[3]); w.z = cvt_pk_bf16(v1[0], v1[1]); w.w = cvt_pk_bf16(v1[2], v1[3]); *(u32x4*)p = w;
}
__device__ __forceinline__ void load8(const bf16_t* p, f32x4& v0, f32x4& v1) {
    const u32x4 w = *(const u32x4*)p; v0 = (f32x4){bflo(w.x), bfhi(w.x), bflo(w.y), bfhi(w.y)}; v1 = (f32x4){bflo(w.z), bfhi(w.z), bflo(w.w), bfhi(w.w)};
}

template <int mode> struct Epi {
    static constexpr bool PERM = true;
    unsigned char* ws; unsigned char* dob; const float* x; const float* w0; const float* a0;
    __device__ __forceinline__ void operator()(const f32x4 (&acc)[2][2][4][2], const Unit& u, int wr, int wc, int fr, int fq) const {
        const int row0 = u.pm * BM + wr * 64 + fr, cb = u.pn * BM + wc * 32 + 8 * fq;
#pragma unroll
        for (int ai = 0; ai < 2; ++ai)
#pragma unroll
            for (int m = 0; m < 4; ++m) {
                const size_t row = (size_t)(row0 + ai * HALF + m * 16);
#pragma unroll
                for (int bj = 0; bj < 2; ++bj) {
                    const int col = cb + bj * HALF;
                    f32x4 v0 = acc[ai][bj][m][0], v1 = acc[ai][bj][m][1];
                    if (mode == 0) {
                        if (col < 4096) store8((bf16_t*)(ws + OFF_PM) + row * LDPM + col, v0, v1);
                        else if (col < 7680) store8((bf16_t*)(ws + OFF_PR) + row * LDPR + (col - 4096), v0, v1);
                        else {
#pragma unroll
                            for (int j = 0; j < 4; ++j) { v0[j] = sigm(v0[j]); v1[j] = sigm(v1[j]); }
                            store8((bf16_t*)(ws + OFF_PG) + row * LDPG + (col - 7680), v0, v1);
                        }
                    } else if (mode == 1) {
                        if (col < 1024) {
                            const f32x4 b0 = *(const f32x4*)(w0 + col), b1 = *(const f32x4*)(w0 + col + 4);
#pragma unroll
                            for (int j = 0; j < 4; ++j) {
                                float z = -(b0[j] + v0[j]); float sp = fmaxf(z, 0.f) + __logf(1.f + __expf(-fabsf(z))); v0[j] = -__expf(-sp - 0.5f);
                                z = -(b1[j] + v1[j]); sp = fmaxf(z, 0.f) + __logf(1.f + __expf(-fabsf(z))); v1[j] = -__expf(-sp - 0.5f);
                            }
                            store8((bf16_t*)(dob + DO_WLOG) + row * 1024 + col, v0, v1);
                        } else {
                            const int c2 = col - 1024;
                            const f32x4 b0 = *(const f32x4*)(a0 + c2), b1 = *(const f32x4*)(a0 + c2 + 4);
#pragma unroll
                            for (int j = 0; j < 4; ++j) { v0[j] = sigm(b0[j] + v0[j]); v1[j] = sigm(b1[j] + v1[j]); }
                            store8((bf16_t*)(dob + DO_AG) + row * 1024 + c2, v0, v1);
                        }
                    } else if (mode == 2) {
                        store8((bf16_t*)(dob + DO_GG) + row * 1024 + col, v0, v1);
                    } else if (mode == 3) {
                        bf16_t* pp = (bf16_t*)(ws + OFF_PG) + row * LDPG + col; f32x4 g0, g1; load8(pp, g0, g1);
                        store8(pp, g0 * v0, g1 * v1);
                    } else if (mode == 4) {
                        bf16_t* pp = (bf16_t*)(ws + OFF_PG) + row * LDPG + col; f32x4 m0, m1, g0, g1; load8(pp, m0, m1); load8(pp + 2048, g0, g1);
                        store8(pp, m0 + g0 * v0, m1 + g1 * v1);
                    } else if (mode == 5) {
                        const float* xp = x + row * DM + col; float* op = (float*)dob + row * DM + col;
                        const f32x4 x0 = *(const f32x4*)xp, x1 = *(const f32x4*)(xp + 4);
                        *(f32x4*)op = x0 + v0; *(f32x4*)(op + 4) = x1 + v1;
                    } else {
                        store8((bf16_t*)(ws + OFF_Q) + row * DM + col, v0, v1);
                    }
                    asm volatile("" ::: "memory");
                }
            }
    }
};

template <class EpiT> __device__ __forceinline__ void gemm_phase(LAS unsigned char* lds, const Gemm g, const StaticOrder& S, const EpiT& E) {
    const int tid = tid_l(), wid = __builtin_amdgcn_readfirstlane(tid >> 6), lane = tid & 63, wr = wid >> 2, wc = wid & 3, fr = lane & 15, fq = lane >> 4;
    const int K = g.K, nt = K / BK;
    unsigned voffA[2], voffB[2];
#pragma unroll
    for (int i = 0; i < 2; ++i) { int R, C; stage_rc(tid * 16 + i * 8192, R, C); const int Rb = (R & ~31) + perm32(R & 31);
        voffA[i] = (unsigned)(R * g.lda + C) * 2u; voffB[i] = (unsigned)(Rb * g.ldb + C) * 2u; }
    const size_t kstep = (size_t)(BK * 2);
    const size_t hstepA = (size_t)HALF * g.lda * 2, hstepB = (size_t)HALF * g.ldb * 2;
    const size_t tstepA = 2 * hstepA, tstepB = 2 * hstepB;
    const unsigned ldsw = (unsigned)wid * 1024u;
    const int aoff = lds_byte(wr * 64 + fr, fq * 8), boff = lds_byte(wc * 32 + fr, fq * 8);
#define PG8_SA(b, h) (((b) * 2 + (h)) * HTB)
#define PG8_SB(b, h) ((4 + (b) * 2 + (h)) * HTB)
#define PG8_STAGE(bufoff, gbase, voff) do { _Pragma("unroll") for (int _i = 0; _i < 2; ++_i) \
        __builtin_amdgcn_global_load_lds((const unsigned*)((const char*)(gbase) + (voff)[_i]), (LAS unsigned*)(lds + (bufoff) + ldsw + _i * 8192), 16, 0, 0); } while (0)
#define PG8_LDA(dst, b, h) do { _Pragma("unroll") for (int m = 0; m < 4; ++m) _Pragma("unroll") for (int k = 0; k < 2; ++k) dst[m][k] = *(const LAS bf16x8*)(lds + PG8_SA(b, h) + aoff + m * 2048 + k * 1024); } while (0)
#define PG8_LDB(dst, b, h) do { _Pragma("unroll") for (int n = 0; n < 2; ++n) _Pragma("unroll") for (int k = 0; k < 2; ++k) dst[n][k] = *(const LAS bf16x8*)(lds + PG8_SB(b, h) + boff + n * 2048 + k * 1024); } while (0)
#define PG8_MMA(ai, bj, At, Bt) do { __builtin_amdgcn_s_setprio(1); _Pragma("unroll") for (int m = 0; m < 4; ++m) _Pragma("unroll") for (int n = 0; n < 2; ++n) _Pragma("unroll") for (int k = 0; k < 2; ++k) \
        acc[ai][bj][m][n] = __builtin_amdgcn_mfma_f32_16x16x32_bf16(Bt[n][k], At[m][k], acc[ai][bj][m][n], 0, 0, 0); __builtin_amdgcn_s_setprio(0); } while (0)
#define PG8_WAIT_V(n) asm volatile("s_waitcnt vmcnt(" #n ")" ::: "memory")
#define PG8_WAIT_L(n) asm volatile("s_waitcnt lgkmcnt(" #n ")" ::: "memory")
#define PG8_BAR __builtin_amdgcn_s_barrier()
#define PG8_SCHED __builtin_amdgcn_sched_barrier(0)
    Unit cur, nxt; int ui = 0;
    if (!S.next(0, cur)) return;
    f32x4 acc[2][2][4][2];
#pragma unroll
    for (int a = 0; a < 2; ++a)
#pragma unroll
        for (int b = 0; b < 2; ++b)
#pragma unroll
            for (int m = 0; m < 4; ++m)
#pragma unroll
                for (int n = 0; n < 2; ++n) acc[a][b][m][n] = (f32x4){0.f, 0.f, 0.f, 0.f};
    bf16x8 At[4][2], B0[2][2], B1[2][2];
    const char* cA = (const char*)g.A + (size_t)cur.pm * tstepA; const char* cB = (const char*)g.Bt + (size_t)cur.pn * tstepB;
    PG8_STAGE(PG8_SB(0, 0), cB, voffB); PG8_STAGE(PG8_SA(0, 0), cA, voffA); PG8_STAGE(PG8_SB(0, 1), cB + hstepB, voffB); PG8_STAGE(PG8_SA(0, 1), cA + hstepA, voffA);
    if (wr == 1) PG8_BAR;
    PG8_WAIT_V(4); PG8_BAR;
    PG8_STAGE(PG8_SB(1, 0), cB + kstep, voffB); PG8_STAGE(PG8_SA(1, 0), cA + kstep, voffA); PG8_STAGE(PG8_SB(1, 1), cB + hstepB + kstep, voffB);
    PG8_WAIT_V(6); PG8_BAR;
    for (;;) {
        const bool has_next = S.next(ui + 1, nxt);
        const char* nA = has_next ? (const char*)g.A + (size_t)nxt.pm * tstepA : cA; const char* nB = has_next ? (const char*)g.Bt + (size_t)nxt.pn * tstepB : cB;
        for (int t = 0; t < nt; t += 2) {
            const bool last = (t == nt - 2);
            const char* a1 = cA + (size_t)(t + 1) * kstep;
            const char* a2 = last ? nA : cA + (size_t)(t + 2) * kstep; const char* b2 = last ? nB : cB + (size_t)(t + 2) * kstep;
            const char* a3 = a2 + kstep; const char* b3 = b2 + kstep;
            PG8_LDB(B0, 0, 0); PG8_SCHED; PG8_LDA(At, 0, 0); PG8_STAGE(PG8_SA(1, 1), a1 + hstepA, voffA);
            PG8_WAIT_L(8); PG8_BAR; PG8_WAIT_L(0); PG8_MMA(0, 0, At, B0); PG8_BAR; PG8_SCHED;
            PG8_LDB(B1, 0, 1); PG8_STAGE(PG8_SB(0, 0), b2, voffB);
            PG8_BAR; PG8_WAIT_L(0); PG8_MMA(0, 1, At, B1); PG8_BAR;
            PG8_LDA(At, 0, 1); PG8_STAGE(PG8_SA(0, 0), a2, voffA);
            PG8_BAR; PG8_WAIT_L(0); PG8_MMA(1, 0, At, B0); PG8_BAR; PG8_SCHED;
            PG8_STAGE(PG8_SB(0, 1), b2 + hstepB, voffB);
            PG8_WAIT_V(6); PG8_BAR; PG8_MMA(1, 1, At, B1); PG8_BAR;
            PG8_LDB(B0, 1, 0); PG8_SCHED; PG8_LDA(At, 1, 0); PG8_STAGE(PG8_SA(0, 1), a2 + hstepA, voffA);
            PG8_WAIT_L(8); PG8_BAR; PG8_WAIT_L(0); PG8_MMA(0, 0, At, B0); PG8_BAR; PG8_SCHED;
            PG8_LDB(B1, 1, 1); PG8_STAGE(PG8_SB(1, 0), b3, voffB);
            PG8_BAR; PG8_WAIT_L(0); PG8_MMA(0, 1, At, B1); PG8_BAR;
            PG8_LDA(At, 1, 1); PG8_STAGE(PG8_SA(1, 0), a3, voffA);
            PG8_BAR; PG8_WAIT_L(0); PG8_MMA(1, 0, At, B0); PG8_BAR; PG8_SCHED;
            PG8_STAGE(PG8_SB(1, 1), b3 + hstepB, voffB);
            PG8_WAIT_V(6); PG8_BAR; PG8_MMA(1, 1, At, B1); PG8_BAR;
        }
        E(acc, cur, wr, wc, fr, fq);
        if (!has_next) break;
#pragma unroll
        for (int a = 0; a < 2; ++a)
#pragma unroll
            for (int b = 0; b < 2; ++b)
#pragma unroll
                for (int m = 0; m < 4; ++m)
#pragma unroll
                    for (int n = 0; n < 2; ++n) acc[a][b][m][n] = (f32x4){0.f, 0.f, 0.f, 0.f};
        cur = nxt; cA = nA; cB = nB; ++ui;
    }
    PG8_WAIT_V(0);
    if (wr == 0) PG8_BAR;
    PG8_BAR;
#undef PG8_SA
#undef PG8_SB
#undef PG8_STAGE
#undef PG8_LDA
#undef PG8_LDB
#undef PG8_MMA
#undef PG8_WAIT_V
#undef PG8_WAIT_L
#undef PG8_BAR
#undef PG8_SCHED
}
}

__device__ __forceinline__ void rmsnorm_rows(const float* src, const float* gain, bf16_t* dst, int gw, int nw, int lane) {
    for (int row = gw; row < NT; row += nw) {
        const f32x4* s = (const f32x4*)(src + (size_t)row * DM);
        f32x4 v[8]; float ss = 0.f;
#pragma unroll
        for (int i = 0; i < 8; ++i) { v[i] = s[i * 64 + lane]; ss += v[i][0] * v[i][0] + v[i][1] * v[i][1] + v[i][2] * v[i][2] + v[i][3] * v[i][3]; }
        ss = wave_sum(ss);
        const float r = rsqrtf(ss * (1.f / DM) + 1e-6f);
        u32x2* d = (u32x2*)(dst + (size_t)row * DM);
#pragma unroll
        for (int i = 0; i < 8; ++i) { const f32x4 gg = ((const f32x4*)gain)[i * 64 + lane]; u32x2 o; o.x = cvt_pk_bf16(v[i][0] * r * gg[0], v[i][1] * r * gg[1]); o.y = cvt_pk_bf16(v[i][2] * r * gg[2], v[i][3] * r * gg[3]); d[i * 64 + lane] = o; }
    }
}

__device__ __forceinline__ void tr_tile(const float* src, int ld, int c0, int nvalid, int k0, bf16_t* dst, int ldd, int r0, int kd0, LAS float* tile, int lane) {
    f32x4 v[16];
    const int c4 = (lane & 15) * 4, kb = lane >> 4;
#pragma unroll
    for (int i = 0; i < 16; ++i) { v[i] = (f32x4){0.f, 0.f, 0.f, 0.f}; if (c4 < nvalid) v[i] = *(const f32x4*)(src + (size_t)(k0 + kb + 4 * i) * ld + c0 + c4); }
#pragma unroll
    for (int i = 0; i < 16; ++i) { const int k = kb + 4 * i; tile[k * 65 + c4] = v[i][0]; tile[k * 65 + c4 + 1] = v[i][1]; tile[k * 65 + c4 + 2] = v[i][2]; tile[k * 65 + c4 + 3] = v[i][3]; }
#pragma unroll
    for (int i = 0; i < 8; ++i) {
        const int c = (lane >> 3) + 8 * i, k8 = (lane & 7) * 8;
        float f[8];
#pragma unroll
        for (int j = 0; j < 8; ++j) f[j] = tile[(k8 + j) * 65 + c];
        u32x4 w; w.x = cvt_pk_bf16(f[0], f[1]); w.y = cvt_pk_bf16(f[2], f[3]); w.z = cvt_pk_bf16(f[4], f[5]); w.w = cvt_pk_bf16(f[6], f[7]);
        *(u32x4*)(dst + (size_t)(r0 + c) * ldd + kd0 + k8) = w;
    }
}

__device__ void phase_prep(const KP& p, LAS unsigned char* lds) {
    const int tid = tid_l(), lane = tid & 63, G = gridDim.x, bid = blockIdx.x;
    unsigned char* ws = p.ws;
    rmsnorm_rows(p.x, p.g_mix, (bf16_t*)(ws + OFF_XN), bid * 8 + (tid >> 6), G * 8, lane);
    LAS float* tile = (LAS float*)lds + (tid >> 6) * (64 * 65 + 16);
    for (int j = bid * 8 + (tid >> 6); j < 8960; j += G * 8) {
        const float* src; bf16_t* dst; int ld = 2048, ldd, c0, nv = 64, rt, kt;
        if (j < 5888) { rt = j >> 5; kt = j & 31; src = p.w_in; ld = 11720; dst = (bf16_t*)(ws + OFF_WINT); ldd = 2048;
            if (rt < 64) c0 = 64 * rt; else if (rt < 119) c0 = 4104 + 64 * (rt - 64); else if (rt == 119) { c0 = 4096; nv = 8; } else c0 = 7624 + 64 * (rt - 120); }
        else if (j < 6400) { const int q = j - 5888; rt = q >> 4; kt = q & 15; src = p.proj_m; dst = (bf16_t*)(ws + OFF_PMT); ldd = 1024; c0 = rt * 64; }
        else if (j < 6912) { const int q = j - 6400; rt = q >> 4; kt = q & 15; src = p.proj_r; dst = (bf16_t*)(ws + OFF_PRT); ldd = 1024; c0 = rt * 64; }
        else if (j < 7936) { const int q = j - 6912; rt = q >> 5; kt = q & 31; src = p.w_out; dst = (bf16_t*)(ws + OFF_WOT); ldd = 2048; c0 = rt * 64; }
        else { const int q = j - 7936; rt = q >> 5; kt = q & 31; src = p.w_query; dst = (bf16_t*)(ws + OFF_WQT); ldd = 2048; c0 = rt * 64; }
        tr_tile(src, ld, c0, nv, kt * 64, dst, ldd, rt * 64, kt * 64, tile, lane);
    }
    const int gt = bid * 512 + tid, gn = G * 512;
    bf16_t* WAT = (bf16_t*)(ws + OFF_WAT);
    for (int i = gt; i < 2048 * 256; i += gn) { const int r = i >> 8, k = i & 255; float v = 0.f;
        if (r < 1024) { if (k < 96) v = p.w2[k * 1024 + r]; } else { if (k >= 96 && k < 192) v = p.a2[(k - 96) * 1024 + (r - 1024)]; }
        WAT[i] = f2bf(v); }
    bf16_t* G2T = (bf16_t*)(ws + OFF_G2T);
    for (int i = gt; i < 1024 * 256; i += gn) { const int r = i >> 8, k = i & 255; G2T[i] = f2bf(p.g2[k * 1024 + r]); }
    bf16_t* SK = (bf16_t*)(ws + OFF_SUBK);
    for (int i = gt; i < 2 * 128 * 128; i += gn) SK[i] = f2bf(p.sub_keys[i]);
    if (gt == 0) *(unsigned*)(ws + OFF_SUBBAR) = 0u;
    for (int i = gt; i < XCD_BAR_WORDS; i += gn) ((unsigned*)(ws + OFF_XBAR))[i] = 0u;
}

__device__ __forceinline__ float bfel(const u32x4& w, int e) { const unsigned u = w[e >> 1]; return (e & 1) ? bfhi(u) : bflo(u); }
__device__ void phase_lora_prep(const KP& p) {
    const bf16_t* PR = (const bf16_t*)(p.ws + OFF_PR);
    bf16_t* AL = (bf16_t*)((unsigned char*)p.out + DO_ALORA);
    const int gt = blockIdx.x * 512 + threadIdx.x, gn = gridDim.x * 512;
    for (int i = gt; i < NT * 64; i += gn) {
        const int tok = i >> 6, g = i & 63;
        u32x4 o = (u32x4){0u, 0u, 0u, 0u};
        if (g < 24 || g >= 32) {
            const int sc = (g < 24) ? (3072 + 8 * g) : (3264 + 8 * (g - 32));
            const u32x4 cu = *(const u32x4*)(PR + (size_t)tok * LDPR + sc);
            u32x4 pv = (u32x4){0u, 0u, 0u, 0u};
            if ((tok & (SEQ - 1)) != 0) pv = *(const u32x4*)(PR + (size_t)(tok - 1) * LDPR + sc);
            const f32x4 m0 = *(const f32x4*)(p.mu + sc), m1 = *(const f32x4*)(p.mu + sc + 4);
            float f[8];
#pragma unroll
            for (int q = 0; q < 4; ++q) {
                const float c0 = bflo(cu[q]), c1 = bfhi(cu[q]), p0 = bflo(pv[q]), p1 = bfhi(pv[q]);
                const float mm0 = (q < 2) ? m0[2 * q] : m1[2 * q - 4], mm1 = (q < 2) ? m0[2 * q + 1] : m1[2 * q - 3];
                f[2 * q] = c0 + (p0 - c0) * mm0; f[2 * q + 1] = c1 + (p1 - c1) * mm1;
            }
            if (g < 12) {
#pragma unroll
                for (int q = 0; q < 8; ++q) f[q] = tanhf(f[q]);
            } else if (g >= 32) {
#pragma unroll
                for (int q = 0; q < 8; ++q) f[q] = sigm(f[q]);
            }
            o.x = cvt_pk_bf16(f[0], f[1]); o.y = cvt_pk_bf16(f[2], f[3]); o.z = cvt_pk_bf16(f[4], f[5]); o.w = cvt_pk_bf16(f[6], f[7]);
        }
        *(u32x4*)(AL + (size_t)tok * 512 + 8 * g) = o;
    }
    {
        const bf16_t* PM = (const bf16_t*)(p.ws + OFF_PM);
        bf16_t* QC = (bf16_t*)(p.ws + OFF_QC); bf16_t* KC = (bf16_t*)(p.ws + OFF_KC);
        for (int i = gt; i < (NT / 8) * 256; i += gn) {
            const int tb = i >> 8, col = (i & 255) * 8; const int tok0 = tb * 8, t0 = tok0 & (SEQ - 1);
            f32x4 cw[4][2];
#pragma unroll
            for (int j = 0; j < 4; ++j) { cw[j][0] = *(const f32x4*)(p.conv_w + j * 2048 + col); cw[j][1] = *(const f32x4*)(p.conv_w + j * 2048 + col + 4); }
            u32x4 raw[11];
#pragma unroll
            for (int q = 0; q < 11; ++q) { const bool neg = (t0 - 3 + q) < 0; u32x4 v = *(const u32x4*)(PM + (size_t)(tok0 + (neg ? 0 : q - 3)) * LDPM + col); if (neg) v = (u32x4){0u, 0u, 0u, 0u}; raw[q] = v; }
            const float scl = (col < 1024) ? 0.0625f : 1.f;
            bf16_t* dst = (col < 1024) ? (QC + (size_t)tok0 * 1024 + col) : (KC + (size_t)tok0 * 1024 + (col - 1024));
#pragma unroll
            for (int r = 0; r < 8; ++r) {
                float o[8];
#pragma unroll
                for (int e = 0; e < 8; ++e) {
                    const float c0 = (e < 4) ? cw[0][0][e] : cw[0][1][e - 4], c1 = (e < 4) ? cw[1][0][e] : cw[1][1][e - 4], c2 = (e < 4) ? cw[2][0][e] : cw[2][1][e - 4], c3 = (e < 4) ? cw[3][0][e] : cw[3][1][e - 4];
                    float sv = c0 * bfel(raw[r], e) + c1 * bfel(raw[r + 1], e) + c2 * bfel(raw[r + 2], e) + c3 * bfel(raw[r + 3], e);
                    o[e] = sv * sigm(sv) * scl;
                }
                u32x4 pk; pk.x = cvt_pk_bf16(o[0], o[1]); pk.y = cvt_pk_bf16(o[2], o[3]); pk.z = cvt_pk_bf16(o[4], o[5]); pk.w = cvt_pk_bf16(o[6], o[7]);
                *(u32x4*)(dst + (size_t)r * 1024) = pk;
            }
        }
    }
    {
        const int lane = threadIdx.x & 63, gw = blockIdx.x * 8 + (threadIdx.x >> 6), nw = gridDim.x * 8;
        float* GB = (float*)((unsigned char*)p.out + DO_GB); float* GA = (float*)((unsigned char*)p.out + DO_GA); float* GW = (float*)((unsigned char*)p.out + DO_GW);
        for (int task = gw; task < 1024; task += nw) {
            const int bh = task >> 6, c = task & 63, bb = bh >> 2, h = bh & 3; const size_t tok = (size_t)bb * SEQ + c * 64 + lane;
            const float iv = bf2f(PR[tok * LDPR + 3520 + h]) + p.b_i[h], fv = bf2f(PR[tok * LDPR + 3524 + h]) + p.b_f[h];
            float lf = fminf(fv, 0.f) - __logf(1.f + __expf(-fabsf(fv)));
#pragma unroll
            for (int d = 1; d < 64; d <<= 1) { const float y = __shfl_up(lf, d); if (lane >= d) lf += y; }
            const float bl = rlane(lf, 63);
            const int o = bh * SEQ + c * 64 + lane;
            GB[o] = lf; GA[o] = iv - lf; GW[o] = __expf(bl - lf + iv);
        }
    }
}

constexpr size_t OFF_YRAW = OFF_WINT, OFF_BON = OFF_WINT + 32 * MiB;
struct RwOps { f32x4 a0, q0, w0, b0, k0; float v, v2, br, kr; };
__device__ __forceinline__ f32x2_t lo2(f32x4 v) { return __builtin_shufflevector(v, v, 0, 1); }
__device__ __forceinline__ f32x2_t hi2(f32x4 v) { return __builtin_shufflevector(v, v, 2, 3); }
__device__ __forceinline__ f32x2_t fma2(f32x2_t a, f32x2_t b, f32x2_t c) { return __builtin_elementwise_fma(a, b, c); }
__device__ void rwkv_scan(const KP& p, int blk, LAS unsigned char* lds) {
    const int tid0 = tid_l();
    const int bh = blk >> 1, half = blk & 1, b = bh >> 4, h = bh & 15;
    constexpr int BUFB = 53760;
    const bf16_t* PR = (const bf16_t*)(p.ws + OFF_PR);
    const bf16_t* WLOG = (const bf16_t*)((const unsigned char*)p.out + DO_WLOG);
    const bf16_t* AG = (const bf16_t*)((const unsigned char*)p.out + DO_AG);
    bf16_t* YRAW = (bf16_t*)(p.ws + OFF_YRAW); float* BON = (float*)(p.ws + OFF_BON);
    const size_t tokbase = (size_t)b * SEQ;
    if (tid0 < 256) {
        const int wv = tid0 >> 6, pi = (tid0 >> 4) & 3, j4 = (tid0 & 15) * 4;
        const int rlA = 8 * wv + pi, rlB = rlA + 4, rowA = 32 * half + rlA, rowB = 32 * half + rlB;
        f32x2_t A0 = (f32x2_t){0.f, 0.f}, A1 = A0, B0 = A0, B1 = A0;
        __syncthreads();
        for (int c = 0; c < 128; ++c) {
            const LAS float* bp = (const LAS float*)(lds + (c & 1) * BUFB);
            LAS float* yb = (LAS float*)(lds + (c & 1) * BUFB + 49408);
#define RW_LD(O, s) do { const LAS float* q_ = bp + (s) * 64 + j4; O.a0 = *(const LAS f32x4*)(q_); O.b0 = *(const LAS f32x4*)(q_ + 2048); O.w0 = *(const LAS f32x4*)(q_ + 4096); O.k0 = *(const LAS f32x4*)(q_ + 6144); \
            O.q0 = *(const LAS f32x4*)(q_ + 8192); O.v = bp[10240 + (s) * 64 + rowA]; O.v2 = bp[10240 + (s) * 64 + rowB]; O.br = bp[12288 + (s)]; O.kr = bp[12320 + (s)]; } while (0)
#define RW_STEP(O, s) do { \
            f32x2_t paA = A0 * lo2(O.a0), pyA = A0 * lo2(O.q0), paB = B0 * lo2(O.a0), pyB = B0 * lo2(O.q0); \
            paA = fma2(A1, hi2(O.a0), paA); pyA = fma2(A1, hi2(O.q0), pyA); paB = fma2(B1, hi2(O.a0), paB); pyB = fma2(B1, hi2(O.q0), pyB); \
            float saA = paA.x + paA.y, yyA = pyA.x + pyA.y, saB = paB.x + paB.y, yyB = pyB.x + pyB.y; \
            saA += dppf<0xB1>(saA); saB += dppf<0xB1>(saB); yyA += dppf<0xB1>(yyA); yyB += dppf<0xB1>(yyB); \
            saA += dppf<0x4E>(saA); saB += dppf<0x4E>(saB); yyA += dppf<0x4E>(yyA); yyB += dppf<0x4E>(yyB); \
            saA += dppf<0x141>(saA); saB += dppf<0x141>(saB); yyA += dppf<0x141>(yyA); yyB += dppf<0x141>(yyB); \
            saA += dppf<0x140>(saA); saB += dppf<0x140>(saB); yyA += dppf<0x140>(yyA); yyB += dppf<0x140>(yyB); \
            const f32x2_t sA2 = (f32x2_t){saA, saA}, vA2 = (f32x2_t){O.v, O.v}, sB2 = (f32x2_t){saB, saB}, vB2 = (f32x2_t){O.v2, O.v2}; \
            A0 = fma2(A0, lo2(O.w0), fma2(vA2, lo2(O.k0), sA2 * lo2(O.b0))); A1 = fma2(A1, hi2(O.w0), fma2(vA2, hi2(O.k0), sA2 * hi2(O.b0))); \
            B0 = fma2(B0, lo2(O.w0), fma2(vB2, lo2(O.k0), sB2 * lo2(O.b0))); B1 = fma2(B1, hi2(O.w0), fma2(vB2, hi2(O.k0), sB2 * hi2(O.b0))); \
            if ((tid0 & 15) == 0) { yb[(s) * 32 + rlA] = yyA + saA * O.br + O.v * O.kr; yb[(s) * 32 + rlB] = yyB + saB * O.br + O.v2 * O.kr; } } while (0)
            RwOps o0, o1;
            RW_LD(o0, 0);
#pragma unroll 1
            for (int s = 0; s < 32; s += 2) {
                RW_LD(o1, s + 1);
                RW_STEP(o0, s);
                { const int sn = (s + 2 < 32) ? s + 2 : 31; RW_LD(o0, sn); }
                RW_STEP(o1, s + 1);
            }
#undef RW_LD
#undef RW_STEP
            __syncthreads();
        }
    } else {
        const int ht = tid0 - 256, tt = ht >> 3, cg8 = (ht & 7) * 8, ch = h * 64 + cg8;
        float mur[8], muk[8], muv[8], kkc[8], kac[8], rkc[8];
#pragma unroll
        for (int e = 0; e < 8; ++e) { mur[e] = p.mu[ch + e]; muk[e] = p.mu[1024 + ch + e]; muv[e] = p.mu[2048 + ch + e]; kkc[e] = p.k_k[ch + e]; kac[e] = p.k_a[ch + e]; rkc[e] = p.r_k[ch + e]; }
        for (int c = -1; c < 128; ++c) {
            if (c >= 1) {
                const LAS float* yb = (const LAS float*)(lds + ((c - 1) & 1) * BUFB + 49408);
                const int r4 = (ht & 7) * 4; const f32x4 y4 = *(const LAS f32x4*)(yb + tt * 32 + r4);
                u32x2 ov; ov.x = cvt_pk_bf16(y4[0], y4[1]); ov.y = cvt_pk_bf16(y4[2], y4[3]);
                *(u32x2*)(YRAW + (tokbase + (size_t)(c - 1) * 32 + tt) * 1024 + h * 64 + 32 * half + r4) = ov;
            }
            if (c + 1 < 128) {
                const int cn = c + 1, t = cn * 32 + tt; const size_t tok = tokbase + t;
                LAS float* bp = (LAS float*)(lds + (cn & 1) * BUFB);
                const bf16_t* pr_ = PR + tok * LDPR + ch;
                const u32x4 r4 = *(const u32x4*)pr_, k4 = *(const u32x4*)(pr_ + 1024), v4 = *(const u32x4*)(pr_ + 2048);
                u32x4 pr4 = (u32x4){0u, 0u, 0u, 0u}, pk4 = pr4, pv4 = pr4;
                if (t > 0) { pr4 = *(const u32x4*)(pr_ - LDPR); pk4 = *(const u32x4*)(pr_ - LDPR + 1024); pv4 = *(const u32x4*)(pr_ - LDPR + 2048); }
                const u32x4 w4 = *(const u32x4*)(WLOG + tok * 1024 + ch), a4 = *(const u32x4*)(AG + tok * 1024 + ch);
                float r[8], k[8], v[8], kk[8], av[8], dec[8];
                float n2 = 0.f;
#pragma unroll
                for (int e = 0; e < 8; ++e) {
                    const float rc = bfel(r4, e), kc = bfel(k4, e), vc = bfel(v4, e);
                    r[e] = rc + (bfel(pr4, e) - rc) * mur[e]; k[e] = kc + (bfel(pk4, e) - kc) * muk[e]; v[e] = vc + (bfel(pv4, e) - vc) * muv[e];
                    kk[e] = k[e] * kkc[e]; n2 += kk[e] * kk[e]; av[e] = bfel(a4, e); dec[e] = __expf(bfel(w4, e));
                }
                n2 = red8(n2);
                const float inv = 1.f / fmaxf(sqrtf(n2), 1e-12f);
                float br = 0.f, kr = 0.f, bon = 0.f;
                f32x4 oa[2], ob[2], ow[2], ok[2], oq[2], ovv[2];
#pragma unroll
                for (int e = 0; e < 8; ++e) {
                    const float kn = kk[e] * inv, k3 = k[e] * (1.f + (av[e] - 1.f) * kac[e]), bb = kn * av[e];
                    oa[e >> 2][e & 3] = -kn; ob[e >> 2][e & 3] = bb; ow[e >> 2][e & 3] = dec[e]; ok[e >> 2][e & 3] = k3; oq[e >> 2][e & 3] = dec[e] * r[e]; ovv[e >> 2][e & 3] = v[e];
                    br += bb * r[e]; kr += k3 * r[e]; bon += r[e] * k3 * rkc[e];
                }
                br = red8(br); kr = red8(kr); bon = red8(bon);
                LAS float* q_ = bp + tt * 64 + cg8;
#pragma unroll
                for (int i = 0; i < 2; ++i) { *(LAS f32x4*)(q_ + 4 * i) = oa[i]; *(LAS f32x4*)(q_ + 2048 + 4 * i) = ob[i]; *(LAS f32x4*)(q_ + 4096 + 4 * i) = ow[i]; *(LAS f32x4*)(q_ + 6144 + 4 * i) = ok[i];
                    *(LAS f32x4*)(q_ + 8192 + 4 * i) = oq[i]; *(LAS f32x4*)(q_ + 10240 + 4 * i) = ovv[i]; }
                if ((ht & 7) == 0) { bp[12288 + tt] = br; bp[12320 + tt] = kr; if (half == 0) BON[tok * 16 + h] = bon; }
            }
            __syncthreads();
        }
        {
            const LAS float* yb = (const LAS float*)(lds + (127 & 1) * BUFB + 49408);
            const int r4 = (ht & 7) * 4; const f32x4 y4 = *(const LAS f32x4*)(yb + tt * 32 + r4);
            u32x2 ov; ov.x = cvt_pk_bf16(y4[0], y4[1]); ov.y = cvt_pk_bf16(y4[2], y4[3]);
            *(u32x2*)(YRAW + (tokbase + (size_t)127 * 32 + tt) * 1024 + h * 64 + 32 * half + r4) = ov;
        }
    }
}

__device__ void phase_rwkv_post(const KP& p) {
    const bf16_t* PR = (const bf16_t*)(p.ws + OFF_PR);
    const bf16_t* GG = (const bf16_t*)((const unsigned char*)p.out + DO_GG);
    bf16_t* YR = (bf16_t*)(p.ws + OFF_YRAW); const float* BON = (const float*)(p.ws + OFF_BON);
    const int gt = blockIdx.x * 512 + tid_l(), gn = gridDim.x * 512;
    for (int i = gt; i < NT * 256; i += gn) {
        const int tok = i >> 8, h = (i >> 4) & 15, ch = h * 64 + (i & 15) * 4;
        const u32x2 y2 = *(const u32x2*)(YR + (size_t)tok * 1024 + ch), v2 = *(const u32x2*)(PR + (size_t)tok * LDPR + 2048 + ch), g2 = *(const u32x2*)(GG + (size_t)tok * 1024 + ch);
        u32x2 pv2 = (u32x2){0u, 0u};
        if ((tok & (SEQ - 1)) != 0) pv2 = *(const u32x2*)(PR + (size_t)(tok - 1) * LDPR + 2048 + ch);
        const float bon = BON[tok * 16 + h];
        const f32x4 muv = *(const f32x4*)(p.mu + 2048 + ch), lnw = *(const f32x4*)(p.ln_w + ch), lnb = *(const f32x4*)(p.ln_b + ch);
        const f32x4 y = (f32x4){bflo(y2.x), bfhi(y2.x), bflo(y2.y), bfhi(y2.y)}, vc = (f32x4){bflo(v2.x), bfhi(v2.x), bflo(v2.y), bfhi(v2.y)}, vp = (f32x4){bflo(pv2.x), bfhi(pv2.x), bflo(pv2.y), bfhi(pv2.y)};
        const f32x4 g = (f32x4){bflo(g2.x), bfhi(g2.x), bflo(g2.y), bfhi(g2.y)};
        const f32x4 v = vc + (vp - vc) * muv;
        const float mean = red16(y[0] + y[1] + y[2] + y[3]) * (1.f / 64.f);
        const f32x4 d = y - mean;
        const float var = red16(d[0] * d[0] + d[1] * d[1] + d[2] * d[2] + d[3] * d[3]) * (1.f / 64.f);
        const float rs = rsqrtf(var + 64e-5f);
        const f32x4 res = (d * rs * lnw + lnb + bon * v) * g;
        u32x2 ov; ov.x = cvt_pk_bf16(res[0], res[1]); ov.y = cvt_pk_bf16(res[2], res[3]);
        *(u32x2*)(YR + (size_t)tok * 1024 + ch) = ov;
    }
}

typedef short v4i16_t __attribute__((ext_vector_type(4)));
__device__ __forceinline__ bf16x8 tr_frag(const LAS unsigned char* base, int stride_b, int krow0, int ncol0, int lane) {
    const int g = lane >> 4, q = (lane & 15) >> 2, pp = lane & 3;
    const LAS unsigned char* a0 = base + (krow0 + 8 * g + q) * stride_b + (ncol0 + 4 * pp) * 2;
    const v4i16_t x = __builtin_amdgcn_ds_read_tr16_b64_v4i16((LAS v4i16_t*)a0), y = __builtin_amdgcn_ds_read_tr16_b64_v4i16((LAS v4i16_t*)(a0 + 4 * stride_b));
    return (bf16x8){x[0], x[1], x[2], x[3], y[0], y[1], y[2], y[3]};
}
__device__ void mlstm_run(const KP& p, int item, LAS unsigned char* lds) {
    const int tid0 = tid_l();
    const int bh = item >> 3, b = bh >> 2, h = bh & 3, dv0 = (item & 7) * 32;
    const size_t tokbase = (size_t)b * SEQ;
    LAS bf16_t* Qs = (LAS bf16_t*)(lds + 0);
    LAS bf16_t* Ks = (LAS bf16_t*)(lds + 33792);
    LAS bf16_t* Vs = (LAS bf16_t*)(lds + 67584);
    LAS bf16_t* Vws = (LAS bf16_t*)(lds + 74752);
    LAS bf16_t* Ss = (LAS bf16_t*)(lds + 81920);
    LAS bf16_t* CT0 = (LAS bf16_t*)(lds + 91136);
    LAS bf16_t* Os = (LAS bf16_t*)(lds + 141824);
    LAS float* BC = (LAS float*)(lds + 146944);
    LAS float* GAs = (LAS float*)(lds + 147200);
    const bf16_t* QC = (const bf16_t*)(p.ws + OFF_QC); const bf16_t* KC = (const bf16_t*)(p.ws + OFF_KC);
    bf16_t* PM = (bf16_t*)(p.ws + OFF_PM);
    const float* GB = (const float*)((const unsigned char*)p.out + DO_GB); const float* GA = (const float*)((const unsigned char*)p.out + DO_GA); const float* GW = (const float*)((const unsigned char*)p.out + DO_GW);
    for (int i = tid0; i < 2 * 48 * 264 / 2; i += 512) ((LAS unsigned*)CT0)[i] = 0u;
    for (int i = tid0; i < 2 * 64 * 56 / 2; i += 512) ((LAS unsigned*)Vs)[i] = 0u;
    __syncthreads();
    if (tid0 < 64) Vs[tid0 * 56 + 32] = (bf16_t)0x3F80;
    f32x4 cacc[6];
#pragma unroll
    for (int i = 0; i < 6; ++i) cacc[i] = (f32x4){0.f, 0.f, 0.f, 0.f};
    u32x4 q4[4], k4[4], vo4; float gb = 0.f, ga = 0.f, gwv = 0.f;
#define ML_LOAD(c, TID) do { const int row_ = (TID) >> 3, pc_ = (TID) & 7; const size_t tk_ = tokbase + (size_t)(c) * 64; \
        const bf16_t* qp_ = QC + (tk_ + row_) * 1024 + h * 256 + pc_ * 32; const bf16_t* kp_ = KC + (tk_ + row_) * 1024 + h * 256 + pc_ * 32; \
        _Pragma("unroll") for (int i_ = 0; i_ < 4; ++i_) { q4[i_] = *(const u32x4*)(qp_ + 8 * i_); k4[i_] = *(const u32x4*)(kp_ + 8 * i_); } \
        const int sg_ = (TID) & 255, s_ = sg_ >> 2, g_ = sg_ & 3; \
        vo4 = *(const u32x4*)(PM + (tk_ + s_) * LDPM + ((TID) < 256 ? 2048 : 3072) + h * 256 + dv0 + 8 * g_); \
        gwv = GW[bh * SEQ + (c) * 64 + s_]; \
        if ((TID) < 64) { gb = GB[bh * SEQ + (c) * 64 + (TID)]; ga = GA[bh * SEQ + (c) * 64 + (TID)]; } } while (0)
    ML_LOAD(0, tid0);
    __syncthreads();
    int cur = 0;
    for (int c = 0; c < 64; ++c) {
        int tid = tid0; asm volatile("" : "+v"(tid));
        const int lane = tid & 63, w = tid >> 6, fr = lane & 15, fq = lane >> 4;
        LAS bf16_t* CTc = CT0 + cur * (48 * 264); LAS bf16_t* CTn = CT0 + (cur ^ 1) * (48 * 264);
        {
            const int row = tid >> 3, pc = tid & 7;
#pragma unroll
            for (int i = 0; i < 4; ++i) { *(LAS u32x4*)(Qs + row * 264 + pc * 32 + 8 * i) = q4[i]; *(LAS u32x4*)(Ks + row * 264 + pc * 32 + 8 * i) = k4[i]; }
            const int sg = tid & 255, s = sg >> 2, g = sg & 3;
            if (tid < 256) {
                *(LAS u32x4*)(Vs + s * 56 + 8 * g) = vo4;
                u32x4 wv;
#pragma unroll
                for (int e = 0; e < 4; ++e) wv[e] = cvt_pk_bf16(bflo(vo4[e]) * gwv, bfhi(vo4[e]) * gwv);
                *(LAS u32x4*)(Vws + s * 56 + 8 * g) = wv;
                if (g == 0) Vws[s * 56 + 32] = f2bf(gwv);
            } else {
                if (c > 0) { const u32x4 yv = *(const LAS u32x4*)(Os + s * 40 + 8 * g); *(u32x4*)(PM + (tokbase + (size_t)(c - 1) * 64 + s) * LDPM + 3072 + h * 256 + dv0 + 8 * g) = yv; }
                *(LAS u32x4*)(Os + s * 40 + 8 * g) = vo4;
            }
            if (tid < 64) { BC[tid] = gb; GAs[tid] = ga; }
        }
        asm volatile("" ::: "memory");
        if (c + 1 < 64) ML_LOAD(c + 1, tid);
        asm volatile("" ::: "memory");
        __syncthreads();
        {
            const int mt = w >> 1, ntb = (w & 1) * 2;
            f32x4 s0 = (f32x4){0.f, 0.f, 0.f, 0.f}, s1 = s0;
#pragma unroll
            for (int ks = 0; ks < 8; ++ks) {
                const bf16x8 a = *(const LAS bf16x8*)(Qs + (16 * mt + fr) * 264 + 32 * ks + 8 * fq);
                const bf16x8 b0 = *(const LAS bf16x8*)(Ks + (16 * ntb + fr) * 264 + 32 * ks + 8 * fq);
                const bf16x8 b1 = *(const LAS bf16x8*)(Ks + (16 * (ntb + 1) + fr) * 264 + 32 * ks + 8 * fq);
                s0 = __builtin_amdgcn_mfma_f32_16x16x32_bf16(a, b0, s0, 0, 0, 0);
                s1 = __builtin_amdgcn_mfma_f32_16x16x32_bf16(a, b1, s1, 0, 0, 0);
            }
            const int sA = 16 * ntb + fr, sB = sA + 16;
            const float gA = GAs[sA], gB = GAs[sB];
#pragma unroll
            for (int j = 0; j < 4; ++j) {
                const int t = 16 * mt + 4 * fq + j; const float bt = BC[t];
                const float vA = (sA <= t) ? s0[j] * __expf(bt + gA) : 0.f, vB = (sB <= t) ? s1[j] * __expf(bt + gB) : 0.f;
                Ss[t * 72 + sA] = f2bf(vA); Ss[t * 72 + sB] = f2bf(vB);
            }
        }
        __syncthreads();
        {
            const int mt = w >> 1, nt = w & 1;
            f32x4 aA = (f32x4){0.f, 0.f, 0.f, 0.f}, aB = aA, xA = aA, xB = aA;
#pragma unroll
            for (int ks = 0; ks < 2; ++ks) {
                const bf16x8 a = *(const LAS bf16x8*)(Ss + (16 * mt + fr) * 72 + 32 * ks + 8 * fq);
                const bf16x8 bm = tr_frag((const LAS unsigned char*)Vs, 112, 32 * ks, 16 * nt, lane);
                const bf16x8 bx = tr_frag((const LAS unsigned char*)Vs, 112, 32 * ks, 32, lane);
                aA = __builtin_amdgcn_mfma_f32_16x16x32_bf16(a, bm, aA, 0, 0, 0);
                xA = __builtin_amdgcn_mfma_f32_16x16x32_bf16(a, bx, xA, 0, 0, 0);
            }
#pragma unroll
            for (int ks = 0; ks < 8; ++ks) {
                const bf16x8 a = *(const LAS bf16x8*)(Qs + (16 * mt + fr) * 264 + 32 * ks + 8 * fq);
                const bf16x8 bm = *(const LAS bf16x8*)(CTc + (16 * nt + fr) * 264 + 32 * ks + 8 * fq);
                const bf16x8 bx = *(const LAS bf16x8*)(CTc + (32 + fr) * 264 + 32 * ks + 8 * fq);
                aB = __builtin_amdgcn_mfma_f32_16x16x32_bf16(a, bm, aB, 0, 0, 0);
                xB = __builtin_amdgcn_mfma_f32_16x16x32_bf16(a, bx, xB, 0, 0, 0);
            }
#pragma unroll
            for (int j = 0; j < 4; ++j) {
                const int t = 16 * mt + 4 * fq + j; const float eb = __expf(BC[t]);
                const float num = aA[j] + eb * aB[j];
                const float den = __shfl(xA[j] + eb * xB[j], lane & 48);
                const float hv = num / fmaxf(fabsf(den), 1.f);
                LAS bf16_t* op = Os + t * 40 + 16 * nt + fr;
                *op = f2bf(hv * sigm(bf2f(*op)));
            }
            const float decay = __expf(BC[63]);
            bf16x8 bw[3][2];
#pragma unroll
            for (int n3 = 0; n3 < 3; ++n3)
#pragma unroll
                for (int ks = 0; ks < 2; ++ks) bw[n3][ks] = tr_frag((const LAS unsigned char*)Vws, 112, 32 * ks, 16 * n3, lane);
#pragma unroll
            for (int m2 = 0; m2 < 2; ++m2) {
                const int mtk = 2 * w + m2;
                const bf16x8 ka0 = tr_frag((const LAS unsigned char*)Ks, 528, 0, 16 * mtk, lane), ka1 = tr_frag((const LAS unsigned char*)Ks, 528, 32, 16 * mtk, lane);
#pragma unroll
                for (int n3 = 0; n3 < 3; ++n3) {
                    f32x4 cc = cacc[m2 * 3 + n3] * decay;
                    cc = __builtin_amdgcn_mfma_f32_16x16x32_bf16(ka0, bw[n3][0], cc, 0, 0, 0);
                    cc = __builtin_amdgcn_mfma_f32_16x16x32_bf16(ka1, bw[n3][1], cc, 0, 0, 0);
                    cacc[m2 * 3 + n3] = cc;
                    u32x2 pk; pk.x = cvt_pk_bf16(cc[0], cc[1]); pk.y = cvt_pk_bf16(cc[2], cc[3]);
                    *(LAS u32x2*)(CTn + (16 * n3 + fr) * 264 + 16 * mtk + 4 * fq) = pk;
                }
            }
        }
        cur ^= 1;
        __syncthreads();
    }
    if (tid0 >= 256) { const int sg = tid0 & 255, s = sg >> 2, g = sg & 3; const u32x4 yv = *(const LAS u32x4*)(Os + s * 40 + 8 * g);
        *(u32x4*)(PM + (tokbase + (size_t)63 * 64 + s) * LDPM + 3072 + h * 256 + dv0 + 8 * g) = yv; }
#undef ML_LOAD
}

__device__ void phase_norm2(const KP& p) {
    const int tid = tid_l(), lane = tid & 63, G = gridDim.x, bid = blockIdx.x;
    rmsnorm_rows(p.out, p.g_ffn, (bf16_t*)(p.ws + OFF_XN2), bid * 8 + (tid >> 6), G * 8, lane);
}
typedef float v16f_t __attribute__((ext_vector_type(16)));
typedef float v32f_t __attribute__((ext_vector_type(32)));
typedef unsigned v6u_t __attribute__((ext_vector_type(6)));
__device__ void convert_tables(const KP& p, int gw, int nw) {
    const int lane = tid_l() & 63;
    for (int tb = 0; tb < 2; ++tb) {
        const float* src = tb ? p.peer_v : p.peer_u; unsigned char* dst = p.ws + (tb ? OFF_PV : OFF_PU); float* sc = (float*)(p.ws + (tb ? OFF_SCV : OFF_SCU));
        for (int row = gw; row < 16384; row += nw) {
            const float* sp = src + (size_t)row * DM + lane * 32;
            f32x4 v[8]; float am = 0.f;
#pragma unroll
            for (int q = 0; q < 8; ++q) { v[q] = *(const f32x4*)(sp + q * 4);
                am = fmaxf(am, fmaxf(fmaxf(fabsf(v[q][0]), fabsf(v[q][1])), fmaxf(fabsf(v[q][2]), fabsf(v[q][3])))); }
            const unsigned amu = wave_max_u32(__float_as_uint(am));
            const float amax = __uint_as_float(amu);
            float scl = 1.f;
            if (amax > 0.f) scl = exp2f(floorf(log2f(7.5f / amax)));
            if (lane == 0) sc[row] = 1.f / scl;
            v16f_t xa, xb;
#pragma unroll
            for (int q = 0; q < 4; ++q)
#pragma unroll
                for (int j = 0; j < 4; ++j) { xa[q * 4 + j] = v[q][j] * scl; xb[q * 4 + j] = v[4 + q][j] * scl; }
            const v6u_t pk = __builtin_amdgcn_cvt_scalef32_2xpk16_fp6_f32(xa, xb, 1.0f);
            unsigned char* dp = dst + (size_t)row * 8192 + lane * 8;
#pragma unroll
            for (int k = 0; k < 3; ++k) { u32x2 o; o.x = pk[2 * k]; o.y = pk[2 * k + 1]; *(u32x2*)(dp + k * 512) = o; }
        }
    }
}

__device__ void phase_peer(const KP& p, LAS unsigned char* lds) {
    const int tid = tid_l(), lane = tid & 63, w = tid >> 6, fr = lane & 15, fq = lane >> 4;
    LAS unsigned* KEYS = (LAS unsigned*)lds;
    LAS int* TI = (LAS int*)(lds + 32768);
    LAS float* TG = (LAS float*)(lds + 49152);
    const bf16_t* Q = (const bf16_t*)(p.ws + OFF_Q);
    const bf16_t* SK = (const bf16_t*)(p.ws + OFF_SUBK);
    const bf16_t* XN2 = (const bf16_t*)(p.ws + OFF_XN2);
    const unsigned char* PU = p.ws + OFF_PU; const unsigned char* PV = p.ws + OFF_PV;
    const float* SCU = (const float*)(p.ws + OFF_SCU); const float* SCV = (const float*)(p.ws + OFF_SCV);
    float* out = p.out;
    LAS int* IJ = (LAS int*)(lds + 65536);
    int ci[4], cj[4]; bool cv[4];
#pragma unroll
    for (int m = 0; m < 4; ++m) { const int e = m * 16 + fr; int i = 0, base = 0;
        for (; i < 16; ++i) { const int cnt = 16 / (i + 1); if (e < base + cnt) break; base += cnt; }
        cv[m] = i < 16; ci[m] = cv[m] ? i : 0; cj[m] = cv[m] ? e - base : 0;
        if (w == 0 && fq == 0) IJ[e] = cv[m] ? ci[m] * 16 + cj[m] : 0; }
    const int pp_ = w >> 2, ntb = (w & 3) * 2;
    __syncthreads();
    LAS float* xs = (LAS float*)(lds + 66048) + w * 2048;
    LAS int* PERM = (LAS int*)(lds + 65792);
    {
        v16f_t ta, tb;
#pragma unroll
        for (int i = 0; i < 16; ++i) { ta[i] = 0.125f * i; tb[i] = (i < 8) ? 2.f + 0.25f * i : 4.f + 0.5f * (i - 8); }
        const v6u_t pk = __builtin_amdgcn_cvt_scalef32_2xpk16_fp6_f32(ta, tb, 1.0f);
        const v32f_t un = __builtin_amdgcn_cvt_scalef32_pk32_f32_fp6(pk, 1.0f);
#pragma unroll
        for (int m = 0; m < 32; ++m) { const float val = un[m]; const float c = val < 2.f ? val * 8.f : (val < 4.f ? 16.f + (val - 2.f) * 4.f : 24.f + (val - 4.f) * 2.f);
            if (tid == 0) PERM[m] = ((int)(c + 0.5f) & 31); }
    }
    __syncthreads();
    for (int tile = blockIdx.x; tile < NT / 32; tile += gridDim.x) {
        const int tk0 = tile * 32;
        bf16x8 bfr[2][4];
#pragma unroll
        for (int n = 0; n < 2; ++n)
#pragma unroll
            for (int ks = 0; ks < 4; ++ks) bfr[n][ks] = *(const bf16x8*)(SK + (size_t)(pp_ * 128 + 16 * (ntb + n) + fr) * 128 + 32 * ks + 8 * fq);
        bf16x8 afn[2][4];
#pragma unroll
        for (int mt = 0; mt < 2; ++mt)
#pragma unroll
            for (int ks = 0; ks < 4; ++ks) afn[mt][ks] = *(const bf16x8*)(Q + (size_t)(tk0 + 16 * mt + fr) * DM + pp_ * 128 + 32 * ks + 8 * fq);
        for (int h = 0; h < 8; ++h) {
            {
                bf16x8 af[2][4];
#pragma unroll
                for (int mt = 0; mt < 2; ++mt)
#pragma unroll
                    for (int ks = 0; ks < 4; ++ks) af[mt][ks] = afn[mt][ks];
                if (h + 1 < 8) {
#pragma unroll
                    for (int mt = 0; mt < 2; ++mt)
#pragma unroll
                        for (int ks = 0; ks < 4; ++ks) afn[mt][ks] = *(const bf16x8*)(Q + (size_t)(tk0 + 16 * mt + fr) * DM + (h + 1) * 256 + pp_ * 128 + 32 * ks + 8 * fq);
                }
                f32x4 acc[2][2];
#pragma unroll
                for (int a_ = 0; a_ < 2; ++a_)
#pragma unroll
                    for (int b_ = 0; b_ < 2; ++b_) acc[a_][b_] = (f32x4){0.f, 0.f, 0.f, 0.f};
#pragma unroll
                for (int ks = 0; ks < 4; ++ks)
#pragma unroll
                    for (int mt = 0; mt < 2; ++mt)
#pragma unroll
                        for (int n = 0; n < 2; ++n) acc[mt][n] = __builtin_amdgcn_mfma_f32_16x16x32_bf16(af[mt][ks], bfr[n][ks], acc[mt][n], 0, 0, 0);
#pragma unroll
                for (int mt = 0; mt < 2; ++mt)
#pragma unroll
                    for (int n = 0; n < 2; ++n)
#pragma unroll
                        for (int j = 0; j < 4; ++j) { const int tokl = 16 * mt + 4 * fq + j, key = 16 * (ntb + n) + fr;
                            KEYS[(tokl * 2 + pp_) * 128 + key] = (ordf(acc[mt][n][j]) & ~0x7Fu) | (unsigned)key; }
            }
            __syncthreads();
            {
                const int tokl = 4 * w + fq, rb = lane & 48;
                unsigned top[2];
#pragma unroll
                for (int pp = 0; pp < 2; ++pp) {
                    unsigned kx[8];
#pragma unroll
                    for (int m = 0; m < 8; ++m) kx[m] = KEYS[(tokl * 2 + pp) * 128 + fr + 16 * m];
                    unsigned tp = 0u;
                    for (int it = 0; it < 16; ++it) {
                        unsigned M = max(max(max(kx[0], kx[1]), max(kx[2], kx[3])), max(max(kx[4], kx[5]), max(kx[6], kx[7])));
                        M = max(M, dppu<0xB1>(M)); M = max(M, dppu<0x4E>(M)); M = max(M, dppu<0x141>(M)); M = max(M, dppu<0x140>(M));
                        if (fr == it) tp = M;
#pragma unroll
                        for (int m = 0; m < 8; ++m) kx[m] = (kx[m] == M) ? 0u : kx[m];
                    }
                    top[pp] = tp;
                }
                unsigned cnd[4];
#pragma unroll
                for (int m = 0; m < 4; ++m) {
                    const float v1 = unordf((unsigned)__shfl((int)top[0], rb + ci[m]) & ~0x7Fu), v2 = unordf((unsigned)__shfl((int)top[1], rb + cj[m]) & ~0x7Fu);
                    cnd[m] = cv[m] ? ((ordf(v1 + v2) & ~0x3Fu) | (unsigned)(m * 16 + fr)) : 0u;
                }
                unsigned best = 0u;
                for (int it = 0; it < 16; ++it) {
                    unsigned M = max(max(cnd[0], cnd[1]), max(cnd[2], cnd[3]));
                    M = max(M, dppu<0xB1>(M)); M = max(M, dppu<0x4E>(M)); M = max(M, dppu<0x141>(M)); M = max(M, dppu<0x140>(M));
                    if (fr == it) best = M;
#pragma unroll
                    for (int m = 0; m < 4; ++m) cnd[m] = (cnd[m] == M) ? 0u : cnd[m];
                }
                const int ij = IJ[best & 0x3Fu];
                const float bv = unordf(best & ~0x3Fu);
                const int e1 = __shfl((int)top[0], rb + (ij >> 4)) & 0x7F, e2 = __shfl((int)top[1], rb + (ij & 15)) & 0x7F;
                const float mx = __shfl(bv, rb);
                const float ev = __expf(bv - mx);
                const float sum = red16(ev);
                TI[tokl * 128 + h * 16 + fr] = e1 * 128 + e2; TG[tokl * 128 + h * 16 + fr] = ev / sum;
            }
            __syncthreads();
        }
        for (int q = 0; q < 4; ++q) {
            const int tokl = 4 * w + q; const size_t tok = (size_t)tk0 + tokl;
#pragma unroll
            for (int i = 0; i < 4; ++i) { const u32x4 x4 = *(const u32x4*)(XN2 + tok * DM + i * 512 + lane * 8);
                *(LAS f32x4*)(xs + i * 512 + lane * 8) = (f32x4){bflo(x4[0]), bfhi(x4[0]), bflo(x4[1]), bfhi(x4[1])}; *(LAS f32x4*)(xs + i * 512 + lane * 8 + 4) = (f32x4){bflo(x4[2]), bfhi(x4[2]), bflo(x4[3]), bfhi(x4[3])}; }
            float xv[32], acc[32];
#pragma unroll
            for (int m = 0; m < 32; ++m) { xv[m] = xs[32 * lane + PERM[m]]; acc[m] = 0.f; }
#define PE_ISSUE(E, e_) do { const int ee_ = (e_) < 128 ? (e_) : 127; const int idx_ = __builtin_amdgcn_readfirstlane(TI[tokl * 128 + ee_]); \
                E.gate = __builtin_bit_cast(float, __builtin_amdgcn_readfirstlane(__builtin_bit_cast(int, TG[tokl * 128 + ee_]))); \
                const unsigned char* up_ = PU + (size_t)idx_ * 8192 + lane * 8; \
                E.u0 = *(const u32x2*)up_; E.u1 = *(const u32x2*)(up_ + 512); E.u2 = *(const u32x2*)(up_ + 1024); \
                E.v0 = *(const u32x2*)(up_ + 2048); E.v1 = *(const u32x2*)(up_ + 2560); E.v2 = *(const u32x2*)(up_ + 3072); \
                E.su = SCU[idx_]; E.sv = SCV[idx_]; } while (0)
#define PE_COMPUTE(E) do { \
                const v32f_t uf = __builtin_amdgcn_cvt_scalef32_pk32_f32_fp6((v6u_t){E.u0.x, E.u0.y, E.u1.x, E.u1.y, E.u2.x, E.u2.y}, 1.0f); \
                float d0 = 0.f, d1 = 0.f, d2 = 0.f, d3 = 0.f; \
                _Pragma("unroll") for (int m = 0; m < 8; ++m) { d0 += xv[4 * m] * uf[4 * m]; d1 += xv[4 * m + 1] * uf[4 * m + 1]; d2 += xv[4 * m + 2] * uf[4 * m + 2]; d3 += xv[4 * m + 3] * uf[4 * m + 3]; } \
                const float act = wave_sum((d0 + d1) + (d2 + d3)) * E.su; \
                const float coef = E.gate * 0.5f * act * (1.f + erff(act * 0.70710678118f)) * E.sv; \
                const v32f_t vf = __builtin_amdgcn_cvt_scalef32_pk32_f32_fp6((v6u_t){E.v0.x, E.v0.y, E.v1.x, E.v1.y, E.v2.x, E.v2.y}, 1.0f); \
                _Pragma("unroll") for (int m = 0; m < 32; ++m) acc[m] += coef * vf[m]; } while (0)
            {
                struct PeEx { u32x2 u0, u1, u2, v0, v1, v2; float su, sv, gate; };
                PeEx q0, q1;
                PE_ISSUE(q0, 0); PE_ISSUE(q1, 1);
#pragma unroll 1
                for (int e = 0; e < 128; e += 2) {
                    PE_COMPUTE(q0); PE_ISSUE(q0, e + 2);
                    PE_COMPUTE(q1); PE_ISSUE(q1, e + 3);
                }
            }
#undef PE_ISSUE
#undef PE_COMPUTE
#pragma unroll
            for (int m = 0; m < 32; ++m) xs[32 * lane + PERM[m]] = acc[m];
            float ss = 0.f;
            float* orow = out + tok * DM;
            f32x4 hv[8];
#pragma unroll
            for (int i = 0; i < 8; ++i) { const f32x4 pa = *(const LAS f32x4*)(xs + i * 256 + lane * 4); const f32x4 h0 = *(const f32x4*)(orow + i * 256 + lane * 4);
                hv[i] = pa + h0; ss += hv[i][0] * hv[i][0] + hv[i][1] * hv[i][1] + hv[i][2] * hv[i][2] + hv[i][3] * hv[i][3]; }
            ss = wave_sum(ss);
            const float r = rsqrtf(ss * (1.f / DM) + 1e-6f);
#pragma unroll
            for (int i = 0; i < 8; ++i) { const f32x4 g0 = *(const f32x4*)(p.g_final + i * 256 + lane * 4); *(f32x4*)(orow + i * 256 + lane * 4) = hv[i] * r * g0; }
        }
        __syncthreads();
    }
}

#define XB_TMO      128
#define XB_XCNT(j)  (256  + 64 * (j))
#define XB_XSUB(j)  (1280 + 64 * (j))
#define XB_XGEN(j)  (2304 + 64 * (j))
#define XB_TOP      3328
#define XB_TOPGEN   3392
#define XB_SPIN_CAP (1u << 18)
__device__ __forceinline__ unsigned xb_ld(unsigned* p)              { return __hip_atomic_load(p, __ATOMIC_RELAXED, __HIP_MEMORY_SCOPE_AGENT); }
__device__ __forceinline__ unsigned xb_add(unsigned* p, unsigned v) { return __hip_atomic_fetch_add(p, v, __ATOMIC_RELAXED, __HIP_MEMORY_SCOPE_AGENT); }
__device__ __forceinline__ unsigned xb_xcc_id() { return (unsigned)__builtin_amdgcn_s_getreg((3 << 11) | 20) & 0xFu; }
#define XB_SPIN(cond, bar) do { unsigned _sp = 0; while (cond) { __builtin_amdgcn_s_sleep(1); \
    if ((++_sp & 255u) == 0u) { if (xb_ld(&(bar)[XB_TMO])) break; if (_sp > XB_SPIN_CAP) { atomicAdd(&(bar)[XB_TMO], 1u); break; } } } } while (0)
struct XcdBarrier { unsigned* bar; unsigned x; volatile LAS unsigned* st; };
__device__ __forceinline__ XcdBarrier xcd_barrier_post(unsigned* bar, volatile LAS unsigned* st) {
    XcdBarrier b; b.bar = bar; b.x = xb_xcc_id(); b.st = st;
    if (threadIdx.x == 0) (void)xb_add(&bar[XB_XCNT(b.x)], 1u);
    return b;
}
__device__ __forceinline__ void xcd_barrier_complete(unsigned* bar, unsigned x, unsigned& nloc, unsigned& nx) {
    const unsigned G = gridDim.x * gridDim.y * gridDim.z;
    unsigned sum, cnt, mine, sp = 0u;
    for (;;) {
        sum = 0u; cnt = 0u; mine = 0u;
#pragma unroll
        for (unsigned j = 0; j < 16; ++j) { const unsigned c = xb_ld(&bar[XB_XCNT(j)]); sum += c; cnt += (c > 0u) ? 1u : 0u; mine = (j == x) ? c : mine; }
        if (sum == G) break;
        __builtin_amdgcn_s_sleep(1);
        if ((++sp & 255u) == 0u) { if (xb_ld(&bar[XB_TMO])) break; if (sp > XB_SPIN_CAP) { atomicAdd(&bar[XB_TMO], 1u); break; } }
    }
    nloc = mine > 0u ? mine : 1u; nx = cnt > 0u ? cnt : 1u;
}
__device__ __forceinline__ void xcd_barrier(const XcdBarrier& b) {
    asm volatile("s_waitcnt vmcnt(0)" ::: "memory");
    __syncthreads();
    if (threadIdx.x == 0) {
        unsigned* bar = b.bar;
        __builtin_amdgcn_s_waitcnt(0);
        unsigned nloc = b.st[0], nx = b.st[1];
        if (nloc == 0u) { xcd_barrier_complete(bar, b.x, nloc, nx); b.st[0] = nloc; b.st[1] = nx; }
        const unsigned old = xb_add(&bar[XB_XSUB(b.x)], 1u);
        const unsigned gen = old / nloc;
        if (old + 1u == (gen + 1u) * nloc) {
            __builtin_amdgcn_fence(__ATOMIC_RELEASE, "agent");
            asm volatile("s_waitcnt vmcnt(0)" ::: "memory");
            const unsigned og = xb_add(&bar[XB_TOP], 1u);
            const unsigned tg = og / nx;
            if (og + 1u == (tg + 1u) * nx) xb_add(&bar[XB_TOPGEN], 1u);
            else XB_SPIN(xb_ld(&bar[XB_TOPGEN]) == tg, bar);
            __builtin_amdgcn_fence(__ATOMIC_ACQUIRE, "agent");
            xb_add(&bar[XB_XGEN(b.x)], 1u);
            asm volatile("s_waitcnt vmcnt(0)" ::: "memory");
        } else {
            XB_SPIN(xb_ld(&bar[XB_XGEN(b.x)]) == gen, bar);
            __builtin_amdgcn_fence(__ATOMIC_ACQUIRE, "agent");
            asm volatile("s_waitcnt vmcnt(0)" ::: "memory");
        }
    }
    __syncthreads();
}

__global__ void __launch_bounds__(512) fwd_megakernel(KP p) {
    extern __shared__ __attribute__((aligned(16))) unsigned char smem[];
    LAS unsigned char* lds = (LAS unsigned char*)smem;
    cg::grid_group grid = cg::this_grid();
#define GRID_SYNC() do { asm volatile("s_waitcnt vmcnt(0) lgkmcnt(0)" ::: "memory"); __syncthreads(); grid.sync(); asm volatile("" ::: "memory"); } while (0)
    const int G = gridDim.x, bid = blockIdx.x;
    unsigned char* ws = p.ws; unsigned char* dob = (unsigned char*)p.out;

#define RUN_GEMM(MODE, ...) do { unsigned char* ws = lp(p.ws); unsigned char* dob = lp((unsigned char*)p.out); const pg8::Gemm g_ = pg8::Gemm{__VA_ARGS__}; pg8::StaticOrder S_; S_.init(g_.M, g_.N, G, bid); \
        const pg8::Epi<MODE> E_{ws, dob, p.x, p.w0, p.a0}; pg8::gemm_phase(lds, g_, S_, E_); } while (0)
    volatile LAS unsigned* xst = (volatile LAS unsigned*)(lds + 150512);
    if (threadIdx.x < 4) xst[threadIdx.x] = 0u;
    phase_prep(p, lds);
    GRID_SYNC();
    const XcdBarrier xbar = xcd_barrier_post((unsigned*)(p.ws + OFF_XBAR), xst);
#define XSYNC() do { xcd_barrier(xbar); asm volatile("" ::: "memory"); } while (0)
    RUN_GEMM(0, (const bf16_t*)(ws + OFF_XN), (const bf16_t*)(ws + OFF_WINT), NT, N1, 2048, 2048, 2048);
    XSYNC();
    phase_lora_prep(p);
    XSYNC();
    RUN_GEMM(1, (const bf16_t*)(dob + DO_ALORA), (const bf16_t*)(ws + OFF_WAT), NT, 2048, 256, 512, 256);
    RUN_GEMM(2, (const bf16_t*)(dob + DO_ALORA) + 256, (const bf16_t*)(ws + OFF_G2T), NT, 1024, 256, 512, 256);
    XSYNC();
    if (bid < 128) rwkv_scan(p, bid, lds);
    else {
        mlstm_run(p, bid - 128, lds);
        convert_tables(p, (bid - 128) * 8 + (tid_l() >> 6), 1024);
        __builtin_amdgcn_fence(__ATOMIC_RELEASE, "agent"); __syncthreads();
        if (threadIdx.x == 0) { unsigned* cnt = (unsigned*)(p.ws + OFF_SUBBAR); __hip_atomic_fetch_add(cnt, 1u, __ATOMIC_RELAXED, __HIP_MEMORY_SCOPE_AGENT);
            while (__hip_atomic_load(cnt, __ATOMIC_RELAXED, __HIP_MEMORY_SCOPE_AGENT) < 128u) __builtin_amdgcn_s_sleep(2); }
        __syncthreads(); __builtin_amdgcn_fence(__ATOMIC_ACQUIRE, "agent");
        { unsigned char* ws = lp(p.ws); unsigned char* dob = lp((unsigned char*)p.out); const pg8::Gemm g_ = pg8::Gemm{(const bf16_t*)(ws + OFF_PM) + 3072, (const bf16_t*)(ws + OFF_PMT), NT, 2048, 1024, LDPM, 1024};
          pg8::StaticOrder S_; S_.init(g_.M, g_.N, 128, bid - 128); const pg8::Epi<3> E_{ws, dob, p.x, p.w0, p.a0}; pg8::gemm_phase(lds, g_, S_, E_); }
    }
    XSYNC();
    phase_rwkv_post(p);
    XSYNC();
    RUN_GEMM(4, (const bf16_t*)(ws + OFF_YR), (const bf16_t*)(ws + OFF_PRT), NT, 2048, 1024, 1024, 1024);
    XSYNC();
    RUN_GEMM(5, (const bf16_t*)(ws + OFF_PG), (const bf16_t*)(ws + OFF_WOT), NT, 2048, 2048, LDPG, 2048);
    XSYNC();
    phase_norm2(p);
    XSYNC();
    RUN_GEMM(6, (const bf16_t*)(ws + OFF_XN2), (const bf16_t*)(ws + OFF_WQT), NT, 2048, 2048, 2048, 2048);
    XSYNC();
    phase_peer(p, lds);
}

extern "C" void kernel_launch(void* const* d_in, const int* in_sizes, int n_in, void* d_out, int out_size, void* d_ws, size_t ws_size, hipStream_t stream) {
    static int grid_blocks = 0;
    if (grid_blocks == 0) {
        if (n_in != 26 || out_size != NT * DM || ws_size < WS_NEED) { fprintf(stderr, "kernel_launch: unexpected shapes: n_in %d out %d ws %zu (need %zu)\n", n_in, out_size, ws_size, (size_t)WS_NEED); grid_blocks = -1; return; }
        int dev = 0, cus = 0, per_cu = 0;
        hipGetDevice(&dev);
        hipDeviceGetAttribute(&cus, hipDeviceAttributeMultiprocessorCount, dev);
        if (hipFuncSetAttribute((const void*)fwd_megakernel, hipFuncAttributeMaxDynamicSharedMemorySize, LDS_BYTES) != hipSuccess) { fprintf(stderr, "kernel_launch: hipFuncSetAttribute failed\n"); grid_blocks = -1; return; }
        hipOccupancyMaxActiveBlocksPerMultiprocessor(&per_cu, (const void*)fwd_megakernel, 512, LDS_BYTES);
        if (per_cu < 1) { fprintf(stderr, "kernel_launch: occupancy query says %d blocks per CU\n", per_cu); per_cu = 1; }
        (void)hipGetLastError();
        grid_blocks = cus * 1;
    }
    if (grid_blocks < 0) return;
    KP p{};
    const float** pp = (const float**)&p;
    for (int i = 0; i < 26; ++i) pp[i] = (const float*)d_in[i];
    p.out = (float*)d_out; p.ws = (unsigned char*)d_ws;
    void* args[] = {&p};
    hipError_t e = hipLaunchCooperativeKernel((void*)fwd_megakernel, dim3(grid_blocks), dim3(512), args, LDS_BYTES, stream);
    if (e != hipSuccess) fprintf(stderr, "cooperative launch failed: %s (grid %d)\n", hipGetErrorString(e), grid_blocks);
}
```

```cpp
#include <hip/hip_runtime.h>
#include <hip/hip_cooperative_groups.h>
#include <cstdio>
namespace cg = cooperative_groups;

#define LAS __attribute__((address_space(3)))
typedef unsigned short bf16_t;
typedef short bf16x8 __attribute__((ext_vector_type(8)));
typedef float f32x4 __attribute__((ext_vector_type(4)));
typedef unsigned u32x4 __attribute__((ext_vector_type(4)));
typedef unsigned u32x2 __attribute__((ext_vector_type(2)));

constexpr int NT = 16384, SEQ = 4096, DM = 2048;
constexpr int LDPM = 4096, LDPR = 3584, LDPG = 4096, N1 = 11776;
constexpr size_t MiB = 1024ull * 1024ull;
constexpr size_t OFF_PM = 0, OFF_PR = 128 * MiB, OFF_PG = 240 * MiB, OFF_XN = 368 * MiB, OFF_WINT = 432 * MiB, OFF_WTS = 478 * MiB;
constexpr size_t OFF_PMT = OFF_WTS, OFF_PRT = OFF_WTS + 4 * MiB, OFF_WOT = OFF_WTS + 8 * MiB, OFF_WQT = OFF_WTS + 16 * MiB, OFF_WAT = OFF_WTS + 24 * MiB,
                 OFF_G2T = OFF_WTS + 25 * MiB, OFF_SUBK = OFF_WTS + 25 * MiB + 512 * 1024, WS_NEED = OFF_WTS + 26 * MiB;
constexpr size_t OFF_QC = OFF_XN, OFF_KC = OFF_XN + 32 * MiB, OFF_YR = OFF_WINT, OFF_Q = OFF_XN, OFF_XN2 = OFF_PR, OFF_PU = OFF_PM, OFF_PV = OFF_PM + 2048, OFF_SUBBAR = OFF_SUBK + 192 * 1024, OFF_XBAR = OFF_SUBBAR + 256,
                 OFF_SCU = OFF_SUBK + 64 * 1024, OFF_SCV = OFF_SCU + 64 * 1024;
constexpr size_t DO_WLOG = 0, DO_AG = 32 * MiB, DO_GG = 64 * MiB, DO_ALORA = 96 * MiB, DO_GB = 112 * MiB, DO_GA = DO_GB + 256 * 1024, DO_GW = DO_GA + 256 * 1024;
constexpr int LDS_BYTES = 150528;
#define XCD_BAR_WORDS 3456

struct KP {
    const float *x, *g_mix, *w_in, *conv_w, *b_i, *b_f, *mu, *w0, *w2, *a0, *a2, *g2, *k_k, *k_a, *r_k, *ln_w, *ln_b, *proj_m, *proj_r, *w_out, *g_ffn,
        *w_query, *sub_keys, *peer_u, *peer_v, *g_final;
    float* out; unsigned char* ws;
};

typedef __bf16 bf16x2_t __attribute__((ext_vector_type(2)));
typedef float f32x2_t __attribute__((ext_vector_type(2)));
__device__ __forceinline__ unsigned cvt_pk_bf16(float lo, float hi) { f32x2_t v = {lo, hi}; bf16x2_t b = __builtin_convertvector(v, bf16x2_t); return __builtin_bit_cast(unsigned, b); }
__device__ __forceinline__ bf16_t f2bf(float f) { return (bf16_t)(cvt_pk_bf16(f, 0.f) & 0xffffu); }
__device__ __forceinline__ float bf2f(bf16_t h) { return __uint_as_float((unsigned)h << 16); }
__device__ __forceinline__ float bflo(unsigned u) { return __uint_as_float(u << 16); }
__device__ __forceinline__ float bfhi(unsigned u) { return __uint_as_float(u & 0xffff0000u); }
__device__ __forceinline__ float sigm(float x) { return __builtin_amdgcn_rcpf(1.f + __expf(-x)); }
template <int CTRL> __device__ __forceinline__ float dppf(float v) { return __builtin_bit_cast(float, __builtin_amdgcn_update_dpp(0, __builtin_bit_cast(int, v), CTRL, 0xF, 0xF, true)); }
template <int CTRL> __device__ __forceinline__ unsigned dppu(unsigned v) { return (unsigned)__builtin_amdgcn_update_dpp(0, (int)v, CTRL, 0xF, 0xF, true); }
__device__ __forceinline__ float red4(float v) { v += dppf<0xB1>(v); v += dppf<0x4E>(v); return v; }
__device__ __forceinline__ float red8(float v) { v = red4(v); v += dppf<0x141>(v); return v; }
__device__ __forceinline__ float red16(float v) { v = red8(v); v += dppf<0x140>(v); return v; }
__device__ __forceinline__ float rlane(float v, int l) { return __builtin_bit_cast(float, __builtin_amdgcn_readlane(__builtin_bit_cast(int, v), l)); }
__device__ __forceinline__ float wave_sum(float v) { v = red16(v); return rlane(v, 0) + rlane(v, 16) + rlane(v, 32) + rlane(v, 48); }
__device__ __forceinline__ unsigned wave_max_u32(unsigned v) {
    v = max(v, dppu<0xB1>(v)); v = max(v, dppu<0x4E>(v)); v = max(v, dppu<0x141>(v)); v = max(v, dppu<0x140>(v));
    unsigned a = (unsigned)__builtin_amdgcn_readlane((int)v, 0), b = (unsigned)__builtin_amdgcn_readlane((int)v, 16), c = (unsigned)__builtin_amdgcn_readlane((int)v, 32), d = (unsigned)__builtin_amdgcn_readlane((int)v, 48);
    return max(max(a, b), max(c, d));
}
__device__ __forceinline__ unsigned ordf(float f) { unsigned u = __float_as_uint(f); return (u & 0x80000000u) ? ~u : (u | 0x80000000u); }
__device__ __forceinline__ float unordf(unsigned k) { return __uint_as_float((k & 0x80000000u) ? (k ^ 0x80000000u) : ~k); }

__device__ __forceinline__ int tid_l() { int t = threadIdx.x; asm volatile("" : "+v"(t)); return t; }
template <class T> __device__ __forceinline__ T* lp(T* q) { asm volatile("" : "+s"(q)); return q; }
__device__ __forceinline__ int bid_l() { int b = blockIdx.x; asm volatile("" : "+s"(b)); return b; }
namespace pg8 {
constexpr int BM = 256, BK = 64, HALF = 128, HTB = HALF * BK * 2, STAGE_BYTES = 8 * HTB, NXCD = 8, WGM = 8;
__device__ __forceinline__ int lds_byte(int r, int c) { const int st = (r >> 4) * 2 + (c >> 5), rr = r & 15, cc = c & 31, ob = rr * 64 + cc * 2; return st * 1024 + (ob ^ (((ob >> 9) & 1) << 5)); }
__device__ __forceinline__ void stage_rc(int b, int& R, int& C) { const int st = b / 1024, sb = b % 1024, swz = sb ^ (((sb >> 9) & 1) << 5); R = (st >> 1) * 16 + swz / 64; C = (st & 1) * 32 + (swz % 64) / 2; }
__device__ __forceinline__ int perm32(int rho) { const int n = rho >> 4, i = rho & 15; return 8 * (i >> 2) + 4 * n + (i & 3); }
struct Unit { int pm, pn; };
struct Gemm { const bf16_t* A; const bf16_t* Bt; int M, N, K, lda, ldb; };
struct StaticOrder {
    int nM, nN, nwg, G, c;
    __device__ void init(int M, int N, int G_, int c_) { nM = M / BM; nN = N / BM; nwg = nM * nN; G = G_; c = c_; }
    __device__ bool next(int i, Unit& u) const {
        const long L = (long)i * G + c; if (L >= nwg) return false;
        int wgid = (int)L; { const int q = nwg / NXCD, r = nwg % NXCD, xcd = wgid % NXCD, off = wgid / NXCD; wgid = (xcd < r ? xcd * (q + 1) : r * (q + 1) + (xcd - r) * q) + off; }
        const int nig = WGM * nN, gid = wgid / nig, fm = gid * WGM, gsz = (nM - fm) < WGM ? (nM - fm) : WGM;
        u.pm = fm + ((wgid % nig) % gsz); u.pn = (wgid % nig) / gsz; return true;
    }
};

__device__ __forceinline__ void store8(bf16_t* p, f32x4 v0, f32x4 v1) {
    u32x4 w; w.x = cvt_pk_bf16(v0[0], v0[1]); w.y = cvt_pk_bf16(v0[2], v0[3]); w.z = cvt_pk_bf16(v1[0], v1[1]); w.w = cvt_pk_bf16(v1[2], v1[3]); *(u32x4*)p = w;
}
__device__ __forceinline__ void load8(const bf16_t* p, f32x4& v0, f32x4& v1) {
    const u32x4 w = *(const u32x4*)p; v0 = (f32x4){bflo(w.x), bfhi(w.x), bflo(w.y), bfhi(w.y)}; v1 = (f32x4){bflo(w.z), bfhi(w.z), bflo(w.w), bfhi(w.w)};
}

template <int mode> struct Epi {
    static constexpr bool PERM = true;
    unsigned char* ws; unsigned char* dob; const float* x; const float* w0; const float* a0; const float* gf;
    __device__ __forceinline__ void operator()(const f32x4 (&acc)[2][2][4][2], const Unit& u, int wr, int wc, int fr, int fq) const {
        const int row0 = u.pm * BM + wr * 64 + fr, cb = u.pn * BM + wc * 32 + 8 * fq;
#pragma unroll
        for (int ai = 0; ai < 2; ++ai)
#pragma unroll
            for (int m = 0; m < 4; ++m) {
                const size_t row = (size_t)(row0 + ai * HALF + m * 16);
#pragma unroll
                for (int bj = 0; bj < 2; ++bj) {
                    const int col = cb + bj * HALF;
                    f32x4 v0 = acc[ai][bj][m][0], v1 = acc[ai][bj][m][1];
                    if (mode == 0) {
                        if (col < 4096) store8((bf16_t*)(ws + OFF_PM) + row * LDPM + col, v0, v1);
                        else if (col < 7680) store8((bf16_t*)(ws + OFF_PR) + row * LDPR + (col - 4096), v0, v1);
                        else {
#pragma unroll
                            for (int j = 0; j < 4; ++j) { v0[j] = sigm(v0[j]); v1[j] = sigm(v1[j]); }
                            store8((bf16_t*)(ws + OFF_PG) + row * LDPG + (col - 7680), v0, v1);
                        }
                    } else if (mode == 1) {
                        if (col < 1024) {
                            const f32x4 b0 = *(const f32x4*)(w0 + col), b1 = *(const f32x4*)(w0 + col + 4);
#pragma unroll
                            for (int j = 0; j < 4; ++j) {
                                float z = -(b0[j] + v0[j]); float sp = fmaxf(z, 0.f) + __logf(1.f + __expf(-fabsf(z))); v0[j] = -__expf(-sp - 0.5f);
                                z = -(b1[j] + v1[j]); sp = fmaxf(z, 0.f) + __logf(1.f + __expf(-fabsf(z))); v1[j] = -__expf(-sp - 0.5f);
                            }
                            store8((bf16_t*)(dob + DO_WLOG) + row * 1024 + col, v0, v1);
                        } else {
                            const int c2 = col - 1024;
                            const f32x4 b0 = *(const f32x4*)(a0 + c2), b1 = *(const f32x4*)(a0 + c2 + 4);
#pragma unroll
                            for (int j = 0; j < 4; ++j) { v0[j] = sigm(b0[j] + v0[j]); v1[j] = sigm(b1[j] + v1[j]); }
                            store8((bf16_t*)(dob + DO_AG) + row * 1024 + c2, v0, v1);
                        }
                    } else if (mode == 2) {
                        store8((bf16_t*)(dob + DO_GG) + row * 1024 + col, v0, v1);
                    } else if (mode == 3) {
                        bf16_t* pp = (bf16_t*)(ws + OFF_PG) + row * LDPG + col; f32x4 g0, g1; load8(pp, g0, g1);
                        store8(pp, g0 * v0, g1 * v1);
                    } else if (mode == 4) {
                        bf16_t* pp = (bf16_t*)(ws + OFF_PG) + row * LDPG + col; f32x4 m0, m1, g0, g1; load8(pp, m0, m1); load8(pp + 2048, g0, g1);
                        store8(pp, m0 + g0 * v0, m1 + g1 * v1);
                    } else if (mode == 5) {
                        const float* xp = x + row * DM + col; float* op = (float*)dob + row * DM + col;
                        const f32x4 x0 = *(const f32x4*)xp, x1 = *(const f32x4*)(xp + 4);
                        const f32x4 h0 = x0 + v0, h1v = x1 + v1;
                        *(f32x4*)op = h0; *(f32x4*)(op + 4) = h1v;
                        const f32x4 g0 = *(const f32x4*)(gf + col), g1 = *(const f32x4*)(gf + col + 4);
                        store8((bf16_t*)(ws + OFF_XN2) + row * DM + col, h0 * g0, h1v * g1);
                    } else {
                        store8((bf16_t*)(ws + OFF_Q) + row * DM + col, v0, v1);
                    }
                    if (mode == 1 || mode == 3 || mode == 4 || mode == 5) asm volatile("" ::: "memory");
                }
            }
    }
};

template <class EpiT> __device__ __forceinline__ void gemm_phase(LAS unsigned char* lds, const Gemm g, const StaticOrder& S, const EpiT& E) {
    const int tid = tid_l(), wid = __builtin_amdgcn_readfirstlane(tid >> 6), lane = tid & 63, wr = wid >> 2, wc = wid & 3, fr = lane & 15, fq = lane >> 4;
    const int K = g.K, nt = K / BK;
    unsigned voffA[2], voffB[2];
#pragma unroll
    for (int i = 0; i < 2; ++i) { int R, C; stage_rc(tid * 16 + i * 8192, R, C); const int Rb = (R & ~31) + perm32(R & 31);
        voffA[i] = (unsigned)(R * g.lda + C) * 2u; voffB[i] = (unsigned)(Rb * g.ldb + C) * 2u; }
    const size_t kstep = (size_t)(BK * 2);
    const size_t hstepA = (size_t)HALF * g.lda * 2, hstepB = (size_t)HALF * g.ldb * 2;
    const size_t tstepA = 2 * hstepA, tstepB = 2 * hstepB;
    const unsigned ldsw = (unsigned)wid * 1024u;
    const int aoff = lds_byte(wr * 64 + fr, fq * 8), boff = lds_byte(wc * 32 + fr, fq * 8);
#define PG8_SA(b, h) (((b) * 2 + (h)) * HTB)
#define PG8_SB(b, h) ((4 + (b) * 2 + (h)) * HTB)
#define PG8_STAGE(bufoff, gbase, voff) do { _Pragma("unroll") for (int _i = 0; _i < 2; ++_i) \
        __builtin_amdgcn_global_load_lds((const unsigned*)((const char*)(gbase) + (voff)[_i]), (LAS unsigned*)(lds + (bufoff) + ldsw + _i * 8192), 16, 0, 0); } while (0)
#define PG8_LDA(dst, b, h) do { _Pragma("unroll") for (int m = 0; m < 4; ++m) _Pragma("unroll") for (int k = 0; k < 2; ++k) dst[m][k] = *(const LAS bf16x8*)(lds + PG8_SA(b, h) + aoff + m * 2048 + k * 1024); } while (0)
#define PG8_LDB(dst, b, h) do { _Pragma("unroll") for (int n = 0; n < 2; ++n) _Pragma("unroll") for (int k = 0; k < 2; ++k) dst[n][k] = *(const LAS bf16x8*)(lds + PG8_SB(b, h) + boff + n * 2048 + k * 1024); } while (0)
#define PG8_MMA(ai, bj, At, Bt) do { __builtin_amdgcn_s_setprio(1); _Pragma("unroll") for (int m = 0; m < 4; ++m) _Pragma("unroll") for (int n = 0; n < 2; ++n) _Pragma("unroll") for (int k = 0; k < 2; ++k) \
        acc[ai][bj][m][n] = __builtin_amdgcn_mfma_f32_16x16x32_bf16(Bt[n][k], At[m][k], acc[ai][bj][m][n], 0, 0, 0); __builtin_amdgcn_s_setprio(0); } while (0)
#define PG8_WAIT_V(n) asm volatile("s_waitcnt vmcnt(" #n ")" ::: "memory")
#define PG8_WAIT_L(n) asm volatile("s_waitcnt lgkmcnt(" #n ")" ::: "memory")
#define PG8_BAR __builtin_amdgcn_s_barrier()
#define PG8_SCHED __builtin_amdgcn_sched_barrier(0)
    Unit cur, nxt; int ui = 0;
    if (!S.next(0, cur)) return;
    f32x4 acc[2][2][4][2];
#pragma unroll
    for (int a = 0; a < 2; ++a)
#pragma unroll
        for (int b = 0; b < 2; ++b)
#pragma unroll
            for (int m = 0; m < 4; ++m)
#pragma unroll
                for (int n = 0; n < 2; ++n) acc[a][b][m][n] = (f32x4){0.f, 0.f, 0.f, 0.f};
    bf16x8 At[4][2], B0[2][2], B1[2][2];
    const char* cA = (const char*)g.A + (size_t)cur.pm * tstepA; const char* cB = (const char*)g.Bt + (size_t)cur.pn * tstepB;
    PG8_STAGE(PG8_SB(0, 0), cB, voffB); PG8_STAGE(PG8_SA(0, 0), cA, voffA); PG8_STAGE(PG8_SB(0, 1), cB + hstepB, voffB); PG8_STAGE(PG8_SA(0, 1), cA + hstepA, voffA);
    if (wr == 1) PG8_BAR;
    PG8_WAIT_V(4); PG8_BAR;
    PG8_STAGE(PG8_SB(1, 0), cB + kstep, voffB); PG8_STAGE(PG8_SA(1, 0), cA + kstep, voffA); PG8_STAGE(PG8_SB(1, 1), cB + hstepB + kstep, voffB);
    PG8_WAIT_V(6); PG8_BAR;
    for (;;) {
        const bool has_next = S.next(ui + 1, nxt);
        const char* nA = has_next ? (const char*)g.A + (size_t)nxt.pm * tstepA : cA; const char* nB = has_next ? (const char*)g.Bt + (size_t)nxt.pn * tstepB : cB;
        for (int t = 0; t < nt; t += 2) {
            const bool last = (t == nt - 2);
            const char* a1 = cA + (size_t)(t + 1) * kstep;
            const char* a2 = last ? nA : cA + (size_t)(t + 2) * kstep; const char* b2 = last ? nB : cB + (size_t)(t + 2) * kstep;
            const char* a3 = a2 + kstep; const char* b3 = b2 + kstep;
            PG8_LDB(B0, 0, 0); PG8_SCHED; PG8_LDA(At, 0, 0); PG8_STAGE(PG8_SA(1, 1), a1 + hstepA, voffA);
            PG8_WAIT_L(8); PG8_BAR; PG8_WAIT_L(0); PG8_MMA(0, 0, At, B0); PG8_BAR; PG8_SCHED;
            PG8_LDB(B1, 0, 1); PG8_STAGE(PG8_SB(0, 0), b2, voffB);
            PG8_BAR; PG8_WAIT_L(0); PG8_MMA(0, 1, At, B1); PG8_BAR;
            PG8_LDA(At, 0, 1); PG8_STAGE(PG8_SA(0, 0), a2, voffA);
            PG8_BAR; PG8_WAIT_L(0); PG8_MMA(1, 0, At, B0); PG8_BAR; PG8_SCHED;
            PG8_STAGE(PG8_SB(0, 1), b2 + hstepB, voffB);
            PG8_WAIT_V(6); PG8_BAR; PG8_MMA(1, 1, At, B1); PG8_BAR;
            PG8_LDB(B0, 1, 0); PG8_SCHED; PG8_LDA(At, 1, 0); PG8_STAGE(PG8_SA(0, 1), a2 + hstepA, voffA);
            PG8_WAIT_L(8); PG8_BAR; PG8_WAIT_L(0); PG8_MMA(0, 0, At, B0); PG8_BAR; PG8_SCHED;
            PG8_LDB(B1, 1, 1); PG8_STAGE(PG8_SB(1, 0), b3, voffB);
            PG8_BAR; PG8_WAIT_L(0); PG8_MMA(0, 1, At, B1); PG8_BAR;
            PG8_LDA(At, 1, 1); PG8_STAGE(PG8_SA(1, 0), a3, voffA);
            PG8_BAR; PG8_WAIT_L(0); PG8_MMA(1, 0, At, B0); PG8_BAR; PG8_SCHED;
            PG8_STAGE(PG8_SB(1, 1), b3 + hstepB, voffB);
            PG8_WAIT_V(6); PG8_BAR; PG8_MMA(1, 1, At, B1); PG8_BAR;
        }
        E(acc, cur, wr, wc, fr, fq);
        if (!has_next) break;
#pragma unroll
        for (int a = 0; a < 2; ++a)
#pragma unroll
            for (int b = 0; b < 2; ++b)
#pragma unroll
                for (int m = 0; m < 4; ++m)
#pragma unroll
                    for (int n = 0; n < 2; ++n) acc[a][b][m][n] = (f32x4){0.f, 0.f, 0.f, 0.f};
        cur = nxt; cA = nA; cB = nB; ++ui;
    }
    PG8_WAIT_V(0);
    if (wr == 0) PG8_BAR;
    PG8_BAR;
#undef PG8_SA
#undef PG8_SB
#undef PG8_STAGE
#undef PG8_LDA
#undef PG8_LDB
#undef PG8_MMA
#undef PG8_WAIT_V
#undef PG8_WAIT_L
#undef PG8_BAR
#undef PG8_SCHED
}
}

__device__ __forceinline__ void rmsnorm_rows(const float* src, const float* gain, bf16_t* dst, int gw, int nw, int lane) {
    for (int row = gw; row < NT; row += nw) {
        const f32x4* s = (const f32x4*)(src + (size_t)row * DM);
        f32x4 v[8]; float ss = 0.f;
#pragma unroll
        for (int i = 0; i < 8; ++i) { v[i] = s[i * 64 + lane]; ss += v[i][0] * v[i][0] + v[i][1] * v[i][1] + v[i][2] * v[i][2] + v[i][3] * v[i][3]; }
        ss = wave_sum(ss);
        const float r = rsqrtf(ss * (1.f / DM) + 1e-6f);
        u32x2* d = (u32x2*)(dst + (size_t)row * DM);
#pragma unroll
        for (int i = 0; i < 8; ++i) { const f32x4 gg = ((const f32x4*)gain)[i * 64 + lane]; u32x2 o; o.x = cvt_pk_bf16(v[i][0] * r * gg[0], v[i][1] * r * gg[1]); o.y = cvt_pk_bf16(v[i][2] * r * gg[2], v[i][3] * r * gg[3]); d[i * 64 + lane] = o; }
    }
}

__device__ __forceinline__ void tr_tile(const float* src, int ld, int c0, int nvalid, int k0, bf16_t* dst, int ldd, int r0, int kd0, LAS float* tile, int lane) {
    f32x4 v[16];
    const int c4 = (lane & 15) * 4, kb = lane >> 4;
#pragma unroll
    for (int i = 0; i < 16; ++i) { v[i] = (f32x4){0.f, 0.f, 0.f, 0.f}; if (c4 < nvalid) v[i] = *(const f32x4*)(src + (size_t)(k0 + kb + 4 * i) * ld + c0 + c4); }
#pragma unroll
    for (int i = 0; i < 16; ++i) { const int k = kb + 4 * i; tile[k * 65 + c4] = v[i][0]; tile[k * 65 + c4 + 1] = v[i][1]; tile[k * 65 + c4 + 2] = v[i][2]; tile[k * 65 + c4 + 3] = v[i][3]; }
#pragma unroll
    for (int i = 0; i < 8; ++i) {
        const int c = (lane >> 3) + 8 * i, k8 = (lane & 7) * 8;
        float f[8];
#pragma unroll
        for (int j = 0; j < 8; ++j) f[j] = tile[(k8 + j) * 65 + c];
        u32x4 w; w.x = cvt_pk_bf16(f[0], f[1]); w.y = cvt_pk_bf16(f[2], f[3]); w.z = cvt_pk_bf16(f[4], f[5]); w.w = cvt_pk_bf16(f[6], f[7]);
        *(u32x4*)(dst + (size_t)(r0 + c) * ldd + kd0 + k8) = w;
    }
}

__device__ void weight_transposes(const KP& p, LAS unsigned char* lds, int j0, int j1, int gw, int nw) {
    const int tid = tid_l(), lane = tid & 63;
    unsigned char* ws = p.ws;
    LAS float* tile = (LAS float*)lds + (tid >> 6) * (64 * 65 + 16);
    for (int j = j0 + gw; j < j1; j += nw) {
        const float* src; bf16_t* dst; int ld = 2048, ldd, c0, nv = 64, rt, kt;
        if (j < 5888) { rt = j >> 5; kt = j & 31; src = p.w_in; ld = 11720; dst = (bf16_t*)(ws + OFF_WINT); ldd = 2048;
            if (rt < 64) c0 = 64 * rt; else if (rt < 119) c0 = 4104 + 64 * (rt - 64); else if (rt == 119) { c0 = 4096; nv = 8; } else c0 = 7624 + 64 * (rt - 120); }
        else if (j < 6400) { const int q = j - 5888; rt = q >> 4; kt = q & 15; src = p.proj_m; dst = (bf16_t*)(ws + OFF_PMT); ldd = 1024; c0 = rt * 64; }
        else if (j < 6912) { const int q = j - 6400; rt = q >> 4; kt = q & 15; src = p.proj_r; dst = (bf16_t*)(ws + OFF_PRT); ldd = 1024; c0 = rt * 64; }
        else if (j < 7936) { const int q = j - 6912; rt = q >> 5; kt = q & 31; src = p.w_out; dst = (bf16_t*)(ws + OFF_WOT); ldd = 2048; c0 = rt * 64; }
        else { const int q = j - 7936; rt = q >> 5; kt = q & 31; src = p.w_query; dst = (bf16_t*)(ws + OFF_WQT); ldd = 2048; c0 = rt * 64; }
        tr_tile(src, ld, c0, nv, kt * 64, dst, ldd, rt * 64, kt * 64, tile, lane);
    }
}

__device__ void phase_prep(const KP& p, LAS unsigned char* lds) {
    const int tid = tid_l(), lane = tid & 63, G = gridDim.x, bid = blockIdx.x;
    unsigned char* ws = p.ws;
    rmsnorm_rows(p.x, p.g_mix, (bf16_t*)(ws + OFF_XN), bid * 8 + (tid >> 6), G * 8, lane);
    weight_transposes(p, lds, 0, 5888, bid * 8 + (tid >> 6), G * 8);
    const int gt = bid_l() * 512 + tid, gn = G * 512;
    bf16_t* WAT = (bf16_t*)(ws + OFF_WAT);
    for (int i = gt; i < 2048 * 256; i += gn) { const int r = i >> 8, k = i & 255; float v = 0.f;
        if (r < 1024) { if (k < 96) v = p.w2[k * 1024 + r]; } else { if (k >= 96 && k < 192) v = p.a2[(k - 96) * 1024 + (r - 1024)]; }
        WAT[i] = f2bf(v); }
    bf16_t* G2T = (bf16_t*)(ws + OFF_G2T);
    for (int i = gt; i < 1024 * 256; i += gn) { const int r = i >> 8, k = i & 255; G2T[i] = f2bf(p.g2[k * 1024 + r]); }
    bf16_t* SK = (bf16_t*)(ws + OFF_SUBK);
    for (int i = gt; i < 2 * 128 * 128; i += gn) SK[i] = f2bf(p.sub_keys[i]);
    if (gt == 0) *(unsigned*)(ws + OFF_SUBBAR) = 0u;
    for (int i = gt; i < XCD_BAR_WORDS; i += gn) ((unsigned*)(ws + OFF_XBAR))[i] = 0u;
}

__device__ __forceinline__ float bfel(const u32x4& w, int e) { const unsigned u = w[e >> 1]; return (e & 1) ? bfhi(u) : bflo(u); }
__device__ void phase_lora_prep(const KP& p) {
    const bf16_t* PR = (const bf16_t*)(p.ws + OFF_PR);
    bf16_t* AL = (bf16_t*)((unsigned char*)p.out + DO_ALORA);
    const int gt = bid_l() * 512 + tid_l(), gn = gridDim.x * 512;
    for (int i = gt; i < NT * 64; i += gn) {
        const int tok = i >> 6, g = i & 63;
        u32x4 o = (u32x4){0u, 0u, 0u, 0u};
        if (g < 24 || g >= 32) {
            const int sc = (g < 24) ? (3072 + 8 * g) : (3264 + 8 * (g - 32));
            const u32x4 cu = *(const u32x4*)(PR + (size_t)tok * LDPR + sc);
            u32x4 pv = (u32x4){0u, 0u, 0u, 0u};
            if ((tok & (SEQ - 1)) != 0) pv = *(const u32x4*)(PR + (size_t)(tok - 1) * LDPR + sc);
            const f32x4 m0 = *(const f32x4*)(p.mu + sc), m1 = *(const f32x4*)(p.mu + sc + 4);
            float f[8];
#pragma unroll
            for (int q = 0; q < 4; ++q) {
                const float c0 = bflo(cu[q]), c1 = bfhi(cu[q]), p0 = bflo(pv[q]), p1 = bfhi(pv[q]);
                const float mm0 = (q < 2) ? m0[2 * q] : m1[2 * q - 4], mm1 = (q < 2) ? m0[2 * q + 1] : m1[2 * q - 3];
                f[2 * q] = c0 + (p0 - c0) * mm0; f[2 * q + 1] = c1 + (p1 - c1) * mm1;
            }
            if (g < 12) {
#pragma unroll
                for (int q = 0; q < 8; ++q) f[q] = tanhf(f[q]);
            } else if (g >= 32) {
#pragma unroll
                for (int q = 0; q < 8; ++q) f[q] = sigm(f[q]);
            }
            o.x = cvt_pk_bf16(f[0], f[1]); o.y = cvt_pk_bf16(f[2], f[3]); o.z = cvt_pk_bf16(f[4], f[5]); o.w = cvt_pk_bf16(f[6], f[7]);
        }
        *(u32x4*)(AL + (size_t)tok * 512 + 8 * g) = o;
    }
    {
        const bf16_t* PM = (const bf16_t*)(p.ws + OFF_PM);
        bf16_t* QC = (bf16_t*)(p.ws + OFF_QC); bf16_t* KC = (bf16_t*)(p.ws + OFF_KC);
        for (int i = gt; i < (NT / 8) * 256; i += gn) {
            const int tb = i >> 8, col = (i & 255) * 8; const int tok0 = tb * 8, t0 = tok0 & (SEQ - 1);
            f32x4 cw[4][2];
#pragma unroll
            for (int j = 0; j < 4; ++j) { cw[j][0] = *(const f32x4*)(p.conv_w + j * 2048 + col); cw[j][1] = *(const f32x4*)(p.conv_w + j * 2048 + col + 4); }
            u32x4 raw[11];
#pragma unroll
            for (int q = 0; q < 11; ++q) { const bool neg = (t0 - 3 + q) < 0; u32x4 v = *(const u32x4*)(PM + (size_t)(tok0 + (neg ? 0 : q - 3)) * LDPM + col); if (neg) v = (u32x4){0u, 0u, 0u, 0u}; raw[q] = v; }
            const float scl = (col < 1024) ? 0.0625f : 1.f;
            bf16_t* dst = (col < 1024) ? (QC + (size_t)tok0 * 1024 + col) : (KC + (size_t)tok0 * 1024 + (col - 1024));
#pragma unroll
            for (int r = 0; r < 8; ++r) {
                float o[8];
#pragma unroll
                for (int e = 0; e < 8; ++e) {
                    const float c0 = (e < 4) ? cw[0][0][e] : cw[0][1][e - 4], c1 = (e < 4) ? cw[1][0][e] : cw[1][1][e - 4], c2 = (e < 4) ? cw[2][0][e] : cw[2][1][e - 4], c3 = (e < 4) ? cw[3][0][e] : cw[3][1][e - 4];
                    float sv = c0 * bfel(raw[r], e) + c1 * bfel(raw[r + 1], e) + c2 * bfel(raw[r + 2], e) + c3 * bfel(raw[r + 3], e);
                    o[e] = sv * sigm(sv) * scl;
                }
                u32x4 pk; pk.x = cvt_pk_bf16(o[0], o[1]); pk.y = cvt_pk_bf16(o[2], o[3]); pk.z = cvt_pk_bf16(o[4], o[5]); pk.w = cvt_pk_bf16(o[6], o[7]);
                *(u32x4*)(dst + (size_t)r * 1024) = pk;
            }
        }
    }
    {
        const int lane = threadIdx.x & 63, gw = blockIdx.x * 8 + (threadIdx.x >> 6), nw = gridDim.x * 8;
        float* GB = (float*)((unsigned char*)p.out + DO_GB); float* GA = (float*)((unsigned char*)p.out + DO_GA); float* GW = (float*)((unsigned char*)p.out + DO_GW);
        for (int task = gw; task < 1024; task += nw) {
            const int bh = task >> 6, c = task & 63, bb = bh >> 2, h = bh & 3; const size_t tok = (size_t)bb * SEQ + c * 64 + lane;
            const float iv = bf2f(PR[tok * LDPR + 3520 + h]) + p.b_i[h], fv = bf2f(PR[tok * LDPR + 3524 + h]) + p.b_f[h];
            float lf = fminf(fv, 0.f) - __logf(1.f + __expf(-fabsf(fv)));
#pragma unroll
            for (int d = 1; d < 64; d <<= 1) { const float y = __shfl_up(lf, d); if (lane >= d) lf += y; }
            const float bl = rlane(lf, 63);
            const int o = bh * SEQ + c * 64 + lane;
            GB[o] = lf; GA[o] = iv - lf; GW[o] = __expf(bl - lf + iv);
        }
    }
}

constexpr size_t OFF_YRAW = OFF_WINT, OFF_BON = OFF_WINT + 32 * MiB;
struct RwOps { f32x4 a0, q0, w0, b0, k0; f32x2_t vA, vB; float br, kr; };
__device__ __forceinline__ f32x2_t lo2(f32x4 v) { return __builtin_shufflevector(v, v, 0, 1); }
__device__ __forceinline__ f32x2_t hi2(f32x4 v) { return __builtin_shufflevector(v, v, 2, 3); }
__device__ __forceinline__ f32x2_t fma2(f32x2_t a, f32x2_t b, f32x2_t c) { return __builtin_elementwise_fma(a, b, c); }
__device__ void rwkv_scan(const KP& p, int blk, LAS unsigned char* lds) {
    const int tid0 = tid_l();
    const int bh = blk >> 1, half = blk & 1, b = bh >> 4, h = bh & 15;
    constexpr int BUFB = 61952;
    const bf16_t* PR = (const bf16_t*)(p.ws + OFF_PR);
    const bf16_t* WLOG = (const bf16_t*)((const unsigned char*)p.out + DO_WLOG);
    const bf16_t* AG = (const bf16_t*)((const unsigned char*)p.out + DO_AG);
    bf16_t* YRAW = (bf16_t*)(p.ws + OFF_YRAW); float* BON = (float*)(p.ws + OFF_BON);
    const size_t tokbase = (size_t)b * SEQ;
    if (tid0 < 256) {
        const int wv = tid0 >> 6, pi = (tid0 >> 4) & 3, j4 = (tid0 & 15) * 4;
        const int rlA = 8 * wv + pi, rlB = rlA + 4, rowA = 32 * half + rlA, rowB = 32 * half + rlB;
        f32x2_t A0 = (f32x2_t){0.f, 0.f}, A1 = A0, B0 = A0, B1 = A0;
        __syncthreads();
        for (int c = 0; c < 128; ++c) {
            const LAS float* bp = (const LAS float*)(lds + (c & 1) * BUFB);
            LAS float* yb = (LAS float*)(lds + (c & 1) * BUFB + 57600);
#define RW_LD(O, s) do { const LAS float* q_ = bp + (s) * 64 + j4; O.a0 = *(const LAS f32x4*)(q_); O.b0 = *(const LAS f32x4*)(q_ + 2048); O.w0 = *(const LAS f32x4*)(q_ + 4096); O.k0 = *(const LAS f32x4*)(q_ + 6144); \
            O.q0 = *(const LAS f32x4*)(q_ + 8192); O.vA = *(const LAS f32x2_t*)(bp + 10240 + ((s) * 64 + rowA) * 2); O.vB = *(const LAS f32x2_t*)(bp + 10240 + ((s) * 64 + rowB) * 2); O.br = bp[14336 + (s)]; O.kr = bp[14368 + (s)]; } while (0)
#define RW_STEP(O, s) do { \
            f32x2_t paA = A0 * lo2(O.a0), pyA = A0 * lo2(O.q0), paB = B0 * lo2(O.a0), pyB = B0 * lo2(O.q0); \
            paA = fma2(A1, hi2(O.a0), paA); pyA = fma2(A1, hi2(O.q0), pyA); paB = fma2(B1, hi2(O.a0), paB); pyB = fma2(B1, hi2(O.q0), pyB); \
            float saA = paA.x + paA.y, yyA = pyA.x + pyA.y, saB = paB.x + paB.y, yyB = pyB.x + pyB.y; \
            saA += dppf<0xB1>(saA); saB += dppf<0xB1>(saB); yyA += dppf<0xB1>(yyA); yyB += dppf<0xB1>(yyB); \
            saA += dppf<0x4E>(saA); saB += dppf<0x4E>(saB); yyA += dppf<0x4E>(yyA); yyB += dppf<0x4E>(yyB); \
            saA += dppf<0x141>(saA); saB += dppf<0x141>(saB); yyA += dppf<0x141>(yyA); yyB += dppf<0x141>(yyB); \
            saA += dppf<0x140>(saA); saB += dppf<0x140>(saB); yyA += dppf<0x140>(yyA); yyB += dppf<0x140>(yyB); \
            const f32x2_t sA2 = (f32x2_t){saA, saA}, vA2 = O.vA, sB2 = (f32x2_t){saB, saB}, vB2 = O.vB; \
            A0 = fma2(A0, lo2(O.w0), fma2(vA2, lo2(O.k0), sA2 * lo2(O.b0))); A1 = fma2(A1, hi2(O.w0), fma2(vA2, hi2(O.k0), sA2 * hi2(O.b0))); \
            B0 = fma2(B0, lo2(O.w0), fma2(vB2, lo2(O.k0), sB2 * lo2(O.b0))); B1 = fma2(B1, hi2(O.w0), fma2(vB2, hi2(O.k0), sB2 * hi2(O.b0))); \
            if ((tid0 & 15) == 0) { yb[(s) * 32 + rlA] = yyA + saA * O.br + O.vA.x * O.kr; yb[(s) * 32 + rlB] = yyB + saB * O.br + O.vB.x * O.kr; } } while (0)
            RwOps o[3];
            RW_LD(o[0], 0); RW_LD(o[1], 1);
#pragma unroll
            for (int s = 0; s < 32; ++s) {
                if (s + 2 < 32) RW_LD(o[(s + 2) % 3], s + 2);
                RW_STEP(o[s % 3], s);
            }
#undef RW_LD
#undef RW_STEP
            __syncthreads();
        }
    } else {
        const int ht = tid0 - 256, tt = ht >> 3, cg8 = (ht & 7) * 8, ch = h * 64 + cg8;
        float mur[8], muk[8], muv[8], kkc[8], kac[8], rkc[8];
#pragma unroll
        for (int e = 0; e < 8; ++e) { mur[e] = p.mu[ch + e]; muk[e] = p.mu[1024 + ch + e]; muv[e] = p.mu[2048 + ch + e]; kkc[e] = p.k_k[ch + e]; kac[e] = p.k_a[ch + e]; rkc[e] = p.r_k[ch + e]; }
        u32x4 r4, k4, v4, pr4, pk4, pv4, w4, a4;
#define RWH_LOAD(cn_) do { const int t_ = (cn_) * 32 + tt; const size_t tok_ = tokbase + t_; const bf16_t* pr_ = PR + tok_ * LDPR + ch; \
            r4 = *(const u32x4*)pr_; k4 = *(const u32x4*)(pr_ + 1024); v4 = *(const u32x4*)(pr_ + 2048); \
            pr4 = (u32x4){0u, 0u, 0u, 0u}; pk4 = pr4; pv4 = pr4; \
            if (t_ > 0) { pr4 = *(const u32x4*)(pr_ - LDPR); pk4 = *(const u32x4*)(pr_ - LDPR + 1024); pv4 = *(const u32x4*)(pr_ - LDPR + 2048); } \
            w4 = *(const u32x4*)(WLOG + tok_ * 1024 + ch); a4 = *(const u32x4*)(AG + tok_ * 1024 + ch); } while (0)
        RWH_LOAD(0);
        for (int c = -1; c < 128; ++c) {
            if (c >= 1) {
                const LAS float* yb = (const LAS float*)(lds + ((c - 1) & 1) * BUFB + 57600);
                const int r4 = (ht & 7) * 4; const f32x4 y4 = *(const LAS f32x4*)(yb + tt * 32 + r4);
                u32x2 ov; ov.x = cvt_pk_bf16(y4[0], y4[1]); ov.y = cvt_pk_bf16(y4[2], y4[3]);
                *(u32x2*)(YRAW + (tokbase + (size_t)(c - 1) * 32 + tt) * 1024 + h * 64 + 32 * half + r4) = ov;
            }
            if (c + 1 < 128) {
                const int cn = c + 1; const size_t tok = tokbase + cn * 32 + tt;
                LAS float* bp = (LAS float*)(lds + (cn & 1) * BUFB);
                float r[8], k[8], v[8], kk[8], av[8], dec[8];
                float n2 = 0.f;
#pragma unroll
                for (int e = 0; e < 8; ++e) {
                    const float rc = bfel(r4, e), kc = bfel(k4, e), vc = bfel(v4, e);
                    r[e] = rc + (bfel(pr4, e) - rc) * mur[e]; k[e] = kc + (bfel(pk4, e) - kc) * muk[e]; v[e] = vc + (bfel(pv4, e) - vc) * muv[e];
                    kk[e] = k[e] * kkc[e]; n2 += kk[e] * kk[e]; av[e] = bfel(a4, e); dec[e] = __expf(bfel(w4, e));
                }
                n2 = red8(n2);
                const float inv = 1.f / fmaxf(sqrtf(n2), 1e-12f);
                float br = 0.f, kr = 0.f, bon = 0.f;
                f32x4 oa[2], ob[2], ow[2], ok[2], oq[2], ovv[2];
#pragma unroll
                for (int e = 0; e < 8; ++e) {
                    const float kn = kk[e] * inv, k3 = k[e] * (1.f + (av[e] - 1.f) * kac[e]), bb = kn * av[e];
                    oa[e >> 2][e & 3] = -kn; ob[e >> 2][e & 3] = bb; ow[e >> 2][e & 3] = dec[e]; ok[e >> 2][e & 3] = k3; oq[e >> 2][e & 3] = dec[e] * r[e]; ovv[e >> 2][e & 3] = v[e];
                    br += bb * r[e]; kr += k3 * r[e]; bon += r[e] * k3 * rkc[e];
                }
                br = red8(br); kr = red8(kr); bon = red8(bon);
                LAS float* q_ = bp + tt * 64 + cg8;
#pragma unroll
                for (int i = 0; i < 2; ++i) { *(LAS f32x4*)(q_ + 4 * i) = oa[i]; *(LAS f32x4*)(q_ + 2048 + 4 * i) = ob[i]; *(LAS f32x4*)(q_ + 4096 + 4 * i) = ow[i]; *(LAS f32x4*)(q_ + 6144 + 4 * i) = ok[i];
                    *(LAS f32x4*)(q_ + 8192 + 4 * i) = oq[i];
                    *(LAS f32x4*)(bp + 10240 + (tt * 64 + cg8 + 4 * i) * 2) = (f32x4){ovv[i][0], ovv[i][0], ovv[i][1], ovv[i][1]}; *(LAS f32x4*)(bp + 10240 + (tt * 64 + cg8 + 4 * i + 2) * 2) = (f32x4){ovv[i][2], ovv[i][2], ovv[i][3], ovv[i][3]}; }
                if ((ht & 7) == 0) { bp[14336 + tt] = br; bp[14368 + tt] = kr; if (half == 0) BON[tok * 16 + h] = bon; }
                if (cn + 1 < 128) RWH_LOAD(cn + 1);
            }
            __syncthreads();
        }
        {
            const LAS float* yb = (const LAS float*)(lds + (127 & 1) * BUFB + 57600);
            const int r4 = (ht & 7) * 4; const f32x4 y4 = *(const LAS f32x4*)(yb + tt * 32 + r4);
            u32x2 ov; ov.x = cvt_pk_bf16(y4[0], y4[1]); ov.y = cvt_pk_bf16(y4[2], y4[3]);
            *(u32x2*)(YRAW + (tokbase + (size_t)127 * 32 + tt) * 1024 + h * 64 + 32 * half + r4) = ov;
        }
    }
}

#undef RWH_LOAD
__device__ void phase_rwkv_post(const KP& p) {
    const bf16_t* PR = (const bf16_t*)(p.ws + OFF_PR);
    const bf16_t* GG = (const bf16_t*)((const unsigned char*)p.out + DO_GG);
    bf16_t* YR = (bf16_t*)(p.ws + OFF_YRAW); const float* BON = (const float*)(p.ws + OFF_BON);
    const int gt = bid_l() * 512 + tid_l(), gn = gridDim.x * 512;
    for (int i = gt; i < NT * 256; i += gn) {
        const int tok = i >> 8, h = (i >> 4) & 15, ch = h * 64 + (i & 15) * 4;
        const u32x2 y2 = *(const u32x2*)(YR + (size_t)tok * 1024 + ch), v2 = *(const u32x2*)(PR + (size_t)tok * LDPR + 2048 + ch), g2 = *(const u32x2*)(GG + (size_t)tok * 1024 + ch);
        u32x2 pv2 = (u32x2){0u, 0u};
        if ((tok & (SEQ - 1)) != 0) pv2 = *(const u32x2*)(PR + (size_t)(tok - 1) * LDPR + 2048 + ch);
        const float bon = BON[tok * 16 + h];
        const f32x4 muv = *(const f32x4*)(p.mu + 2048 + ch), lnw = *(const f32x4*)(p.ln_w + ch), lnb = *(const f32x4*)(p.ln_b + ch);
        const f32x4 y = (f32x4){bflo(y2.x), bfhi(y2.x), bflo(y2.y), bfhi(y2.y)}, vc = (f32x4){bflo(v2.x), bfhi(v2.x), bflo(v2.y), bfhi(v2.y)}, vp = (f32x4){bflo(pv2.x), bfhi(pv2.x), bflo(pv2.y), bfhi(pv2.y)};
        const f32x4 g = (f32x4){bflo(g2.x), bfhi(g2.x), bflo(g2.y), bfhi(g2.y)};
        const f32x4 v = vc + (vp - vc) * muv;
        const float mean = red16(y[0] + y[1] + y[2] + y[3]) * (1.f / 64.f);
        const f32x4 d = y - mean;
        const float var = red16(d[0] * d[0] + d[1] * d[1] + d[2] * d[2] + d[3] * d[3]) * (1.f / 64.f);
        const float rs = rsqrtf(var + 64e-5f);
        const f32x4 res = (d * rs * lnw + lnb + bon * v) * g;
        u32x2 ov; ov.x = cvt_pk_bf16(res[0], res[1]); ov.y = cvt_pk_bf16(res[2], res[3]);
        *(u32x2*)(YR + (size_t)tok * 1024 + ch) = ov;
    }
}

typedef short v4i16_t __attribute__((ext_vector_type(4)));
__device__ __forceinline__ bf16x8 tr_frag(const LAS unsigned char* base, int stride_b, int krow0, int ncol0, int lane) {
    const int g = lane >> 4, q = (lane & 15) >> 2, pp = lane & 3;
    const LAS unsigned char* a0 = base + (krow0 + 8 * g + q) * stride_b + (ncol0 + 4 * pp) * 2;
    const v4i16_t x = __builtin_amdgcn_ds_read_tr16_b64_v4i16((LAS v4i16_t*)a0), y = __builtin_amdgcn_ds_read_tr16_b64_v4i16((LAS v4i16_t*)(a0 + 4 * stride_b));
    return (bf16x8){x[0], x[1], x[2], x[3], y[0], y[1], y[2], y[3]};
}
__device__ void mlstm_run(const KP& p, int item, LAS unsigned char* lds) {
    const int tid0 = tid_l();
    const int bh = item >> 3, b = bh >> 2, h = bh & 3, dv0 = (item & 7) * 32;
    const size_t tokbase = (size_t)b * SEQ;
    LAS bf16_t* Qs = (LAS bf16_t*)(lds + 0);
    LAS bf16_t* Ks = (LAS bf16_t*)(lds + 33792);
    LAS bf16_t* Vs = (LAS bf16_t*)(lds + 67584);
    LAS bf16_t* Vws = (LAS bf16_t*)(lds + 74752);
    LAS bf16_t* Ss = (LAS bf16_t*)(lds + 81920);
    LAS bf16_t* CT0 = (LAS bf16_t*)(lds + 91136);
    LAS bf16_t* Os = (LAS bf16_t*)(lds + 141824);
    LAS float* BC = (LAS float*)(lds + 146944);
    LAS float* GAs = (LAS float*)(lds + 147200);
    const bf16_t* QC = (const bf16_t*)(p.ws + OFF_QC); const bf16_t* KC = (const bf16_t*)(p.ws + OFF_KC);
    bf16_t* PM = (bf16_t*)(p.ws + OFF_PM);
    const float* GB = (const float*)((const unsigned char*)p.out + DO_GB); const float* GA = (const float*)((const unsigned char*)p.out + DO_GA); const float* GW = (const float*)((const unsigned char*)p.out + DO_GW);
    for (int i = tid0; i < 2 * 48 * 264 / 2; i += 512) ((LAS unsigned*)CT0)[i] = 0u;
    for (int i = tid0; i < 2 * 64 * 56 / 2; i += 512) ((LAS unsigned*)Vs)[i] = 0u;
    __syncthreads();
    if (tid0 < 64) Vs[tid0 * 56 + 32] = (bf16_t)0x3F80;
    f32x4 cacc[6];
#pragma unroll
    for (int i = 0; i < 6; ++i) cacc[i] = (f32x4){0.f, 0.f, 0.f, 0.f};
    u32x4 q4[4], k4[4], vo4; float gb = 0.f, ga = 0.f, gwv = 0.f;
#define ML_LOAD(c, TID) do { const int row_ = (TID) >> 3, pc_ = (TID) & 7; const size_t tk_ = tokbase + (size_t)(c) * 64; \
        const bf16_t* qp_ = QC + (tk_ + row_) * 1024 + h * 256 + pc_ * 32; const bf16_t* kp_ = KC + (tk_ + row_) * 1024 + h * 256 + pc_ * 32; \
        _Pragma("unroll") for (int i_ = 0; i_ < 4; ++i_) { q4[i_] = *(const u32x4*)(qp_ + 8 * i_); k4[i_] = *(const u32x4*)(kp_ + 8 * i_); } \
        const int sg_ = (TID) & 255, s_ = sg_ >> 2, g_ = sg_ & 3; \
        vo4 = *(const u32x4*)(PM + (tk_ + s_) * LDPM + ((TID) < 256 ? 2048 : 3072) + h * 256 + dv0 + 8 * g_); \
        gwv = GW[bh * SEQ + (c) * 64 + s_]; \
        if ((TID) < 64) { gb = GB[bh * SEQ + (c) * 64 + (TID)]; ga = GA[bh * SEQ + (c) * 64 + (TID)]; } } while (0)
    ML_LOAD(0, tid0);
    __syncthreads();
    int cur = 0;
    for (int c = 0; c < 64; ++c) {
        int tid = tid0; asm volatile("" : "+v"(tid));
        const int lane = tid & 63, w = tid >> 6, fr = lane & 15, fq = lane >> 4;
        LAS bf16_t* CTc = CT0 + cur * (48 * 264); LAS bf16_t* CTn = CT0 + (cur ^ 1) * (48 * 264);
        {
            const int row = tid >> 3, pc = tid & 7;
#pragma unroll
            for (int i = 0; i < 4; ++i) { *(LAS u32x4*)(Qs + row * 264 + pc * 32 + 8 * i) = q4[i]; *(LAS u32x4*)(Ks + row * 264 + pc * 32 + 8 * i) = k4[i]; }
            const int sg = tid & 255, s = sg >> 2, g = sg & 3;
            if (tid < 256) {
                *(LAS u32x4*)(Vs + s * 56 + 8 * g) = vo4;
                u32x4 wv;
#pragma unroll
                for (int e = 0; e < 4; ++e) wv[e] = cvt_pk_bf16(bflo(vo4[e]) * gwv, bfhi(vo4[e]) * gwv);
                *(LAS u32x4*)(Vws + s * 56 + 8 * g) = wv;
                if (g == 0) Vws[s * 56 + 32] = f2bf(gwv);
            } else {
                if (c > 0) { const u32x4 yv = *(const LAS u32x4*)(Os + s * 40 + 8 * g); *(u32x4*)(PM + (tokbase + (size_t)(c - 1) * 64 + s) * LDPM + 3072 + h * 256 + dv0 + 8 * g) = yv; }
                *(LAS u32x4*)(Os + s * 40 + 8 * g) = vo4;
            }
            if (tid < 64) { BC[tid] = gb; GAs[tid] = ga; }
        }
        asm volatile("" ::: "memory");
        if (c + 1 < 64) ML_LOAD(c + 1, tid);
        asm volatile("" ::: "memory");
        __syncthreads();
        {
            const int mt = w >> 1, ntb = (w & 1) * 2;
            f32x4 s0 = (f32x4){0.f, 0.f, 0.f, 0.f}, s1 = s0;
#pragma unroll
            for (int ks = 0; ks < 8; ++ks) {
                const bf16x8 a = *(const LAS bf16x8*)(Qs + (16 * mt + fr) * 264 + 32 * ks + 8 * fq);
                const bf16x8 b0 = *(const LAS bf16x8*)(Ks + (16 * ntb + fr) * 264 + 32 * ks + 8 * fq);
                const bf16x8 b1 = *(const LAS bf16x8*)(Ks + (16 * (ntb + 1) + fr) * 264 + 32 * ks + 8 * fq);
                s0 = __builtin_amdgcn_mfma_f32_16x16x32_bf16(a, b0, s0, 0, 0, 0);
                s1 = __builtin_amdgcn_mfma_f32_16x16x32_bf16(a, b1, s1, 0, 0, 0);
            }
            const int sA = 16 * ntb + fr, sB = sA + 16;
            const float gA = GAs[sA], gB = GAs[sB];
#pragma unroll
            for (int j = 0; j < 4; ++j) {
                const int t = 16 * mt + 4 * fq + j; const float bt = BC[t];
                const float vA = (sA <= t) ? s0[j] * __expf(bt + gA) : 0.f, vB = (sB <= t) ? s1[j] * __expf(bt + gB) : 0.f;
                Ss[t * 72 + sA] = f2bf(vA); Ss[t * 72 + sB] = f2bf(vB);
            }
        }
        __syncthreads();
        {
            const int mt = w >> 1, nt = w & 1;
            f32x4 aA = (f32x4){0.f, 0.f, 0.f, 0.f}, aB = aA, xA = aA, xB = aA;
#pragma unroll
            for (int ks = 0; ks < 2; ++ks) {
                const bf16x8 a = *(const LAS bf16x8*)(Ss + (16 * mt + fr) * 72 + 32 * ks + 8 * fq);
                const bf16x8 bm = tr_frag((const LAS unsigned char*)Vs, 112, 32 * ks, 16 * nt, lane);
                const bf16x8 bx = tr_frag((const LAS unsigned char*)Vs, 112, 32 * ks, 32, lane);
                aA = __builtin_amdgcn_mfma_f32_16x16x32_bf16(a, bm, aA, 0, 0, 0);
                xA = __builtin_amdgcn_mfma_f32_16x16x32_bf16(a, bx, xA, 0, 0, 0);
            }
#pragma unroll
            for (int ks = 0; ks < 8; ++ks) {
                const bf16x8 a = *(const LAS bf16x8*)(Qs + (16 * mt + fr) * 264 + 32 * ks + 8 * fq);
                const bf16x8 bm = *(const LAS bf16x8*)(CTc + (16 * nt + fr) * 264 + 32 * ks + 8 * fq);
                const bf16x8 bx = *(const LAS bf16x8*)(CTc + (32 + fr) * 264 + 32 * ks + 8 * fq);
                aB = __builtin_amdgcn_mfma_f32_16x16x32_bf16(a, bm, aB, 0, 0, 0);
                xB = __builtin_amdgcn_mfma_f32_16x16x32_bf16(a, bx, xB, 0, 0, 0);
            }
#pragma unroll
            for (int j = 0; j < 4; ++j) {
                const int t = 16 * mt + 4 * fq + j; const float eb = __expf(BC[t]);
                const float num = aA[j] + eb * aB[j];
                const float den = __shfl(xA[j] + eb * xB[j], lane & 48);
                const float hv = num / fmaxf(fabsf(den), 1.f);
                LAS bf16_t* op = Os + t * 40 + 16 * nt + fr;
                *op = f2bf(hv * sigm(bf2f(*op)));
            }
            const float decay = __expf(BC[63]);
            bf16x8 bw[3][2];
#pragma unroll
            for (int n3 = 0; n3 < 3; ++n3)
#pragma unroll
                for (int ks = 0; ks < 2; ++ks) bw[n3][ks] = tr_frag((const LAS unsigned char*)Vws, 112, 32 * ks, 16 * n3, lane);
#pragma unroll
            for (int m2 = 0; m2 < 2; ++m2) {
                const int mtk = 2 * w + m2;
                const bf16x8 ka0 = tr_frag((const LAS unsigned char*)Ks, 528, 0, 16 * mtk, lane), ka1 = tr_frag((const LAS unsigned char*)Ks, 528, 32, 16 * mtk, lane);
#pragma unroll
                for (int n3 = 0; n3 < 3; ++n3) {
                    f32x4 cc = cacc[m2 * 3 + n3] * decay;
                    cc = __builtin_amdgcn_mfma_f32_16x16x32_bf16(ka0, bw[n3][0], cc, 0, 0, 0);
                    cc = __builtin_amdgcn_mfma_f32_16x16x32_bf16(ka1, bw[n3][1], cc, 0, 0, 0);
                    cacc[m2 * 3 + n3] = cc;
                    u32x2 pk; pk.x = cvt_pk_bf16(cc[0], cc[1]); pk.y = cvt_pk_bf16(cc[2], cc[3]);
                    *(LAS u32x2*)(CTn + (16 * n3 + fr) * 264 + 16 * mtk + 4 * fq) = pk;
                }
            }
        }
        cur ^= 1;
        __syncthreads();
    }
    if (tid0 >= 256) { const int sg = tid0 & 255, s = sg >> 2, g = sg & 3; const u32x4 yv = *(const LAS u32x4*)(Os + s * 40 + 8 * g);
        *(u32x4*)(PM + (tokbase + (size_t)63 * 64 + s) * LDPM + 3072 + h * 256 + dv0 + 8 * g) = yv; }
#undef ML_LOAD
}

__device__ void phase_norm2(const KP& p) {
    const int tid = tid_l(), lane = tid & 63, G = gridDim.x, bid = blockIdx.x;
    rmsnorm_rows(p.out, p.g_ffn, (bf16_t*)(p.ws + OFF_XN2), bid * 8 + (tid >> 6), G * 8, lane);
}
typedef float v16f_t __attribute__((ext_vector_type(16)));
typedef float v32f_t __attribute__((ext_vector_type(32)));
typedef unsigned v6u_t __attribute__((ext_vector_type(6)));
__device__ void convert_tables(const KP& p, int gw, int nw) {
    const int lane = tid_l() & 63;
    for (int tb = 0; tb < 2; ++tb) {
        const float* src = tb ? p.peer_v : p.peer_u; unsigned char* dst = p.ws + (tb ? OFF_PV : OFF_PU); float* sc = (float*)(p.ws + (tb ? OFF_SCV : OFF_SCU));
        for (int row = gw; row < 16384; row += nw) {
            const float* sp = src + (size_t)row * DM + lane * 32;
            f32x4 v[8]; float am = 0.f;
#pragma unroll
            for (int q = 0; q < 8; ++q) { v[q] = *(const f32x4*)(sp + q * 4);
                am = fmaxf(am, fmaxf(fmaxf(fabsf(v[q][0]), fabsf(v[q][1])), fmaxf(fabsf(v[q][2]), fabsf(v[q][3])))); }
            const unsigned amu = wave_max_u32(__float_as_uint(am));
            const float amax = __uint_as_float(amu);
            float scl = 1.f;
            if (amax > 0.f) scl = exp2f(floorf(log2f(7.5f / amax)));
            if (lane == 0) sc[row] = 1.f / scl;
            v16f_t xa, xb;
#pragma unroll
            for (int q = 0; q < 4; ++q)
#pragma unroll
                for (int j = 0; j < 4; ++j) { xa[q * 4 + j] = v[q][j] * scl; xb[q * 4 + j] = v[4 + q][j] * scl; }
            const v6u_t pk = __builtin_amdgcn_cvt_scalef32_2xpk16_fp6_f32(xa, xb, 1.0f);
            unsigned char* dp = dst + (size_t)row * 8192 + lane * 8;
#pragma unroll
            for (int k = 0; k < 3; ++k) { u32x2 o; o.x = pk[2 * k]; o.y = pk[2 * k + 1]; *(u32x2*)(dp + k * 512) = o; }
        }
    }
}

__device__ __forceinline__ float gelu_erf(float v) {
    const float av = fabsf(v), t = __builtin_amdgcn_rcpf(av * 0.2316418882f + 1.0f);
    float q = t * 0.5307027145f + (-0.7265760135f); q = q * t + 0.7107068705f; q = q * t + (-0.142248368f); q = q * t + 0.127414796f; q = q * t;
    const float m = v * (q * __builtin_amdgcn_exp2f((v * v) * (-0.72134752044f)));
    return v < 0.f ? m : v - m;
}
__device__ void phase_peer(const KP& p, LAS unsigned char* lds) {
    const int tid = tid_l(), lane = tid & 63, w = tid >> 6, fr = lane & 15, fq = lane >> 4;
    LAS unsigned* KEYS = (LAS unsigned*)lds;
    LAS int* TI = (LAS int*)(lds + 32768);
    LAS float* TG = (LAS float*)(lds + 49152);
    const bf16_t* Q = (const bf16_t*)(p.ws + OFF_Q);
    const bf16_t* SK = (const bf16_t*)(p.ws + OFF_SUBK);
    const bf16_t* XN2 = (const bf16_t*)(p.ws + OFF_XN2);
    const unsigned char* PU = p.ws + OFF_PU; const unsigned char* PV = p.ws + OFF_PV;
    const float* SCU = (const float*)(p.ws + OFF_SCU); const float* SCV = (const float*)(p.ws + OFF_SCV);
    float* out = p.out;
    LAS int* IJ = (LAS int*)(lds + 65536);
    if (w == 0 && fq == 0) {
#pragma unroll
        for (int m = 0; m < 4; ++m) { const int e = m * 16 + fr; int i = 0, base = 0;
            for (; i < 16; ++i) { const int cnt = 16 / (i + 1); if (e < base + cnt) break; base += cnt; }
            IJ[e] = (i < 16) ? i * 16 + (e - base) : 0; }
    }
    __syncthreads();
    LAS int* PERM = (LAS int*)(lds + 65792);
    {
        v16f_t ta, tb;
#pragma unroll
        for (int i = 0; i < 16; ++i) { ta[i] = 0.125f * i; tb[i] = (i < 8) ? 2.f + 0.25f * i : 4.f + 0.5f * (i - 8); }
        const v6u_t pk = __builtin_amdgcn_cvt_scalef32_2xpk16_fp6_f32(ta, tb, 1.0f);
        const v32f_t un = __builtin_amdgcn_cvt_scalef32_pk32_f32_fp6(pk, 1.0f);
#pragma unroll
        for (int m = 0; m < 32; ++m) { const float val = un[m]; const float c = val < 2.f ? val * 8.f : (val < 4.f ? 16.f + (val - 2.f) * 4.f : 24.f + (val - 4.f) * 2.f);
            if (tid == 0) PERM[m] = ((int)(c + 0.5f) & 31); }
    }
    __syncthreads();
    for (int tile = blockIdx.x; tile < NT / 32; tile += gridDim.x) {
        const int tk0 = tile * 32;
        int tl_ = tid; asm volatile("" : "+v"(tl_));
        const int lane = tl_ & 63, w = tl_ >> 6, fr = lane & 15, fq = lane >> 4;
        const int pp_ = w >> 2, ntb = (w & 3) * 2;
        LAS float* xs = (LAS float*)(lds + 66048) + w * 2048;
        bf16x8 bfr[2][4];
#pragma unroll
        for (int n = 0; n < 2; ++n)
#pragma unroll
            for (int ks = 0; ks < 4; ++ks) bfr[n][ks] = *(const bf16x8*)(SK + (size_t)(pp_ * 128 + 16 * (ntb + n) + fr) * 128 + 32 * ks + 8 * fq);
        bf16x8 afn[2][4];
#pragma unroll
        for (int mt = 0; mt < 2; ++mt)
#pragma unroll
            for (int ks = 0; ks < 4; ++ks) afn[mt][ks] = *(const bf16x8*)(Q + (size_t)(tk0 + 16 * mt + fr) * DM + pp_ * 128 + 32 * ks + 8 * fq);
        for (int h = 0; h < 8; ++h) {
            {
                bf16x8 af[2][4];
#pragma unroll
                for (int mt = 0; mt < 2; ++mt)
#pragma unroll
                    for (int ks = 0; ks < 4; ++ks) af[mt][ks] = afn[mt][ks];
                if (h + 1 < 8) {
#pragma unroll
                    for (int mt = 0; mt < 2; ++mt)
#pragma unroll
                        for (int ks = 0; ks < 4; ++ks) afn[mt][ks] = *(const bf16x8*)(Q + (size_t)(tk0 + 16 * mt + fr) * DM + (h + 1) * 256 + pp_ * 128 + 32 * ks + 8 * fq);
                }
                f32x4 acc[2][2];
#pragma unroll
                for (int a_ = 0; a_ < 2; ++a_)
#pragma unroll
                    for (int b_ = 0; b_ < 2; ++b_) acc[a_][b_] = (f32x4){0.f, 0.f, 0.f, 0.f};
#pragma unroll
                for (int ks = 0; ks < 4; ++ks)
#pragma unroll
                    for (int mt = 0; mt < 2; ++mt)
#pragma unroll
                        for (int n = 0; n < 2; ++n) acc[mt][n] = __builtin_amdgcn_mfma_f32_16x16x32_bf16(af[mt][ks], bfr[n][ks], acc[mt][n], 0, 0, 0);
#pragma unroll
                for (int mt = 0; mt < 2; ++mt)
#pragma unroll
                    for (int n = 0; n < 2; ++n)
#pragma unroll
                        for (int j = 0; j < 4; ++j) { const int tokl = 16 * mt + 4 * fq + j, key = 16 * (ntb + n) + fr;
                            KEYS[(tokl * 2 + pp_) * 128 + key] = (ordf(acc[mt][n][j]) & ~0x7Fu) | (unsigned)key; }
            }
            __syncthreads();
            {
                const int tokl = 4 * w + fq, rb = lane & 48;
                unsigned top[2];
#pragma unroll
                for (int pp = 0; pp < 2; ++pp) {
                    unsigned kx[8];
#pragma unroll
                    for (int m = 0; m < 8; ++m) kx[m] = KEYS[(tokl * 2 + pp) * 128 + fr + 16 * m];
                    unsigned tp = 0u;
                    for (int it = 0; it < 16; ++it) {
                        unsigned M = max(max(max(kx[0], kx[1]), max(kx[2], kx[3])), max(max(kx[4], kx[5]), max(kx[6], kx[7])));
                        M = max(M, dppu<0xB1>(M)); M = max(M, dppu<0x4E>(M)); M = max(M, dppu<0x141>(M)); M = max(M, dppu<0x140>(M));
                        if (fr == it) tp = M;
#pragma unroll
                        for (int m = 0; m < 8; ++m) kx[m] = (kx[m] == M) ? 0u : kx[m];
                    }
                    top[pp] = tp;
                }
                unsigned cnd[4];
#pragma unroll
                for (int m = 0; m < 4; ++m) {
                    const int ij_ = IJ[m * 16 + fr];
                    const float v1 = unordf((unsigned)__shfl((int)top[0], rb + (ij_ >> 4)) & ~0x7Fu), v2 = unordf((unsigned)__shfl((int)top[1], rb + (ij_ & 15)) & ~0x7Fu);
                    cnd[m] = (m * 16 + fr < 50) ? ((ordf(v1 + v2) & ~0x3Fu) | (unsigned)(m * 16 + fr)) : 0u;
                }
                unsigned best = 0u;
                for (int it = 0; it < 16; ++it) {
                    unsigned M = max(max(cnd[0], cnd[1]), max(cnd[2], cnd[3]));
                    M = max(M, dppu<0xB1>(M)); M = max(M, dppu<0x4E>(M)); M = max(M, dppu<0x141>(M)); M = max(M, dppu<0x140>(M));
                    if (fr == it) best = M;
#pragma unroll
                    for (int m = 0; m < 4; ++m) cnd[m] = (cnd[m] == M) ? 0u : cnd[m];
                }
                const int ij = IJ[best & 0x3Fu];
                const float bv = unordf(best & ~0x3Fu);
                const int e1 = __shfl((int)top[0], rb + (ij >> 4)) & 0x7F, e2 = __shfl((int)top[1], rb + (ij & 15)) & 0x7F;
                const float mx = __shfl(bv, rb);
                TI[tokl * 128 + h * 16 + fr] = e1 * 128 + e2; TG[tokl * 128 + h * 16 + fr] = bv - mx;
            }
            __syncthreads();
        }
        for (int q = 0; q < 4; ++q) {
            const int tokl = 4 * w + q; const size_t tok = (size_t)tk0 + tokl;
            { const float* hrow = out + tok * DM; f32x4 hr[8]; float ss0 = 0.f;
#pragma unroll
              for (int i = 0; i < 8; ++i) { hr[i] = *(const f32x4*)(hrow + i * 256 + lane * 4); ss0 += hr[i][0] * hr[i][0] + hr[i][1] * hr[i][1] + hr[i][2] * hr[i][2] + hr[i][3] * hr[i][3]; }
              const float rt = rsqrtf(wave_sum(ss0) * (1.f / DM) + 1e-6f);
#pragma unroll
              for (int i = 0; i < 8; ++i) { const f32x4 g0 = *(const f32x4*)(p.g_ffn + i * 256 + lane * 4); *(LAS f32x4*)(xs + i * 256 + lane * 4) = hr[i] * g0 * rt; }
#pragma unroll
              for (int u = 0; u < 2; ++u) { const float ev = __expf(TG[tokl * 128 + u * 64 + lane] * rt); const float sum = red16(ev); TG[tokl * 128 + u * 64 + lane] = ev / sum; } }
            float xv[32], acc[32];
#pragma unroll
            for (int m = 0; m < 32; ++m) { xv[m] = xs[32 * lane + PERM[m]]; acc[m] = 0.f; }
#define PE_ISSUE(E, e_) do { const int ee_ = (e_) < 128 ? (e_) : 127; const int idx_ = __builtin_amdgcn_readfirstlane(TI[tokl * 128 + ee_]); \
                E.gate = __builtin_bit_cast(float, __builtin_amdgcn_readfirstlane(__builtin_bit_cast(int, TG[tokl * 128 + ee_]))); \
                const unsigned char* up_ = PU + (size_t)idx_ * 8192 + lane * 8; \
                E.u0 = *(const u32x2*)up_; E.u1 = *(const u32x2*)(up_ + 512); E.u2 = *(const u32x2*)(up_ + 1024); \
                E.v0 = *(const u32x2*)(up_ + 2048); E.v1 = *(const u32x2*)(up_ + 2560); E.v2 = *(const u32x2*)(up_ + 3072); \
                E.su = SCU[idx_]; E.sv = SCV[idx_]; } while (0)
#define PE_COMPUTE(E) do { \
                const v32f_t uf = __builtin_amdgcn_cvt_scalef32_pk32_f32_fp6((v6u_t){E.u0.x, E.u0.y, E.u1.x, E.u1.y, E.u2.x, E.u2.y}, 1.0f); \
                float d0 = 0.f, d1 = 0.f, d2 = 0.f, d3 = 0.f; \
                _Pragma("unroll") for (int m = 0; m < 8; ++m) { d0 += xv[4 * m] * uf[4 * m]; d1 += xv[4 * m + 1] * uf[4 * m + 1]; d2 += xv[4 * m + 2] * uf[4 * m + 2]; d3 += xv[4 * m + 3] * uf[4 * m + 3]; } \
                const float act = wave_sum((d0 + d1) + (d2 + d3)) * E.su; \
                const float coef = E.gate * gelu_erf(act) * E.sv; \
                const v32f_t vf = __builtin_amdgcn_cvt_scalef32_pk32_f32_fp6((v6u_t){E.v0.x, E.v0.y, E.v1.x, E.v1.y, E.v2.x, E.v2.y}, 1.0f); \
                _Pragma("unroll") for (int m = 0; m < 32; ++m) acc[m] += coef * vf[m]; } while (0)
            {
                struct PeEx { u32x2 u0, u1, u2, v0, v1, v2; float su, sv, gate; };
                PeEx q0, q1;
                PE_ISSUE(q0, 0); PE_ISSUE(q1, 1);
#pragma unroll 1
                for (int e = 0; e < 128; e += 2) {
                    PE_COMPUTE(q0); PE_ISSUE(q0, e + 2);
                    PE_COMPUTE(q1); PE_ISSUE(q1, e + 3);
                }
            }
#undef PE_ISSUE
#undef PE_COMPUTE
#pragma unroll
            for (int m = 0; m < 32; ++m) xs[32 * lane + PERM[m]] = acc[m];
            float ss = 0.f;
            float* orow = out + tok * DM;
#pragma unroll 4
            for (int i = 0; i < 8; ++i) { const f32x4 hv = *(const LAS f32x4*)(xs + i * 256 + lane * 4) + *(const f32x4*)(orow + i * 256 + lane * 4);
                *(LAS f32x4*)(xs + i * 256 + lane * 4) = hv; ss += hv[0] * hv[0] + hv[1] * hv[1] + hv[2] * hv[2] + hv[3] * hv[3]; }
            ss = wave_sum(ss);
            const float r = rsqrtf(ss * (1.f / DM) + 1e-6f);
#pragma unroll 4
            for (int i = 0; i < 8; ++i) { const f32x4 hv = *(const LAS f32x4*)(xs + i * 256 + lane * 4);
                const f32x4 g0 = *(const f32x4*)(p.g_final + i * 256 + lane * 4); *(f32x4*)(orow + i * 256 + lane * 4) = hv * r * g0; }
        }
        __syncthreads();
    }
}

#define XB_TMO      128
#define XB_XCNT(j)  (256  + 64 * (j))
#define XB_XSUB(j)  (1280 + 64 * (j))
#define XB_XGEN(j)  (2304 + 64 * (j))
#define XB_TOP      3328
#define XB_TOPGEN   3392
#define XB_SPIN_CAP (1u << 18)
__device__ __forceinline__ unsigned xb_ld(unsigned* p)              { return __hip_atomic_load(p, __ATOMIC_RELAXED, __HIP_MEMORY_SCOPE_AGENT); }
__device__ __forceinline__ unsigned xb_add(unsigned* p, unsigned v) { return __hip_atomic_fetch_add(p, v, __ATOMIC_RELAXED, __HIP_MEMORY_SCOPE_AGENT); }
__device__ __forceinline__ unsigned xb_xcc_id() { return (unsigned)__builtin_amdgcn_s_getreg((3 << 11) | 20) & 0xFu; }
#define XB_SPIN(cond, bar) do { unsigned _sp = 0; while (cond) { __builtin_amdgcn_s_sleep(1); \
    if ((++_sp & 255u) == 0u) { if (xb_ld(&(bar)[XB_TMO])) break; if (_sp > XB_SPIN_CAP) { atomicAdd(&(bar)[XB_TMO], 1u); break; } } } } while (0)
struct XcdBarrier { unsigned* bar; unsigned x; volatile LAS unsigned* st; };
__device__ __forceinline__ XcdBarrier xcd_barrier_post(unsigned* bar, volatile LAS unsigned* st) {
    XcdBarrier b; b.bar = bar; b.x = xb_xcc_id(); b.st = st;
    if (threadIdx.x == 0) (void)xb_add(&bar[XB_XCNT(b.x)], 1u);
    return b;
}
__device__ __forceinline__ void xcd_barrier_complete(unsigned* bar, unsigned x, unsigned& nloc, unsigned& nx) {
    const unsigned G = gridDim.x * gridDim.y * gridDim.z;
    unsigned sum, cnt, mine, sp = 0u;
    for (;;) {
        sum = 0u; cnt = 0u; mine = 0u;
#pragma unroll
        for (unsigned j = 0; j < 16; ++j) { const unsigned c = xb_ld(&bar[XB_XCNT(j)]); sum += c; cnt += (c > 0u) ? 1u : 0u; mine = (j == x) ? c : mine; }
        if (sum == G) break;
        __builtin_amdgcn_s_sleep(1);
        if ((++sp & 255u) == 0u) { if (xb_ld(&bar[XB_TMO])) break; if (sp > XB_SPIN_CAP) { atomicAdd(&bar[XB_TMO], 1u); break; } }
    }
    nloc = mine > 0u ? mine : 1u; nx = cnt > 0u ? cnt : 1u;
}
__device__ __forceinline__ void xcd_barrier(const XcdBarrier& b) {
    asm volatile("s_waitcnt vmcnt(0)" ::: "memory");
    __syncthreads();
    if (threadIdx.x == 0) {
        unsigned* bar = b.bar;
        __builtin_amdgcn_s_waitcnt(0);
        unsigned nloc = b.st[0], nx = b.st[1];
        if (nloc == 0u) { xcd_barrier_complete(bar, b.x, nloc, nx); b.st[0] = nloc; b.st[1] = nx; }
        const unsigned old = xb_add(&bar[XB_XSUB(b.x)], 1u);
        const unsigned gen = old / nloc;
        if (old + 1u == (gen + 1u) * nloc) {
            __builtin_amdgcn_fence(__ATOMIC_RELEASE, "agent");
            asm volatile("s_waitcnt vmcnt(0)" ::: "memory");
            const unsigned og = xb_add(&bar[XB_TOP], 1u);
            const unsigned tg = og / nx;
            if (og + 1u == (tg + 1u) * nx) xb_add(&bar[XB_TOPGEN], 1u);
            else XB_SPIN(xb_ld(&bar[XB_TOPGEN]) == tg, bar);
            __builtin_amdgcn_fence(__ATOMIC_ACQUIRE, "agent");
            xb_add(&bar[XB_XGEN(b.x)], 1u);
            asm volatile("s_waitcnt vmcnt(0)" ::: "memory");
        } else {
            XB_SPIN(xb_ld(&bar[XB_XGEN(b.x)]) == gen, bar);
            __builtin_amdgcn_fence(__ATOMIC_ACQUIRE, "agent");
            asm volatile("s_waitcnt vmcnt(0)" ::: "memory");
        }
    }
    __syncthreads();
}

__global__ void __launch_bounds__(512) fwd_megakernel(KP p) {
    extern __shared__ __attribute__((aligned(16))) unsigned char smem[];
    LAS unsigned char* lds = (LAS unsigned char*)smem;
    cg::grid_group grid = cg::this_grid();
#define GRID_SYNC() do { asm volatile("s_waitcnt vmcnt(0) lgkmcnt(0)" ::: "memory"); __syncthreads(); grid.sync(); asm volatile("" ::: "memory"); } while (0)
    const int G = gridDim.x, bid = blockIdx.x;
    unsigned char* ws = p.ws; unsigned char* dob = (unsigned char*)p.out;

#define RUN_GEMM(MODE, ...) do { unsigned char* ws = lp(p.ws); unsigned char* dob = lp((unsigned char*)p.out); const pg8::Gemm g_ = pg8::Gemm{__VA_ARGS__}; pg8::StaticOrder S_; S_.init(g_.M, g_.N, G, bid); \
        const pg8::Epi<MODE> E_{ws, dob, p.x, p.w0, p.a0, p.g_ffn}; pg8::gemm_phase(lds, g_, S_, E_); } while (0)
    volatile LAS unsigned* xst = (volatile LAS unsigned*)(lds + 150512);
    if (threadIdx.x < 4) xst[threadIdx.x] = 0u;
    phase_prep(p, lds);
    GRID_SYNC();
    const XcdBarrier xbar = xcd_barrier_post((unsigned*)(p.ws + OFF_XBAR), xst);
#define XSYNC() do { xcd_barrier(xbar); asm volatile("" ::: "memory"); } while (0)
    RUN_GEMM(0, (const bf16_t*)(ws + OFF_XN), (const bf16_t*)(ws + OFF_WINT), NT, N1, 2048, 2048, 2048);
    if (bid >= G / 2) weight_transposes(p, lds, 5888, 8960, (bid - G / 2) * 8 + (tid_l() >> 6), (G - G / 2) * 8);
    XSYNC();
    phase_lora_prep(p);
    XSYNC();
    RUN_GEMM(1, (const bf16_t*)(dob + DO_ALORA), (const bf16_t*)(ws + OFF_WAT), NT, 2048, 256, 512, 256);
    RUN_GEMM(2, (const bf16_t*)(dob + DO_ALORA) + 256, (const bf16_t*)(ws + OFF_G2T), NT, 1024, 256, 512, 256);
    XSYNC();
    if (bid < 128) rwkv_scan(p, bid, lds);
    else {
        mlstm_run(p, bid - 128, lds);
        convert_tables(p, (bid - 128) * 8 + (tid_l() >> 6), 1024);
        __builtin_amdgcn_fence(__ATOMIC_RELEASE, "agent"); __syncthreads();
        if (threadIdx.x == 0) { unsigned* cnt = (unsigned*)(p.ws + OFF_SUBBAR); __hip_atomic_fetch_add(cnt, 1u, __ATOMIC_RELAXED, __HIP_MEMORY_SCOPE_AGENT);
            while (__hip_atomic_load(cnt, __ATOMIC_RELAXED, __HIP_MEMORY_SCOPE_AGENT) < 128u) __builtin_amdgcn_s_sleep(2); }
        __syncthreads(); __builtin_amdgcn_fence(__ATOMIC_ACQUIRE, "agent");
        { unsigned char* ws = lp(p.ws); unsigned char* dob = lp((unsigned char*)p.out); const pg8::Gemm g_ = pg8::Gemm{(const bf16_t*)(ws + OFF_PM) + 3072, (const bf16_t*)(ws + OFF_PMT), NT, 2048, 1024, LDPM, 1024};
          pg8::StaticOrder S_; S_.init(g_.M, g_.N, 128, bid - 128); const pg8::Epi<3> E_{ws, dob, p.x, p.w0, p.a0, p.g_ffn}; pg8::gemm_phase(lds, g_, S_, E_); }
    }
    XSYNC();
    phase_rwkv_post(p);
    XSYNC();
    RUN_GEMM(4, (const bf16_t*)(ws + OFF_YR), (const bf16_t*)(ws + OFF_PRT), NT, 2048, 1024, 1024, 1024);
    XSYNC();
    RUN_GEMM(5, (const bf16_t*)(ws + OFF_PG), (const bf16_t*)(ws + OFF_WOT), NT, 2048, 2048, LDPG, 2048);
    XSYNC();
    RUN_GEMM(6, (const bf16_t*)(ws + OFF_XN2), (const bf16_t*)(ws + OFF_WQT), NT, 2048, 2048, 2048, 2048);
    XSYNC();
    phase_peer(p, lds);
}

extern "C" void kernel_launch(void* const* d_in, const int* in_sizes, int n_in, void* d_out, int out_size, void* d_ws, size_t ws_size, hipStream_t stream) {
    static int grid_blocks = 0;
    if (grid_blocks == 0) {
        if (n_in != 26 || out_size != NT * DM || ws_size < WS_NEED) { fprintf(stderr, "kernel_launch: unexpected shapes: n_in %d out %d ws %zu (need %zu)\n", n_in, out_size, ws_size, (size_t)WS_NEED); grid_blocks = -1; return; }
        int dev = 0, cus = 0, per_cu = 0;
        hipGetDevice(&dev);
        hipDeviceGetAttribute(&cus, hipDeviceAttributeMultiprocessorCount, dev);
        if (hipFuncSetAttribute((const void*)fwd_megakernel, hipFuncAttributeMaxDynamicSharedMemorySize, LDS_BYTES) != hipSuccess) { fprintf(stderr, "kernel_launch: hipFuncSetAttribute failed\n"); grid_blocks = -1; return; }
        hipOccupancyMaxActiveBlocksPerMultiprocessor(&per_cu, (const void*)fwd_megakernel, 512, LDS_BYTES);
        if (per_cu < 1) { fprintf(stderr, "kernel_launch: occupancy query says %d blocks per CU\n", per_cu); per_cu = 1; }
        (void)hipGetLastError();
        grid_blocks = cus * 1;
    }
    if (grid_blocks < 0) return;
    KP p{};
    const float** pp = (const float**)&p;
    for (int i = 0; i < 26; ++i) pp[i] = (const float*)d_in[i];
    p.out = (float*)d_out; p.ws = (unsigned char*)d_ws;
    void* args[] = {&p};
    hipError_t e = hipLaunchCooperativeKernel((void*)fwd_megakernel, dim3(grid_blocks), dim3(512), args, LDS_BYTES, stream);
    if (e != hipSuccess) fprintf(stderr, "cooperative launch failed: %s (grid %d)\n", hipGetErrorString(e), grid_blocks);
}
```

```cpp
#include <hip/hip_runtime.h>
#include <hip/hip_cooperative_groups.h>
#include <cstdio>
namespace cg = cooperative_groups;

#define LAS __attribute__((address_space(3)))
typedef unsigned short bf16_t;
typedef short bf16x8 __attribute__((ext_vector_type(8)));
typedef float f32x4 __attribute__((ext_vector_type(4)));
typedef unsigned u32x4 __attribute__((ext_vector_type(4)));
typedef unsigned u32x2 __attribute__((ext_vector_type(2)));

constexpr int NT = 16384, SEQ = 4096, DM = 2048;
constexpr int LDPM = 4096, LDPR = 3584, LDPG = 4096, N1 = 11776;
constexpr size_t MiB = 1024ull * 1024ull;
constexpr size_t OFF_PM = 0, OFF_PR = 128 * MiB, OFF_PG = 240 * MiB, OFF_XN = 368 * MiB, OFF_WINT = 432 * MiB, OFF_WTS = 478 * MiB;
constexpr size_t OFF_PMT = OFF_WTS, OFF_PRT = OFF_WTS + 4 * MiB, OFF_WOT = OFF_WTS + 8 * MiB, OFF_WQT = OFF_WTS + 16 * MiB, OFF_WAT = OFF_WTS + 24 * MiB,
                 OFF_G2T = OFF_WTS + 25 * MiB, OFF_SUBK = OFF_WTS + 25 * MiB + 512 * 1024, WS_NEED = OFF_WTS + 26 * MiB;
constexpr size_t OFF_QC = OFF_XN, OFF_KC = OFF_XN + 32 * MiB, OFF_YR = OFF_WINT, OFF_Q = OFF_XN, OFF_XN2 = OFF_PR, OFF_PU = OFF_PM, OFF_PV = OFF_PM + 2048, OFF_SUBBAR = OFF_SUBK + 192 * 1024, OFF_XBAR = OFF_SUBBAR + 256,
                 OFF_SCU = OFF_SUBK + 64 * 1024, OFF_SCV = OFF_SCU + 64 * 1024;
constexpr size_t DO_WLOG = 0, DO_AG = 32 * MiB, DO_GG = 64 * MiB, DO_ALORA = 96 * MiB, DO_GB = 112 * MiB, DO_GA = DO_GB + 256 * 1024, DO_GW = DO_GA + 256 * 1024;
constexpr int LDS_BYTES = 150528;
#define XCD_BAR_WORDS 3456

struct KP {
    const float *x, *g_mix, *w_in, *conv_w, *b_i, *b_f, *mu, *w0, *w2, *a0, *a2, *g2, *k_k, *k_a, *r_k, *ln_w, *ln_b, *proj_m, *proj_r, *w_out, *g_ffn,
        *w_query, *sub_keys, *peer_u, *peer_v, *g_final;
    float* out; unsigned char* ws;
};

typedef __bf16 bf16x2_t __attribute__((ext_vector_type(2)));
typedef float f32x2_t __attribute__((ext_vector_type(2)));
__device__ __forceinline__ unsigned cvt_pk_bf16(float lo, float hi) { f32x2_t v = {lo, hi}; bf16x2_t b = __builtin_convertvector(v, bf16x2_t); return __builtin_bit_cast(unsigned, b); }
__device__ __forceinline__ bf16_t f2bf(float f) { return (bf16_t)(cvt_pk_bf16(f, 0.f) & 0xffffu); }
__device__ __forceinline__ float bf2f(bf16_t h) { return __uint_as_float((unsigned)h << 16); }
__device__ __forceinline__ float bflo(unsigned u) { return __uint_as_float(u << 16); }
__device__ __forceinline__ float bfhi(unsigned u) { return __uint_as_float(u & 0xffff0000u); }
__device__ __forceinline__ float sigm(float x) { return __builtin_amdgcn_rcpf(1.f + __expf(-x)); }
template <int CTRL> __device__ __forceinline__ float dppf(float v) { return __builtin_bit_cast(float, __builtin_amdgcn_update_dpp(0, __builtin_bit_cast(int, v), CTRL, 0xF, 0xF, true)); }
template <int CTRL> __device__ __forceinline__ unsigned dppu(unsigned v) { return (unsigned)__builtin_amdgcn_update_dpp(0, (int)v, CTRL, 0xF, 0xF, true); }
__device__ __forceinline__ float red4(float v) { v += dppf<0xB1>(v); v += dppf<0x4E>(v); return v; }
__device__ __forceinline__ float red8(float v) { v = red4(v); v += dppf<0x141>(v); return v; }
__device__ __forceinline__ float red16(float v) { v = red8(v); v += dppf<0x140>(v); return v; }
__device__ __forceinline__ float rlane(float v, int l) { return __builtin_bit_cast(float, __builtin_amdgcn_readlane(__builtin_bit_cast(int, v), l)); }
__device__ __forceinline__ float wave_sum(float v) { v = red16(v); return rlane(v, 0) + rlane(v, 16) + rlane(v, 32) + rlane(v, 48); }
__device__ __forceinline__ unsigned wave_max_u32(unsigned v) {
    v = max(v, dppu<0xB1>(v)); v = max(v, dppu<0x4E>(v)); v = max(v, dppu<0x141>(v)); v = max(v, dppu<0x140>(v));
    unsigned a = (unsigned)__builtin_amdgcn_readlane((int)v, 0), b = (unsigned)__builtin_amdgcn_readlane((int)v, 16), c = (unsigned)__builtin_amdgcn_readlane((int)v, 32), d = (unsigned)__builtin_amdgcn_readlane((int)v, 48);
    return max(max(a, b), max(c, d));
}
__device__ __forceinline__ unsigned ordf(float f) { unsigned u = __float_as_uint(f); return (u & 0x80000000u) ? ~u : (u | 0x80000000u); }
__device__ __forceinline__ float unordf(unsigned k) { return __uint_as_float((k & 0x80000000u) ? (k ^ 0x80000000u) : ~k); }

__device__ __forceinline__ int tid_l() { int t = threadIdx.x; asm volatile("" : "+v"(t)); return t; }
template <class T> __device__ __forceinline__ T* lp(T* q) { asm volatile("" : "+s"(q)); return q; }
__device__ __forceinline__ int bid_l() { int b = blockIdx.x; asm volatile("" : "+s"(b)); return b; }
namespace pg8 {
constexpr int BM = 256, BK = 64, HALF = 128, HTB = HALF * BK * 2, STAGE_BYTES = 8 * HTB, NXCD = 8, WGM = 8;
__device__ __forceinline__ int lds_byte(int r, int c) { const int st = (r >> 4) * 2 + (c >> 5), rr = r & 15, cc = c & 31, ob = rr * 64 + cc * 2; return st * 1024 + (ob ^ (((ob >> 9) & 1) << 5)); }
__device__ __forceinline__ void stage_rc(int b, int& R, int& C) { const int st = b / 1024, sb = b % 1024, swz = sb ^ (((sb >> 9) & 1) << 5); R = (st >> 1) * 16 + swz / 64; C = (st & 1) * 32 + (swz % 64) / 2; }
__device__ __forceinline__ int perm32(int rho) { const int n = rho >> 4, i = rho & 15; return 8 * (i >> 2) + 4 * n + (i & 3); }
struct Unit { int pm, pn; };
struct Gemm { const bf16_t* A; const bf16_t* Bt; int M, N, K, lda, ldb; };
struct StaticOrder {
    int nM, nN, nwg, G, c;
    __device__ void init(int M, int N, int G_, int c_) { nM = M / BM; nN = N / BM; nwg = nM * nN; G = G_; c = c_; }
    __device__ bool next(int i, Unit& u) const {
        const long L = (long)i * G + c; if (L >= nwg) return false;
        int wgid = (int)L; { const int q = nwg / NXCD, r = nwg % NXCD, xcd = wgid % NXCD, off = wgid / NXCD; wgid = (xcd < r ? xcd * (q + 1) : r * (q + 1) + (xcd - r) * q) + off; }
        const int nig = WGM * nN, gid = wgid / nig, fm = gid * WGM, gsz = (nM - fm) < WGM ? (nM - fm) : WGM;
        u.pm = fm + ((wgid % nig) % gsz); u.pn = (wgid % nig) / gsz; return true;
    }
};

__device__ __forceinline__ void store8(bf16_t* p, f32x4 v0, f32x4 v1) {
    u32x4 w; w.x = cvt_pk_bf16(v0[0], v0[1]); w.y = cvt_pk_bf16(v0[2], v0[3]); w.z = cvt_pk_bf16(v1[0], v1[1]); w.w = cvt_pk_bf16(v1[2], v1[3]); *(u32x4*)p = w;
}
__device__ __forceinline__ void load8(const bf16_t* p, f32x4& v0, f32x4& v1) {
    const u32x4 w = *(const u32x4*)p; v0 = (f32x4){bflo(w.x), bfhi(w.x), bflo(w.y), bfhi(w.y)}; v1 = (f32x4){bflo(w.z), bfhi(w.z), bflo(w.w), bfhi(w.w)};
}

template <int mode> struct Epi {
    static constexpr bool PERM = true;
    unsigned char* ws; unsigned char* dob; const float* x; const float* w0; const float* a0; const float* gf;
    __device__ __forceinline__ void operator()(const f32x4 (&acc)[2][2][4][2], const Unit& u, int wr, int wc, int fr, int fq) const {
        const int row0 = u.pm * BM + wr * 64 + fr, cb = u.pn * BM + wc * 32 + 8 * fq;
#pragma unroll
        for (int ai = 0; ai < 2; ++ai)
#pragma unroll
            for (int m = 0; m < 4; ++m) {
                const size_t row = (size_t)(row0 + ai * HALF + m * 16);
#pragma unroll
                for (int bj = 0; bj < 2; ++bj) {
                    const int col = cb + bj * HALF;
                    f32x4 v0 = acc[ai][bj][m][0], v1 = acc[ai][bj][m][1];
                    if (mode == 0) {
                        if (col < 4096) store8((bf16_t*)(ws + OFF_PM) + row * LDPM + col, v0, v1);
                        else if (col < 7680) store8((bf16_t*)(ws + OFF_PR) + row * LDPR + (col - 4096), v0, v1);
                        else {
#pragma unroll
                            for (int j = 0; j < 4; ++j) { v0[j] = sigm(v0[j]); v1[j] = sigm(v1[j]); }
                            store8((bf16_t*)(ws + OFF_PG) + row * LDPG + (col - 7680), v0, v1);
                        }
                    } else if (mode == 1) {
                        if (col < 1024) {
                            const f32x4 b0 = *(const f32x4*)(w0 + col), b1 = *(const f32x4*)(w0 + col + 4);
#pragma unroll
                            for (int j = 0; j < 4; ++j) {
                                float z = -(b0[j] + v0[j]); float sp = fmaxf(z, 0.f) + __logf(1.f + __expf(-fabsf(z))); v0[j] = -__expf(-sp - 0.5f);
                                z = -(b1[j] + v1[j]); sp = fmaxf(z, 0.f) + __logf(1.f + __expf(-fabsf(z))); v1[j] = -__expf(-sp - 0.5f);
                            }
                            store8((bf16_t*)(dob + DO_WLOG) + row * 1024 + col, v0, v1);
                        } else {
                            const int c2 = col - 1024;
                            const f32x4 b0 = *(const f32x4*)(a0 + c2), b1 = *(const f32x4*)(a0 + c2 + 4);
#pragma unroll
                            for (int j = 0; j < 4; ++j) { v0[j] = sigm(b0[j] + v0[j]); v1[j] = sigm(b1[j] + v1[j]); }
                            store8((bf16_t*)(dob + DO_AG) + row * 1024 + c2, v0, v1);
                        }
                    } else if (mode == 2) {
                        store8((bf16_t*)(dob + DO_GG) + row * 1024 + col, v0, v1);
                    } else if (mode == 3) {
                        bf16_t* pp = (bf16_t*)(ws + OFF_PG) + row * LDPG + col; f32x4 g0, g1; load8(pp, g0, g1);
                        store8(pp, g0 * v0, g1 * v1);
                    } else if (mode == 4) {
                        bf16_t* pp = (bf16_t*)(ws + OFF_PG) + row * LDPG + col; f32x4 m0, m1, g0, g1; load8(pp, m0, m1); load8(pp + 2048, g0, g1);
                        store8(pp, m0 + g0 * v0, m1 + g1 * v1);
                    } else if (mode == 5) {
                        const float* xp = x + row * DM + col; float* op = (float*)dob + row * DM + col;
                        const f32x4 x0 = *(const f32x4*)xp, x1 = *(const f32x4*)(xp + 4);
                        const f32x4 h0 = x0 + v0, h1v = x1 + v1;
                        *(f32x4*)op = h0; *(f32x4*)(op + 4) = h1v;
                        const f32x4 g0 = *(const f32x4*)(gf + col), g1 = *(const f32x4*)(gf + col + 4);
                        store8((bf16_t*)(ws + OFF_XN2) + row * DM + col, h0 * g0, h1v * g1);
                    } else {
                        store8((bf16_t*)(ws + OFF_Q) + row * DM + col, v0, v1);
                    }
                    if (mode == 1 || mode == 3 || mode == 4 || mode == 5) asm volatile("" ::: "memory");
                }
            }
    }
};

template <class EpiT> __device__ __forceinline__ void gemm_phase(LAS unsigned char* lds, const Gemm g, const StaticOrder& S, const EpiT& E) {
    const int tid = tid_l(), wid = __builtin_amdgcn_readfirstlane(tid >> 6), lane = tid & 63, wr = wid >> 2, wc = wid & 3, fr = lane & 15, fq = lane >> 4;
    const int K = g.K, nt = K / BK;
    unsigned voffA[2], voffB[2];
#pragma unroll
    for (int i = 0; i < 2; ++i) { int R, C; stage_rc(tid * 16 + i * 8192, R, C); const int Rb = (R & ~31) + perm32(R & 31);
        voffA[i] = (unsigned)(R * g.lda + C) * 2u; voffB[i] = (unsigned)(Rb * g.ldb + C) * 2u; }
    const size_t kstep = (size_t)(BK * 2);
    const size_t hstepA = (size_t)HALF * g.lda * 2, hstepB = (size_t)HALF * g.ldb * 2;
    const size_t tstepA = 2 * hstepA, tstepB = 2 * hstepB;
    const unsigned ldsw = (unsigned)wid * 1024u;
    const int aoff = lds_byte(wr * 64 + fr, fq * 8), boff = lds_byte(wc * 32 + fr, fq * 8);
#define PG8_SA(b, h) (((b) * 2 + (h)) * HTB)
#define PG8_SB(b, h) ((4 + (b) * 2 + (h)) * HTB)
#define PG8_STAGE(bufoff, gbase, voff) do { _Pragma("unroll") for (int _i = 0; _i < 2; ++_i) \
        __builtin_amdgcn_global_load_lds((const unsigned*)((const char*)(gbase) + (voff)[_i]), (LAS unsigned*)(lds + (bufoff) + ldsw + _i * 8192), 16, 0, 0); } while (0)
#define PG8_LDA(dst, b, h) do { _Pragma("unroll") for (int m = 0; m < 4; ++m) _Pragma("unroll") for (int k = 0; k < 2; ++k) dst[m][k] = *(const LAS bf16x8*)(lds + PG8_SA(b, h) + aoff + m * 2048 + k * 1024); } while (0)
#define PG8_LDB(dst, b, h) do { _Pragma("unroll") for (int n = 0; n < 2; ++n) _Pragma("unroll") for (int k = 0; k < 2; ++k) dst[n][k] = *(const LAS bf16x8*)(lds + PG8_SB(b, h) + boff + n * 2048 + k * 1024); } while (0)
#define PG8_MMA(ai, bj, At, Bt) do { __builtin_amdgcn_s_setprio(1); _Pragma("unroll") for (int m = 0; m < 4; ++m) _Pragma("unroll") for (int n = 0; n < 2; ++n) _Pragma("unroll") for (int k = 0; k < 2; ++k) \
        acc[ai][bj][m][n] = __builtin_amdgcn_mfma_f32_16x16x32_bf16(Bt[n][k], At[m][k], acc[ai][bj][m][n], 0, 0, 0); __builtin_amdgcn_s_setprio(0); } while (0)
#define PG8_WAIT_V(n) asm volatile("s_waitcnt vmcnt(" #n ")" ::: "memory")
#define PG8_WAIT_L(n) asm volatile("s_waitcnt lgkmcnt(" #n ")" ::: "memory")
#define PG8_BAR __builtin_amdgcn_s_barrier()
#define PG8_SCHED __builtin_amdgcn_sched_barrier(0)
    Unit cur, nxt; int ui = 0;
    if (!S.next(0, cur)) return;
    f32x4 acc[2][2][4][2];
#pragma unroll
    for (int a = 0; a < 2; ++a)
#pragma unroll
        for (int b = 0; b < 2; ++b)
#pragma unroll
            for (int m = 0; m < 4; ++m)
#pragma unroll
                for (int n = 0; n < 2; ++n) acc[a][b][m][n] = (f32x4){0.f, 0.f, 0.f, 0.f};
    bf16x8 At[4][2], B0[2][2], B1[2][2];
    const char* cA = (const char*)g.A + (size_t)cur.pm * tstepA; const char* cB = (const char*)g.Bt + (size_t)cur.pn * tstepB;
    PG8_STAGE(PG8_SB(0, 0), cB, voffB); PG8_STAGE(PG8_SA(0, 0), cA, voffA); PG8_STAGE(PG8_SB(0, 1), cB + hstepB, voffB); PG8_STAGE(PG8_SA(0, 1), cA + hstepA, voffA);
    if (wr == 1) PG8_BAR;
    PG8_WAIT_V(4); PG8_BAR;
    PG8_STAGE(PG8_SB(1, 0), cB + kstep, voffB); PG8_STAGE(PG8_SA(1, 0), cA + kstep, voffA); PG8_STAGE(PG8_SB(1, 1), cB + hstepB + kstep, voffB);
    PG8_WAIT_V(6); PG8_BAR;
    for (;;) {
        const bool has_next = S.next(ui + 1, nxt);
        const char* nA = has_next ? (const char*)g.A + (size_t)nxt.pm * tstepA : cA; const char* nB = has_next ? (const char*)g.Bt + (size_t)nxt.pn * tstepB : cB;
        for (int t = 0; t < nt; t += 2) {
            const bool last = (t == nt - 2);
            const char* a1 = cA + (size_t)(t + 1) * kstep;
            const char* a2 = last ? nA : cA + (size_t)(t + 2) * kstep; const char* b2 = last ? nB : cB + (size_t)(t + 2) * kstep;
            const char* a3 = a2 + kstep; const char* b3 = b2 + kstep;
            PG8_LDB(B0, 0, 0); PG8_SCHED; PG8_LDA(At, 0, 0); PG8_STAGE(PG8_SA(1, 1), a1 + hstepA, voffA);
            PG8_WAIT_L(8); PG8_BAR; PG8_WAIT_L(0); PG8_MMA(0, 0, At, B0); PG8_BAR; PG8_SCHED;
            PG8_LDB(B1, 0, 1); PG8_STAGE(PG8_SB(0, 0), b2, voffB);
            PG8_BAR; PG8_WAIT_L(0); PG8_MMA(0, 1, At, B1); PG8_BAR;
            PG8_LDA(At, 0, 1); PG8_STAGE(PG8_SA(0, 0), a2, voffA);
            PG8_BAR; PG8_WAIT_L(0); PG8_MMA(1, 0, At, B0); PG8_BAR; PG8_SCHED;
            PG8_STAGE(PG8_SB(0, 1), b2 + hstepB, voffB);
            PG8_WAIT_V(6); PG8_BAR; PG8_MMA(1, 1, At, B1); PG8_BAR;
            PG8_LDB(B0, 1, 0); PG8_SCHED; PG8_LDA(At, 1, 0); PG8_STAGE(PG8_SA(0, 1), a2 + hstepA, voffA);
            PG8_WAIT_L(8); PG8_BAR; PG8_WAIT_L(0); PG8_MMA(0, 0, At, B0); PG8_BAR; PG8_SCHED;
            PG8_LDB(B1, 1, 1); PG8_STAGE(PG8_SB(1, 0), b3, voffB);
            PG8_BAR; PG8_WAIT_L(0); PG8_MMA(0, 1, At, B1); PG8_BAR;
            PG8_LDA(At, 1, 1); PG8_STAGE(PG8_SA(1, 0), a3, voffA);
            PG8_BAR; PG8_WAIT_L(0); PG8_MMA(1, 0, At, B0); PG8_BAR; PG8_SCHED;
            PG8_STAGE(PG8_SB(1, 1), b3 + hstepB, voffB);
            PG8_WAIT_V(6); PG8_BAR; PG8_MMA(1, 1, At, B1); PG8_BAR;
        }
        E(acc, cur, wr, wc, fr, fq);
        if (!has_next) break;
#pragma unroll
        for (int a = 0; a < 2; ++a)
#pragma unroll
            for (int b = 0; b < 2; ++b)
#pragma unroll
                for (int m = 0; m < 4; ++m)
#pragma unroll
                    for (int n = 0; n < 2; ++n) acc[a][b][m][n] = (f32x4){0.f, 0.f, 0.f, 0.f};
        cur = nxt; cA = nA; cB = nB; ++ui;
    }
    PG8_WAIT_V(0);
    if (wr == 0) PG8_BAR;
    PG8_BAR;
#undef PG8_SA
#undef PG8_SB
#undef PG8_STAGE
#undef PG8_LDA
#undef PG8_LDB
#undef PG8_MMA
#undef PG8_WAIT_V
#undef PG8_WAIT_L
#undef PG8_BAR
#undef PG8_SCHED
}
}

__device__ __forceinline__ void rmsnorm_rows(const float* src, const float* gain, bf16_t* dst, int gw, int nw, int lane) {
    for (int row = gw; row < NT; row += nw) {
        const f32x4* s = (const f32x4*)(src + (size_t)row * DM);
        f32x4 v[8]; float ss = 0.f;
#pragma unroll
        for (int i = 0; i < 8; ++i) { v[i] = s[i * 64 + lane]; ss += v[i][0] * v[i][0] + v[i][1] * v[i][1] + v[i][2] * v[i][2] + v[i][3] * v[i][3]; }
        ss = wave_sum(ss);
        const float r = rsqrtf(ss * (1.f / DM) + 1e-6f);
        u32x2* d = (u32x2*)(dst + (size_t)row * DM);
#pragma unroll
        for (int i = 0; i < 8; ++i) { const f32x4 gg = ((const f32x4*)gain)[i * 64 + lane]; u32x2 o; o.x = cvt_pk_bf16(v[i][0] * r * gg[0], v[i][1] * r * gg[1]); o.y = cvt_pk_bf16(v[i][2] * r * gg[2], v[i][3] * r * gg[3]); d[i * 64 + lane] = o; }
    }
}

__device__ __forceinline__ void tr_tile(const float* src, int ld, int c0, int nvalid, int k0, bf16_t* dst, int ldd, int r0, int kd0, LAS float* tile, int lane) {
    f32x4 v[16];
    const int c4 = (lane & 15) * 4, kb = lane >> 4;
#pragma unroll
    for (int i = 0; i < 16; ++i) { v[i] = (f32x4){0.f, 0.f, 0.f, 0.f}; if (c4 < nvalid) v[i] = *(const f32x4*)(src + (size_t)(k0 + kb + 4 * i) * ld + c0 + c4); }
#pragma unroll
    for (int i = 0; i < 16; ++i) { const int k = kb + 4 * i; tile[k * 65 + c4] = v[i][0]; tile[k * 65 + c4 + 1] = v[i][1]; tile[k * 65 + c4 + 2] = v[i][2]; tile[k * 65 + c4 + 3] = v[i][3]; }
#pragma unroll
    for (int i = 0; i < 8; ++i) {
        const int c = (lane >> 3) + 8 * i, k8 = (lane & 7) * 8;
        float f[8];
#pragma unroll
        for (int j = 0; j < 8; ++j) f[j] = tile[(k8 + j) * 65 + c];
        u32x4 w; w.x = cvt_pk_bf16(f[0], f[1]); w.y = cvt_pk_bf16(f[2], f[3]); w.z = cvt_pk_bf16(f[4], f[5]); w.w = cvt_pk_bf16(f[6], f[7]);
        *(u32x4*)(dst + (size_t)(r0 + c) * ldd + kd0 + k8) = w;
    }
}

__device__ void weight_transposes(const KP& p, LAS unsigned char* lds, int j0, int j1, int gw, int nw) {
    const int tid = tid_l(), lane = tid & 63;
    unsigned char* ws = p.ws;
    LAS float* tile = (LAS float*)lds + (tid >> 6) * (64 * 65 + 16);
    for (int j = j0 + gw; j < j1; j += nw) {
        const float* src; bf16_t* dst; int ld = 2048, ldd, c0, nv = 64, rt, kt;
        if (j < 5888) { rt = j >> 5; kt = j & 31; src = p.w_in; ld = 11720; dst = (bf16_t*)(ws + OFF_WINT); ldd = 2048;
            if (rt < 64) c0 = 64 * rt; else if (rt < 119) c0 = 4104 + 64 * (rt - 64); else if (rt == 119) { c0 = 4096; nv = 8; } else c0 = 7624 + 64 * (rt - 120); }
        else if (j < 6400) { const int q = j - 5888; rt = q >> 4; kt = q & 15; src = p.proj_m; dst = (bf16_t*)(ws + OFF_PMT); ldd = 1024; c0 = rt * 64; }
        else if (j < 6912) { const int q = j - 6400; rt = q >> 4; kt = q & 15; src = p.proj_r; dst = (bf16_t*)(ws + OFF_PRT); ldd = 1024; c0 = rt * 64; }
        else if (j < 7936) { const int q = j - 6912; rt = q >> 5; kt = q & 31; src = p.w_out; dst = (bf16_t*)(ws + OFF_WOT); ldd = 2048; c0 = rt * 64; }
        else { const int q = j - 7936; rt = q >> 5; kt = q & 31; src = p.w_query; dst = (bf16_t*)(ws + OFF_WQT); ldd = 2048; c0 = rt * 64; }
        tr_tile(src, ld, c0, nv, kt * 64, dst, ldd, rt * 64, kt * 64, tile, lane);
    }
}

__device__ void phase_prep(const KP& p, LAS unsigned char* lds) {
    const int tid = tid_l(), lane = tid & 63, G = gridDim.x, bid = blockIdx.x;
    unsigned char* ws = p.ws;
    rmsnorm_rows(p.x, p.g_mix, (bf16_t*)(ws + OFF_XN), bid * 8 + (tid >> 6), G * 8, lane);
    weight_transposes(p, lds, 0, 5888, bid * 8 + (tid >> 6), G * 8);
    const int gt = bid_l() * 512 + tid, gn = G * 512;
    bf16_t* WAT = (bf16_t*)(ws + OFF_WAT);
    for (int i = gt; i < 2048 * 256; i += gn) { const int r = i >> 8, k = i & 255; float v = 0.f;
        if (r < 1024) { if (k < 96) v = p.w2[k * 1024 + r]; } else { if (k >= 96 && k < 192) v = p.a2[(k - 96) * 1024 + (r - 1024)]; }
        WAT[i] = f2bf(v); }
    bf16_t* G2T = (bf16_t*)(ws + OFF_G2T);
    for (int i = gt; i < 1024 * 256; i += gn) { const int r = i >> 8, k = i & 255; G2T[i] = f2bf(p.g2[k * 1024 + r]); }
    bf16_t* SK = (bf16_t*)(ws + OFF_SUBK);
    for (int i = gt; i < 2 * 128 * 128; i += gn) SK[i] = f2bf(p.sub_keys[i]);
    if (gt == 0) *(unsigned*)(ws + OFF_SUBBAR) = 0u;
    for (int i = gt; i < XCD_BAR_WORDS; i += gn) ((unsigned*)(ws + OFF_XBAR))[i] = 0u;
}

__device__ __forceinline__ float bfel(const u32x4& w, int e) { const unsigned u = w[e >> 1]; return (e & 1) ? bfhi(u) : bflo(u); }
__device__ void phase_lora_prep(const KP& p) {
    const bf16_t* PR = (const bf16_t*)(p.ws + OFF_PR);
    bf16_t* AL = (bf16_t*)((unsigned char*)p.out + DO_ALORA);
    const int gt = bid_l() * 512 + tid_l(), gn = gridDim.x * 512;
    for (int i = gt; i < NT * 64; i += gn) {
        const int tok = i >> 6, g = i & 63;
        u32x4 o = (u32x4){0u, 0u, 0u, 0u};
        if (g < 24 || g >= 32) {
            const int sc = (g < 24) ? (3072 + 8 * g) : (3264 + 8 * (g - 32));
            const u32x4 cu = *(const u32x4*)(PR + (size_t)tok * LDPR + sc);
            u32x4 pv = (u32x4){0u, 0u, 0u, 0u};
            if ((tok & (SEQ - 1)) != 0) pv = *(const u32x4*)(PR + (size_t)(tok - 1) * LDPR + sc);
            const f32x4 m0 = *(const f32x4*)(p.mu + sc), m1 = *(const f32x4*)(p.mu + sc + 4);
            float f[8];
#pragma unroll
            for (int q = 0; q < 4; ++q) {
                const float c0 = bflo(cu[q]), c1 = bfhi(cu[q]), p0 = bflo(pv[q]), p1 = bfhi(pv[q]);
                const float mm0 = (q < 2) ? m0[2 * q] : m1[2 * q - 4], mm1 = (q < 2) ? m0[2 * q + 1] : m1[2 * q - 3];
                f[2 * q] = c0 + (p0 - c0) * mm0; f[2 * q + 1] = c1 + (p1 - c1) * mm1;
            }
            if (g < 12) {
#pragma unroll
                for (int q = 0; q < 8; ++q) f[q] = tanhf(f[q]);
            } else if (g >= 32) {
#pragma unroll
                for (int q = 0; q < 8; ++q) f[q] = sigm(f[q]);
            }
            o.x = cvt_pk_bf16(f[0], f[1]); o.y = cvt_pk_bf16(f[2], f[3]); o.z = cvt_pk_bf16(f[4], f[5]); o.w = cvt_pk_bf16(f[6], f[7]);
        }
        *(u32x4*)(AL + (size_t)tok * 512 + 8 * g) = o;
    }
    {
        const bf16_t* PM = (const bf16_t*)(p.ws + OFF_PM);
        bf16_t* QC = (bf16_t*)(p.ws + OFF_QC); bf16_t* KC = (bf16_t*)(p.ws + OFF_KC);
        for (int i = gt; i < (NT / 8) * 256; i += gn) {
            const int tb = i >> 8, col = (i & 255) * 8; const int tok0 = tb * 8, t0 = tok0 & (SEQ - 1);
            f32x4 cw[4][2];
#pragma unroll
            for (int j = 0; j < 4; ++j) { cw[j][0] = *(const f32x4*)(p.conv_w + j * 2048 + col); cw[j][1] = *(const f32x4*)(p.conv_w + j * 2048 + col + 4); }
            u32x4 raw[11];
#pragma unroll
            for (int q = 0; q < 11; ++q) { const bool neg = (t0 - 3 + q) < 0; u32x4 v = *(const u32x4*)(PM + (size_t)(tok0 + (neg ? 0 : q - 3)) * LDPM + col); if (neg) v = (u32x4){0u, 0u, 0u, 0u}; raw[q] = v; }
            const float scl = (col < 1024) ? 0.0625f : 1.f;
            bf16_t* dst = (col < 1024) ? (QC + (size_t)tok0 * 1024 + col) : (KC + (size_t)tok0 * 1024 + (col - 1024));
#pragma unroll
            for (int r = 0; r < 8; ++r) {
                float o[8];
#pragma unroll
                for (int e = 0; e < 8; ++e) {
                    const float c0 = (e < 4) ? cw[0][0][e] : cw[0][1][e - 4], c1 = (e < 4) ? cw[1][0][e] : cw[1][1][e - 4], c2 = (e < 4) ? cw[2][0][e] : cw[2][1][e - 4], c3 = (e < 4) ? cw[3][0][e] : cw[3][1][e - 4];
                    float sv = c0 * bfel(raw[r], e) + c1 * bfel(raw[r + 1], e) + c2 * bfel(raw[r + 2], e) + c3 * bfel(raw[r + 3], e);
                    o[e] = sv * sigm(sv) * scl;
                }
                u32x4 pk; pk.x = cvt_pk_bf16(o[0], o[1]); pk.y = cvt_pk_bf16(o[2], o[3]); pk.z = cvt_pk_bf16(o[4], o[5]); pk.w = cvt_pk_bf16(o[6], o[7]);
                *(u32x4*)(dst + (size_t)r * 1024) = pk;
            }
        }
    }
    {
        const int lane = threadIdx.x & 63, gw = blockIdx.x * 8 + (threadIdx.x >> 6), nw = gridDim.x * 8;
        float* GB = (float*)((unsigned char*)p.out + DO_GB); float* GA = (float*)((unsigned char*)p.out + DO_GA); float* GW = (float*)((unsigned char*)p.out + DO_GW);
        for (int task = gw; task < 1024; task += nw) {
            const int bh = task >> 6, c = task & 63, bb = bh >> 2, h = bh & 3; const size_t tok = (size_t)bb * SEQ + c * 64 + lane;
            const float iv = bf2f(PR[tok * LDPR + 3520 + h]) + p.b_i[h], fv = bf2f(PR[tok * LDPR + 3524 + h]) + p.b_f[h];
            float lf = fminf(fv, 0.f) - __logf(1.f + __expf(-fabsf(fv)));
#pragma unroll
            for (int d = 1; d < 64; d <<= 1) { const float y = __shfl_up(lf, d); if (lane >= d) lf += y; }
            const float bl = rlane(lf, 63);
            const int o = bh * SEQ + c * 64 + lane;
            GB[o] = lf; GA[o] = iv - lf; GW[o] = __expf(bl - lf + iv);
        }
    }
}

constexpr size_t OFF_YRAW = OFF_WINT, OFF_BON = OFF_WINT + 32 * MiB;
struct RwOps { f32x4 a0, q0, w0, b0, k0; f32x2_t vA, vB; float br, kr; };
__device__ __forceinline__ f32x2_t lo2(f32x4 v) { return __builtin_shufflevector(v, v, 0, 1); }
__device__ __forceinline__ f32x2_t hi2(f32x4 v) { return __builtin_shufflevector(v, v, 2, 3); }
__device__ __forceinline__ f32x2_t fma2(f32x2_t a, f32x2_t b, f32x2_t c) { return __builtin_elementwise_fma(a, b, c); }
__device__ void rwkv_scan(const KP& p, int blk, LAS unsigned char* lds) {
    const int tid0 = tid_l();
    const int bh = blk >> 1, half = blk & 1, b = bh >> 4, h = bh & 15;
    constexpr int BUFB = 61952;
    const bf16_t* PR = (const bf16_t*)(p.ws + OFF_PR);
    const bf16_t* WLOG = (const bf16_t*)((const unsigned char*)p.out + DO_WLOG);
    const bf16_t* AG = (const bf16_t*)((const unsigned char*)p.out + DO_AG);
    bf16_t* YRAW = (bf16_t*)(p.ws + OFF_YRAW); float* BON = (float*)(p.ws + OFF_BON);
    const size_t tokbase = (size_t)b * SEQ;
    if (tid0 < 256) {
        const int wv = tid0 >> 6, pi = (tid0 >> 4) & 3, j4 = (tid0 & 15) * 4;
        const int rlA = 8 * wv + pi, rlB = rlA + 4, rowA = 32 * half + rlA, rowB = 32 * half + rlB;
        f32x2_t A0 = (f32x2_t){0.f, 0.f}, A1 = A0, B0 = A0, B1 = A0;
        __syncthreads();
        for (int c = 0; c < 128; ++c) {
            const LAS float* bp = (const LAS float*)(lds + (c & 1) * BUFB);
            LAS float* yb = (LAS float*)(lds + (c & 1) * BUFB + 57600);
#define RW_LD(O, s) do { const LAS float* q_ = bp + (s) * 64 + j4; O.a0 = *(const LAS f32x4*)(q_); O.b0 = *(const LAS f32x4*)(q_ + 2048); O.w0 = *(const LAS f32x4*)(q_ + 4096); O.k0 = *(const LAS f32x4*)(q_ + 6144); \
            O.q0 = *(const LAS f32x4*)(q_ + 8192); O.vA = *(const LAS f32x2_t*)(bp + 10240 + ((s) * 64 + rowA) * 2); O.vB = *(const LAS f32x2_t*)(bp + 10240 + ((s) * 64 + rowB) * 2); O.br = bp[14336 + (s)]; O.kr = bp[14368 + (s)]; } while (0)
#define RW_STEP(O, s) do { \
            f32x2_t paA = A0 * lo2(O.a0), pyA = A0 * lo2(O.q0), paB = B0 * lo2(O.a0), pyB = B0 * lo2(O.q0); \
            paA = fma2(A1, hi2(O.a0), paA); pyA = fma2(A1, hi2(O.q0), pyA); paB = fma2(B1, hi2(O.a0), paB); pyB = fma2(B1, hi2(O.q0), pyB); \
            float saA = paA.x + paA.y, yyA = pyA.x + pyA.y, saB = paB.x + paB.y, yyB = pyB.x + pyB.y; \
            saA += dppf<0xB1>(saA); saB += dppf<0xB1>(saB); yyA += dppf<0xB1>(yyA); yyB += dppf<0xB1>(yyB); \
            saA += dppf<0x4E>(saA); saB += dppf<0x4E>(saB); yyA += dppf<0x4E>(yyA); yyB += dppf<0x4E>(yyB); \
            saA += dppf<0x141>(saA); saB += dppf<0x141>(saB); yyA += dppf<0x141>(yyA); yyB += dppf<0x141>(yyB); \
            saA += dppf<0x140>(saA); saB += dppf<0x140>(saB); yyA += dppf<0x140>(yyA); yyB += dppf<0x140>(yyB); \
            const f32x2_t sA2 = (f32x2_t){saA, saA}, vA2 = O.vA, sB2 = (f32x2_t){saB, saB}, vB2 = O.vB; \
            A0 = fma2(A0, lo2(O.w0), fma2(vA2, lo2(O.k0), sA2 * lo2(O.b0))); A1 = fma2(A1, hi2(O.w0), fma2(vA2, hi2(O.k0), sA2 * hi2(O.b0))); \
            B0 = fma2(B0, lo2(O.w0), fma2(vB2, lo2(O.k0), sB2 * lo2(O.b0))); B1 = fma2(B1, hi2(O.w0), fma2(vB2, hi2(O.k0), sB2 * hi2(O.b0))); \
            if ((tid0 & 15) == 0) { yb[(s) * 32 + rlA] = yyA + saA * O.br + O.vA.x * O.kr; yb[(s) * 32 + rlB] = yyB + saB * O.br + O.vB.x * O.kr; } } while (0)
            RwOps o[3];
            RW_LD(o[0], 0); RW_LD(o[1], 1);
#pragma unroll
            for (int s = 0; s < 32; ++s) {
                if (s + 2 < 32) RW_LD(o[(s + 2) % 3], s + 2);
                RW_STEP(o[s % 3], s);
            }
#undef RW_LD
#undef RW_STEP
            __syncthreads();
        }
    } else {
        const int ht = tid0 - 256, tt = ht >> 3, cg8 = (ht & 7) * 8, ch = h * 64 + cg8;
        float mur[8], muk[8], muv[8], kkc[8], kac[8], rkc[8];
#pragma unroll
        for (int e = 0; e < 8; ++e) { mur[e] = p.mu[ch + e]; muk[e] = p.mu[1024 + ch + e]; muv[e] = p.mu[2048 + ch + e]; kkc[e] = p.k_k[ch + e]; kac[e] = p.k_a[ch + e]; rkc[e] = p.r_k[ch + e]; }
        u32x4 r4, k4, v4, pr4, pk4, pv4, w4, a4;
#define RWH_LOAD(cn_) do { const int t_ = (cn_) * 32 + tt; const size_t tok_ = tokbase + t_; const bf16_t* pr_ = PR + tok_ * LDPR + ch; \
            r4 = *(const u32x4*)pr_; k4 = *(const u32x4*)(pr_ + 1024); v4 = *(const u32x4*)(pr_ + 2048); \
            pr4 = (u32x4){0u, 0u, 0u, 0u}; pk4 = pr4; pv4 = pr4; \
            if (t_ > 0) { pr4 = *(const u32x4*)(pr_ - LDPR); pk4 = *(const u32x4*)(pr_ - LDPR + 1024); pv4 = *(const u32x4*)(pr_ - LDPR + 2048); } \
            w4 = *(const u32x4*)(WLOG + tok_ * 1024 + ch); a4 = *(const u32x4*)(AG + tok_ * 1024 + ch); } while (0)
        RWH_LOAD(0);
        for (int c = -1; c < 128; ++c) {
            if (c >= 1) {
                const LAS float* yb = (const LAS float*)(lds + ((c - 1) & 1) * BUFB + 57600);
                const int r4 = (ht & 7) * 4; const f32x4 y4 = *(const LAS f32x4*)(yb + tt * 32 + r4);
                u32x2 ov; ov.x = cvt_pk_bf16(y4[0], y4[1]); ov.y = cvt_pk_bf16(y4[2], y4[3]);
                *(u32x2*)(YRAW + (tokbase + (size_t)(c - 1) * 32 + tt) * 1024 + h * 64 + 32 * half + r4) = ov;
            }
            if (c + 1 < 128) {
                const int cn = c + 1; const size_t tok = tokbase + cn * 32 + tt;
                LAS float* bp = (LAS float*)(lds + (cn & 1) * BUFB);
                float r[8], k[8], v[8], kk[8], av[8], dec[8];
                float n2 = 0.f;
#pragma unroll
                for (int e = 0; e < 8; ++e) {
                    const float rc = bfel(r4, e), kc = bfel(k4, e), vc = bfel(v4, e);
                    r[e] = rc + (bfel(pr4, e) - rc) * mur[e]; k[e] = kc + (bfel(pk4, e) - kc) * muk[e]; v[e] = vc + (bfel(pv4, e) - vc) * muv[e];
                    kk[e] = k[e] * kkc[e]; n2 += kk[e] * kk[e]; av[e] = bfel(a4, e); dec[e] = __expf(bfel(w4, e));
                }
                n2 = red8(n2);
                const float inv = 1.f / fmaxf(sqrtf(n2), 1e-12f);
                float br = 0.f, kr = 0.f, bon = 0.f;
                f32x4 oa[2], ob[2], ow[2], ok[2], oq[2], ovv[2];
#pragma unroll
                for (int e = 0; e < 8; ++e) {
                    const float kn = kk[e] * inv, k3 = k[e] * (1.f + (av[e] - 1.f) * kac[e]), bb = kn * av[e];
                    oa[e >> 2][e & 3] = -kn; ob[e >> 2][e & 3] = bb; ow[e >> 2][e & 3] = dec[e]; ok[e >> 2][e & 3] = k3; oq[e >> 2][e & 3] = dec[e] * r[e]; ovv[e >> 2][e & 3] = v[e];
                    br += bb * r[e]; kr += k3 * r[e]; bon += r[e] * k3 * rkc[e];
                }
                br = red8(br); kr = red8(kr); bon = red8(bon);
                LAS float* q_ = bp + tt * 64 + cg8;
#pragma unroll
                for (int i = 0; i < 2; ++i) { *(LAS f32x4*)(q_ + 4 * i) = oa[i]; *(LAS f32x4*)(q_ + 2048 + 4 * i) = ob[i]; *(LAS f32x4*)(q_ + 4096 + 4 * i) = ow[i]; *(LAS f32x4*)(q_ + 6144 + 4 * i) = ok[i];
                    *(LAS f32x4*)(q_ + 8192 + 4 * i) = oq[i];
                    *(LAS f32x4*)(bp + 10240 + (tt * 64 + cg8 + 4 * i) * 2) = (f32x4){ovv[i][0], ovv[i][0], ovv[i][1], ovv[i][1]}; *(LAS f32x4*)(bp + 10240 + (tt * 64 + cg8 + 4 * i + 2) * 2) = (f32x4){ovv[i][2], ovv[i][2], ovv[i][3], ovv[i][3]}; }
                if ((ht & 7) == 0) { bp[14336 + tt] = br; bp[14368 + tt] = kr; if (half == 0) BON[tok * 16 + h] = bon; }
                if (cn + 1 < 128) RWH_LOAD(cn + 1);
            }
            __syncthreads();
        }
        {
            const LAS float* yb = (const LAS float*)(lds + (127 & 1) * BUFB + 57600);
            const int r4 = (ht & 7) * 4; const f32x4 y4 = *(const LAS f32x4*)(yb + tt * 32 + r4);
            u32x2 ov; ov.x = cvt_pk_bf16(y4[0], y4[1]); ov.y = cvt_pk_bf16(y4[2], y4[3]);
            *(u32x2*)(YRAW + (tokbase + (size_t)127 * 32 + tt) * 1024 + h * 64 + 32 * half + r4) = ov;
        }
    }
}

#undef RWH_LOAD
__device__ void phase_rwkv_post(const KP& p) {
    const bf16_t* PR = (const bf16_t*)(p.ws + OFF_PR);
    const bf16_t* GG = (const bf16_t*)((const unsigned char*)p.out + DO_GG);
    bf16_t* YR = (bf16_t*)(p.ws + OFF_YRAW); const float* BON = (const float*)(p.ws + OFF_BON);
    const int gt = bid_l() * 512 + tid_l(), gn = gridDim.x * 512;
    for (int i = gt; i < NT * 256; i += gn) {
        const int tok = i >> 8, h = (i >> 4) & 15, ch = h * 64 + (i & 15) * 4;
        const u32x2 y2 = *(const u32x2*)(YR + (size_t)tok * 1024 + ch), v2 = *(const u32x2*)(PR + (size_t)tok * LDPR + 2048 + ch), g2 = *(const u32x2*)(GG + (size_t)tok * 1024 + ch);
        u32x2 pv2 = (u32x2){0u, 0u};
        if ((tok & (SEQ - 1)) != 0) pv2 = *(const u32x2*)(PR + (size_t)(tok - 1) * LDPR + 2048 + ch);
        const float bon = BON[tok * 16 + h];
        const f32x4 muv = *(const f32x4*)(p.mu + 2048 + ch), lnw = *(const f32x4*)(p.ln_w + ch), lnb = *(const f32x4*)(p.ln_b + ch);
        const f32x4 y = (f32x4){bflo(y2.x), bfhi(y2.x), bflo(y2.y), bfhi(y2.y)}, vc = (f32x4){bflo(v2.x), bfhi(v2.x), bflo(v2.y), bfhi(v2.y)}, vp = (f32x4){bflo(pv2.x), bfhi(pv2.x), bflo(pv2.y), bfhi(pv2.y)};
        const f32x4 g = (f32x4){bflo(g2.x), bfhi(g2.x), bflo(g2.y), bfhi(g2.y)};
        const f32x4 v = vc + (vp - vc) * muv;
        const float mean = red16(y[0] + y[1] + y[2] + y[3]) * (1.f / 64.f);
        const f32x4 d = y - mean;
        const float var = red16(d[0] * d[0] + d[1] * d[1] + d[2] * d[2] + d[3] * d[3]) * (1.f / 64.f);
        const float rs = rsqrtf(var + 64e-5f);
        const f32x4 res = (d * rs * lnw + lnb + bon * v) * g;
        u32x2 ov; ov.x = cvt_pk_bf16(res[0], res[1]); ov.y = cvt_pk_bf16(res[2], res[3]);
        *(u32x2*)(YR + (size_t)tok * 1024 + ch) = ov;
    }
}

typedef short v4i16_t __attribute__((ext_vector_type(4)));
__device__ __forceinline__ bf16x8 tr_frag(const LAS unsigned char* base, int stride_b, int krow0, int ncol0, int lane) {
    const int g = lane >> 4, q = (lane & 15) >> 2, pp = lane & 3;
    const LAS unsigned char* a0 = base + (krow0 + 8 * g + q) * stride_b + (ncol0 + 4 * pp) * 2;
    const v4i16_t x = __builtin_amdgcn_ds_read_tr16_b64_v4i16((LAS v4i16_t*)a0), y = __builtin_amdgcn_ds_read_tr16_b64_v4i16((LAS v4i16_t*)(a0 + 4 * stride_b));
    return (bf16x8){x[0], x[1], x[2], x[3], y[0], y[1], y[2], y[3]};
}
__device__ void mlstm_run(const KP& p, int item, LAS unsigned char* lds) {
    const int tid0 = tid_l();
    const int bh = item >> 3, b = bh >> 2, h = bh & 3, dv0 = (item & 7) * 32;
    const size_t tokbase = (size_t)b * SEQ;
    LAS bf16_t* Qs = (LAS bf16_t*)(lds + 0);
    LAS bf16_t* Ks = (LAS bf16_t*)(lds + 33792);
    LAS bf16_t* Vs = (LAS bf16_t*)(lds + 67584);
    LAS bf16_t* Vws = (LAS bf16_t*)(lds + 74752);
    LAS bf16_t* Ss = (LAS bf16_t*)(lds + 81920);
    LAS bf16_t* CT0 = (LAS bf16_t*)(lds + 91136);
    LAS bf16_t* Os = (LAS bf16_t*)(lds + 141824);
    LAS float* BC = (LAS float*)(lds + 146944);
    LAS float* GAs = (LAS float*)(lds + 147200);
    const bf16_t* QC = (const bf16_t*)(p.ws + OFF_QC); const bf16_t* KC = (const bf16_t*)(p.ws + OFF_KC);
    bf16_t* PM = (bf16_t*)(p.ws + OFF_PM);
    const float* GB = (const float*)((const unsigned char*)p.out + DO_GB); const float* GA = (const float*)((const unsigned char*)p.out + DO_GA); const float* GW = (const float*)((const unsigned char*)p.out + DO_GW);
    for (int i = tid0; i < 2 * 48 * 264 / 2; i += 512) ((LAS unsigned*)CT0)[i] = 0u;
    for (int i = tid0; i < 2 * 64 * 56 / 2; i += 512) ((LAS unsigned*)Vs)[i] = 0u;
    __syncthreads();
    if (tid0 < 64) Vs[tid0 * 56 + 32] = (bf16_t)0x3F80;
    f32x4 cacc[6];
#pragma unroll
    for (int i = 0; i < 6; ++i) cacc[i] = (f32x4){0.f, 0.f, 0.f, 0.f};
    u32x4 q4[4], k4[4], vo4; float gb = 0.f, ga = 0.f, gwv = 0.f;
#define ML_LOAD(c, TID) do { const int row_ = (TID) >> 3, pc_ = (TID) & 7; const size_t tk_ = tokbase + (size_t)(c) * 64; \
        const bf16_t* qp_ = QC + (tk_ + row_) * 1024 + h * 256 + pc_ * 32; const bf16_t* kp_ = KC + (tk_ + row_) * 1024 + h * 256 + pc_ * 32; \
        _Pragma("unroll") for (int i_ = 0; i_ < 4; ++i_) { q4[i_] = *(const u32x4*)(qp_ + 8 * i_); k4[i_] = *(const u32x4*)(kp_ + 8 * i_); } \
        const int sg_ = (TID) & 255, s_ = sg_ >> 2, g_ = sg_ & 3; \
        vo4 = *(const u32x4*)(PM + (tk_ + s_) * LDPM + ((TID) < 256 ? 2048 : 3072) + h * 256 + dv0 + 8 * g_); \
        gwv = GW[bh * SEQ + (c) * 64 + s_]; \
        if ((TID) < 64) { gb = GB[bh * SEQ + (c) * 64 + (TID)]; ga = GA[bh * SEQ + (c) * 64 + (TID)]; } } while (0)
    ML_LOAD(0, tid0);
    __syncthreads();
    int cur = 0;
    for (int c = 0; c < 64; ++c) {
        int tid = tid0; asm volatile("" : "+v"(tid));
        const int lane = tid & 63, w = tid >> 6, fr = lane & 15, fq = lane >> 4;
        LAS bf16_t* CTc = CT0 + cur * (48 * 264); LAS bf16_t* CTn = CT0 + (cur ^ 1) * (48 * 264);
        {
            const int row = tid >> 3, pc = tid & 7;
#pragma unroll
            for (int i = 0; i < 4; ++i) { *(LAS u32x4*)(Qs + row * 264 + pc * 32 + 8 * i) = q4[i]; *(LAS u32x4*)(Ks + row * 264 + pc * 32 + 8 * i) = k4[i]; }
            const int sg = tid & 255, s = sg >> 2, g = sg & 3;
            if (tid < 256) {
                *(LAS u32x4*)(Vs + s * 56 + 8 * g) = vo4;
                u32x4 wv;
#pragma unroll
                for (int e = 0; e < 4; ++e) wv[e] = cvt_pk_bf16(bflo(vo4[e]) * gwv, bfhi(vo4[e]) * gwv);
                *(LAS u32x4*)(Vws + s * 56 + 8 * g) = wv;
                if (g == 0) Vws[s * 56 + 32] = f2bf(gwv);
            } else {
                if (c > 0) { const u32x4 yv = *(const LAS u32x4*)(Os + s * 40 + 8 * g); *(u32x4*)(PM + (tokbase + (size_t)(c - 1) * 64 + s) * LDPM + 3072 + h * 256 + dv0 + 8 * g) = yv; }
                *(LAS u32x4*)(Os + s * 40 + 8 * g) = vo4;
            }
            if (tid < 64) { BC[tid] = gb; GAs[tid] = ga; }
        }
        asm volatile("" ::: "memory");
        if (c + 1 < 64) ML_LOAD(c + 1, tid);
        asm volatile("" ::: "memory");
        __syncthreads();
        {
            const int mt = w >> 1, ntb = (w & 1) * 2;
            f32x4 s0 = (f32x4){0.f, 0.f, 0.f, 0.f}, s1 = s0;
#pragma unroll
            for (int ks = 0; ks < 8; ++ks) {
                const bf16x8 a = *(const LAS bf16x8*)(Qs + (16 * mt + fr) * 264 + 32 * ks + 8 * fq);
                const bf16x8 b0 = *(const LAS bf16x8*)(Ks + (16 * ntb + fr) * 264 + 32 * ks + 8 * fq);
                const bf16x8 b1 = *(const LAS bf16x8*)(Ks + (16 * (ntb + 1) + fr) * 264 + 32 * ks + 8 * fq);
                s0 = __builtin_amdgcn_mfma_f32_16x16x32_bf16(a, b0, s0, 0, 0, 0);
                s1 = __builtin_amdgcn_mfma_f32_16x16x32_bf16(a, b1, s1, 0, 0, 0);
            }
            const int sA = 16 * ntb + fr, sB = sA + 16;
            const float gA = GAs[sA], gB = GAs[sB];
#pragma unroll
            for (int j = 0; j < 4; ++j) {
                const int t = 16 * mt + 4 * fq + j; const float bt = BC[t];
                const float vA = (sA <= t) ? s0[j] * __expf(bt + gA) : 0.f, vB = (sB <= t) ? s1[j] * __expf(bt + gB) : 0.f;
                Ss[t * 72 + sA] = f2bf(vA); Ss[t * 72 + sB] = f2bf(vB);
            }
        }
        __syncthreads();
        {
            const int mt = w >> 1, nt = w & 1;
            f32x4 aA = (f32x4){0.f, 0.f, 0.f, 0.f}, aB = aA, xA = aA, xB = aA;
#pragma unroll
            for (int ks = 0; ks < 2; ++ks) {
                const bf16x8 a = *(const LAS bf16x8*)(Ss + (16 * mt + fr) * 72 + 32 * ks + 8 * fq);
                const bf16x8 bm = tr_frag((const LAS unsigned char*)Vs, 112, 32 * ks, 16 * nt, lane);
                const bf16x8 bx = tr_frag((const LAS unsigned char*)Vs, 112, 32 * ks, 32, lane);
                aA = __builtin_amdgcn_mfma_f32_16x16x32_bf16(a, bm, aA, 0, 0, 0);
                xA = __builtin_amdgcn_mfma_f32_16x16x32_bf16(a, bx, xA, 0, 0, 0);
            }
#pragma unroll
            for (int ks = 0; ks < 8; ++ks) {
                const bf16x8 a = *(const LAS bf16x8*)(Qs + (16 * mt + fr) * 264 + 32 * ks + 8 * fq);
                const bf16x8 bm = *(const LAS bf16x8*)(CTc + (16 * nt + fr) * 264 + 32 * ks + 8 * fq);
                const bf16x8 bx = *(const LAS bf16x8*)(CTc + (32 + fr) * 264 + 32 * ks + 8 * fq);
                aB = __builtin_amdgcn_mfma_f32_16x16x32_bf16(a, bm, aB, 0, 0, 0);
                xB = __builtin_amdgcn_mfma_f32_16x16x32_bf16(a, bx, xB, 0, 0, 0);
            }
#pragma unroll
            for (int j = 0; j < 4; ++j) {
                const int t = 16 * mt + 4 * fq + j; const float eb = __expf(BC[t]);
                const float num = aA[j] + eb * aB[j];
                const float den = __shfl(xA[j] + eb * xB[j], lane & 48);
                const float hv = num / fmaxf(fabsf(den), 1.f);
                LAS bf16_t* op = Os + t * 40 + 16 * nt + fr;
                *op = f2bf(hv * sigm(bf2f(*op)));
            }
            const float decay = __expf(BC[63]);
            bf16x8 bw[3][2];
#pragma unroll
            for (int n3 = 0; n3 < 3; ++n3)
#pragma unroll
                for (int ks = 0; ks < 2; ++ks) bw[n3][ks] = tr_frag((const LAS unsigned char*)Vws, 112, 32 * ks, 16 * n3, lane);
#pragma unroll
            for (int m2 = 0; m2 < 2; ++m2) {
                const int mtk = 2 * w + m2;
                const bf16x8 ka0 = tr_frag((const LAS unsigned char*)Ks, 528, 0, 16 * mtk, lane), ka1 = tr_frag((const LAS unsigned char*)Ks, 528, 32, 16 * mtk, lane);
#pragma unroll
                for (int n3 = 0; n3 < 3; ++n3) {
                    f32x4 cc = cacc[m2 * 3 + n3] * decay;
                    cc = __builtin_amdgcn_mfma_f32_16x16x32_bf16(ka0, bw[n3][0], cc, 0, 0, 0);
                    cc = __builtin_amdgcn_mfma_f32_16x16x32_bf16(ka1, bw[n3][1], cc, 0, 0, 0);
                    cacc[m2 * 3 + n3] = cc;
                    u32x2 pk; pk.x = cvt_pk_bf16(cc[0], cc[1]); pk.y = cvt_pk_bf16(cc[2], cc[3]);
                    *(LAS u32x2*)(CTn + (16 * n3 + fr) * 264 + 16 * mtk + 4 * fq) = pk;
                }
            }
        }
        cur ^= 1;
        __syncthreads();
    }
    if (tid0 >= 256) { const int sg = tid0 & 255, s = sg >> 2, g = sg & 3; const u32x4 yv = *(const LAS u32x4*)(Os + s * 40 + 8 * g);
        *(u32x4*)(PM + (tokbase + (size_t)63 * 64 + s) * LDPM + 3072 + h * 256 + dv0 + 8 * g) = yv; }
#undef ML_LOAD
}

__device__ void phase_norm2(const KP& p) {
    const int tid = tid_l(), lane = tid & 63, G = gridDim.x, bid = blockIdx.x;
    rmsnorm_rows(p.out, p.g_ffn, (bf16_t*)(p.ws + OFF_XN2), bid * 8 + (tid >> 6), G * 8, lane);
}
typedef float v16f_t __attribute__((ext_vector_type(16)));
typedef float v32f_t __attribute__((ext_vector_type(32)));
typedef unsigned v6u_t __attribute__((ext_vector_type(6)));
__device__ void convert_tables(const KP& p, int gw, int nw) {
    const int lane = tid_l() & 63;
    for (int tb = 0; tb < 2; ++tb) {
        const float* src = tb ? p.peer_v : p.peer_u; unsigned char* dst = p.ws + (tb ? OFF_PV : OFF_PU); float* sc = (float*)(p.ws + (tb ? OFF_SCV : OFF_SCU));
        for (int row = gw; row < 16384; row += nw) {
            const float* sp = src + (size_t)row * DM + lane * 32;
            f32x4 v[8]; float am = 0.f;
#pragma unroll
            for (int q = 0; q < 8; ++q) { v[q] = *(const f32x4*)(sp + q * 4);
                am = fmaxf(am, fmaxf(fmaxf(fabsf(v[q][0]), fabsf(v[q][1])), fmaxf(fabsf(v[q][2]), fabsf(v[q][3])))); }
            const unsigned amu = wave_max_u32(__float_as_uint(am));
            const float amax = __uint_as_float(amu);
            float scl = 1.f;
            if (amax > 0.f) scl = exp2f(floorf(log2f(7.5f / amax)));
            if (lane == 0) sc[row] = 1.f / scl;
            v16f_t xa, xb;
#pragma unroll
            for (int q = 0; q < 4; ++q)
#pragma unroll
                for (int j = 0; j < 4; ++j) { xa[q * 4 + j] = v[q][j] * scl; xb[q * 4 + j] = v[4 + q][j] * scl; }
            const v6u_t pk = __builtin_amdgcn_cvt_scalef32_2xpk16_fp6_f32(xa, xb, 1.0f);
            unsigned char* dp = dst + (size_t)row * 8192 + lane * 8;
            { u32x4 o4; o4.x = pk[0]; o4.y = pk[1]; o4.z = pk[2]; o4.w = pk[3]; *(u32x4*)(dp + lane * 8) = o4; u32x2 o2; o2.x = pk[4]; o2.y = pk[5]; *(u32x2*)(dp + 1024) = o2; }
        }
    }
}

__device__ void phase_peer(const KP& p, LAS unsigned char* lds) {
    const int tid = tid_l(), lane = tid & 63, w = tid >> 6, fr = lane & 15, fq = lane >> 4;
    LAS unsigned* KEYS = (LAS unsigned*)lds;
    LAS int* TI = (LAS int*)(lds + 32768);
    LAS float* TG = (LAS float*)(lds + 49152);
    const bf16_t* Q = (const bf16_t*)(p.ws + OFF_Q);
    const bf16_t* SK = (const bf16_t*)(p.ws + OFF_SUBK);
    const bf16_t* XN2 = (const bf16_t*)(p.ws + OFF_XN2);
    const unsigned char* PU = p.ws + OFF_PU; const unsigned char* PV = p.ws + OFF_PV;
    const float* SCU = (const float*)(p.ws + OFF_SCU); const float* SCV = (const float*)(p.ws + OFF_SCV);
    float* out = p.out;
    LAS int* IJ = (LAS int*)(lds + 65536);
    if (w == 0 && fq == 0) {
#pragma unroll
        for (int m = 0; m < 4; ++m) { const int e = m * 16 + fr; int i = 0, base = 0;
            for (; i < 16; ++i) { const int cnt = 16 / (i + 1); if (e < base + cnt) break; base += cnt; }
            IJ[e] = (i < 16) ? i * 16 + (e - base) : 0; }
    }
    __syncthreads();
    LAS int* PERM = (LAS int*)(lds + 65792);
    {
        v16f_t ta, tb;
#pragma unroll
        for (int i = 0; i < 16; ++i) { ta[i] = 0.125f * i; tb[i] = (i < 8) ? 2.f + 0.25f * i : 4.f + 0.5f * (i - 8); }
        const v6u_t pk = __builtin_amdgcn_cvt_scalef32_2xpk16_fp6_f32(ta, tb, 1.0f);
        const v32f_t un = __builtin_amdgcn_cvt_scalef32_pk32_f32_fp6(pk, 1.0f);
#pragma unroll
        for (int m = 0; m < 32; ++m) { const float val = un[m]; const float c = val < 2.f ? val * 8.f : (val < 4.f ? 16.f + (val - 2.f) * 4.f : 24.f + (val - 4.f) * 2.f);
            if (tid == 0) PERM[m] = ((int)(c + 0.5f) & 31); }
    }
    __syncthreads();
    for (int tile = blockIdx.x; tile < NT / 32; tile += gridDim.x) {
        const int tk0 = tile * 32;
        int tl_ = tid; asm volatile("" : "+v"(tl_));
        const int lane = tl_ & 63, w = tl_ >> 6, fr = lane & 15, fq = lane >> 4;
        const int pp_ = w >> 2, ntb = (w & 3) * 2;
        LAS float* xs = (LAS float*)(lds + 66048) + w * 2048;
        bf16x8 bfr[2][4];
#pragma unroll
        for (int n = 0; n < 2; ++n)
#pragma unroll
            for (int ks = 0; ks < 4; ++ks) bfr[n][ks] = *(const bf16x8*)(SK + (size_t)(pp_ * 128 + 16 * (ntb + n) + fr) * 128 + 32 * ks + 8 * fq);
        bf16x8 afn[2][4];
#pragma unroll
        for (int mt = 0; mt < 2; ++mt)
#pragma unroll
            for (int ks = 0; ks < 4; ++ks) afn[mt][ks] = *(const bf16x8*)(Q + (size_t)(tk0 + 16 * mt + fr) * DM + pp_ * 128 + 32 * ks + 8 * fq);
        for (int h = 0; h < 8; ++h) {
            {
                bf16x8 af[2][4];
#pragma unroll
                for (int mt = 0; mt < 2; ++mt)
#pragma unroll
                    for (int ks = 0; ks < 4; ++ks) af[mt][ks] = afn[mt][ks];
                if (h + 1 < 8) {
#pragma unroll
                    for (int mt = 0; mt < 2; ++mt)
#pragma unroll
                        for (int ks = 0; ks < 4; ++ks) afn[mt][ks] = *(const bf16x8*)(Q + (size_t)(tk0 + 16 * mt + fr) * DM + (h + 1) * 256 + pp_ * 128 + 32 * ks + 8 * fq);
                }
                f32x4 acc[2][2];
#pragma unroll
                for (int a_ = 0; a_ < 2; ++a_)
#pragma unroll
                    for (int b_ = 0; b_ < 2; ++b_) acc[a_][b_] = (f32x4){0.f, 0.f, 0.f, 0.f};
#pragma unroll
                for (int ks = 0; ks < 4; ++ks)
#pragma unroll
                    for (int mt = 0; mt < 2; ++mt)
#pragma unroll
                        for (int n = 0; n < 2; ++n) acc[mt][n] = __builtin_amdgcn_mfma_f32_16x16x32_bf16(af[mt][ks], bfr[n][ks], acc[mt][n], 0, 0, 0);
#pragma unroll
                for (int mt = 0; mt < 2; ++mt)
#pragma unroll
                    for (int n = 0; n < 2; ++n)
#pragma unroll
                        for (int j = 0; j < 4; ++j) { const int tokl = 16 * mt + 4 * fq + j, key = 16 * (ntb + n) + fr;
                            KEYS[(tokl * 2 + pp_) * 128 + key] = (ordf(acc[mt][n][j]) & ~0x7Fu) | (unsigned)key; }
            }
            __syncthreads();
            {
                const int tokl = 4 * w + fq, rb = lane & 48;
                unsigned top[2];
#pragma unroll
                for (int pp = 0; pp < 2; ++pp) {
                    unsigned kx[8];
#pragma unroll
                    for (int m = 0; m < 8; ++m) kx[m] = KEYS[(tokl * 2 + pp) * 128 + fr + 16 * m];
                    unsigned tp = 0u;
                    for (int it = 0; it < 16; ++it) {
                        unsigned M = max(max(max(kx[0], kx[1]), max(kx[2], kx[3])), max(max(kx[4], kx[5]), max(kx[6], kx[7])));
                        M = max(M, dppu<0xB1>(M)); M = max(M, dppu<0x4E>(M)); M = max(M, dppu<0x141>(M)); M = max(M, dppu<0x140>(M));
                        if (fr == it) tp = M;
#pragma unroll
                        for (int m = 0; m < 8; ++m) kx[m] = (kx[m] == M) ? 0u : kx[m];
                    }
                    top[pp] = tp;
                }
                unsigned cnd[4];
#pragma unroll
                for (int m = 0; m < 4; ++m) {
                    const int ij_ = IJ[m * 16 + fr];
                    const float v1 = unordf((unsigned)__shfl((int)top[0], rb + (ij_ >> 4)) & ~0x7Fu), v2 = unordf((unsigned)__shfl((int)top[1], rb + (ij_ & 15)) & ~0x7Fu);
                    cnd[m] = (m * 16 + fr < 50) ? ((ordf(v1 + v2) & ~0x3Fu) | (unsigned)(m * 16 + fr)) : 0u;
                }
                unsigned best = 0u;
                for (int it = 0; it < 16; ++it) {
                    unsigned M = max(max(cnd[0], cnd[1]), max(cnd[2], cnd[3]));
                    M = max(M, dppu<0xB1>(M)); M = max(M, dppu<0x4E>(M)); M = max(M, dppu<0x141>(M)); M = max(M, dppu<0x140>(M));
                    if (fr == it) best = M;
#pragma unroll
                    for (int m = 0; m < 4; ++m) cnd[m] = (cnd[m] == M) ? 0u : cnd[m];
                }
                const int ij = IJ[best & 0x3Fu];
                const float bv = unordf(best & ~0x3Fu);
                const int e1 = __shfl((int)top[0], rb + (ij >> 4)) & 0x7F, e2 = __shfl((int)top[1], rb + (ij & 15)) & 0x7F;
                const float mx = __shfl(bv, rb);
                TI[tokl * 128 + h * 16 + fr] = e1 * 128 + e2; TG[tokl * 128 + h * 16 + fr] = bv - mx;
            }
            __syncthreads();
        }
        for (int q = 0; q < 4; ++q) {
            const int tokl = 4 * w + q; const size_t tok = (size_t)tk0 + tokl;
            { const float* hrow = out + tok * DM; f32x4 hr[8]; float ss0 = 0.f;
#pragma unroll
              for (int i = 0; i < 8; ++i) { hr[i] = *(const f32x4*)(hrow + i * 256 + lane * 4); ss0 += hr[i][0] * hr[i][0] + hr[i][1] * hr[i][1] + hr[i][2] * hr[i][2] + hr[i][3] * hr[i][3]; }
              const float rt = rsqrtf(wave_sum(ss0) * (1.f / DM) + 1e-6f);
#pragma unroll
              for (int i = 0; i < 8; ++i) { const f32x4 g0 = *(const f32x4*)(p.g_ffn + i * 256 + lane * 4); *(LAS f32x4*)(xs + i * 256 + lane * 4) = hr[i] * g0 * rt; }
#pragma unroll
              for (int u = 0; u < 2; ++u) { const float ev = __expf(TG[tokl * 128 + u * 64 + lane] * rt); const float sum = red16(ev); TG[tokl * 128 + u * 64 + lane] = ev / sum; } }
            float xv[32], acc[32];
#pragma unroll
            for (int m = 0; m < 32; ++m) { xv[m] = xs[32 * lane + PERM[m]]; acc[m] = 0.f; }
#define PE_ISSUE(E, e_) do { const int ee_ = (e_) < 128 ? (e_) : 127; const int idx_ = __builtin_amdgcn_readfirstlane(TI[tokl * 128 + ee_]); \
                E.gate = __builtin_bit_cast(float, __builtin_amdgcn_readfirstlane(__builtin_bit_cast(int, TG[tokl * 128 + ee_]))); \
                const unsigned char* up_ = PU + (size_t)idx_ * 8192 + lane * 8; \
                E.ua = *(const u32x4*)(up_ + lane * 8); E.ub = *(const u32x2*)(up_ + 1024); \
                E.va = *(const u32x4*)(up_ + 2048 + lane * 8); E.vb = *(const u32x2*)(up_ + 3072); \
                E.su = SCU[idx_]; E.sv = SCV[idx_]; } while (0)
#define PE_COMPUTE(E) do { \
                const v32f_t uf = __builtin_amdgcn_cvt_scalef32_pk32_f32_fp6((v6u_t){E.ua.x, E.ua.y, E.ua.z, E.ua.w, E.ub.x, E.ub.y}, 1.0f); \
                float d0 = 0.f, d1 = 0.f, d2 = 0.f, d3 = 0.f; \
                _Pragma("unroll") for (int m = 0; m < 8; ++m) { d0 += xv[4 * m] * uf[4 * m]; d1 += xv[4 * m + 1] * uf[4 * m + 1]; d2 += xv[4 * m + 2] * uf[4 * m + 2]; d3 += xv[4 * m + 3] * uf[4 * m + 3]; } \
                const float act = wave_sum((d0 + d1) + (d2 + d3)) * E.su; \
                const float coef = E.gate * 0.5f * act * (1.f + erff(act * 0.70710678118f)) * E.sv; \
                const v32f_t vf = __builtin_amdgcn_cvt_scalef32_pk32_f32_fp6((v6u_t){E.va.x, E.va.y, E.va.z, E.va.w, E.vb.x, E.vb.y}, 1.0f); \
                _Pragma("unroll") for (int m = 0; m < 32; ++m) acc[m] += coef * vf[m]; } while (0)
            {
                struct PeEx { u32x4 ua, va; u32x2 ub, vb; float su, sv, gate; };
                PeEx q0, q1;
                PE_ISSUE(q0, 0); PE_ISSUE(q1, 1);
#pragma unroll 1
                for (int e = 0; e < 128; e += 2) {
                    PE_COMPUTE(q0); PE_ISSUE(q0, e + 2);
                    PE_COMPUTE(q1); PE_ISSUE(q1, e + 3);
                }
            }
#undef PE_ISSUE
#undef PE_COMPUTE
#pragma unroll
            for (int m = 0; m < 32; ++m) xs[32 * lane + PERM[m]] = acc[m];
            float ss = 0.f;
            float* orow = out + tok * DM;
#pragma unroll 4
            for (int i = 0; i < 8; ++i) { const f32x4 hv = *(const LAS f32x4*)(xs + i * 256 + lane * 4) + *(const f32x4*)(orow + i * 256 + lane * 4);
                *(LAS f32x4*)(xs + i * 256 + lane * 4) = hv; ss += hv[0] * hv[0] + hv[1] * hv[1] + hv[2] * hv[2] + hv[3] * hv[3]; }
            ss = wave_sum(ss);
            const float r = rsqrtf(ss * (1.f / DM) + 1e-6f);
#pragma unroll 4
            for (int i = 0; i < 8; ++i) { const f32x4 hv = *(const LAS f32x4*)(xs + i * 256 + lane * 4);
                const f32x4 g0 = *(const f32x4*)(p.g_final + i * 256 + lane * 4); *(f32x4*)(orow + i * 256 + lane * 4) = hv * r * g0; }
        }
        __syncthreads();
    }
}

#define XB_TMO      128
#define XB_XCNT(j)  (256  + 64 * (j))
#define XB_XSUB(j)  (1280 + 64 * (j))
#define XB_XGEN(j)  (2304 + 64 * (j))
#define XB_TOP      3328
#define XB_TOPGEN   3392
#define XB_SPIN_CAP (1u << 18)
__device__ __forceinline__ unsigned xb_ld(unsigned* p)              { return __hip_atomic_load(p, __ATOMIC_RELAXED, __HIP_MEMORY_SCOPE_AGENT); }
__device__ __forceinline__ unsigned xb_add(unsigned* p, unsigned v) { return __hip_atomic_fetch_add(p, v, __ATOMIC_RELAXED, __HIP_MEMORY_SCOPE_AGENT); }
__device__ __forceinline__ unsigned xb_xcc_id() { return (unsigned)__builtin_amdgcn_s_getreg((3 << 11) | 20) & 0xFu; }
#define XB_SPIN(cond, bar) do { unsigned _sp = 0; while (cond) { __builtin_amdgcn_s_sleep(1); \
    if ((++_sp & 255u) == 0u) { if (xb_ld(&(bar)[XB_TMO])) break; if (_sp > XB_SPIN_CAP) { atomicAdd(&(bar)[XB_TMO], 1u); break; } } } } while (0)
struct XcdBarrier { unsigned* bar; unsigned x; volatile LAS unsigned* st; };
__device__ __forceinline__ XcdBarrier xcd_barrier_post(unsigned* bar, volatile LAS unsigned* st) {
    XcdBarrier b; b.bar = bar; b.x = xb_xcc_id(); b.st = st;
    if (threadIdx.x == 0) (void)xb_add(&bar[XB_XCNT(b.x)], 1u);
    return b;
}
__device__ __forceinline__ void xcd_barrier_complete(unsigned* bar, unsigned x, unsigned& nloc, unsigned& nx) {
    const unsigned G = gridDim.x * gridDim.y * gridDim.z;
    unsigned sum, cnt, mine, sp = 0u;
    for (;;) {
        sum = 0u; cnt = 0u; mine = 0u;
#pragma unroll
        for (unsigned j = 0; j < 16; ++j) { const unsigned c = xb_ld(&bar[XB_XCNT(j)]); sum += c; cnt += (c > 0u) ? 1u : 0u; mine = (j == x) ? c : mine; }
        if (sum == G) break;
        __builtin_amdgcn_s_sleep(1);
        if ((++sp & 255u) == 0u) { if (xb_ld(&bar[XB_TMO])) break; if (sp > XB_SPIN_CAP) { atomicAdd(&bar[XB_TMO], 1u); break; } }
    }
    nloc = mine > 0u ? mine : 1u; nx = cnt > 0u ? cnt : 1u;
}
__device__ __forceinline__ void xcd_barrier(const XcdBarrier& b) {
    asm volatile("s_waitcnt vmcnt(0)" ::: "memory");
    __syncthreads();
    if (threadIdx.x == 0) {
        unsigned* bar = b.bar;
        __builtin_amdgcn_s_waitcnt(0);
        unsigned nloc = b.st[0], nx = b.st[1];
        if (nloc == 0u) { xcd_barrier_complete(bar, b.x, nloc, nx); b.st[0] = nloc; b.st[1] = nx; }
        const unsigned old = xb_add(&bar[XB_XSUB(b.x)], 1u);
        const unsigned gen = old / nloc;
        if (old + 1u == (gen + 1u) * nloc) {
            __builtin_amdgcn_fence(__ATOMIC_RELEASE, "agent");
            asm volatile("s_waitcnt vmcnt(0)" ::: "memory");
            const unsigned og = xb_add(&bar[XB_TOP], 1u);
            const unsigned tg = og / nx;
            if (og + 1u == (tg + 1u) * nx) xb_add(&bar[XB_TOPGEN], 1u);
            else XB_SPIN(xb_ld(&bar[XB_TOPGEN]) == tg, bar);
            __builtin_amdgcn_fence(__ATOMIC_ACQUIRE, "agent");
            xb_add(&bar[XB_XGEN(b.x)], 1u);
            asm volatile("s_waitcnt vmcnt(0)" ::: "memory");
        } else {
            XB_SPIN(xb_ld(&bar[XB_XGEN(b.x)]) == gen, bar);
            __builtin_amdgcn_fence(__ATOMIC_ACQUIRE, "agent");
            asm volatile("s_waitcnt vmcnt(0)" ::: "memory");
        }
    }
    __syncthreads();
}

__global__ void __launch_bounds__(512) fwd_megakernel(KP p) {
    extern __shared__ __attribute__((aligned(16))) unsigned char smem[];
    LAS unsigned char* lds = (LAS unsigned char*)smem;
    cg::grid_group grid = cg::this_grid();
#define GRID_SYNC() do { asm volatile("s_waitcnt vmcnt(0) lgkmcnt(0)" ::: "memory"); __syncthreads(); grid.sync(); asm volatile("" ::: "memory"); } while (0)
    const int G = gridDim.x, bid = blockIdx.x;
    unsigned char* ws = p.ws; unsigned char* dob = (unsigned char*)p.out;

#define RUN_GEMM(MODE, ...) do { unsigned char* ws = lp(p.ws); unsigned char* dob = lp((unsigned char*)p.out); const pg8::Gemm g_ = pg8::Gemm{__VA_ARGS__}; pg8::StaticOrder S_; S_.init(g_.M, g_.N, G, bid); \
        const pg8::Epi<MODE> E_{ws, dob, p.x, p.w0, p.a0, p.g_ffn}; pg8::gemm_phase(lds, g_, S_, E_); } while (0)
    volatile LAS unsigned* xst = (volatile LAS unsigned*)(lds + 150512);
    if (threadIdx.x < 4) xst[threadIdx.x] = 0u;
    phase_prep(p, lds);
    GRID_SYNC();
    const XcdBarrier xbar = xcd_barrier_post((unsigned*)(p.ws + OFF_XBAR), xst);
#define XSYNC() do { xcd_barrier(xbar); asm volatile("" ::: "memory"); } while (0)
    RUN_GEMM(0, (const bf16_t*)(ws + OFF_XN), (const bf16_t*)(ws + OFF_WINT), NT, N1, 2048, 2048, 2048);
    if (bid >= G / 2) weight_transposes(p, lds, 5888, 8960, (bid - G / 2) * 8 + (tid_l() >> 6), (G - G / 2) * 8);
    XSYNC();
    phase_lora_prep(p);
    XSYNC();
    RUN_GEMM(1, (const bf16_t*)(dob + DO_ALORA), (const bf16_t*)(ws + OFF_WAT), NT, 2048, 256, 512, 256);
    RUN_GEMM(2, (const bf16_t*)(dob + DO_ALORA) + 256, (const bf16_t*)(ws + OFF_G2T), NT, 1024, 256, 512, 256);
    XSYNC();
    if (bid < 128) rwkv_scan(p, bid, lds);
    else {
        mlstm_run(p, bid - 128, lds);
        convert_tables(p, (bid - 128) * 8 + (tid_l() >> 6), 1024);
        __builtin_amdgcn_fence(__ATOMIC_RELEASE, "agent"); __syncthreads();
        if (threadIdx.x == 0) { unsigned* cnt = (unsigned*)(p.ws + OFF_SUBBAR); __hip_atomic_fetch_add(cnt, 1u, __ATOMIC_RELAXED, __HIP_MEMORY_SCOPE_AGENT);
            while (__hip_atomic_load(cnt, __ATOMIC_RELAXED, __HIP_MEMORY_SCOPE_AGENT) < 128u) __builtin_amdgcn_s_sleep(2); }
        __syncthreads(); __builtin_amdgcn_fence(__ATOMIC_ACQUIRE, "agent");
        { unsigned char* ws = lp(p.ws); unsigned char* dob = lp((unsigned char*)p.out); const pg8::Gemm g_ = pg8::Gemm{(const bf16_t*)(ws + OFF_PM) + 3072, (const bf16_t*)(ws + OFF_PMT), NT, 2048, 1024, LDPM, 1024};
          pg8::StaticOrder S_; S_.init(g_.M, g_.N, 128, bid - 128); const pg8::Epi<3> E_{ws, dob, p.x, p.w0, p.a0, p.g_ffn}; pg8::gemm_phase(lds, g_, S_, E_); }
    }
    XSYNC();
    phase_rwkv_post(p);
    XSYNC();
    RUN_GEMM(4, (const bf16_t*)(ws + OFF_YR), (const bf16_t*)(ws + OFF_PRT), NT, 2048, 1024, 1024, 1024);
    XSYNC();
    RUN_GEMM(5, (const bf16_t*)(ws + OFF_PG), (const bf16_t*)(ws + OFF_WOT), NT, 2048, 2048, LDPG, 2048);
    XSYNC();
    RUN_GEMM(6, (const bf16_t*)(ws + OFF_XN2), (const bf16_t*)(ws + OFF_WQT), NT, 2048, 2048, 2048, 2048);
    XSYNC();
    phase_peer(p, lds);
}

extern "C" void kernel_launch(void* const* d_in, const int* in_sizes, int n_in, void* d_out, int out_size, void* d_ws, size_t ws_size, hipStream_t stream) {
    static int grid_blocks = 0;
    if (grid_blocks == 0) {
        if (n_in != 26 || out_size != NT * DM || ws_size < WS_NEED) { fprintf(stderr, "kernel_launch: unexpected shapes: n_in %d out %d ws %zu (need %zu)\n", n_in, out_size, ws_size, (size_t)WS_NEED); grid_blocks = -1; return; }
        int dev = 0, cus = 0, per_cu = 0;
        hipGetDevice(&dev);
        hipDeviceGetAttribute(&cus, hipDeviceAttributeMultiprocessorCount, dev);
        if (hipFuncSetAttribute((const void*)fwd_megakernel, hipFuncAttributeMaxDynamicSharedMemorySize, LDS_BYTES) != hipSuccess) { fprintf(stderr, "kernel_launch: hipFuncSetAttribute failed\n"); grid_blocks = -1; return; }
        hipOccupancyMaxActiveBlocksPerMultiprocessor(&per_cu, (const void*)fwd_megakernel, 512, LDS_BYTES);
        if (per_cu < 1) { fprintf(stderr, "kernel_launch: occupancy query says %d blocks per CU\n", per_cu); per_cu = 1; }
        (void)hipGetLastError();
        grid_blocks = cus * 1;
    }
    if (grid_blocks < 0) return;
    KP p{};
    const float** pp = (const float**)&p;
    for (int i = 0; i < 26; ++i) pp[i] = (const float*)d_in[i];
    p.out = (float*)d_out; p.ws = (unsigned char*)d_ws;
    void* args[] = {&p};
    hipError_t e = hipLaunchCooperativeKernel((void*)fwd_megakernel, dim3(grid_blocks), dim3(512), args, LDS_BYTES, stream);
    if (e != hipSuccess) fprintf(stderr, "cooperative launch failed: %s (grid %d)\n", hipGetErrorString(e), grid_blocks);
}
```
